# Optimizing an MI355X kernel written in HIP

```python
import jax
import jax.numpy as jnp
from jax import lax
import numpy as np

D_MODEL = 2048
BATCH = 1
SEQ = 8192
DEPTH = 1

MEM_LEN = 256
D_MIX = D_MODEL
MLSTM_HEADS = 4
MLSTM_V_DIM = (D_MIX // 2) // MLSTM_HEADS
MLSTM_QK_DIM = MLSTM_V_DIM // 2
MLSTM_CHUNK = 128
MLSTM_CONV = 4
MOBA_HEADS = 8
MOBA_HEAD_DIM = (D_MIX // 2) // MOBA_HEADS
MOBA_BLOCK = 256
MOBA_TOPK = 3
MOBA_QCHUNK = 64
ROPE_DIM = MOBA_HEAD_DIM // 4
ROPE_THETA = 500000.0
XA_HEADS = 4
XA_HEAD_DIM = D_MODEL // XA_HEADS
MOE_GROUPS = 8
MOE_EXPERTS_PER_GROUP = 8
MOE_EXPERTS = MOE_GROUPS * MOE_EXPERTS_PER_GROUP
MOE_TOPK = 2
MOE_FF = D_MODEL // 4
MOE_BLOCK_ROWS = 128
EPS = 1e-6

MLSTM_QK_W = MLSTM_HEADS * MLSTM_QK_DIM
MLSTM_V_W = MLSTM_HEADS * MLSTM_V_DIM
MOBA_W = MOBA_HEADS * MOBA_HEAD_DIM
IN_WIDTHS = (MLSTM_QK_W, MLSTM_QK_W, MLSTM_V_W, MLSTM_V_W, 2 * MLSTM_HEADS, MOBA_W, MOBA_W, MOBA_W)
D_IN = 2 * MLSTM_QK_W + 2 * MLSTM_V_W + 2 * MLSTM_HEADS + 3 * MOBA_W

kernel_name = 'hybrid_mlstm_moba_hmoe_layer'


def rms_norm(x, g):
    xf = x.astype(jnp.float32)
    y = xf * lax.rsqrt(jnp.mean(xf * xf, axis=-1, keepdims=True) + EPS)
    return (y * g.astype(jnp.float32)).astype(x.dtype)


def split_heads(a, n_heads):
    b, s, w = a.shape
    return a.reshape(b, s, n_heads, w // n_heads).transpose(0, 2, 1, 3)


def partial_rotary(x, positions):
    half = ROPE_DIM // 2
    inv_freq = ROPE_THETA ** (-jnp.arange(half, dtype=jnp.float32) * 2.0 / ROPE_DIM)
    ang = positions.astype(jnp.float32)[:, None, :, None] * inv_freq
    cos, sin = jnp.cos(ang), jnp.sin(ang)
    xr = x[..., :ROPE_DIM].astype(jnp.float32)
    x1, x2 = xr[..., :half], xr[..., half:]
    rot = jnp.concatenate([x1 * cos - x2 * sin, x2 * cos + x1 * sin], axis=-1)
    return jnp.concatenate([rot.astype(x.dtype), x[..., ROPE_DIM:]], axis=-1)


def causal_depthwise_conv(x, w, b):
    c = x.shape[-1]
    y = lax.conv_general_dilated(x, w[:, None, :].astype(x.dtype), window_strides=(1,),
                                 padding=((MLSTM_CONV - 1, 0),),
                                 dimension_numbers=('NWC', 'WIO', 'NWC'), feature_group_count=c)
    return y + b.astype(x.dtype)


def mlstm_chunkwise(q, k, v, i_pre, f_pre):
    bsz, nh, s, dk = q.shape
    dv = v.shape[-1]
    L = MLSTM_CHUNK
    nc = s // L
    q = q * (dk ** -0.5)
    log_f = jax.nn.log_sigmoid(f_pre)

    def to_chunks(a):
        return jnp.moveaxis(a.reshape(bsz, nh, nc, L, *a.shape[3:]), 2, 0)

    causal = jnp.tril(jnp.ones((L, L), dtype=bool))

    def chunk_step(carry, inp):
        c_prev, n_prev, m_prev = carry
        qb, kb, vb, ib, fb = inp
        b = jnp.cumsum(fb, axis=-1)
        g = b[..., -1]
        d = jnp.where(causal, b[..., :, None] - b[..., None, :] + ib[..., None, :], -jnp.inf)
        inter = b + m_prev[..., None]
        m_t = jnp.maximum(inter, jnp.max(d, axis=-1))
        w_inter = jnp.exp(inter - m_t)
        p = jnp.exp(d - m_t[..., None]) * jnp.einsum('bhtd,bhsd->bhts', qb, kb)
        num = (w_inter[..., None] * jnp.einsum('bhtd,bhde->bhte', qb, c_prev)
               + jnp.einsum('bhts,bhse->bhte', p, vb))
        den = w_inter * jnp.einsum('bhtd,bhd->bht', qb, n_prev) + jnp.sum(p, axis=-1)
        h = num / jnp.maximum(jnp.abs(den), jnp.exp(-m_t))[..., None]
        a = g[..., None] - b + ib
        m_new = jnp.maximum(g + m_prev, jnp.max(a, axis=-1))
        w_k = jnp.exp(a - m_new[..., None])
        decay = jnp.exp(g + m_prev - m_new)
        c_new = decay[..., None, None] * c_prev + jnp.einsum('bhs,bhsd,bhse->bhde', w_k, kb, vb)
        n_new = decay[..., None] * n_prev + jnp.einsum('bhs,bhsd->bhd', w_k, kb)
        return (c_new, n_new, m_new), h

    init = (jnp.zeros((bsz, nh, dk, dv), jnp.float32),
            jnp.zeros((bsz, nh, dk), jnp.float32),
            jnp.zeros((bsz, nh), jnp.float32))
    xs = (to_chunks(q), to_chunks(k), to_chunks(v), to_chunks(i_pre), to_chunks(log_f))
    _, hs = lax.scan(chunk_step, init, xs)
    return jnp.moveaxis(hs, 0, 2).reshape(bsz, nh, s, dv)


def moba_attention(q, k, v):
    bsz, nh, s, hd = q.shape
    nb = -(-s // MOBA_BLOCK)
    n_sel = min(MOBA_TOPK, nb)
    pad = nb * MOBA_BLOCK - s
    kp = jnp.pad(k, ((0, 0), (0, 0), (0, pad), (0, 0)))
    vp = jnp.pad(v, ((0, 0), (0, 0), (0, pad), (0, 0)))
    k_blocks = kp.reshape(bsz, nh, nb, MOBA_BLOCK, hd)
    v_blocks = vp.reshape(bsz, nh, nb, MOBA_BLOCK, hd)
    k_mean = jnp.mean(k_blocks.astype(jnp.float32), axis=3)
    scale = hd ** -0.5
    bi = jnp.arange(bsz)[:, None, None, None]
    hi = jnp.arange(nh)[None, :, None, None]

    def query_chunk(c):
        t0 = c * MOBA_QCHUNK
        cur = t0 // MOBA_BLOCK
        qc = lax.dynamic_slice_in_dim(q, t0, MOBA_QCHUNK, axis=2)
        gate = jnp.einsum('bhtd,bhnd->bhtn', qc.astype(jnp.float32), k_mean)
        gate = jnp.where(jnp.arange(nb) < cur, gate, -jnp.inf)
        _, idx = lax.top_k(gate, n_sel)
        valid = jnp.arange(n_sel) < cur
        k_sel = k_blocks[bi, hi, idx]
        v_sel = v_blocks[bi, hi, idx]
        s_past = jnp.einsum('bhtd,bhtjsd->bhtjs', qc, k_sel).astype(jnp.float32) * scale
        s_past = jnp.where(valid[:, None], s_past, -jnp.inf)
        s_past = s_past.reshape(bsz, nh, MOBA_QCHUNK, n_sel * MOBA_BLOCK)
        k_own = lax.dynamic_slice_in_dim(kp, cur * MOBA_BLOCK, MOBA_BLOCK, axis=2)
        v_own = lax.dynamic_slice_in_dim(vp, cur * MOBA_BLOCK, MOBA_BLOCK, axis=2)
        s_own = jnp.einsum('bhtd,bhsd->bhts', qc, k_own).astype(jnp.float32) * scale
        q_pos = t0 + jnp.arange(MOBA_QCHUNK)
        k_pos = cur * MOBA_BLOCK + jnp.arange(MOBA_BLOCK)
        s_own = jnp.where(k_pos[None, :] <= q_pos[:, None], s_own, -jnp.inf)
        p = jax.nn.softmax(jnp.concatenate([s_past, s_own], axis=-1), axis=-1).astype(v.dtype)
        p_past = p[..., :n_sel * MOBA_BLOCK].reshape(bsz, nh, MOBA_QCHUNK, n_sel, MOBA_BLOCK)
        p_own = p[..., n_sel * MOBA_BLOCK:]
        return (jnp.einsum('bhtjs,bhtjsd->bhtd', p_past, v_sel)
                + jnp.einsum('bhts,bhsd->bhtd', p_own, v_own))

    out = lax.map(query_chunk, jnp.arange(s // MOBA_QCHUNK))
    return jnp.moveaxis(out, 0, 2).reshape(bsz, nh, s, hd)


def hybrid_mixer(xn, positions, w_in, gate_b, conv_w, conv_b, out_g, q_g, k_g, w_out):
    bsz, s, _ = xn.shape
    dt = xn.dtype
    cuts = [int(c) for c in np.cumsum(IN_WIDTHS)[:-1]]
    mq, mk, mv, mo, mgate, aq, ak, av = jnp.split(xn @ w_in, cuts, axis=-1)
    qk = jax.nn.silu(causal_depthwise_conv(jnp.concatenate([mq, mk], axis=-1), conv_w, conv_b))
    mq, mk = jnp.split(qk, [MLSTM_QK_W], axis=-1)
    gates = mgate.astype(jnp.float32) + gate_b.astype(jnp.float32)
    i_pre = jnp.transpose(gates[..., :MLSTM_HEADS], (0, 2, 1))
    f_pre = jnp.transpose(gates[..., MLSTM_HEADS:], (0, 2, 1))
    hm = mlstm_chunkwise(split_heads(mq, MLSTM_HEADS).astype(jnp.float32),
                         split_heads(mk, MLSTM_HEADS).astype(jnp.float32),
                         split_heads(mv, MLSTM_HEADS).astype(jnp.float32), i_pre, f_pre)
    hm = hm * lax.rsqrt(jnp.mean(hm * hm, axis=-1, keepdims=True) + EPS)
    hm = hm.transpose(0, 2, 1, 3).reshape(bsz, s, MLSTM_V_W) * out_g.astype(jnp.float32)
    hm = (hm * jax.nn.sigmoid(mo.astype(jnp.float32))).astype(dt)
    aq = partial_rotary(rms_norm(split_heads(aq, MOBA_HEADS), q_g), positions)
    ak = partial_rotary(rms_norm(split_heads(ak, MOBA_HEADS), k_g), positions)
    ha = moba_attention(aq, ak, split_heads(av, MOBA_HEADS))
    ha = ha.transpose(0, 2, 1, 3).reshape(bsz, s, MOBA_W)
    return jnp.concatenate([hm, ha], axis=-1) @ w_out


def cross_attention(hn, memn, wq, wkv, q_g, k_g, wo):
    bsz, s, d = hn.shape
    q = rms_norm((hn @ wq).reshape(bsz, s, XA_HEADS, XA_HEAD_DIM), q_g)
    k, v = jnp.split(memn @ wkv, 2, axis=-1)
    k = rms_norm(k.reshape(bsz, -1, XA_HEADS, XA_HEAD_DIM), k_g)
    v = v.reshape(bsz, -1, XA_HEADS, XA_HEAD_DIM)
    sc = jnp.einsum('bshd,bmhd->bhsm', q, k).astype(jnp.float32) * (XA_HEAD_DIM ** -0.5)
    p = jax.nn.softmax(sc, axis=-1).astype(v.dtype)
    o = jnp.einsum('bhsm,bmhd->bshd', p, v).reshape(bsz, s, d)
    return o @ wo


def hier_moe(hn, wg, bg, we, be, w_gate, w_up, w_down):
    bsz, s, d = hn.shape
    n_tok = bsz * s
    xt = hn.reshape(n_tok, d)
    gprob = jax.nn.softmax((xt @ wg).astype(jnp.float32) + bg.astype(jnp.float32), axis=-1)
    gsel = jnp.argmax(gprob, axis=-1)
    pg = jnp.max(gprob, axis=-1)
    elog = ((xt @ we).astype(jnp.float32) + be.astype(jnp.float32)).reshape(n_tok, MOE_GROUPS, MOE_EXPERTS_PER_GROUP)
    gidx = jnp.broadcast_to(gsel[:, None, None], (n_tok, 1, MOE_EXPERTS_PER_GROUP))
    eprob = jax.nn.softmax(jnp.take_along_axis(elog, gidx, axis=1)[:, 0], axis=-1)
    ptop, ltop = lax.top_k(eprob, MOE_TOPK)
    wts = pg[:, None] * ptop / jnp.sum(ptop, axis=-1, keepdims=True)
    eid = gsel[:, None] * MOE_EXPERTS_PER_GROUP + ltop
    n_pair = n_tok * MOE_TOPK
    flat_e = eid.reshape(-1)
    flat_t = jnp.repeat(jnp.arange(n_tok, dtype=jnp.int32), MOE_TOPK)
    flat_w = wts.reshape(-1)
    order = jnp.argsort(flat_e)
    e_s, t_s, w_s = flat_e[order], flat_t[order], flat_w[order]
    counts = jnp.zeros((MOE_EXPERTS,), jnp.int32).at[flat_e].add(1)
    padded = ((counts + MOE_BLOCK_ROWS - 1) // MOE_BLOCK_ROWS) * MOE_BLOCK_ROWS
    start = jnp.cumsum(counts) - counts
    pend = jnp.cumsum(padded)
    pstart = pend - padded
    dest = pstart[e_s] + (jnp.arange(n_pair) - start[e_s])
    n_blk = -(-n_pair // MOE_BLOCK_ROWS) + MOE_EXPERTS
    n_rows = n_blk * MOE_BLOCK_ROWS
    row_tok = jnp.zeros((n_rows,), jnp.int32).at[dest].set(t_s)
    row_w = jnp.zeros((n_rows,), jnp.float32).at[dest].set(w_s)
    blk_e = jnp.minimum(jnp.searchsorted(pend, jnp.arange(n_blk) * MOE_BLOCK_ROWS, side='right'), MOE_EXPERTS - 1)
    xg = xt[row_tok].reshape(n_blk, MOE_BLOCK_ROWS, d)

    def expert_block(args):
        xb, e = args
        return (jax.nn.silu(xb @ w_gate[e]) * (xb @ w_up[e])) @ w_down[e]

    y = lax.map(expert_block, (xg, blk_e)).reshape(n_rows, d)
    y = y * row_w[:, None].astype(y.dtype)
    out = jnp.zeros((n_tok, d), y.dtype).at[row_tok].add(y)
    return out.reshape(bsz, s, d)


def setup_inputs(seed: int = 0) -> dict:
    key = jax.random.key(seed)
    ks = jax.random.split(key, 32)
    f32 = jnp.float32

    def nrm(k, shape, scale):
        return jax.random.normal(k, shape, f32) * scale

    def gain(k, shape):
        return 1.0 + 0.05 * jax.random.normal(k, shape, f32)

    D, L, E, F = D_MODEL, DEPTH, MOE_EXPERTS, MOE_FF
    return {
        'x': nrm(ks[0], (BATCH, SEQ, D), 1.0),
        'mem': nrm(ks[1], (BATCH, MEM_LEN, D), 1.0),
        'positions': jnp.tile(jnp.arange(SEQ, dtype=jnp.int32)[None, :], (BATCH, 1)),
        'norm_mix_g': gain(ks[2], (L, D)),
        'w_in': nrm(ks[3], (L, D, D_IN), D ** -0.5),
        'mlstm_gate_b': jnp.concatenate([nrm(ks[4], (L, MLSTM_HEADS), 0.1),
                                         3.0 + nrm(ks[5], (L, MLSTM_HEADS), 0.5)], axis=-1),
        'mlstm_conv_w': nrm(ks[6], (L, MLSTM_CONV, 2 * MLSTM_QK_W), MLSTM_CONV ** -0.5),
        'mlstm_conv_b': nrm(ks[7], (L, 2 * MLSTM_QK_W), 0.02),
        'mlstm_out_g': gain(ks[8], (L, MLSTM_V_W)),
        'moba_q_g': gain(ks[9], (L, MOBA_HEAD_DIM)),
        'moba_k_g': gain(ks[10], (L, MOBA_HEAD_DIM)),
        'w_out': nrm(ks[11], (L, D_MIX, D), D_MIX ** -0.5),
        'norm_cross_g': gain(ks[12], (L, D)),
        'norm_mem_g': gain(ks[13], (L, D)),
        'xa_wq': nrm(ks[14], (L, D, D), D ** -0.5),
        'xa_wkv': nrm(ks[15], (L, D, 2 * D), D ** -0.5),
        'xa_q_g': gain(ks[16], (L, XA_HEAD_DIM)),
        'xa_k_g': gain(ks[17], (L, XA_HEAD_DIM)),
        'xa_wo': nrm(ks[18], (L, D, D), D ** -0.5),
        'norm_ffn_g': gain(ks[19], (L, D)),
        'router_group_w': nrm(ks[20], (L, D, MOE_GROUPS), D ** -0.5),
        'router_group_b': nrm(ks[21], (L, MOE_GROUPS), 0.01),
        'router_expert_w': nrm(ks[22], (L, D, E), D ** -0.5),
        'router_expert_b': nrm(ks[23], (L, E), 0.01),
        'exp_w_gate': nrm(ks[24], (L, E, D, F), D ** -0.5),
        'exp_w_up': nrm(ks[25], (L, E, D, F), D ** -0.5),
        'exp_w_down': nrm(ks[26], (L, E, F, D), F ** -0.5),
    }


def reference(x, mem, positions, norm_mix_g, w_in, mlstm_gate_b, mlstm_conv_w, mlstm_conv_b,
              mlstm_out_g, moba_q_g, moba_k_g, w_out, norm_cross_g, norm_mem_g, xa_wq, xa_wkv,
              xa_q_g, xa_k_g, xa_wo, norm_ffn_g, router_group_w, router_group_b, router_expert_w,
              router_expert_b, exp_w_gate, exp_w_up, exp_w_down):
    h = x
    for l in range(DEPTH):
        h = h + hybrid_mixer(rms_norm(h, norm_mix_g[l]), positions, w_in[l], mlstm_gate_b[l],
                             mlstm_conv_w[l], mlstm_conv_b[l], mlstm_out_g[l], moba_q_g[l],
                             moba_k_g[l], w_out[l])
        h = h + cross_attention(rms_norm(h, norm_cross_g[l]), rms_norm(mem, norm_mem_g[l]),
                                xa_wq[l], xa_wkv[l], xa_q_g[l], xa_k_g[l], xa_wo[l])
        h = h + hier_moe(rms_norm(h, norm_ffn_g[l]), router_group_w[l], router_group_b[l],
                         router_expert_w[l], router_expert_b[l], exp_w_gate[l], exp_w_up[l],
                         exp_w_down[l])
    return h
```

```cpp
#include <hip/hip_runtime.h>
#include <hip/hip_cooperative_groups.h>
#include <cstdio>
#include <cstdint>
namespace cg = cooperative_groups;

#ifndef MK_SINGLE
#define MK_SINGLE 1
#endif

#define LAS __attribute__((address_space(3)))
typedef unsigned short bf16_t;
typedef short bf16x8 __attribute__((ext_vector_type(8)));
typedef float f32x4 __attribute__((ext_vector_type(4)));
typedef float f32x2 __attribute__((ext_vector_type(2)));
typedef unsigned u32x4 __attribute__((ext_vector_type(4)));
typedef unsigned u32x2 __attribute__((ext_vector_type(2)));

constexpr int S = 8192, D = 2048, DIN = 6152, NPROJ = 6144, MEML = 256;
constexpr int NPH = 15;
constexpr float EPS = 1e-6f;
constexpr int PC_MQ = 0, PC_MK = 512, PC_MV = 1024, PC_MO = 2048, PC_AQ = 3072, PC_AK = 4096, PC_AV = 5120;
constexpr int DVP = 272;

constexpr size_t MiB = 1u << 20;
constexpr size_t WS_CTL = 0;
constexpr size_t WS_WIN = 1 * MiB;
constexpr size_t WS_WOUT = 25 * MiB;
constexpr size_t WS_WQ = 33 * MiB;
constexpr size_t WS_WKV = 41 * MiB;
constexpr size_t WS_WO = 57 * MiB;
constexpr size_t WS_WGU = 65 * MiB;
constexpr size_t WS_WD = 321 * MiB;
constexpr size_t WS_XN = 449 * MiB;
constexpr size_t WS_MEMN = 481 * MiB;
constexpr size_t WS_PROJ = 482 * MiB;
constexpr size_t WS_KVMEM = 578 * MiB;
constexpr size_t WS_QC = 580 * MiB;
constexpr size_t WS_KC = 588 * MiB;
constexpr size_t WS_KWT = 596 * MiB;
constexpr size_t WS_VT = 604 * MiB;
constexpr size_t WS_CTL_LOC = 621 * MiB;
constexpr size_t WS_CTP = 655 * MiB;
constexpr size_t WS_QP = 672 * MiB;
constexpr size_t WS_KP = 688 * MiB;
constexpr size_t WS_VTP = 704 * MiB;
constexpr size_t WS_KM = 720 * MiB;
constexpr size_t WS_VTM = 721 * MiB;
constexpr size_t WS_HCAT = 722 * MiB;
constexpr size_t WS_H1B = 754 * MiB;
constexpr size_t WS_QX = 786 * MiB;
constexpr size_t WS_OX = 818 * MiB;
constexpr size_t WS_MISC = 850 * MiB;
constexpr size_t WS_ACT = 854 * MiB;
constexpr size_t WS_YB = 886 * MiB;
constexpr size_t WS_END = 950 * MiB;
constexpr size_t WS_XG = WS_PROJ;
constexpr size_t WS_HNB = WS_XN;
constexpr size_t MO_GATES = 0;
constexpr size_t MO_BV = 256 * 1024;
constexpr size_t MO_UV = 384 * 1024;
constexpr size_t MO_PMX = 512 * 1024;
constexpr size_t MO_GC = 640 * 1024;
constexpr size_t MO_AMAX = 641 * 1024;
constexpr size_t MO_MPREV = 642 * 1024;
constexpr size_t MO_KMEAN = 648 * 1024;
constexpr size_t MO_SSQ = 1024 * 1024;
constexpr size_t MO_WR = 2048 * 1024;
constexpr size_t MO_PAIR_E = 2752 * 1024;
constexpr size_t MO_PAIR_SLOT = 2816 * 1024;
constexpr size_t MO_PAIR_W = 2880 * 1024;
constexpr size_t MO_ROWPAIR = 2944 * 1024;
constexpr size_t MO_TILE_E = 3072 * 1024;
constexpr size_t MO_TOFF = 3073 * 1024;
constexpr int CW_ECNT = 1024;
constexpr int CW_NTILES = 1100;

struct Args { const void* in[27]; float* out; unsigned char* ws; int ph_lo, ph_hi; int single, pad; };

__device__ __forceinline__ unsigned cvt_pk_bf16(float lo, float hi) { unsigned r; asm("v_cvt_pk_bf16_f32 %0, %1, %2" : "=v"(r) : "v"(lo), "v"(hi)); return r; }
__device__ __forceinline__ float bf_lo(unsigned u) { return __uint_as_float(u << 16); }
__device__ __forceinline__ float bf_hi(unsigned u) { return __uint_as_float(u & 0xffff0000u); }
__device__ __forceinline__ float bf1(bf16_t h) { return __uint_as_float(((unsigned)h) << 16); }
__device__ __forceinline__ bf16_t f2bf(float f) { return (bf16_t)(cvt_pk_bf16(f, 0.f) & 0xffffu); }
__device__ __forceinline__ void unpack8(u32x4 v, float (&f)[8]) {
    f[0] = bf_lo(v.x); f[1] = bf_hi(v.x); f[2] = bf_lo(v.y); f[3] = bf_hi(v.y); f[4] = bf_lo(v.z); f[5] = bf_hi(v.z); f[6] = bf_lo(v.w); f[7] = bf_hi(v.w);
}
__device__ __forceinline__ u32x4 pack8(const float (&f)[8]) {
    u32x4 v; v.x = cvt_pk_bf16(f[0], f[1]); v.y = cvt_pk_bf16(f[2], f[3]); v.z = cvt_pk_bf16(f[4], f[5]); v.w = cvt_pk_bf16(f[6], f[7]); return v;
}
__device__ __forceinline__ bf16x8 as_frag(u32x4 v) { return __builtin_bit_cast(bf16x8, v); }
__device__ __forceinline__ u32x4 as_u4(bf16x8 v) { return __builtin_bit_cast(u32x4, v); }
__device__ __forceinline__ float wave_sum(float v) {
#pragma unroll
    for (int o = 1; o < 64; o <<= 1) v += __shfl_xor(v, o);
    return v;
}
__device__ __forceinline__ float sigmoidf_(float x) { return 1.f / (1.f + __expf(-x)); }
__device__ __forceinline__ f32x4 mfma16(bf16x8 a, bf16x8 b, f32x4 c) { return __builtin_amdgcn_mfma_f32_16x16x32_bf16(a, b, c, 0, 0, 0); }
__device__ __forceinline__ int pi32(int tq, int i) { return 8 * (i >> 2) + 4 * tq + (i & 3); }
#define LDS_WAIT() asm volatile("s_waitcnt lgkmcnt(0)" ::: "memory")

namespace pg8 {
constexpr int BM = 256, BK = 64, HALF = 128, HTB = HALF * BK * 2, STAGE_BYTES = 8 * HTB, NXCD = 8, WGM = 8;
__device__ __forceinline__ int lds_byte(int r, int c) { const int st = (r >> 4) * 2 + (c >> 5), rr = r & 15, cc = c & 31, ob = rr * 64 + cc * 2; return st * 1024 + (ob ^ (((ob >> 9) & 1) << 5)); }
__device__ __forceinline__ void stage_rc(int b, int& R, int& C) { const int st = b / 1024, sb = b % 1024, swz = sb ^ (((sb >> 9) & 1) << 5); R = (st >> 1) * 16 + swz / 64; C = (st & 1) * 32 + (swz % 64) / 2; }
__device__ __forceinline__ int perm32(int rho) { const int n = rho >> 4, i = rho & 15; return 8 * (i >> 2) + 4 * n + (i & 3); }
struct Unit { int pm, pn; };
struct Gemm { const bf16_t* A; const bf16_t* Bt; int K; };
struct StaticOrder {
    int nM, nN, nwg, G, c;
    __device__ void init(int M, int N, int G_, int c_) { nM = M / BM; nN = N / BM; nwg = nM * nN; G = G_; c = c_; }
    __device__ bool next(int i, Unit& u) const {
        const long L = (long)i * G + c; if (L >= nwg) return false;
        int wgid = (int)L; { const int q = nwg / NXCD, r = nwg % NXCD, xcd = wgid % NXCD, off = wgid / NXCD; wgid = (xcd < r ? xcd * (q + 1) : r * (q + 1) + (xcd - r) * q) + off; }
        const int nig = WGM * nN, gid = wgid / nig, fm = gid * WGM, gsz = (nM - fm) < WGM ? (nM - fm) : WGM;
        u.pm = fm + ((wgid % nig) % gsz); u.pn = (wgid % nig) / gsz; return true;
    }
};
struct GroupedOrder {
    const int* tile_e; int ntiles, nN, G, c;
    __device__ bool next(int i, Unit& u) const {
        const long L = (long)i * G + c; if (L >= (long)ntiles * nN) return false;
        const int pm = (int)(L / nN), pl = (int)(L % nN);
        const int e = __builtin_amdgcn_readfirstlane(__hip_atomic_load(tile_e + pm, __ATOMIC_RELAXED, __HIP_MEMORY_SCOPE_AGENT));
        u.pm = pm; u.pn = e * nN + pl; return true;
    }
};

template <class Epi, class Sched, bool ALIGN_EPI, bool SP2>
__device__ __forceinline__ void gemm_phase(LAS unsigned char* lds, const Gemm g, const Sched& S, const Epi& E) {
    const int tid = threadIdx.x, wid = __builtin_amdgcn_readfirstlane(tid >> 6), lane = tid & 63, wr = wid >> 2, wc = wid & 3, fr = lane & 15, fq = lane >> 4;
    const int K = g.K, nt = K / BK;
    unsigned voffA[2], voffB[2];
#pragma unroll
    for (int i = 0; i < 2; ++i) { int R, C; stage_rc(tid * 16 + i * 8192, R, C); const int Rb = Epi::PERM ? ((R & ~31) + perm32(R & 31)) : R;
        voffA[i] = (unsigned)(R * K + C) * 2u; voffB[i] = (unsigned)(Rb * K + C) * 2u; }
    const size_t kstep = (size_t)(BK * 2);
    const size_t hstep = (size_t)HALF * K * 2;
    const size_t tstep = 2 * hstep;
    const unsigned ldsw = (unsigned)wid * 1024u;
    const int aoff = lds_byte(wr * 64 + fr, fq * 8), boff = lds_byte(wc * 32 + fr, fq * 8);
#define PG8_SA(b, h) (((b) * 2 + (h)) * HTB)
#define PG8_SB(b, h) ((4 + (b) * 2 + (h)) * HTB)
#define PG8_STAGE(bufoff, gbase, voff) do { _Pragma("unroll") for (int _i = 0; _i < 2; ++_i) \
        __builtin_amdgcn_global_load_lds((const unsigned*)((const char*)(gbase) + (voff)[_i]), (LAS unsigned*)(lds + (bufoff) + ldsw + _i * 8192), 16, 0, 0); } while (0)
#define PG8_LDA(dst, b, h) do { _Pragma("unroll") for (int m = 0; m < 4; ++m) _Pragma("unroll") for (int k = 0; k < 2; ++k) dst[m][k] = *(const LAS bf16x8*)(lds + PG8_SA(b, h) + aoff + m * 2048 + k * 1024); } while (0)
#define PG8_LDB(dst, b, h) do { _Pragma("unroll") for (int n = 0; n < 2; ++n) _Pragma("unroll") for (int k = 0; k < 2; ++k) dst[n][k] = *(const LAS bf16x8*)(lds + PG8_SB(b, h) + boff + n * 2048 + k * 1024); } while (0)
#define PG8_MMA(ai, bj, At, Bt) do { __builtin_amdgcn_s_setprio(1); _Pragma("unroll") for (int m = 0; m < 4; ++m) _Pragma("unroll") for (int n = 0; n < 2; ++n) _Pragma("unroll") for (int k = 0; k < 2; ++k) \
        acc[ai][bj][m][n] = __builtin_amdgcn_mfma_f32_16x16x32_bf16(Bt[n][k], At[m][k], acc[ai][bj][m][n], 0, 0, 0); __builtin_amdgcn_s_setprio(0); } while (0)
#define PG8_WAIT_V(n) asm volatile("s_waitcnt vmcnt(" #n ")" ::: "memory")
#define PG8_WAIT_L(n) asm volatile("s_waitcnt lgkmcnt(" #n ")" ::: "memory")
#define PG8_BAR __builtin_amdgcn_s_barrier()
#define PG8_SCHED __builtin_amdgcn_sched_barrier(0)
    Unit cur, nxt; int ui = 0;
    if (!S.next(0, cur)) return;
    f32x4 acc[2][2][4][2];
#pragma unroll
    for (int a = 0; a < 2; ++a)
#pragma unroll
        for (int b = 0; b < 2; ++b)
#pragma unroll
            for (int m = 0; m < 4; ++m)
#pragma unroll
                for (int n = 0; n < 2; ++n) acc[a][b][m][n] = (f32x4){0.f, 0.f, 0.f, 0.f};
    bf16x8 At[4][2], B0[2][2], B1[2][2];
    const char* cA = (const char*)g.A + (size_t)cur.pm * tstep; const char* cB = (const char*)g.Bt + (size_t)cur.pn * tstep;
    if constexpr (SP2) {
        PG8_STAGE(PG8_SB(0, 0), cB, voffB); PG8_STAGE(PG8_SB(0, 1), cB + hstep, voffB); PG8_STAGE(PG8_SA(0, 0), cA, voffA); PG8_STAGE(PG8_SA(0, 1), cA + hstep, voffA);
        if (wr == 1) PG8_BAR;
        PG8_WAIT_V(2); PG8_BAR;
        PG8_STAGE(PG8_SB(1, 0), cB + kstep, voffB); PG8_STAGE(PG8_SA(1, 0), cA + kstep, voffA); PG8_STAGE(PG8_SB(1, 1), cB + hstep + kstep, voffB);
        PG8_WAIT_V(6); PG8_BAR;
    } else {
        PG8_STAGE(PG8_SB(0, 0), cB, voffB); PG8_STAGE(PG8_SA(0, 0), cA, voffA); PG8_STAGE(PG8_SB(0, 1), cB + hstep, voffB); PG8_STAGE(PG8_SA(0, 1), cA + hstep, voffA);
        if (wr == 1) PG8_BAR;
        PG8_WAIT_V(4); PG8_BAR;
        PG8_STAGE(PG8_SB(1, 0), cB + kstep, voffB); PG8_STAGE(PG8_SA(1, 0), cA + kstep, voffA); PG8_STAGE(PG8_SB(1, 1), cB + hstep + kstep, voffB);
        PG8_WAIT_V(6); PG8_BAR;
    }
    for (;;) {
        const bool has_next = S.next(ui + 1, nxt);
        const char* nA = has_next ? (const char*)g.A + (size_t)nxt.pm * tstep : cA; const char* nB = has_next ? (const char*)g.Bt + (size_t)nxt.pn * tstep : cB;
        for (int t = 0; t < nt; t += 2) {
            const bool last = (t == nt - 2);
            const char* a1 = cA + (size_t)(t + 1) * kstep;
            const char* a2 = last ? nA : cA + (size_t)(t + 2) * kstep; const char* b2 = last ? nB : cB + (size_t)(t + 2) * kstep;
            const char* a3 = a2 + kstep; const char* b3 = b2 + kstep;
            if constexpr (SP2) {
            PG8_LDB(B0, 0, 0); PG8_LDB(B1, 0, 1); PG8_SCHED; PG8_LDA(At, 0, 0); PG8_STAGE(PG8_SA(1, 1), a1 + hstep, voffA);
            PG8_WAIT_V(8); PG8_WAIT_L(0); PG8_BAR; PG8_MMA(0, 0, At, B0); PG8_MMA(0, 1, At, B1); PG8_BAR; PG8_SCHED;
            PG8_LDA(At, 0, 1); PG8_STAGE(PG8_SB(0, 0), b2, voffB); PG8_STAGE(PG8_SB(0, 1), b2 + hstep, voffB); PG8_STAGE(PG8_SA(0, 0), a2, voffA);
            PG8_WAIT_V(8); PG8_WAIT_L(0); PG8_BAR; PG8_MMA(1, 0, At, B0); PG8_MMA(1, 1, At, B1); PG8_BAR; PG8_SCHED;
            PG8_LDB(B0, 1, 0); PG8_LDB(B1, 1, 1); PG8_SCHED; PG8_LDA(At, 1, 0); PG8_STAGE(PG8_SA(0, 1), a2 + hstep, voffA);
            PG8_WAIT_V(8); PG8_WAIT_L(0); PG8_BAR; PG8_MMA(0, 0, At, B0); PG8_MMA(0, 1, At, B1); PG8_BAR; PG8_SCHED;
            PG8_LDA(At, 1, 1); PG8_STAGE(PG8_SB(1, 0), b3, voffB); PG8_STAGE(PG8_SB(1, 1), b3 + hstep, voffB); PG8_STAGE(PG8_SA(1, 0), a3, voffA);
            PG8_WAIT_V(8); PG8_WAIT_L(0); PG8_BAR; PG8_MMA(1, 0, At, B0); PG8_MMA(1, 1, At, B1); PG8_BAR; PG8_SCHED;
            } else {
            PG8_LDB(B0, 0, 0); PG8_SCHED; PG8_LDA(At, 0, 0); PG8_STAGE(PG8_SA(1, 1), a1 + hstep, voffA);
            PG8_WAIT_L(8); PG8_BAR; PG8_WAIT_L(0); PG8_MMA(0, 0, At, B0); PG8_BAR; PG8_SCHED;
            PG8_LDB(B1, 0, 1); PG8_STAGE(PG8_SB(0, 0), b2, voffB);
            PG8_BAR; PG8_WAIT_L(0); PG8_MMA(0, 1, At, B1); PG8_BAR;
            PG8_LDA(At, 0, 1); PG8_STAGE(PG8_SA(0, 0), a2, voffA);
            PG8_BAR; PG8_WAIT_L(0); PG8_MMA(1, 0, At, B0); PG8_BAR; PG8_SCHED;
            PG8_STAGE(PG8_SB(0, 1), b2 + hstep, voffB);
            PG8_WAIT_V(6); PG8_BAR; PG8_MMA(1, 1, At, B1); PG8_BAR;
            PG8_LDB(B0, 1, 0); PG8_SCHED; PG8_LDA(At, 1, 0); PG8_STAGE(PG8_SA(0, 1), a2 + hstep, voffA);
            PG8_WAIT_L(8); PG8_BAR; PG8_WAIT_L(0); PG8_MMA(0, 0, At, B0); PG8_BAR; PG8_SCHED;
            PG8_LDB(B1, 1, 1); PG8_STAGE(PG8_SB(1, 0), b3, voffB);
            PG8_BAR; PG8_WAIT_L(0); PG8_MMA(0, 1, At, B1); PG8_BAR;
            PG8_LDA(At, 1, 1); PG8_STAGE(PG8_SA(1, 0), a3, voffA);
            PG8_BAR; PG8_WAIT_L(0); PG8_MMA(1, 0, At, B0); PG8_BAR; PG8_SCHED;
            PG8_STAGE(PG8_SB(1, 1), b3 + hstep, voffB);
            PG8_WAIT_V(6); PG8_BAR; PG8_MMA(1, 1, At, B1); PG8_BAR;
            }
        }
        if constexpr (ALIGN_EPI) { if (wr == 0) PG8_BAR; }
        E(acc, cur, wr, wc, fr, fq);
        if (!has_next) break;
#pragma unroll
        for (int a = 0; a < 2; ++a)
#pragma unroll
            for (int b = 0; b < 2; ++b)
#pragma unroll
                for (int m = 0; m < 4; ++m)
#pragma unroll
                    for (int n = 0; n < 2; ++n) acc[a][b][m][n] = (f32x4){0.f, 0.f, 0.f, 0.f};
        cur = nxt; cA = nA; cB = nB; ++ui;
        if constexpr (ALIGN_EPI) { if (wr == 1) PG8_BAR; }
    }
    PG8_WAIT_V(0);
    if constexpr (!ALIGN_EPI) { if (wr == 0) PG8_BAR; }
    PG8_BAR;
#undef PG8_SA
#undef PG8_SB
#undef PG8_STAGE
#undef PG8_LDA
#undef PG8_LDB
#undef PG8_MMA
#undef PG8_WAIT_V
#undef PG8_WAIT_L
#undef PG8_BAR
#undef PG8_SCHED
}

struct EpiBf16 {
    static constexpr bool PERM = true;
    bf16_t* O; int ldc; const float* ssq;
    __device__ __forceinline__ void operator()(const f32x4 (&acc)[2][2][4][2], const Unit& u, int wr, int wc, int fr, int fq) const {
        const int row0 = u.pm * BM + wr * 64 + fr, col0 = u.pn * BM + wc * 32 + 8 * fq;
#pragma unroll
        for (int ai = 0; ai < 2; ++ai)
#pragma unroll
            for (int m = 0; m < 4; ++m) {
                const int row = row0 + ai * HALF + m * 16; float sc = 1.f;
                if (ssq) { const f32x4* p = (const f32x4*)(ssq + (size_t)row * 32); float s = 0.f;
#pragma unroll
                    for (int q = 0; q < 8; ++q) { const f32x4 v = p[q]; s += (v[0] + v[1]) + (v[2] + v[3]); }
                    sc = rsqrtf(s * (1.f / 2048.f) + EPS); }
                bf16_t* rowp = O + (size_t)row * ldc + col0;
#pragma unroll
                for (int bj = 0; bj < 2; ++bj) { const f32x4 v0 = acc[ai][bj][m][0] * sc, v1 = acc[ai][bj][m][1] * sc;
                    u32x4 w; w.x = cvt_pk_bf16(v0[0], v0[1]); w.y = cvt_pk_bf16(v0[2], v0[3]); w.z = cvt_pk_bf16(v1[0], v1[1]); w.w = cvt_pk_bf16(v1[2], v1[3]);
                    *(u32x4*)(rowp + bj * HALF) = w; }
            }
    }
};
struct EpiResid {
    static constexpr bool PERM = false;
    const float* base; float* out; bf16_t* hb; float* ssq;
    __device__ __forceinline__ void operator()(const f32x4 (&acc)[2][2][4][2], const Unit& u, int wr, int wc, int fr, int fq) const {
        const int row0 = u.pm * BM + wr * 64 + fr, col0 = u.pn * BM + wc * 32 + 4 * fq;
#pragma unroll
        for (int ai = 0; ai < 2; ++ai)
#pragma unroll
            for (int m = 0; m < 4; ++m) {
                const int row = row0 + ai * HALF + m * 16; const size_t off = (size_t)row * 2048 + col0; float s = 0.f;
#pragma unroll
                for (int bj = 0; bj < 2; ++bj)
#pragma unroll
                    for (int n = 0; n < 2; ++n) {
                        const f32x4 b = *(const f32x4*)(base + off + bj * HALF + n * 16); const f32x4 o = b + acc[ai][bj][m][n];
                        *(f32x4*)(out + off + bj * HALF + n * 16) = o;
                        if (hb) { u32x2 w; w.x = cvt_pk_bf16(o[0], o[1]); w.y = cvt_pk_bf16(o[2], o[3]); *(u32x2*)(hb + off + bj * HALF + n * 16) = w;
                            s += (o[0] * o[0] + o[1] * o[1]) + (o[2] * o[2] + o[3] * o[3]); }
                    }
                if (hb) { s += __shfl_xor(s, 16); s += __shfl_xor(s, 32); if (fq == 0) ssq[(size_t)row * 32 + u.pn * 4 + wc] = s; }
            }
    }
};
struct EpiMoe1 {
    static constexpr bool PERM = true;
    bf16_t* act;
    __device__ __forceinline__ void operator()(const f32x4 (&acc)[2][2][4][2], const Unit& u, int wr, int wc, int fr, int fq) const {
        const int row0 = u.pm * BM + wr * 64 + fr, col0 = (u.pn & 3) * 128 + wc * 32 + 8 * fq;
#pragma unroll
        for (int ai = 0; ai < 2; ++ai)
#pragma unroll
            for (int m = 0; m < 4; ++m) {
                const int row = row0 + ai * HALF + m * 16; float v[8];
#pragma unroll
                for (int n = 0; n < 2; ++n)
#pragma unroll
                    for (int i = 0; i < 4; ++i) { const float gt = acc[ai][0][m][n][i], up = acc[ai][1][m][n][i]; v[n * 4 + i] = gt / (1.f + __expf(-gt)) * up; }
                *(u32x4*)(act + (size_t)row * 512 + col0) = pack8(v);
            }
    }
};
struct EpiMoe2 {
    static constexpr bool PERM = true;
    bf16_t* yb; const int* rowpair; const float* pair_w; const int* tile_e; const int* toff; const unsigned* ecnt;
    __device__ __forceinline__ void operator()(const f32x4 (&acc)[2][2][4][2], const Unit& u, int wr, int wc, int fr, int fq) const {
        const int e = tile_e[u.pm]; const int base_slot = (u.pm - toff[e]) * 256; const int cnt = (int)ecnt[e];
        const int col0 = (u.pn & 7) * 256 + wc * 32 + 8 * fq;
#pragma unroll
        for (int ai = 0; ai < 2; ++ai)
#pragma unroll
            for (int m = 0; m < 4; ++m) {
                const int rr = wr * 64 + fr + ai * HALF + m * 16;
                if (base_slot + rr < cnt) {
                    const int pr = rowpair[u.pm * 256 + rr]; const float w = pair_w[pr];
                    bf16_t* rowp = yb + (size_t)pr * 2048 + col0;
#pragma unroll
                    for (int bj = 0; bj < 2; ++bj) { const f32x4 v0 = acc[ai][bj][m][0] * w, v1 = acc[ai][bj][m][1] * w;
                        u32x4 x; x.x = cvt_pk_bf16(v0[0], v0[1]); x.y = cvt_pk_bf16(v0[2], v0[3]); x.z = cvt_pk_bf16(v1[0], v1[1]); x.w = cvt_pk_bf16(v1[2], v1[3]);
                        *(u32x4*)(rowp + bj * HALF) = x; }
                }
            }
    }
};
}

struct Ctx {
    LAS unsigned char* lds;
    int tid, lane, wave, bid, G, gw, NGW;
    unsigned char* ws; float* out;
};
#define INF(i) ((const float*)a.in[i])

__device__ __forceinline__ void transpose_item(const float* __restrict__ W, int ldw, int k0, int n_src0, bf16_t* WT, int K_dst, LAS float* scr, int lane, const float* kscale) {
#pragma unroll 8
    for (int i = 0; i < 32; ++i) { const int kk = 2 * i + (lane >> 5); float v = W[(size_t)(k0 + kk) * ldw + n_src0 + (lane & 31)]; if (kscale) v *= kscale[k0 + kk]; scr[kk * 33 + (lane & 31)] = v; }
    LDS_WAIT();
    const int c = lane & 7;
#pragma unroll
    for (int j = 0; j < 4; ++j) { const int n = (lane >> 3) + 8 * j; const LAS float* s = scr + (8 * c) * 33 + n;
        u32x4 o; o.x = cvt_pk_bf16(s[0 * 33], s[1 * 33]); o.y = cvt_pk_bf16(s[2 * 33], s[3 * 33]); o.z = cvt_pk_bf16(s[4 * 33], s[5 * 33]); o.w = cvt_pk_bf16(s[6 * 33], s[7 * 33]);
        *(u32x4*)(WT + (size_t)n * K_dst + k0 + 8 * c) = o; }
    LDS_WAIT();
}

__device__ __forceinline__ void phase0(const Args& a, const Ctx& c) {
    unsigned char* ws = c.ws;
    LAS float* scr = (LAS float*)(c.lds + c.wave * 16384);
    constexpr int N_DENSE = 16384, N_EXP = 64 * 1536;
    for (int it = c.gw; it < N_DENSE + N_EXP; it += c.NGW) {
        if (it < N_DENSE) {
            int r = it;
            if (r < 6144) {
                const int seg = r / 3072; r -= seg * 3072; const int kb = r / 96, nb = r % 96;
                transpose_item(INF(4), DIN, 64 * kb, (seg ? 3080 : 0) + 32 * nb, (bf16_t*)(ws + WS_WIN) + (size_t)(seg * 3072 + 32 * nb) * 2048, 2048, scr, c.lane, nullptr);
            } else if (r < 8192) { r -= 6144; const int kb = r / 64, nb = r % 64;
                transpose_item(INF(11), 2048, 64 * kb, 32 * nb, (bf16_t*)(ws + WS_WOUT) + (size_t)(32 * nb) * 2048, 2048, scr, c.lane, nullptr);
            } else if (r < 10240) { r -= 8192; const int kb = r / 64, nb = r % 64;
                transpose_item(INF(14), 2048, 64 * kb, 32 * nb, (bf16_t*)(ws + WS_WQ) + (size_t)(32 * nb) * 2048, 2048, scr, c.lane, INF(12));
            } else if (r < 14336) { r -= 10240; const int kb = r / 128, nb = r % 128;
                transpose_item(INF(15), 4096, 64 * kb, 32 * nb, (bf16_t*)(ws + WS_WKV) + (size_t)(32 * nb) * 2048, 2048, scr, c.lane, nullptr);
            } else { r -= 14336; const int kb = r / 64, nb = r % 64;
                transpose_item(INF(18), 2048, 64 * kb, 32 * nb, (bf16_t*)(ws + WS_WO) + (size_t)(32 * nb) * 2048, 2048, scr, c.lane, nullptr);
            }
        } else {
            const int r = it - N_DENSE; const int e = r / 1536, q = r % 1536, type = q / 512, idx = q % 512;
            if (type < 2) { const int kb = idx / 16, nb = idx % 16, f0 = 32 * nb;
                const float* W = INF(type == 0 ? 24 : 25) + (size_t)e * 2048 * 512;
                const int drow = e * 1024 + (f0 >> 7) * 256 + (type ? 128 : 0) + (f0 & 127);
                transpose_item(W, 512, 64 * kb, f0, (bf16_t*)(ws + WS_WGU) + (size_t)drow * 2048, 2048, scr, c.lane, nullptr);
            } else { const int kb = idx / 64, nb = idx % 64;
                const float* W = INF(26) + (size_t)e * 512 * 2048;
                transpose_item(W, 2048, 64 * kb, 32 * nb, (bf16_t*)(ws + WS_WD) + (size_t)(e * 2048 + 32 * nb) * 512, 512, scr, c.lane, nullptr);
            }
        }
    }
    {
        float* WR = (float*)(ws + WS_MISC + MO_WR);
        const float* gf = INF(19); const float* wg = INF(20); const float* we = INF(22);
        for (int i = c.bid * 512 + c.tid; i < 2048 * 80; i += c.G * 512) { const int k = i / 80, j = i % 80;
            float v = 0.f; if (j < 8) v = wg[k * 8 + j]; else if (j < 72) v = we[k * 64 + (j - 8)];
            WR[i] = v * gf[k]; }
        if (c.bid == 0 && c.tid < 128) ((unsigned*)(ws + WS_CTL))[CW_ECNT + c.tid] = 0u;
    }
    __syncthreads();
    {
        LAS float* wgl = (LAS float*)c.lds; const float* win = INF(4); const float* gm = INF(3);
        for (int idx = c.tid; idx < 4096; idx += 512) { const int k = idx >> 1, hf = idx & 1;
            f32x4 v = *(const f32x4*)(win + (size_t)k * DIN + 3072 + 4 * hf); v = v * gm[k];
            const int j = k >> 8, l = (k >> 2) & 63, i = k & 3;
            *(LAS f32x4*)(wgl + (((i * 8 + j) * 64 + l) * 8 + 4 * hf)) = v; }
    }
    __syncthreads();
    {
        const LAS float* wgl = (const LAS float*)c.lds; const float* gm = INF(3); const float* x = INF(0); const float* gb = INF(5);
        bf16_t* XN = (bf16_t*)(ws + WS_XN); float* GATES = (float*)(ws + WS_MISC + MO_GATES);
        f32x4 g4[8];
#pragma unroll
        for (int j = 0; j < 8; ++j) g4[j] = *(const f32x4*)(gm + 256 * j + 4 * c.lane);
        for (int m = c.gw; m < S; m += c.NGW) {
            const f32x4* xr = (const f32x4*)(x + (size_t)m * D) + c.lane;
            f32x4 v[8]; float ss = 0.f; float ga[8];
#pragma unroll
            for (int q = 0; q < 8; ++q) ga[q] = 0.f;
#pragma unroll
            for (int j = 0; j < 8; ++j) { v[j] = xr[64 * j]; ss += (v[j][0] * v[j][0] + v[j][1] * v[j][1]) + (v[j][2] * v[j][2] + v[j][3] * v[j][3]); }
#pragma unroll
            for (int j = 0; j < 8; ++j) {
                asm volatile("" ::: "memory");
#pragma unroll
                for (int i = 0; i < 4; ++i) { const LAS f32x4* wp = (const LAS f32x4*)(wgl + ((i * 8 + j) * 64 + c.lane) * 8); const f32x4 w0 = wp[0], w1 = wp[1]; const float xv = v[j][i];
                    ga[0] += xv * w0[0]; ga[1] += xv * w0[1]; ga[2] += xv * w0[2]; ga[3] += xv * w0[3]; ga[4] += xv * w1[0]; ga[5] += xv * w1[1]; ga[6] += xv * w1[2]; ga[7] += xv * w1[3]; }
            }
            ss = wave_sum(ss); const float rstd = rsqrtf(ss * (1.f / D) + EPS);
#pragma unroll
            for (int q = 0; q < 8; ++q) ga[q] = wave_sum(ga[q]);
            if (c.lane < 8) { float gv = ga[0];
#pragma unroll
                for (int q = 1; q < 8; ++q) gv = (c.lane == q) ? ga[q] : gv;
                GATES[(size_t)m * 8 + c.lane] = gv * rstd + gb[c.lane]; }
            u32x2* o8 = (u32x2*)(XN + (size_t)m * D) + c.lane;
#pragma unroll
            for (int j = 0; j < 8; ++j) { const f32x4 y = v[j] * rstd * g4[j]; u32x2 w; w.x = cvt_pk_bf16(y[0], y[1]); w.y = cvt_pk_bf16(y[2], y[3]); o8[64 * j] = w; }
        }
        const float* mem = INF(1); const float* gmem = INF(13); bf16_t* MEMN = (bf16_t*)(ws + WS_MEMN);
        for (int m = c.gw; m < MEML; m += c.NGW) {
            const f32x4* xr = (const f32x4*)(mem + (size_t)m * D) + c.lane; f32x4 v[8]; float ss = 0.f;
#pragma unroll
            for (int j = 0; j < 8; ++j) { v[j] = xr[64 * j]; ss += (v[j][0] * v[j][0] + v[j][1] * v[j][1]) + (v[j][2] * v[j][2] + v[j][3] * v[j][3]); }
            ss = wave_sum(ss); const float rstd = rsqrtf(ss * (1.f / D) + EPS);
            u32x2* o8 = (u32x2*)(MEMN + (size_t)m * D) + c.lane;
#pragma unroll
            for (int j = 0; j < 8; ++j) { const f32x4 gg = *(const f32x4*)(gmem + 256 * j + 4 * c.lane); const f32x4 y = v[j] * rstd * gg; u32x2 w; w.x = cvt_pk_bf16(y[0], y[1]); w.y = cvt_pk_bf16(y[2], y[3]); o8[64 * j] = w; }
        }
    }
}

__device__ __forceinline__ void prep_mlstm(const Args& a, const Ctx& c, int h, int ch) {
    unsigned char* ws = c.ws; const int t0 = ch * 128;
    const float* GATES = (const float*)(ws + WS_MISC + MO_GATES);
    float* BV = (float*)(ws + WS_MISC + MO_BV); float* UV = (float*)(ws + WS_MISC + MO_UV); float* PMX = (float*)(ws + WS_MISC + MO_PMX);
    float* GC = (float*)(ws + WS_MISC + MO_GC); float* AMAX = (float*)(ws + WS_MISC + MO_AMAX);
    const bf16_t* PROJ = (const bf16_t*)(ws + WS_PROJ);
    LAS float* sc_w = (LAS float*)c.lds;
    LAS bf16_t* kws = (LAS bf16_t*)(c.lds + 1024);
    LAS bf16_t* vs = (LAS bf16_t*)(c.lds + 1024 + 128 * 260);
    if (c.wave == 0) {
        const int l = c.lane; const int ta = 2 * l, tb = 2 * l + 1;
        const float i0 = GATES[(size_t)(t0 + ta) * 8 + h], f0 = GATES[(size_t)(t0 + ta) * 8 + 4 + h];
        const float i1 = GATES[(size_t)(t0 + tb) * 8 + h], f1 = GATES[(size_t)(t0 + tb) * 8 + 4 + h];
        const float lf0 = fminf(f0, 0.f) - log1pf(__expf(-fabsf(f0))), lf1 = fminf(f1, 0.f) - log1pf(__expf(-fabsf(f1)));
        float incl = lf0 + lf1;
#pragma unroll
        for (int o = 1; o < 64; o <<= 1) { const float t = __shfl_up(incl, o); if (l >= o) incl += t; }
        const float excl = incl - (lf0 + lf1);
        const float b0 = excl + lf0, b1 = excl + lf0 + lf1;
        const float u0 = i0 - b0, u1 = i1 - b1;
        float pm = fmaxf(u0, u1);
#pragma unroll
        for (int o = 1; o < 64; o <<= 1) { const float t = __shfl_up(pm, o); if (l >= o) pm = fmaxf(pm, t); }
        float pme = __shfl_up(pm, 1); if (l == 0) pme = -INFINITY;
        const float p0 = fmaxf(pme, u0), p1 = pm;
        const float ptot = __shfl(pm, 63), gtot = __shfl(b1, 63);
        BV[h * S + t0 + ta] = b0; BV[h * S + t0 + tb] = b1; UV[h * S + t0 + ta] = u0; UV[h * S + t0 + tb] = u1; PMX[h * S + t0 + ta] = p0; PMX[h * S + t0 + tb] = p1;
        sc_w[ta] = __expf(u0 - ptot); sc_w[tb] = __expf(u1 - ptot);
        if (l == 63) { GC[h * 64 + ch] = gtot; AMAX[h * 64 + ch] = gtot + ptot; }
    }
    __syncthreads();
    {
        const float* cw = INF(6); const float* cb = INF(7);
        bf16_t* QC = (bf16_t*)(ws + WS_QC); bf16_t* KC = (bf16_t*)(ws + WS_KC);
        const int t = c.tid >> 2, qt = c.tid & 3; const float ws_ = sc_w[t];
#pragma unroll
        for (int qk = 0; qk < 2; ++qk)
#pragma unroll
            for (int gq = 0; gq < 4; ++gq) {
                const int ch0 = qt * 32 + 8 * gq; const int cch = qk * 512 + h * 128 + ch0; const int pcol = (qk ? PC_MK : PC_MQ) + h * 128 + ch0;
                float y[8];
#pragma unroll
                for (int i = 0; i < 8; ++i) y[i] = cb[cch + i];
#pragma unroll
                for (int j = 0; j < 4; ++j) { const int tr = t0 + t - 3 + j;
                    if (tr >= 0) { float xv[8]; unpack8(*(const u32x4*)(PROJ + (size_t)tr * NPROJ + pcol), xv);
#pragma unroll
                        for (int i = 0; i < 8; ++i) y[i] += cw[j * 1024 + cch + i] * xv[i]; } }
#pragma unroll
                for (int i = 0; i < 8; ++i) y[i] = y[i] / (1.f + __expf(-y[i]));
                if (qk == 0) {
#pragma unroll
                    for (int i = 0; i < 8; ++i) y[i] *= 0.08838834764831845f;
                    *(u32x4*)(QC + ((size_t)(h * S + t0 + t)) * 128 + ch0) = pack8(y);
                } else {
                    *(u32x4*)(KC + ((size_t)(h * S + t0 + t)) * 128 + ch0) = pack8(y);
#pragma unroll
                    for (int i = 0; i < 8; ++i) kws[t * 130 + ch0 + i] = f2bf(y[i] * ws_);
                }
            }
        const int part = c.tid & 3;
#pragma unroll
        for (int q = 0; q < 8; ++q) { const int dv0 = part * 64 + 8 * q;
            *(LAS u32x4*)(vs + t * 264 + dv0) = *(const u32x4*)(PROJ + (size_t)(t0 + t) * NPROJ + PC_MV + h * 256 + dv0); }
    }
    __syncthreads();
    {
        bf16_t* KWT = (bf16_t*)(ws + WS_KWT); bf16_t* VT = (bf16_t*)(ws + WS_VT);
        const int d = c.tid >> 2, sq = c.tid & 3;
#pragma unroll
        for (int gq = 0; gq < 4; ++gq) { const int s0 = sq * 32 + 8 * gq; u32x4 o;
            o.x = (unsigned)kws[(s0 + 0) * 130 + d] | ((unsigned)kws[(s0 + 1) * 130 + d] << 16); o.y = (unsigned)kws[(s0 + 2) * 130 + d] | ((unsigned)kws[(s0 + 3) * 130 + d] << 16);
            o.z = (unsigned)kws[(s0 + 4) * 130 + d] | ((unsigned)kws[(s0 + 5) * 130 + d] << 16); o.w = (unsigned)kws[(s0 + 6) * 130 + d] | ((unsigned)kws[(s0 + 7) * 130 + d] << 16);
            *(u32x4*)(KWT + ((size_t)(h * 128 + d)) * S + t0 + s0) = o; }
        const int dv = c.tid >> 1, hf = c.tid & 1;
#pragma unroll
        for (int gq = 0; gq < 8; ++gq) { const int s0 = hf * 64 + 8 * gq; u32x4 o;
            o.x = (unsigned)vs[(s0 + 0) * 264 + dv] | ((unsigned)vs[(s0 + 1) * 264 + dv] << 16); o.y = (unsigned)vs[(s0 + 2) * 264 + dv] | ((unsigned)vs[(s0 + 3) * 264 + dv] << 16);
            o.z = (unsigned)vs[(s0 + 4) * 264 + dv] | ((unsigned)vs[(s0 + 5) * 264 + dv] << 16); o.w = (unsigned)vs[(s0 + 6) * 264 + dv] | ((unsigned)vs[(s0 + 7) * 264 + dv] << 16);
            *(u32x4*)(VT + ((size_t)(h * DVP + dv)) * S + t0 + s0) = o; }
        if (c.tid < 256) { const int row = 256 + (c.tid >> 4), ck = c.tid & 15; const unsigned val = (row == 256) ? 0x3F803F80u : 0u;
            *(u32x4*)(VT + ((size_t)(h * DVP + row)) * S + t0 + 8 * ck) = (u32x4){val, val, val, val}; }
    }
    __syncthreads();
}

__device__ __forceinline__ void prep_moba(const Args& a, const Ctx& c, int h, int jb) {
    unsigned char* ws = c.ws; const int t0 = jb * 256;
    const bf16_t* PROJ = (const bf16_t*)(ws + WS_PROJ); const int* pos = (const int*)a.in[2];
    bf16_t* QP = (bf16_t*)(ws + WS_QP); bf16_t* KP = (bf16_t*)(ws + WS_KP); bf16_t* VTP = (bf16_t*)(ws + WS_VTP); float* KMEAN = (float*)(ws + WS_MISC + MO_KMEAN);
    LAS float* red = (LAS float*)c.lds;
    LAS bf16_t* vs = (LAS bf16_t*)(c.lds + 16384);
    const int li = c.tid & 15, rg = c.tid >> 4, d0 = 8 * li;
    float qg[8], kg[8], kacc[8];
#pragma unroll
    for (int i = 0; i < 8; ++i) { qg[i] = INF(9)[d0 + i]; kg[i] = INF(10)[d0 + i]; kacc[i] = 0.f; }
    float invf[8];
#pragma unroll
    for (int i = 0; i < 8; ++i) { const int fi = (li & 1) * 8 + i; invf[i] = exp2f(-(float)fi * (18.931568569324174f / 16.f)); }
    for (int p = 0; p < 8; ++p) {
        const int row = p * 32 + rg; const size_t prow = (size_t)(t0 + row) * NPROJ + h * 128 + d0;
        const float fpos = (float)pos[t0 + row];
        float cs[8], sn[8];
        if (li < 4) {
#pragma unroll
            for (int i = 0; i < 8; ++i) { float s_, c_; sincosf(fpos * invf[i], &s_, &c_); cs[i] = c_; sn[i] = s_; }
        } else {
#pragma unroll
            for (int i = 0; i < 8; ++i) { cs[i] = 1.f; sn[i] = 0.f; }
        }
#pragma unroll
        for (int qk = 0; qk < 2; ++qk) {
            float x[8]; unpack8(*(const u32x4*)(PROJ + prow + (qk ? PC_AK : PC_AQ)), x);
            float ss = 0.f;
#pragma unroll
            for (int i = 0; i < 8; ++i) ss += x[i] * x[i];
            ss += __shfl_xor(ss, 1); ss += __shfl_xor(ss, 2); ss += __shfl_xor(ss, 4); ss += __shfl_xor(ss, 8);
            const float rstd = rsqrtf(ss * (1.f / 128.f) + EPS);
            float y[8];
#pragma unroll
            for (int i = 0; i < 8; ++i) y[i] = x[i] * rstd * (qk ? kg[i] : qg[i]);
            float o[8];
#pragma unroll
            for (int i = 0; i < 8; ++i) { const float ot = __shfl_xor(y[i], 2); o[i] = (li < 2) ? (y[i] * cs[i] - ot * sn[i]) : (li < 4 ? (y[i] * cs[i] + ot * sn[i]) : y[i]); }
            if (qk == 0) *(u32x4*)(QP + ((size_t)(h * S + t0 + row)) * 128 + d0) = pack8(o);
            else { *(u32x4*)(KP + ((size_t)(h * S + t0 + row)) * 128 + d0) = pack8(o);
#pragma unroll
                for (int i = 0; i < 8; ++i) kacc[i] += o[i]; }
        }
        *(LAS u32x4*)(vs + row * 136 + d0) = *(const u32x4*)(PROJ + prow + PC_AV);
    }
#pragma unroll
    for (int i = 0; i < 8; ++i) red[rg * 128 + d0 + i] = kacc[i];
    __syncthreads();
    if (c.tid < 128) { float s = 0.f;
#pragma unroll 8
        for (int r = 0; r < 32; ++r) s += red[r * 128 + c.tid];
        KMEAN[(h * 32 + jb) * 128 + c.tid] = s * (1.f / 256.f); }
    {
        const int d = c.tid >> 2, sq = c.tid & 3;
#pragma unroll
        for (int gq = 0; gq < 8; ++gq) { const int s0 = sq * 64 + 8 * gq; u32x4 o;
            o.x = (unsigned)vs[(s0 + 0) * 136 + d] | ((unsigned)vs[(s0 + 1) * 136 + d] << 16); o.y = (unsigned)vs[(s0 + 2) * 136 + d] | ((unsigned)vs[(s0 + 3) * 136 + d] << 16);
            o.z = (unsigned)vs[(s0 + 4) * 136 + d] | ((unsigned)vs[(s0 + 5) * 136 + d] << 16); o.w = (unsigned)vs[(s0 + 6) * 136 + d] | ((unsigned)vs[(s0 + 7) * 136 + d] << 16);
            *(u32x4*)(VTP + ((size_t)(h * 128 + d)) * S + t0 + s0) = o; }
    }
    __syncthreads();
}

__device__ __forceinline__ void prep_xamem(const Args& a, const Ctx& c) {
    unsigned char* ws = c.ws; const bf16_t* KVMEM = (const bf16_t*)(ws + WS_KVMEM);
    bf16_t* KM = (bf16_t*)(ws + WS_KM); bf16_t* VTM = (bf16_t*)(ws + WS_VTM); const float* kg = INF(17);
    for (int it = c.gw; it < 1024; it += c.NGW) { const int m = it >> 2, h = it & 3;
        float x[8]; unpack8(*(const u32x4*)(KVMEM + (size_t)m * 4096 + h * 512 + 8 * c.lane), x);
        float ss = 0.f;
#pragma unroll
        for (int i = 0; i < 8; ++i) ss += x[i] * x[i];
        ss = wave_sum(ss); const float rstd = rsqrtf(ss * (1.f / 512.f) + EPS);
#pragma unroll
        for (int i = 0; i < 8; ++i) x[i] = x[i] * rstd * kg[8 * c.lane + i];
        *(u32x4*)(KM + ((size_t)(h * 256 + m)) * 512 + 8 * c.lane) = pack8(x); }
    for (int idx = c.bid * 512 + c.tid; idx < 65536; idx += c.G * 512) { const int d = idx & 511, mg = (idx >> 9) & 31, h = idx >> 14;
        unsigned short v[8];
#pragma unroll
        for (int j = 0; j < 8; ++j) v[j] = KVMEM[(size_t)(8 * mg + j) * 4096 + 2048 + h * 512 + d];
        u32x4 o; o.x = v[0] | ((unsigned)v[1] << 16); o.y = v[2] | ((unsigned)v[3] << 16); o.z = v[4] | ((unsigned)v[5] << 16); o.w = v[6] | ((unsigned)v[7] << 16);
        *(u32x4*)(VTM + ((size_t)(h * 512 + d)) * 256 + 8 * mg) = o; }
}

__device__ __forceinline__ void mlstm_local(const Ctx& c, int h, int ch) {
    unsigned char* ws = c.ws; const bf16_t* KWT = (const bf16_t*)(ws + WS_KWT); const bf16_t* VT = (const bf16_t*)(ws + WS_VT); float* CTL = (float*)(ws + WS_CTL_LOC);
    const int tt = c.lane & 15, g = c.lane >> 4, w = c.wave, t0 = ch * 128;
    bf16x8 bfr[4];
#pragma unroll
    for (int ks = 0; ks < 4; ++ks) bfr[ks] = *(const bf16x8*)(KWT + ((size_t)(h * 128 + 16 * w + tt)) * S + t0 + 32 * ks + 8 * g);
#pragma unroll
    for (int mt = 0; mt < 17; ++mt) {
        f32x4 acc = {0.f, 0.f, 0.f, 0.f};
#pragma unroll
        for (int ks = 0; ks < 4; ++ks) { const bf16x8 af = *(const bf16x8*)(VT + ((size_t)(h * DVP + 16 * mt + tt)) * S + t0 + 32 * ks + 8 * g); acc = mfma16(af, bfr[ks], acc); }
#pragma unroll
        for (int r = 0; r < 4; ++r) CTL[((size_t)((h * 64 + ch) * DVP + 16 * mt + 4 * g + r)) * 128 + 16 * w + tt] = acc[r];
    }
}

__device__ __forceinline__ void lds_fadd(LAS float* p, float v) { __hip_atomic_fetch_add(p, v, __ATOMIC_RELAXED, __HIP_MEMORY_SCOPE_WORKGROUP); }

__device__ __forceinline__ void moba_item(const Ctx& c, int h, int cb, int half) {
    unsigned char* ws = c.ws;
    const bf16_t* QP = (const bf16_t*)(ws + WS_QP); const bf16_t* KP = (const bf16_t*)(ws + WS_KP); const bf16_t* VTP = (const bf16_t*)(ws + WS_VTP);
    const float* KMEAN = (const float*)(ws + WS_MISC + MO_KMEAN); bf16_t* HCAT = (bf16_t*)(ws + WS_HCAT);
    LAS unsigned char* Qs = c.lds;
    LAS float* Os = (LAS float*)(c.lds + 34816);
    LAS float* Ls = (LAS float*)(c.lds + 34816 + 67584);
    LAS unsigned char* Pb = c.lds + 102912;
    LAS float* lpart = (LAS float*)(c.lds + 102912 + 16384);
    LAS int* cnt = (LAS int*)(c.lds + 102912 + 16384 + 1024);
    LAS int* boff = cnt + 32;
    LAS short* qlist = (LAS short*)(cnt + 80);
    const int tid = c.tid, lane = c.lane, w = c.wave, tt = lane & 15, g = lane >> 4;
    const int q0 = cb * 256 + half * 128;
    for (int i = tid; i < 128 * 16; i += 512) { const int r = i >> 4, ck = i & 15; *(LAS u32x4*)(Qs + r * 272 + ck * 16) = *(const u32x4*)(QP + ((size_t)(h * S + q0 + r)) * 128 + 8 * ck); }
    for (int i = tid; i < 128 * 132; i += 512) Os[i] = 0.f;
    if (tid < 128) Ls[tid] = 0.f;
    if (tid < 32) cnt[tid] = 0;
    for (int i = tid; i < 1024; i += 512) qlist[i] = (short)-1;
    { LAS f32x4* km = (LAS f32x4*)Pb; const f32x4* src = (const f32x4*)(KMEAN + (size_t)h * 32 * 128);
      for (int i = tid; i < cb * 32; i += 512) km[i] = src[i]; }
    __syncthreads();
    {
        const int q = tid >> 2, sub = tid & 3;
        float bv0 = -INFINITY, bv1 = -INFINITY, bv2 = -INFINITY; int bi0 = 255, bi1 = 255, bi2 = 255;
        if (cb > 0) {
            float qv[128];
#pragma unroll
            for (int ck = 0; ck < 16; ++ck) { float t8[8]; unpack8(*(const LAS u32x4*)(Qs + q * 272 + ck * 16), t8);
#pragma unroll
                for (int i = 0; i < 8; ++i) qv[ck * 8 + i] = t8[i]; }
            const LAS float* km = (const LAS float*)Pb;
            for (int j = sub; j < cb; j += 4) {
                float s = 0.f;
#pragma unroll
                for (int d4 = 0; d4 < 32; ++d4) { const f32x4 kv = *(const LAS f32x4*)(km + j * 128 + 4 * d4); s += qv[4 * d4] * kv[0] + qv[4 * d4 + 1] * kv[1] + qv[4 * d4 + 2] * kv[2] + qv[4 * d4 + 3] * kv[3]; }
                if (s > bv0) { bv2 = bv1; bi2 = bi1; bv1 = bv0; bi1 = bi0; bv0 = s; bi0 = j; }
                else if (s > bv1) { bv2 = bv1; bi2 = bi1; bv1 = s; bi1 = j; }
                else if (s > bv2) { bv2 = s; bi2 = j; }
            }
        }
#pragma unroll
        for (int o = 1; o <= 2; o <<= 1) {
            const float ov0 = __shfl_xor(bv0, o), ov1 = __shfl_xor(bv1, o), ov2 = __shfl_xor(bv2, o);
            const int oi0 = __shfl_xor(bi0, o), oi1 = __shfl_xor(bi1, o), oi2 = __shfl_xor(bi2, o);
            float nv[3] = {ov0, ov1, ov2}; int ni[3] = {oi0, oi1, oi2};
#pragma unroll
            for (int k = 0; k < 3; ++k) { const float s = nv[k]; const int j = ni[k];
                const bool b0 = (s > bv0) || (s == bv0 && j < bi0), b1 = (s > bv1) || (s == bv1 && j < bi1), b2 = (s > bv2) || (s == bv2 && j < bi2);
                if (b0) { bv2 = bv1; bi2 = bi1; bv1 = bv0; bi1 = bi0; bv0 = s; bi0 = j; }
                else if (b1) { bv2 = bv1; bi2 = bi1; bv1 = s; bi1 = j; }
                else if (b2) { bv2 = s; bi2 = j; } }
        }
        int p0 = -1, p1 = -1, p2 = -1;
        if (sub == 0) {
            if (bi0 < cb) p0 = __hip_atomic_fetch_add(cnt + bi0, 1, __ATOMIC_RELAXED, __HIP_MEMORY_SCOPE_WORKGROUP);
            if (bi1 < cb) p1 = __hip_atomic_fetch_add(cnt + bi1, 1, __ATOMIC_RELAXED, __HIP_MEMORY_SCOPE_WORKGROUP);
            if (bi2 < cb) p2 = __hip_atomic_fetch_add(cnt + bi2, 1, __ATOMIC_RELAXED, __HIP_MEMORY_SCOPE_WORKGROUP);
        }
        __syncthreads();
        if (tid < 64) { const int cn = (lane < cb) ? cnt[lane] : 0; const int pad = (cn + 15) & ~15; int incl = pad;
#pragma unroll
            for (int o = 1; o < 64; o <<= 1) { const int t = __shfl_up(incl, o); if (lane >= o) incl += t; }
            if (lane < 33) boff[lane] = incl - pad; }
        __syncthreads();
        if (sub == 0) { if (p0 >= 0) qlist[boff[bi0] + p0] = (short)q; if (p1 >= 0) qlist[boff[bi1] + p1] = (short)q; if (p2 >= 0) qlist[boff[bi2] + p2] = (short)q; }
        __syncthreads();
    }
    int buf = 0;
    for (int j = 0; j <= cb; ++j) {
        const bool own = (j == cb);
        const int base = own ? 0 : boff[j];
        const int ntile = own ? 8 : ((boff[j + 1] - boff[j]) >> 4);
        if (ntile == 0) continue;
        const int kb = j * 256;
        bf16x8 Kf[2][4], Vf[8];
#pragma unroll
        for (int tq = 0; tq < 2; ++tq)
#pragma unroll
            for (int ks = 0; ks < 4; ++ks) Kf[tq][ks] = *(const bf16x8*)(KP + ((size_t)(h * S + kb + 32 * w + pi32(tq, tt))) * 128 + 32 * ks + 8 * g);
#pragma unroll
        for (int ks = 0; ks < 8; ++ks) Vf[ks] = *(const bf16x8*)(VTP + ((size_t)(h * 128 + 16 * w + tt)) * S + kb + 32 * ks + 8 * g);
        for (int tl = 0; tl < ntile; ++tl) {
            const int qi = own ? (16 * tl + tt) : (int)qlist[base + 16 * tl + tt];
            const int qr = qi < 0 ? 0 : qi;
            f32x4 s0 = {0.f, 0.f, 0.f, 0.f}, s1 = {0.f, 0.f, 0.f, 0.f};
#pragma unroll
            for (int ks = 0; ks < 4; ++ks) { const bf16x8 qf = *(const LAS bf16x8*)(Qs + qr * 272 + (32 * ks + 8 * g) * 2); s0 = mfma16(Kf[0][ks], qf, s0); s1 = mfma16(Kf[1][ks], qf, s1); }
            float p[8]; float lsum = 0.f;
            const int kloc = 32 * w + 8 * g;
            const int qloc = half * 128 + qi;
#pragma unroll
            for (int r = 0; r < 4; ++r) { p[r] = __expf(s0[r] * 0.08838834764831845f); p[4 + r] = __expf(s1[r] * 0.08838834764831845f); }
#pragma unroll
            for (int i = 0; i < 8; ++i) { const bool ok = (qi >= 0) && (!own || (kloc + i <= qloc)); p[i] = ok ? p[i] : 0.f; lsum += p[i]; }
            lsum += __shfl_xor(lsum, 16); lsum += __shfl_xor(lsum, 32);
            *(LAS u32x4*)(Pb + buf * 8192 + w * 1024 + lane * 16) = pack8(p);
            if (g == 0) lpart[(buf * 8 + w) * 16 + tt] = lsum;
            LDS_WAIT(); __builtin_amdgcn_s_barrier(); asm volatile("" ::: "memory");
            f32x4 o = {0.f, 0.f, 0.f, 0.f};
#pragma unroll
            for (int ks = 0; ks < 8; ++ks) { const bf16x8 pf = *(const LAS bf16x8*)(Pb + buf * 8192 + ks * 1024 + lane * 16); o = mfma16(Vf[ks], pf, o); }
            if (qi >= 0) {
#pragma unroll
                for (int r = 0; r < 4; ++r) lds_fadd(Os + qi * 132 + 16 * w + 4 * g + r, o[r]);
                if (w == 0 && g == 0) { float lt = 0.f;
#pragma unroll
                    for (int ww = 0; ww < 8; ++ww) lt += lpart[(buf * 8 + ww) * 16 + tt];
                    lds_fadd(Ls + qi, lt); }
            }
            buf ^= 1;
        }
    }
    __syncthreads();
    { const int q = tid >> 2, part = tid & 3; const float inv = 1.f / Ls[q];
#pragma unroll
      for (int ck = 0; ck < 4; ++ck) { float v[8];
#pragma unroll
          for (int i = 0; i < 8; ++i) v[i] = Os[q * 132 + part * 32 + ck * 8 + i] * inv;
          *(u32x4*)(HCAT + (size_t)(q0 + q) * 2048 + 1024 + h * 128 + part * 32 + ck * 8) = pack8(v); } }
    __syncthreads();
}

__device__ __forceinline__ void mlstm_scan(const Ctx& c) {
    unsigned char* ws = c.ws; const float* CTL = (const float*)(ws + WS_CTL_LOC); bf16_t* CTP = (bf16_t*)(ws + WS_CTP);
    const float* GC = (const float*)(ws + WS_MISC + MO_GC); const float* AMAX = (const float*)(ws + WS_MISC + MO_AMAX); float* MPREV = (float*)(ws + WS_MISC + MO_MPREV);
    const int e2 = c.bid * 512 + c.tid; constexpr int PER_H = DVP * 128 / 2;
    if (e2 >= 4 * PER_H) return;
    const int h = e2 / PER_H, rem = e2 % PER_H;
    f32x2 st = {0.f, 0.f}; float mprev = 0.f;
    for (int c0 = 0; c0 < 64; c0 += 8) {
        f32x2 loc[8];
#pragma unroll
        for (int k = 0; k < 8; ++k) loc[k] = *(const f32x2*)(CTL + ((size_t)(h * 64 + c0 + k)) * (DVP * 128) + 2 * rem);
#pragma unroll
        for (int k = 0; k < 8; ++k) { const int ch = c0 + k; const float gg = GC[h * 64 + ch], am = AMAX[h * 64 + ch];
            *(unsigned*)(CTP + ((size_t)(h * 64 + ch)) * (DVP * 128) + 2 * rem) = cvt_pk_bf16(st[0], st[1]);
            if (rem == 0) MPREV[h * 64 + ch] = mprev;
            const float mnew = fmaxf(gg + mprev, am), dec = __expf(gg + mprev - mnew), sc = __expf(am - mnew);
            st = st * dec + loc[k] * sc; mprev = mnew; }
    }
}

__device__ __forceinline__ bf16x8 scale_frag(bf16x8 f, float s) { float v[8]; unpack8(as_u4(f), v);
#pragma unroll
    for (int i = 0; i < 8; ++i) v[i] *= s;
    return as_frag(pack8(v)); }

__device__ __forceinline__ void mlstm_out(const Args& a, const Ctx& c, int h, int ch) {
    unsigned char* ws = c.ws;
    const bf16_t* QC = (const bf16_t*)(ws + WS_QC); const bf16_t* KC = (const bf16_t*)(ws + WS_KC); const bf16_t* VT = (const bf16_t*)(ws + WS_VT); const bf16_t* CTP = (const bf16_t*)(ws + WS_CTP);
    const float* BV = (const float*)(ws + WS_MISC + MO_BV); const float* UV = (const float*)(ws + WS_MISC + MO_UV); const float* PMX = (const float*)(ws + WS_MISC + MO_PMX);
    const float* MPREV = (const float*)(ws + WS_MISC + MO_MPREV); const bf16_t* PROJ = (const bf16_t*)(ws + WS_PROJ); bf16_t* HCAT = (bf16_t*)(ws + WS_HCAT);
    const int tt = c.lane & 15, g = c.lane >> 4, w = c.wave, t0 = ch * 128, trow = t0 + 16 * w + tt;
    const float b_t = BV[h * S + trow], pm_t = PMX[h * S + trow], mprev = MPREV[h * 64 + ch];
    const float m_t = b_t + fmaxf(mprev, pm_t), w_inter = __expf((b_t + mprev) - m_t), bm = b_t - m_t;
    bf16x8 qf[4], qs[4], pf[4];
#pragma unroll
    for (int kd = 0; kd < 4; ++kd) { qf[kd] = *(const bf16x8*)(QC + ((size_t)(h * S + trow)) * 128 + 32 * kd + 8 * g); qs[kd] = scale_frag(qf[kd], w_inter); }
    const int nsg = (w >> 1) + 1;
#pragma unroll
    for (int sg = 0; sg < 4; ++sg) {
        if (sg < nsg) {
            f32x4 s0 = {0.f, 0.f, 0.f, 0.f}, s1 = {0.f, 0.f, 0.f, 0.f};
#pragma unroll
            for (int kd = 0; kd < 4; ++kd) {
                const bf16x8 a0 = *(const bf16x8*)(KC + ((size_t)(h * S + t0 + 32 * sg + pi32(0, tt))) * 128 + 32 * kd + 8 * g);
                const bf16x8 a1 = *(const bf16x8*)(KC + ((size_t)(h * S + t0 + 32 * sg + pi32(1, tt))) * 128 + 32 * kd + 8 * g);
                s0 = mfma16(a0, qf[kd], s0); s1 = mfma16(a1, qf[kd], s1); }
            const f32x4 ua = *(const f32x4*)(UV + h * S + t0 + 32 * sg + 8 * g), ub = *(const f32x4*)(UV + h * S + t0 + 32 * sg + 8 * g + 4);
            float p[8]; const int sl = 32 * sg + 8 * g, tl = 16 * w + tt;
#pragma unroll
            for (int r = 0; r < 4; ++r) { p[r] = (sl + r <= tl) ? s0[r] * __expf(bm + ua[r]) : 0.f; p[4 + r] = (sl + 4 + r <= tl) ? s1[r] * __expf(bm + ub[r]) : 0.f; }
            pf[sg] = as_frag(pack8(p));
        } else pf[sg] = (bf16x8){0, 0, 0, 0, 0, 0, 0, 0};
    }
    f32x4 oacc[17];
#pragma unroll
    for (int mt = 0; mt < 17; ++mt) {
        f32x4 o = {0.f, 0.f, 0.f, 0.f};
#pragma unroll
        for (int sg = 0; sg < 4; ++sg) if (sg < nsg) { const bf16x8 af = *(const bf16x8*)(VT + ((size_t)(h * DVP + 16 * mt + tt)) * S + t0 + 32 * sg + 8 * g); o = mfma16(af, pf[sg], o); }
#pragma unroll
        for (int kd = 0; kd < 4; ++kd) { const bf16x8 af = *(const bf16x8*)(CTP + ((size_t)((h * 64 + ch) * DVP + 16 * mt + tt)) * 128 + 32 * kd + 8 * g); o = mfma16(af, qs[kd], o); }
        oacc[mt] = o;
    }
    const float den = __shfl(oacc[16][0], tt);
    const float inv = 1.f / fmaxf(fabsf(den), __expf(-m_t));
    float ss = 0.f;
#pragma unroll
    for (int mt = 0; mt < 16; ++mt) { oacc[mt] = oacc[mt] * inv; ss += (oacc[mt][0] * oacc[mt][0] + oacc[mt][1] * oacc[mt][1]) + (oacc[mt][2] * oacc[mt][2] + oacc[mt][3] * oacc[mt][3]); }
    ss += __shfl_xor(ss, 16); ss += __shfl_xor(ss, 32);
    const float rstd = rsqrtf(ss * (1.f / 256.f) + EPS);
    const float* og = INF(8);
#pragma unroll
    for (int mt = 0; mt < 16; ++mt) { const int dv = 16 * mt + 4 * g;
        const f32x4 o4 = *(const f32x4*)(og + h * 256 + dv); const u32x2 mo = *(const u32x2*)(PROJ + (size_t)trow * NPROJ + PC_MO + h * 256 + dv);
        const float v0 = oacc[mt][0] * rstd * o4[0] * sigmoidf_(bf_lo(mo.x)), v1 = oacc[mt][1] * rstd * o4[1] * sigmoidf_(bf_hi(mo.x));
        const float v2 = oacc[mt][2] * rstd * o4[2] * sigmoidf_(bf_lo(mo.y)), v3 = oacc[mt][3] * rstd * o4[3] * sigmoidf_(bf_hi(mo.y));
        u32x2 wv; wv.x = cvt_pk_bf16(v0, v1); wv.y = cvt_pk_bf16(v2, v3);
        *(u32x2*)(HCAT + (size_t)trow * 2048 + h * 256 + dv) = wv; }
}

__device__ __forceinline__ void xattn_item(const Args& a, const Ctx& c, int h, int tile) {
    unsigned char* ws = c.ws; const bf16_t* QX = (const bf16_t*)(ws + WS_QX); const bf16_t* KM = (const bf16_t*)(ws + WS_KM); const bf16_t* VTM = (const bf16_t*)(ws + WS_VTM); bf16_t* OX = (bf16_t*)(ws + WS_OX);
    const int tt = c.lane & 15, g = c.lane >> 4, w = c.wave, trow = tile * 128 + 16 * w + tt;
    const float* qg = INF(16);
    bf16x8 qf[16]; float ss = 0.f;
#pragma unroll
    for (int ks = 0; ks < 16; ++ks) { qf[ks] = *(const bf16x8*)(QX + (size_t)trow * 2048 + h * 512 + 32 * ks + 8 * g); float v[8]; unpack8(as_u4(qf[ks]), v);
#pragma unroll
        for (int i = 0; i < 8; ++i) ss += v[i] * v[i]; }
    ss += __shfl_xor(ss, 16); ss += __shfl_xor(ss, 32);
    const float rs = rsqrtf(ss * (1.f / 512.f) + EPS) * 0.04419417382415922f;
#pragma unroll
    for (int ks = 0; ks < 16; ++ks) { float v[8]; unpack8(as_u4(qf[ks]), v); const f32x4 g0 = *(const f32x4*)(qg + 32 * ks + 8 * g), g1 = *(const f32x4*)(qg + 32 * ks + 8 * g + 4);
        v[0] *= rs * g0[0]; v[1] *= rs * g0[1]; v[2] *= rs * g0[2]; v[3] *= rs * g0[3]; v[4] *= rs * g1[0]; v[5] *= rs * g1[1]; v[6] *= rs * g1[2]; v[7] *= rs * g1[3];
        qf[ks] = as_frag(pack8(v)); }
    f32x4 sacc[16];
#pragma unroll
    for (int mt = 0; mt < 16; ++mt) { f32x4 s = {0.f, 0.f, 0.f, 0.f}; const int key = 32 * (mt >> 1) + pi32(mt & 1, tt);
#pragma unroll
        for (int ks = 0; ks < 16; ++ks) { const bf16x8 af = *(const bf16x8*)(KM + ((size_t)(h * 256 + key)) * 512 + 32 * ks + 8 * g); s = mfma16(af, qf[ks], s); }
        sacc[mt] = s; }
    float mx = -INFINITY;
#pragma unroll
    for (int mt = 0; mt < 16; ++mt) mx = fmaxf(mx, fmaxf(fmaxf(sacc[mt][0], sacc[mt][1]), fmaxf(sacc[mt][2], sacc[mt][3])));
    mx = fmaxf(mx, __shfl_xor(mx, 16)); mx = fmaxf(mx, __shfl_xor(mx, 32));
    float l = 0.f; bf16x8 pf[8];
#pragma unroll
    for (int kk = 0; kk < 8; ++kk) { float p[8];
#pragma unroll
        for (int r = 0; r < 4; ++r) { p[r] = __expf(sacc[2 * kk][r] - mx); p[4 + r] = __expf(sacc[2 * kk + 1][r] - mx); }
#pragma unroll
        for (int i = 0; i < 8; ++i) l += p[i];
        pf[kk] = as_frag(pack8(p)); }
    l += __shfl_xor(l, 16); l += __shfl_xor(l, 32);
    const float inv = 1.f / l;
#pragma unroll
    for (int mt = 0; mt < 32; ++mt) { f32x4 o = {0.f, 0.f, 0.f, 0.f};
#pragma unroll
        for (int kk = 0; kk < 8; ++kk) { const bf16x8 af = *(const bf16x8*)(VTM + ((size_t)(h * 512 + 16 * mt + tt)) * 256 + 32 * kk + 8 * g); o = mfma16(af, pf[kk], o); }
        o = o * inv; u32x2 wv; wv.x = cvt_pk_bf16(o[0], o[1]); wv.y = cvt_pk_bf16(o[2], o[3]);
        *(u32x2*)(OX + (size_t)trow * 2048 + h * 512 + 16 * mt + 4 * g) = wv; }
}

__device__ __forceinline__ void route_block(const Args& a, const Ctx& c) {
    unsigned char* ws = c.ws; const float* WR = (const float*)(ws + WS_MISC + MO_WR); const float* H2 = c.out;
    unsigned* ECNT = (unsigned*)(ws + WS_CTL) + CW_ECNT; int* PAIR_E = (int*)(ws + WS_MISC + MO_PAIR_E); int* PAIR_SLOT = (int*)(ws + WS_MISC + MO_PAIR_SLOT); float* PAIR_W = (float*)(ws + WS_MISC + MO_PAIR_W);
    bf16_t* HNB = (bf16_t*)(ws + WS_HNB);
    LAS float* lg = (LAS float*)c.lds;
    LAS float* ssqp = lg + 8 * 16 * 80;
    LAS float* rsd = ssqp + 128;
    const int w = c.wave, lane = c.lane, n = lane & 15, g = lane >> 4, tw = w >> 2, kq = w & 3;
    const int r0 = (c.bid * 2 + tw) * 16;
    f32x4 acc[5];
#pragma unroll
    for (int i = 0; i < 5; ++i) acc[i] = (f32x4){0.f, 0.f, 0.f, 0.f};
    float ssq = 0.f;
    const float* arow = H2 + (size_t)(r0 + n) * 2048 + 512 * kq + 4 * g;
    const float* brow = WR + (size_t)(512 * kq + 4 * g) * 80 + n;
    for (int kk = 0; kk < 32; ++kk) {
        const f32x4 a4 = *(const f32x4*)(arow + 16 * kk);
        ssq += (a4[0] * a4[0] + a4[1] * a4[1]) + (a4[2] * a4[2] + a4[3] * a4[3]);
#pragma unroll
        for (int j = 0; j < 4; ++j)
#pragma unroll
            for (int nt = 0; nt < 5; ++nt) { const float bv = brow[(size_t)(16 * kk + j) * 80 + 16 * nt]; acc[nt] = __builtin_amdgcn_mfma_f32_16x16x4f32(a4[j], bv, acc[nt], 0, 0, 0); }
    }
    ssq += __shfl_xor(ssq, 16); ssq += __shfl_xor(ssq, 32);
#pragma unroll
    for (int nt = 0; nt < 5; ++nt)
#pragma unroll
        for (int r = 0; r < 4; ++r) lg[(w * 16 + 4 * g + r) * 80 + 16 * nt + n] = acc[nt][r];
    if (g == 0) ssqp[w * 16 + n] = ssq;
    __syncthreads();
    if (kq == 0 && lane < 16) {
        const int rr = lane; const int t = r0 + rr;
        const float sq = ssqp[(tw * 4 + 0) * 16 + rr] + ssqp[(tw * 4 + 1) * 16 + rr] + ssqp[(tw * 4 + 2) * 16 + rr] + ssqp[(tw * 4 + 3) * 16 + rr];
        const float rstd = rsqrtf(sq * (1.f / 2048.f) + EPS); rsd[tw * 16 + rr] = rstd;
        const float* bg = INF(21); const float* be = INF(23);
        float gl[8]; float gm = -INFINITY; int gs = 0;
#pragma unroll
        for (int j = 0; j < 8; ++j) { float v = 0.f;
#pragma unroll
            for (int q = 0; q < 4; ++q) v += lg[((tw * 4 + q) * 16 + rr) * 80 + j];
            gl[j] = v * rstd + bg[j]; if (gl[j] > gm) { gm = gl[j]; gs = j; } }
        float gsum = 0.f;
#pragma unroll
        for (int j = 0; j < 8; ++j) gsum += __expf(gl[j] - gm);
        const float pg = 1.f / gsum;
        float el[8]; float m0 = -INFINITY; int i0 = 0;
#pragma unroll
        for (int j = 0; j < 8; ++j) { float v = 0.f;
#pragma unroll
            for (int q = 0; q < 4; ++q) v += lg[((tw * 4 + q) * 16 + rr) * 80 + 8 + 8 * gs + j];
            el[j] = v * rstd + be[8 * gs + j]; if (el[j] > m0) { m0 = el[j]; i0 = j; } }
        float m1 = -INFINITY; int i1 = 0;
#pragma unroll
        for (int j = 0; j < 8; ++j) if (j != i0 && el[j] > m1) { m1 = el[j]; i1 = j; }
        const float e1 = __expf(m1 - m0); const float w0 = pg / (1.f + e1), w1 = pg * e1 / (1.f + e1);
        const int ea = 8 * gs + i0, eb = 8 * gs + i1;
        const int sa = (int)__hip_atomic_fetch_add(ECNT + ea, 1u, __ATOMIC_RELAXED, __HIP_MEMORY_SCOPE_AGENT);
        const int sb = (int)__hip_atomic_fetch_add(ECNT + eb, 1u, __ATOMIC_RELAXED, __HIP_MEMORY_SCOPE_AGENT);
        PAIR_E[2 * t] = ea; PAIR_SLOT[2 * t] = sa; PAIR_W[2 * t] = w0; PAIR_E[2 * t + 1] = eb; PAIR_SLOT[2 * t + 1] = sb; PAIR_W[2 * t + 1] = w1;
    }
    __syncthreads();
    const float* gf = INF(19);
#pragma unroll
    for (int i = 0; i < 4; ++i) { const int rl = 4 * w + i; const int t = c.bid * 32 + rl; const float rstd = rsd[rl];
        const f32x4* xr = (const f32x4*)(H2 + (size_t)t * 2048) + lane; u32x2* o8 = (u32x2*)(HNB + (size_t)t * 2048) + lane;
#pragma unroll
        for (int j = 0; j < 8; ++j) { const f32x4 gg = *(const f32x4*)(gf + 256 * j + 4 * lane); const f32x4 y = xr[64 * j] * rstd * gg; u32x2 wv; wv.x = cvt_pk_bf16(y[0], y[1]); wv.y = cvt_pk_bf16(y[2], y[3]); o8[64 * j] = wv; } }
    __syncthreads();
}

__device__ __forceinline__ void moe_gather(const Ctx& c) {
    unsigned char* ws = c.ws; unsigned* CTLW = (unsigned*)(ws + WS_CTL); const unsigned* ECNT = CTLW + CW_ECNT;
    const int* PAIR_E = (const int*)(ws + WS_MISC + MO_PAIR_E); const int* PAIR_SLOT = (const int*)(ws + WS_MISC + MO_PAIR_SLOT); int* ROWPAIR = (int*)(ws + WS_MISC + MO_ROWPAIR);
    int* TILE_E = (int*)(ws + WS_MISC + MO_TILE_E); int* TOFF = (int*)(ws + WS_MISC + MO_TOFF);
    const bf16_t* HNB = (const bf16_t*)(ws + WS_HNB); bf16_t* XG = (bf16_t*)(ws + WS_XG);
    LAS int* toffs = (LAS int*)c.lds;
    if (c.tid < 64) { const int cn = (int)ECNT[c.tid]; const int nt = (cn + 255) >> 8; int incl = nt;
#pragma unroll
        for (int o = 1; o < 64; o <<= 1) { const int t = __shfl_up(incl, o); if (c.lane >= o) incl += t; }
        toffs[c.tid] = incl - nt; if (c.tid == 63) toffs[64] = incl;
        if (c.bid == 0) { TOFF[c.tid] = incl - nt; for (int k = 0; k < nt; ++k) TILE_E[incl - nt + k] = c.tid; if (c.tid == 63) CTLW[CW_NTILES] = (unsigned)incl; } }
    __syncthreads();
    for (int p = c.gw; p < 16384; p += c.NGW) { const int e = PAIR_E[p], sl = PAIR_SLOT[p]; const int row = toffs[e] * 256 + sl;
        const u32x4* src = (const u32x4*)(HNB + (size_t)(p >> 1) * 2048) + c.lane; u32x4* dst = (u32x4*)(XG + (size_t)row * 2048) + c.lane;
#pragma unroll
        for (int j = 0; j < 4; ++j) dst[64 * j] = src[64 * j];
        if (c.lane == 0) ROWPAIR[row] = p; }
    __syncthreads();
}

__device__ __forceinline__ void moe_combine(const Ctx& c) {
    const bf16_t* YB = (const bf16_t*)(c.ws + WS_YB);
    for (int t = c.gw; t < S; t += c.NGW) {
        f32x4* orow = (f32x4*)(c.out + (size_t)t * 2048); const u32x4* y0 = (const u32x4*)(YB + (size_t)(2 * t) * 2048); const u32x4* y1 = (const u32x4*)(YB + (size_t)(2 * t + 1) * 2048);
#pragma unroll
        for (int j = 0; j < 4; ++j) { const int ck = 64 * j + c.lane; float a8[8], b8[8]; unpack8(y0[ck], a8); unpack8(y1[ck], b8);
            f32x4 o0 = orow[2 * ck], o1 = orow[2 * ck + 1];
            o0[0] += a8[0] + b8[0]; o0[1] += a8[1] + b8[1]; o0[2] += a8[2] + b8[2]; o0[3] += a8[3] + b8[3]; o1[0] += a8[4] + b8[4]; o1[1] += a8[5] + b8[5]; o1[2] += a8[6] + b8[6]; o1[3] += a8[7] + b8[7];
            orow[2 * ck] = o0; orow[2 * ck + 1] = o1; }
    }
}

__global__ void __launch_bounds__(512, 2) mega(Args a) {
    extern __shared__ __attribute__((aligned(16))) unsigned char lds_raw[];
    Ctx c; c.lds = (LAS unsigned char*)lds_raw; c.tid = threadIdx.x; c.lane = c.tid & 63; c.wave = __builtin_amdgcn_readfirstlane(c.tid >> 6);
    c.bid = blockIdx.x; c.G = gridDim.x; c.gw = c.bid * 8 + c.wave; c.NGW = c.G * 8; c.ws = a.ws; c.out = a.out;
    unsigned char* ws = a.ws;
    const int lo = a.ph_lo, hi = a.ph_hi;
#ifdef ONLY_PH
#define IN(k) ((k) == ONLY_PH)
#else
#define IN(k) (lo <= (k) && (k) < hi)
#endif
#define SEAM(k) do { if (IN(k) && IN((k) + 1)) { cg::this_grid().sync(); } } while (0)

    if (IN(0)) { phase0(a, c); __syncthreads(); }
    SEAM(0);
    if (IN(1)) {
        { pg8::Gemm g{(const bf16_t*)(ws + WS_XN), (const bf16_t*)(ws + WS_WIN), 2048}; pg8::StaticOrder So; So.init(S, NPROJ, c.G, c.bid);
          pg8::EpiBf16 E{(bf16_t*)(ws + WS_PROJ), NPROJ, nullptr};
          pg8::gemm_phase<pg8::EpiBf16, pg8::StaticOrder, true, true>(c.lds, g, So, E); }
        { pg8::Gemm g{(const bf16_t*)(ws + WS_MEMN), (const bf16_t*)(ws + WS_WKV), 2048}; pg8::StaticOrder So; So.init(MEML, 4096, c.G, c.bid);
          pg8::EpiBf16 E{(bf16_t*)(ws + WS_KVMEM), 4096, nullptr};
          pg8::gemm_phase<pg8::EpiBf16, pg8::StaticOrder, true, true>(c.lds, g, So, E); }
    }
    SEAM(1);
    if (IN(2)) {
        for (int it = c.bid; it < 256; it += c.G) prep_mlstm(a, c, it >> 6, it & 63);
        for (int it = c.bid; it < 256; it += c.G) prep_moba(a, c, it >> 5, it & 31);
        prep_xamem(a, c);
    }
    SEAM(2);
    if (IN(3)) {
        for (int it = c.bid; it < 256; it += c.G) mlstm_local(c, it >> 6, it & 63);
        for (int it = c.bid; it < 512; it += c.G) { const int cb = (it < 256) ? (31 - (it >> 4)) : ((it - 256) >> 4); moba_item(c, (it & 15) >> 1, cb, it & 1); }
    }
    SEAM(3);
    if (IN(4)) { if (c.G * 512 >= 4 * DVP * 64) mlstm_scan(c); }
    SEAM(4);
    if (IN(5)) { for (int it = c.bid; it < 256; it += c.G) mlstm_out(a, c, it >> 6, it & 63); }
    SEAM(5);
    if (IN(6)) {
        pg8::Gemm g{(const bf16_t*)(ws + WS_HCAT), (const bf16_t*)(ws + WS_WOUT), 2048}; pg8::StaticOrder So; So.init(S, 2048, c.G, c.bid);
        pg8::EpiResid E{INF(0), a.out, (bf16_t*)(ws + WS_H1B), (float*)(ws + WS_MISC + MO_SSQ)};
        pg8::gemm_phase<pg8::EpiResid, pg8::StaticOrder, false, true>(c.lds, g, So, E);
    }
    SEAM(6);
    if (IN(7)) {
        pg8::Gemm g{(const bf16_t*)(ws + WS_H1B), (const bf16_t*)(ws + WS_WQ), 2048}; pg8::StaticOrder So; So.init(S, 2048, c.G, c.bid);
        pg8::EpiBf16 E{(bf16_t*)(ws + WS_QX), 2048, (const float*)(ws + WS_MISC + MO_SSQ)};
        pg8::gemm_phase<pg8::EpiBf16, pg8::StaticOrder, false, true>(c.lds, g, So, E);
    }
    SEAM(7);
    if (IN(8)) { for (int it = c.bid; it < 256; it += c.G) xattn_item(a, c, it & 3, it >> 2); }
    SEAM(8);
    if (IN(9)) {
        pg8::Gemm g{(const bf16_t*)(ws + WS_OX), (const bf16_t*)(ws + WS_WO), 2048}; pg8::StaticOrder So; So.init(S, 2048, c.G, c.bid);
        pg8::EpiResid E{a.out, a.out, nullptr, nullptr};
        pg8::gemm_phase<pg8::EpiResid, pg8::StaticOrder, false, true>(c.lds, g, So, E);
    }
    SEAM(9);
    if (IN(10)) { if (c.G == 256) route_block(a, c); }
    SEAM(10);
    if (IN(11)) moe_gather(c);
    SEAM(11);
    if (IN(12)) {
        const int ntiles = (int)__hip_atomic_load((unsigned*)(ws + WS_CTL) + CW_NTILES, __ATOMIC_RELAXED, __HIP_MEMORY_SCOPE_AGENT);
        pg8::Gemm g{(const bf16_t*)(ws + WS_XG), (const bf16_t*)(ws + WS_WGU), 2048};
        pg8::GroupedOrder So{(const int*)(ws + WS_MISC + MO_TILE_E), ntiles, 4, c.G, c.bid};
        pg8::EpiMoe1 E{(bf16_t*)(ws + WS_ACT)};
        pg8::gemm_phase<pg8::EpiMoe1, pg8::GroupedOrder, true, true>(c.lds, g, So, E);
    }
    SEAM(12);
    if (IN(13)) {
        const int ntiles = (int)__hip_atomic_load((unsigned*)(ws + WS_CTL) + CW_NTILES, __ATOMIC_RELAXED, __HIP_MEMORY_SCOPE_AGENT);
        pg8::Gemm g{(const bf16_t*)(ws + WS_ACT), (const bf16_t*)(ws + WS_WD), 512};
        pg8::GroupedOrder So{(const int*)(ws + WS_MISC + MO_TILE_E), ntiles, 8, c.G, c.bid};
        pg8::EpiMoe2 E{(bf16_t*)(ws + WS_YB), (const int*)(ws + WS_MISC + MO_ROWPAIR), (const float*)(ws + WS_MISC + MO_PAIR_W), (const int*)(ws + WS_MISC + MO_TILE_E), (const int*)(ws + WS_MISC + MO_TOFF),
                        (const unsigned*)(ws + WS_CTL) + CW_ECNT};
        pg8::gemm_phase<pg8::EpiMoe2, pg8::GroupedOrder, true, true>(c.lds, g, So, E);
    }
    SEAM(13);
    if (IN(14)) moe_combine(c);
#undef IN
#undef SEAM
}

constexpr int LDS_BYTES = 147456;
extern "C" void kernel_launch(void* const* d_in, const int* in_sizes, int n_in, void* d_out, int out_size, void* d_ws, size_t ws_size, hipStream_t stream) {
    static int grid = 0;
    if (grid == 0) {
        if (n_in != 27 || out_size != S * D || ws_size < WS_END) { fprintf(stderr, "kernel_launch: unexpected shapes (n_in %d out %d ws %zu)\n", n_in, out_size, ws_size); grid = -1; return; }
        int dev = 0, cus = 0, per_cu = 0;
        hipGetDevice(&dev); hipDeviceGetAttribute(&cus, hipDeviceAttributeMultiprocessorCount, dev);
        hipFuncSetAttribute((const void*)mega, hipFuncAttributeMaxDynamicSharedMemorySize, LDS_BYTES);
        hipOccupancyMaxActiveBlocksPerMultiprocessor(&per_cu, (const void*)mega, 512, LDS_BYTES);
        (void)hipGetLastError();
        grid = (per_cu >= 1) ? cus : -1;
        if (grid != 256) { fprintf(stderr, "kernel_launch: needs a 256-CU device with one resident block per CU (cus %d per_cu %d)\n", cus, per_cu); grid = -1; return; }
    }
    if (grid < 0) return;
    Args a{};
    for (int i = 0; i < 27; ++i) a.in[i] = d_in[i];
    a.out = (float*)d_out; a.ws = (unsigned char*)d_ws; a.single = MK_SINGLE; a.pad = 0;
#if MK_SINGLE
    a.ph_lo = 0; a.ph_hi = NPH;
    void* args[] = {&a};
    hipError_t e = hipLaunchCooperativeKernel((const void*)mega, dim3(grid), dim3(512), args, LDS_BYTES, stream);
    if (e != hipSuccess) fprintf(stderr, "cooperative launch failed: %s\n", hipGetErrorString(e));
#else
    for (int p = 0; p < NPH; ++p) { a.ph_lo = p; a.ph_hi = p + 1; hipLaunchKernelGGL(mega, dim3(grid), dim3(512), LDS_BYTES, stream, a); }
#endif
}
```

```cpp
#include <hip/hip_runtime.h>
#include <hip/hip_cooperative_groups.h>
#include <cstdio>
#include <cstdint>
namespace cg = cooperative_groups;

#ifndef MK_SINGLE
#define MK_SINGLE 1
#endif

#define LAS __attribute__((address_space(3)))
typedef unsigned short bf16_t;
typedef short bf16x8 __attribute__((ext_vector_type(8)));
typedef float f32x4 __attribute__((ext_vector_type(4)));
typedef float f32x2 __attribute__((ext_vector_type(2)));
typedef unsigned u32x4 __attribute__((ext_vector_type(4)));
typedef unsigned u32x2 __attribute__((ext_vector_type(2)));

constexpr int S = 8192, D = 2048, DIN = 6152, NPROJ = 6144, MEML = 256;
constexpr int NPH = 15;
constexpr float EPS = 1e-6f;
constexpr int PC_MQ = 0, PC_MK = 512, PC_MV = 1024, PC_MO = 2048, PC_AQ = 3072, PC_AK = 4096, PC_AV = 5120;
constexpr int DVP = 272;

constexpr size_t MiB = 1u << 20;
constexpr size_t WS_CTL = 0;
constexpr size_t WS_WIN = 1 * MiB;
constexpr size_t WS_WOUT = 25 * MiB;
constexpr size_t WS_WQ = 33 * MiB;
constexpr size_t WS_WKV = 41 * MiB;
constexpr size_t WS_WO = 57 * MiB;
constexpr size_t WS_WGU = 65 * MiB;
constexpr size_t WS_WD = 321 * MiB;
constexpr size_t WS_XN = 449 * MiB;
constexpr size_t WS_MEMN = 481 * MiB;
constexpr size_t WS_PROJ = 482 * MiB;
constexpr size_t WS_KVMEM = 578 * MiB;
constexpr size_t WS_QC = 580 * MiB;
constexpr size_t WS_KC = 588 * MiB;
constexpr size_t WS_KWT = 596 * MiB;
constexpr size_t WS_VT = 604 * MiB;
constexpr size_t WS_CTL_LOC = 621 * MiB;
constexpr size_t WS_CTP = 655 * MiB;
constexpr size_t WS_QP = 672 * MiB;
constexpr size_t WS_KP = 688 * MiB;
constexpr size_t WS_VTP = 704 * MiB;
constexpr size_t WS_KM = 720 * MiB;
constexpr size_t WS_VTM = 721 * MiB;
constexpr size_t WS_HCAT = 722 * MiB;
constexpr size_t WS_H1B = 754 * MiB;
constexpr size_t WS_QX = 786 * MiB;
constexpr size_t WS_OX = 818 * MiB;
constexpr size_t WS_MISC = 850 * MiB;
constexpr size_t WS_ACT = 854 * MiB;
constexpr size_t WS_YB = 886 * MiB;
constexpr size_t WS_END = 950 * MiB;
constexpr size_t WS_PART = WS_END;
constexpr size_t WS_BLIST = WS_END + 48 * MiB;
constexpr size_t WS_LPART = WS_END + 52 * MiB;
constexpr size_t WS_PSLOT = WS_END + 53 * MiB;
constexpr size_t WS_POFF = WS_END + 54 * MiB;
constexpr size_t WS_ELIST = WS_END + 56 * MiB;
constexpr size_t WS_END2 = WS_END + 58 * MiB;
constexpr size_t WS_XG = WS_PROJ;
constexpr size_t WS_HNB = WS_XN;
constexpr size_t MO_GATES = 0;
constexpr size_t MO_BV = 256 * 1024;
constexpr size_t MO_UV = 384 * 1024;
constexpr size_t MO_PMX = 512 * 1024;
constexpr size_t MO_GC = 640 * 1024;
constexpr size_t MO_AMAX = 641 * 1024;
constexpr size_t MO_MPREV = 642 * 1024;
constexpr size_t MO_KMEAN = 648 * 1024;
constexpr size_t MO_SSQ = 1024 * 1024;
constexpr size_t MO_WR = 2048 * 1024;
constexpr size_t MO_PAIR_E = 2752 * 1024;
constexpr size_t MO_PAIR_SLOT = 2816 * 1024;
constexpr size_t MO_PAIR_W = 2880 * 1024;
constexpr size_t MO_ROWPAIR = 2944 * 1024;
constexpr size_t MO_TILE_E = 3072 * 1024;
constexpr size_t MO_TOFF = 3073 * 1024;
constexpr int CW_ECNT = 1024;
constexpr int CW_NTILES = 1100;
constexpr int CW_BCNT = 1280;
constexpr int CW_BAR = 4096;
constexpr size_t CTL_ZERO_BYTES = 65536;

struct Args { const void* in[27]; float* out; unsigned char* ws; int ph_lo, ph_hi; int single, pad; };

__device__ __forceinline__ unsigned cvt_pk_bf16(float lo, float hi) { unsigned r; asm("v_cvt_pk_bf16_f32 %0, %1, %2" : "=v"(r) : "v"(lo), "v"(hi)); return r; }
__device__ __forceinline__ float bf_lo(unsigned u) { return __uint_as_float(u << 16); }
__device__ __forceinline__ float bf_hi(unsigned u) { return __uint_as_float(u & 0xffff0000u); }
__device__ __forceinline__ float bf1(bf16_t h) { return __uint_as_float(((unsigned)h) << 16); }
__device__ __forceinline__ bf16_t f2bf(float f) { return (bf16_t)(cvt_pk_bf16(f, 0.f) & 0xffffu); }
__device__ __forceinline__ void unpack8(u32x4 v, float (&f)[8]) {
    f[0] = bf_lo(v.x); f[1] = bf_hi(v.x); f[2] = bf_lo(v.y); f[3] = bf_hi(v.y); f[4] = bf_lo(v.z); f[5] = bf_hi(v.z); f[6] = bf_lo(v.w); f[7] = bf_hi(v.w);
}
__device__ __forceinline__ u32x4 pack8(const float (&f)[8]) {
    u32x4 v; v.x = cvt_pk_bf16(f[0], f[1]); v.y = cvt_pk_bf16(f[2], f[3]); v.z = cvt_pk_bf16(f[4], f[5]); v.w = cvt_pk_bf16(f[6], f[7]); return v;
}
__device__ __forceinline__ bf16x8 as_frag(u32x4 v) { return __builtin_bit_cast(bf16x8, v); }
__device__ __forceinline__ u32x4 as_u4(bf16x8 v) { return __builtin_bit_cast(u32x4, v); }
__device__ __forceinline__ float wave_sum(float v) {
#pragma unroll
    for (int o = 1; o < 64; o <<= 1) v += __shfl_xor(v, o);
    return v;
}
__device__ __forceinline__ float sigmoidf_(float x) { return 1.f / (1.f + __expf(-x)); }
__device__ __forceinline__ f32x4 mfma16(bf16x8 a, bf16x8 b, f32x4 c) { return __builtin_amdgcn_mfma_f32_16x16x32_bf16(a, b, c, 0, 0, 0); }
__device__ __forceinline__ int pi32(int tq, int i) { return 8 * (i >> 2) + 4 * tq + (i & 3); }
#define LDS_WAIT() asm volatile("s_waitcnt lgkmcnt(0)" ::: "memory")

namespace pg8 {
constexpr int BM = 256, BK = 64, HALF = 128, HTB = HALF * BK * 2, STAGE_BYTES = 8 * HTB, NXCD = 8, WGM = 8;
__device__ __forceinline__ int lds_byte(int r, int c) { const int st = (r >> 4) * 2 + (c >> 5), rr = r & 15, cc = c & 31, ob = rr * 64 + cc * 2; return st * 1024 + (ob ^ (((ob >> 9) & 1) << 5)); }
__device__ __forceinline__ void stage_rc(int b, int& R, int& C) { const int st = b / 1024, sb = b % 1024, swz = sb ^ (((sb >> 9) & 1) << 5); R = (st >> 1) * 16 + swz / 64; C = (st & 1) * 32 + (swz % 64) / 2; }
__device__ __forceinline__ int perm32(int rho) { const int n = rho >> 4, i = rho & 15; return 8 * (i >> 2) + 4 * n + (i & 3); }
struct Unit { int pm, pn; };
struct Gemm { const bf16_t* A; const bf16_t* Bt; int K; };
struct StaticOrder {
    int nM, nN, nwg, G, c;
    __device__ void init(int M, int N, int G_, int c_) { nM = M / BM; nN = N / BM; nwg = nM * nN; G = G_; c = c_; }
    __device__ bool next(int i, Unit& u) const {
        const long L = (long)i * G + c; if (L >= nwg) return false;
        int wgid = (int)L; { const int q = nwg / NXCD, r = nwg % NXCD, xcd = wgid % NXCD, off = wgid / NXCD; wgid = (xcd < r ? xcd * (q + 1) : r * (q + 1) + (xcd - r) * q) + off; }
        const int nig = WGM * nN, gid = wgid / nig, fm = gid * WGM, gsz = (nM - fm) < WGM ? (nM - fm) : WGM;
        u.pm = fm + ((wgid % nig) % gsz); u.pn = (wgid % nig) / gsz; return true;
    }
};
struct GroupedOrder {
    const int* tile_e; int ntiles, nN, G, c;
    __device__ bool next(int i, Unit& u) const {
        const long L = (long)i * G + c; if (L >= (long)ntiles * nN) return false;
        const int pm = (int)(L / nN), pl = (int)(L % nN);
        const int e = __builtin_amdgcn_readfirstlane(__hip_atomic_load(tile_e + pm, __ATOMIC_RELAXED, __HIP_MEMORY_SCOPE_AGENT));
        u.pm = pm; u.pn = e * nN + pl; return true;
    }
};

template <class Epi, class Sched, bool ALIGN_EPI, bool SP2>
__device__ __forceinline__ void gemm_phase(LAS unsigned char* lds, const Gemm g, const Sched& S, const Epi& E) {
    const int tid = threadIdx.x, wid = __builtin_amdgcn_readfirstlane(tid >> 6), lane = tid & 63, wr = wid >> 2, wc = wid & 3, fr = lane & 15, fq = lane >> 4;
    const int K = g.K, nt = K / BK;
    unsigned voffA[2], voffB[2];
#pragma unroll
    for (int i = 0; i < 2; ++i) { int R, C; stage_rc(tid * 16 + i * 8192, R, C); const int Rb = Epi::PERM ? ((R & ~31) + perm32(R & 31)) : R;
        voffA[i] = (unsigned)(R * K + C) * 2u; voffB[i] = (unsigned)(Rb * K + C) * 2u; }
    const size_t kstep = (size_t)(BK * 2);
    const size_t hstep = (size_t)HALF * K * 2;
    const size_t tstep = 2 * hstep;
    const unsigned ldsw = (unsigned)wid * 1024u;
    const int aoff = lds_byte(wr * 64 + fr, fq * 8), boff = lds_byte(wc * 32 + fr, fq * 8);
#define PG8_SA(b, h) (((b) * 2 + (h)) * HTB)
#define PG8_SB(b, h) ((4 + (b) * 2 + (h)) * HTB)
#define PG8_STAGE(bufoff, gbase, voff) do { _Pragma("unroll") for (int _i = 0; _i < 2; ++_i) \
        __builtin_amdgcn_global_load_lds((const unsigned*)((const char*)(gbase) + (voff)[_i]), (LAS unsigned*)(lds + (bufoff) + ldsw + _i * 8192), 16, 0, 0); } while (0)
#define PG8_LDA(dst, b, h) do { _Pragma("unroll") for (int m = 0; m < 4; ++m) _Pragma("unroll") for (int k = 0; k < 2; ++k) dst[m][k] = *(const LAS bf16x8*)(lds + PG8_SA(b, h) + aoff + m * 2048 + k * 1024); } while (0)
#define PG8_LDB(dst, b, h) do { _Pragma("unroll") for (int n = 0; n < 2; ++n) _Pragma("unroll") for (int k = 0; k < 2; ++k) dst[n][k] = *(const LAS bf16x8*)(lds + PG8_SB(b, h) + boff + n * 2048 + k * 1024); } while (0)
#define PG8_MMA(ai, bj, At, Bt) do { __builtin_amdgcn_s_setprio(1); _Pragma("unroll") for (int m = 0; m < 4; ++m) _Pragma("unroll") for (int n = 0; n < 2; ++n) _Pragma("unroll") for (int k = 0; k < 2; ++k) \
        acc[ai][bj][m][n] = __builtin_amdgcn_mfma_f32_16x16x32_bf16(Bt[n][k], At[m][k], acc[ai][bj][m][n], 0, 0, 0); __builtin_amdgcn_s_setprio(0); } while (0)
#define PG8_WAIT_V(n) asm volatile("s_waitcnt vmcnt(" #n ")" ::: "memory")
#define PG8_WAIT_L(n) asm volatile("s_waitcnt lgkmcnt(" #n ")" ::: "memory")
#define PG8_BAR __builtin_amdgcn_s_barrier()
#define PG8_SCHED __builtin_amdgcn_sched_barrier(0)
    Unit cur, nxt; int ui = 0;
    if (!S.next(0, cur)) return;
    f32x4 acc[2][2][4][2];
#pragma unroll
    for (int a = 0; a < 2; ++a)
#pragma unroll
        for (int b = 0; b < 2; ++b)
#pragma unroll
            for (int m = 0; m < 4; ++m)
#pragma unroll
                for (int n = 0; n < 2; ++n) acc[a][b][m][n] = (f32x4){0.f, 0.f, 0.f, 0.f};
    bf16x8 At[4][2], B0[2][2], B1[2][2];
    const char* cA = (const char*)g.A + (size_t)cur.pm * tstep; const char* cB = (const char*)g.Bt + (size_t)cur.pn * tstep;
    if constexpr (SP2) {
        PG8_STAGE(PG8_SB(0, 0), cB, voffB); PG8_STAGE(PG8_SB(0, 1), cB + hstep, voffB); PG8_STAGE(PG8_SA(0, 0), cA, voffA); PG8_STAGE(PG8_SA(0, 1), cA + hstep, voffA);
        if (wr == 1) PG8_BAR;
        PG8_WAIT_V(2); PG8_BAR;
        PG8_STAGE(PG8_SB(1, 0), cB + kstep, voffB); PG8_STAGE(PG8_SA(1, 0), cA + kstep, voffA); PG8_STAGE(PG8_SB(1, 1), cB + hstep + kstep, voffB);
        PG8_WAIT_V(6); PG8_BAR;
    } else {
        PG8_STAGE(PG8_SB(0, 0), cB, voffB); PG8_STAGE(PG8_SA(0, 0), cA, voffA); PG8_STAGE(PG8_SB(0, 1), cB + hstep, voffB); PG8_STAGE(PG8_SA(0, 1), cA + hstep, voffA);
        if (wr == 1) PG8_BAR;
        PG8_WAIT_V(4); PG8_BAR;
        PG8_STAGE(PG8_SB(1, 0), cB + kstep, voffB); PG8_STAGE(PG8_SA(1, 0), cA + kstep, voffA); PG8_STAGE(PG8_SB(1, 1), cB + hstep + kstep, voffB);
        PG8_WAIT_V(6); PG8_BAR;
    }
    for (;;) {
        const bool has_next = S.next(ui + 1, nxt);
        const char* nA = has_next ? (const char*)g.A + (size_t)nxt.pm * tstep : cA; const char* nB = has_next ? (const char*)g.Bt + (size_t)nxt.pn * tstep : cB;
        for (int t = 0; t < nt; t += 2) {
            const bool last = (t == nt - 2);
            const char* a1 = cA + (size_t)(t + 1) * kstep;
            const char* a2 = last ? nA : cA + (size_t)(t + 2) * kstep; const char* b2 = last ? nB : cB + (size_t)(t + 2) * kstep;
            const char* a3 = a2 + kstep; const char* b3 = b2 + kstep;
            if constexpr (SP2) {
            PG8_LDB(B0, 0, 0); PG8_LDB(B1, 0, 1); PG8_SCHED; PG8_LDA(At, 0, 0); PG8_STAGE(PG8_SA(1, 1), a1 + hstep, voffA);
            PG8_WAIT_V(8); PG8_WAIT_L(0); PG8_BAR; PG8_MMA(0, 0, At, B0); PG8_MMA(0, 1, At, B1); PG8_BAR; PG8_SCHED;
            PG8_LDA(At, 0, 1); PG8_STAGE(PG8_SB(0, 0), b2, voffB); PG8_STAGE(PG8_SB(0, 1), b2 + hstep, voffB); PG8_STAGE(PG8_SA(0, 0), a2, voffA);
            PG8_WAIT_V(8); PG8_WAIT_L(0); PG8_BAR; PG8_MMA(1, 0, At, B0); PG8_MMA(1, 1, At, B1); PG8_BAR; PG8_SCHED;
            PG8_LDB(B0, 1, 0); PG8_LDB(B1, 1, 1); PG8_SCHED; PG8_LDA(At, 1, 0); PG8_STAGE(PG8_SA(0, 1), a2 + hstep, voffA);
            PG8_WAIT_V(8); PG8_WAIT_L(0); PG8_BAR; PG8_MMA(0, 0, At, B0); PG8_MMA(0, 1, At, B1); PG8_BAR; PG8_SCHED;
            PG8_LDA(At, 1, 1); PG8_STAGE(PG8_SB(1, 0), b3, voffB); PG8_STAGE(PG8_SB(1, 1), b3 + hstep, voffB); PG8_STAGE(PG8_SA(1, 0), a3, voffA);
            PG8_WAIT_V(8); PG8_WAIT_L(0); PG8_BAR; PG8_MMA(1, 0, At, B0); PG8_MMA(1, 1, At, B1); PG8_BAR; PG8_SCHED;
            } else {
            PG8_LDB(B0, 0, 0); PG8_SCHED; PG8_LDA(At, 0, 0); PG8_STAGE(PG8_SA(1, 1), a1 + hstep, voffA);
            PG8_WAIT_L(8); PG8_BAR; PG8_WAIT_L(0); PG8_MMA(0, 0, At, B0); PG8_BAR; PG8_SCHED;
            PG8_LDB(B1, 0, 1); PG8_STAGE(PG8_SB(0, 0), b2, voffB);
            PG8_BAR; PG8_WAIT_L(0); PG8_MMA(0, 1, At, B1); PG8_BAR;
            PG8_LDA(At, 0, 1); PG8_STAGE(PG8_SA(0, 0), a2, voffA);
            PG8_BAR; PG8_WAIT_L(0); PG8_MMA(1, 0, At, B0); PG8_BAR; PG8_SCHED;
            PG8_STAGE(PG8_SB(0, 1), b2 + hstep, voffB);
            PG8_WAIT_V(6); PG8_BAR; PG8_MMA(1, 1, At, B1); PG8_BAR;
            PG8_LDB(B0, 1, 0); PG8_SCHED; PG8_LDA(At, 1, 0); PG8_STAGE(PG8_SA(0, 1), a2 + hstep, voffA);
            PG8_WAIT_L(8); PG8_BAR; PG8_WAIT_L(0); PG8_MMA(0, 0, At, B0); PG8_BAR; PG8_SCHED;
            PG8_LDB(B1, 1, 1); PG8_STAGE(PG8_SB(1, 0), b3, voffB);
            PG8_BAR; PG8_WAIT_L(0); PG8_MMA(0, 1, At, B1); PG8_BAR;
            PG8_LDA(At, 1, 1); PG8_STAGE(PG8_SA(1, 0), a3, voffA);
            PG8_BAR; PG8_WAIT_L(0); PG8_MMA(1, 0, At, B0); PG8_BAR; PG8_SCHED;
            PG8_STAGE(PG8_SB(1, 1), b3 + hstep, voffB);
            PG8_WAIT_V(6); PG8_BAR; PG8_MMA(1, 1, At, B1); PG8_BAR;
            }
        }
        if constexpr (ALIGN_EPI) { if (wr == 0) PG8_BAR; }
        E(acc, cur, wr, wc, fr, fq);
        if (!has_next) break;
#pragma unroll
        for (int a = 0; a < 2; ++a)
#pragma unroll
            for (int b = 0; b < 2; ++b)
#pragma unroll
                for (int m = 0; m < 4; ++m)
#pragma unroll
                    for (int n = 0; n < 2; ++n) acc[a][b][m][n] = (f32x4){0.f, 0.f, 0.f, 0.f};
        cur = nxt; cA = nA; cB = nB; ++ui;
        if constexpr (ALIGN_EPI) { if (wr == 1) PG8_BAR; }
    }
    PG8_WAIT_V(0);
    if constexpr (!ALIGN_EPI) { if (wr == 0) PG8_BAR; }
    PG8_BAR;
#undef PG8_SA
#undef PG8_SB
#undef PG8_STAGE
#undef PG8_LDA
#undef PG8_LDB
#undef PG8_MMA
#undef PG8_WAIT_V
#undef PG8_WAIT_L
#undef PG8_BAR
#undef PG8_SCHED
}

struct EpiBf16 {
    static constexpr bool PERM = true;
    bf16_t* O; int ldc; const float* ssq;
    __device__ __forceinline__ void operator()(const f32x4 (&acc)[2][2][4][2], const Unit& u, int wr, int wc, int fr, int fq) const {
        const int row0 = u.pm * BM + wr * 64 + fr, col0 = u.pn * BM + wc * 32 + 8 * fq;
#pragma unroll
        for (int ai = 0; ai < 2; ++ai)
#pragma unroll
            for (int m = 0; m < 4; ++m) {
                const int row = row0 + ai * HALF + m * 16; float sc = 1.f;
                if (ssq) { const f32x4* p = (const f32x4*)(ssq + (size_t)row * 32); float s = 0.f;
#pragma unroll
                    for (int q = 0; q < 8; ++q) { const f32x4 v = p[q]; s += (v[0] + v[1]) + (v[2] + v[3]); }
                    sc = rsqrtf(s * (1.f / 2048.f) + EPS); }
                bf16_t* rowp = O + (size_t)row * ldc + col0;
#pragma unroll
                for (int bj = 0; bj < 2; ++bj) { const f32x4 v0 = acc[ai][bj][m][0] * sc, v1 = acc[ai][bj][m][1] * sc;
                    u32x4 w; w.x = cvt_pk_bf16(v0[0], v0[1]); w.y = cvt_pk_bf16(v0[2], v0[3]); w.z = cvt_pk_bf16(v1[0], v1[1]); w.w = cvt_pk_bf16(v1[2], v1[3]);
                    *(u32x4*)(rowp + bj * HALF) = w; }
            }
    }
};
struct EpiResid {
    static constexpr bool PERM = false;
    const float* base; float* out; bf16_t* hb; float* ssq;
    __device__ __forceinline__ void operator()(const f32x4 (&acc)[2][2][4][2], const Unit& u, int wr, int wc, int fr, int fq) const {
        const int row0 = u.pm * BM + wr * 64 + fr, col0 = u.pn * BM + wc * 32 + 4 * fq;
#pragma unroll
        for (int ai = 0; ai < 2; ++ai)
#pragma unroll
            for (int m = 0; m < 4; ++m) {
                const int row = row0 + ai * HALF + m * 16; const size_t off = (size_t)row * 2048 + col0; float s = 0.f;
#pragma unroll
                for (int bj = 0; bj < 2; ++bj)
#pragma unroll
                    for (int n = 0; n < 2; ++n) {
                        const f32x4 b = *(const f32x4*)(base + off + bj * HALF + n * 16); const f32x4 o = b + acc[ai][bj][m][n];
                        *(f32x4*)(out + off + bj * HALF + n * 16) = o;
                        if (hb) { u32x2 w; w.x = cvt_pk_bf16(o[0], o[1]); w.y = cvt_pk_bf16(o[2], o[3]); *(u32x2*)(hb + off + bj * HALF + n * 16) = w;
                            s += (o[0] * o[0] + o[1] * o[1]) + (o[2] * o[2] + o[3] * o[3]); }
                    }
                if (hb) { s += __shfl_xor(s, 16); s += __shfl_xor(s, 32); if (fq == 0) ssq[(size_t)row * 32 + u.pn * 4 + wc] = s; }
            }
    }
};
struct EpiMoe1 {
    static constexpr bool PERM = true;
    bf16_t* act;
    __device__ __forceinline__ void operator()(const f32x4 (&acc)[2][2][4][2], const Unit& u, int wr, int wc, int fr, int fq) const {
        const int row0 = u.pm * BM + wr * 64 + fr, col0 = (u.pn & 3) * 128 + wc * 32 + 8 * fq;
#pragma unroll
        for (int ai = 0; ai < 2; ++ai)
#pragma unroll
            for (int m = 0; m < 4; ++m) {
                const int row = row0 + ai * HALF + m * 16; float v[8];
#pragma unroll
                for (int n = 0; n < 2; ++n)
#pragma unroll
                    for (int i = 0; i < 4; ++i) { const float gt = acc[ai][0][m][n][i], up = acc[ai][1][m][n][i]; v[n * 4 + i] = gt / (1.f + __expf(-gt)) * up; }
                *(u32x4*)(act + (size_t)row * 512 + col0) = pack8(v);
            }
    }
};
struct EpiMoe2 {
    static constexpr bool PERM = true;
    bf16_t* yb; const int* rowpair; const float* pair_w; const int* tile_e; const int* toff; const unsigned* ecnt;
    __device__ __forceinline__ void operator()(const f32x4 (&acc)[2][2][4][2], const Unit& u, int wr, int wc, int fr, int fq) const {
        const int e = tile_e[u.pm]; const int base_slot = (u.pm - toff[e]) * 256; const int cnt = (int)ecnt[e];
        const int col0 = (u.pn & 7) * 256 + wc * 32 + 8 * fq;
        int prs[8]; float pws[8];
#pragma unroll
        for (int q = 0; q < 8; ++q) { const int rr = wr * 64 + fr + (q >> 2) * HALF + (q & 3) * 16; const int rc = (base_slot + rr < cnt) ? rr : 0; prs[q] = rowpair[u.pm * 256 + rc]; }
#pragma unroll
        for (int q = 0; q < 8; ++q) pws[q] = pair_w[prs[q]];
#pragma unroll
        for (int ai = 0; ai < 2; ++ai)
#pragma unroll
            for (int m = 0; m < 4; ++m) {
                const int rr = wr * 64 + fr + ai * HALF + m * 16;
                if (base_slot + rr < cnt) {
                    const int pr = prs[ai * 4 + m]; const float w = pws[ai * 4 + m];
                    bf16_t* rowp = yb + (size_t)pr * 2048 + col0;
#pragma unroll
                    for (int bj = 0; bj < 2; ++bj) { const f32x4 v0 = acc[ai][bj][m][0] * w, v1 = acc[ai][bj][m][1] * w;
                        u32x4 x; x.x = cvt_pk_bf16(v0[0], v0[1]); x.y = cvt_pk_bf16(v0[2], v0[3]); x.z = cvt_pk_bf16(v1[0], v1[1]); x.w = cvt_pk_bf16(v1[2], v1[3]);
                        *(u32x4*)(rowp + bj * HALF) = x; }
                }
            }
    }
};
}

#define XB_TMO      128
#define XB_XCNT(j)  (256  + 64 * (j))
#define XB_XSUB(j)  (1280 + 64 * (j))
#define XB_XGEN(j)  (2304 + 64 * (j))
#define XB_TOP      3328
#define XB_TOPGEN   3392
#define XCD_BAR_WORDS 3456
#define XB_SPIN_CAP (1u << 18)
__device__ __forceinline__ unsigned xb_ld(unsigned* p)              { return __hip_atomic_load(p, __ATOMIC_RELAXED, __HIP_MEMORY_SCOPE_AGENT); }
__device__ __forceinline__ unsigned xb_add(unsigned* p, unsigned v) { return __hip_atomic_fetch_add(p, v, __ATOMIC_RELAXED, __HIP_MEMORY_SCOPE_AGENT); }
__device__ __forceinline__ unsigned xb_xcc_id() { return (unsigned)__builtin_amdgcn_s_getreg((3 << 11) | 20) & 0xFu; }
#define XB_SPIN(cond, bar) do { unsigned _sp = 0; while (cond) { __builtin_amdgcn_s_sleep(1); \
    if ((++_sp & 255u) == 0u) { if (xb_ld(&(bar)[XB_TMO])) break; if (_sp > XB_SPIN_CAP) { atomicAdd(&(bar)[XB_TMO], 1u); break; } } } } while (0)
struct XcdBarrier { unsigned* bar; unsigned x; volatile LAS unsigned* st; };
__device__ __forceinline__ XcdBarrier xcd_barrier_post(unsigned* bar, volatile LAS unsigned* st) {
    XcdBarrier b; b.bar = bar; b.x = xb_xcc_id(); b.st = st;
    if (threadIdx.x == 0) (void)xb_add(&bar[XB_XCNT(b.x)], 1u);
    return b;
}
__device__ __forceinline__ void xcd_barrier_complete(unsigned* bar, unsigned x, unsigned& nloc, unsigned& nx) {
    const unsigned G = gridDim.x * gridDim.y * gridDim.z;
    unsigned sum, cnt, mine, sp = 0u;
    for (;;) {
        sum = 0u; cnt = 0u; mine = 0u;
#pragma unroll
        for (unsigned j = 0; j < 16; ++j) { const unsigned cc = xb_ld(&bar[XB_XCNT(j)]); sum += cc; cnt += (cc > 0u) ? 1u : 0u; mine = (j == x) ? cc : mine; }
        if (sum == G) break;
        __builtin_amdgcn_s_sleep(1);
        if ((++sp & 255u) == 0u) { if (xb_ld(&bar[XB_TMO])) break; if (sp > XB_SPIN_CAP) { atomicAdd(&bar[XB_TMO], 1u); break; } }
    }
    nloc = mine > 0u ? mine : 1u; nx = cnt > 0u ? cnt : 1u;
}
__device__ __forceinline__ void xcd_barrier(const XcdBarrier& b) {
    asm volatile("s_waitcnt vmcnt(0)" ::: "memory");
    __syncthreads();
    if (threadIdx.x == 0) {
        unsigned* bar = b.bar;
        __builtin_amdgcn_s_waitcnt(0);
        unsigned nloc = b.st[0], nx = b.st[1];
        if (nloc == 0u) { xcd_barrier_complete(bar, b.x, nloc, nx); b.st[0] = nloc; b.st[1] = nx; }
        const unsigned old = xb_add(&bar[XB_XSUB(b.x)], 1u);
        const unsigned gen = old / nloc;
        if (old + 1u == (gen + 1u) * nloc) {
            __builtin_amdgcn_fence(__ATOMIC_RELEASE, "agent");
            asm volatile("s_waitcnt vmcnt(0)" ::: "memory");
            const unsigned og = xb_add(&bar[XB_TOP], 1u);
            const unsigned tg = og / nx;
            if (og + 1u == (tg + 1u) * nx) xb_add(&bar[XB_TOPGEN], 1u);
            else XB_SPIN(xb_ld(&bar[XB_TOPGEN]) == tg, bar);
            __builtin_amdgcn_fence(__ATOMIC_ACQUIRE, "agent");
            xb_add(&bar[XB_XGEN(b.x)], 1u);
            asm volatile("s_waitcnt vmcnt(0)" ::: "memory");
        } else {
            XB_SPIN(xb_ld(&bar[XB_XGEN(b.x)]) == gen, bar);
            __builtin_amdgcn_fence(__ATOMIC_ACQUIRE, "agent");
            asm volatile("s_waitcnt vmcnt(0)" ::: "memory");
        }
    }
    __syncthreads();
}

struct Ctx {
    LAS unsigned char* lds;
    int tid, lane, wave, bid, G, gw, NGW;
    unsigned char* ws; float* out;
};
#define INF(i) ((const float*)a.in[i])

__device__ __forceinline__ void transpose_item(const float* __restrict__ W, int ldw, int k0, int n_src0, bf16_t* WT, int K_dst, LAS float* scr, int lane, const float* kscale) {
#pragma unroll 8
    for (int i = 0; i < 32; ++i) { const int kk = 2 * i + (lane >> 5); float v = W[(size_t)(k0 + kk) * ldw + n_src0 + (lane & 31)]; if (kscale) v *= kscale[k0 + kk]; scr[kk * 33 + (lane & 31)] = v; }
    LDS_WAIT();
    const int c = lane & 7;
#pragma unroll
    for (int j = 0; j < 4; ++j) { const int n = (lane >> 3) + 8 * j; const LAS float* s = scr + (8 * c) * 33 + n;
        u32x4 o; o.x = cvt_pk_bf16(s[0 * 33], s[1 * 33]); o.y = cvt_pk_bf16(s[2 * 33], s[3 * 33]); o.z = cvt_pk_bf16(s[4 * 33], s[5 * 33]); o.w = cvt_pk_bf16(s[6 * 33], s[7 * 33]);
        *(u32x4*)(WT + (size_t)n * K_dst + k0 + 8 * c) = o; }
    LDS_WAIT();
}

__device__ __forceinline__ void phase0(const Args& a, const Ctx& c) {
    unsigned char* ws = c.ws;
    LAS float* scr = (LAS float*)(c.lds + c.wave * 16384);
    constexpr int N_DENSE = 16384, N_EXP = 64 * 1536;
    for (int it = c.gw; it < N_DENSE; it += c.NGW) {
        if (it < N_DENSE) {
            int r = it;
            if (r < 6144) {
                const int seg = r / 3072; r -= seg * 3072; const int kb = r / 96, nb = r % 96;
                transpose_item(INF(4), DIN, 64 * kb, (seg ? 3080 : 0) + 32 * nb, (bf16_t*)(ws + WS_WIN) + (size_t)(seg * 3072 + 32 * nb) * 2048, 2048, scr, c.lane, nullptr);
            } else if (r < 8192) { r -= 6144; const int kb = r / 64, nb = r % 64;
                transpose_item(INF(11), 2048, 64 * kb, 32 * nb, (bf16_t*)(ws + WS_WOUT) + (size_t)(32 * nb) * 2048, 2048, scr, c.lane, nullptr);
            } else if (r < 10240) { r -= 8192; const int kb = r / 64, nb = r % 64;
                transpose_item(INF(14), 2048, 64 * kb, 32 * nb, (bf16_t*)(ws + WS_WQ) + (size_t)(32 * nb) * 2048, 2048, scr, c.lane, INF(12));
            } else if (r < 14336) { r -= 10240; const int kb = r / 128, nb = r % 128;
                transpose_item(INF(15), 4096, 64 * kb, 32 * nb, (bf16_t*)(ws + WS_WKV) + (size_t)(32 * nb) * 2048, 2048, scr, c.lane, nullptr);
            } else { r -= 14336; const int kb = r / 64, nb = r % 64;
                transpose_item(INF(18), 2048, 64 * kb, 32 * nb, (bf16_t*)(ws + WS_WO) + (size_t)(32 * nb) * 2048, 2048, scr, c.lane, nullptr);
            }
        } else {
            const int r = it - N_DENSE; const int e = r / 1536, q = r % 1536, type = q / 512, idx = q % 512;
            if (type < 2) { const int kb = idx / 16, nb = idx % 16, f0 = 32 * nb;
                const float* W = INF(type == 0 ? 24 : 25) + (size_t)e * 2048 * 512;
                const int drow = e * 1024 + (f0 >> 7) * 256 + (type ? 128 : 0) + (f0 & 127);
                transpose_item(W, 512, 64 * kb, f0, (bf16_t*)(ws + WS_WGU) + (size_t)drow * 2048, 2048, scr, c.lane, nullptr);
            } else { const int kb = idx / 64, nb = idx % 64;
                const float* W = INF(26) + (size_t)e * 512 * 2048;
                transpose_item(W, 2048, 64 * kb, 32 * nb, (bf16_t*)(ws + WS_WD) + (size_t)(e * 2048 + 32 * nb) * 512, 512, scr, c.lane, nullptr);
            }
        }
    }
    {
        float* WR = (float*)(ws + WS_MISC + MO_WR);
        const float* gf = INF(19); const float* wg = INF(20); const float* we = INF(22);
        for (int i = c.bid * 512 + c.tid; i < 2048 * 80; i += c.G * 512) { const int k = i / 80, j = i % 80;
            float v = 0.f; if (j < 8) v = wg[k * 8 + j]; else if (j < 72) v = we[k * 64 + (j - 8)];
            WR[i] = v * gf[k]; }
        if (c.bid == 0 && c.tid < 128) ((unsigned*)(ws + WS_CTL))[CW_ECNT + c.tid] = 0u;
        if (c.bid == 0 && c.tid < 256) ((unsigned*)(ws + WS_CTL))[CW_BCNT + c.tid] = 0u;
    }
    __syncthreads();
    {
        LAS float* wgl = (LAS float*)c.lds; const float* win = INF(4); const float* gm = INF(3);
        for (int idx = c.tid; idx < 4096; idx += 512) { const int k = idx >> 1, hf = idx & 1;
            f32x4 v = *(const f32x4*)(win + (size_t)k * DIN + 3072 + 4 * hf); v = v * gm[k];
            const int j = k >> 8, l = (k >> 2) & 63, i = k & 3;
            *(LAS f32x4*)(wgl + (((i * 8 + j) * 64 + l) * 8 + 4 * hf)) = v; }
    }
    __syncthreads();
    {
        const LAS float* wgl = (const LAS float*)c.lds; const float* gm = INF(3); const float* x = INF(0); const float* gb = INF(5);
        bf16_t* XN = (bf16_t*)(ws + WS_XN); float* GATES = (float*)(ws + WS_MISC + MO_GATES);
        f32x4 g4[8];
#pragma unroll
        for (int j = 0; j < 8; ++j) g4[j] = *(const f32x4*)(gm + 256 * j + 4 * c.lane);
        for (int m = c.gw; m < S; m += c.NGW) {
            const f32x4* xr = (const f32x4*)(x + (size_t)m * D) + c.lane;
            f32x4 v[8]; float ss = 0.f; float ga[8];
#pragma unroll
            for (int q = 0; q < 8; ++q) ga[q] = 0.f;
#pragma unroll
            for (int j = 0; j < 8; ++j) { v[j] = xr[64 * j]; ss += (v[j][0] * v[j][0] + v[j][1] * v[j][1]) + (v[j][2] * v[j][2] + v[j][3] * v[j][3]); }
#pragma unroll
            for (int j = 0; j < 8; ++j) {
                asm volatile("" ::: "memory");
#pragma unroll
                for (int i = 0; i < 4; ++i) { const LAS f32x4* wp = (const LAS f32x4*)(wgl + ((i * 8 + j) * 64 + c.lane) * 8); const f32x4 w0 = wp[0], w1 = wp[1]; const float xv = v[j][i];
                    ga[0] += xv * w0[0]; ga[1] += xv * w0[1]; ga[2] += xv * w0[2]; ga[3] += xv * w0[3]; ga[4] += xv * w1[0]; ga[5] += xv * w1[1]; ga[6] += xv * w1[2]; ga[7] += xv * w1[3]; }
            }
            ss = wave_sum(ss); const float rstd = rsqrtf(ss * (1.f / D) + EPS);
#pragma unroll
            for (int q = 0; q < 8; ++q) ga[q] = wave_sum(ga[q]);
            if (c.lane < 8) { float gv = ga[0];
#pragma unroll
                for (int q = 1; q < 8; ++q) gv = (c.lane == q) ? ga[q] : gv;
                GATES[(size_t)m * 8 + c.lane] = gv * rstd + gb[c.lane]; }
            u32x2* o8 = (u32x2*)(XN + (size_t)m * D) + c.lane;
#pragma unroll
            for (int j = 0; j < 8; ++j) { const f32x4 y = v[j] * rstd * g4[j]; u32x2 w; w.x = cvt_pk_bf16(y[0], y[1]); w.y = cvt_pk_bf16(y[2], y[3]); o8[64 * j] = w; }
        }
        const float* mem = INF(1); const float* gmem = INF(13); bf16_t* MEMN = (bf16_t*)(ws + WS_MEMN);
        for (int m = c.gw; m < MEML; m += c.NGW) {
            const f32x4* xr = (const f32x4*)(mem + (size_t)m * D) + c.lane; f32x4 v[8]; float ss = 0.f;
#pragma unroll
            for (int j = 0; j < 8; ++j) { v[j] = xr[64 * j]; ss += (v[j][0] * v[j][0] + v[j][1] * v[j][1]) + (v[j][2] * v[j][2] + v[j][3] * v[j][3]); }
            ss = wave_sum(ss); const float rstd = rsqrtf(ss * (1.f / D) + EPS);
            u32x2* o8 = (u32x2*)(MEMN + (size_t)m * D) + c.lane;
#pragma unroll
            for (int j = 0; j < 8; ++j) { const f32x4 gg = *(const f32x4*)(gmem + 256 * j + 4 * c.lane); const f32x4 y = v[j] * rstd * gg; u32x2 w; w.x = cvt_pk_bf16(y[0], y[1]); w.y = cvt_pk_bf16(y[2], y[3]); o8[64 * j] = w; }
        }
    }
}

__device__ __forceinline__ void prep_mlstm(const Args& a, const Ctx& c, int h, int ch) {
    unsigned char* ws = c.ws; const int t0 = ch * 128;
    const float* GATES = (const float*)(ws + WS_MISC + MO_GATES);
    float* BV = (float*)(ws + WS_MISC + MO_BV); float* UV = (float*)(ws + WS_MISC + MO_UV); float* PMX = (float*)(ws + WS_MISC + MO_PMX);
    float* GC = (float*)(ws + WS_MISC + MO_GC); float* AMAX = (float*)(ws + WS_MISC + MO_AMAX);
    const bf16_t* PROJ = (const bf16_t*)(ws + WS_PROJ);
    LAS float* sc_w = (LAS float*)c.lds;
    LAS bf16_t* kws = (LAS bf16_t*)(c.lds + 1024);
    LAS bf16_t* vs = (LAS bf16_t*)(c.lds + 1024 + 128 * 260);
    if (c.wave == 0) {
        const int l = c.lane; const int ta = 2 * l, tb = 2 * l + 1;
        const float i0 = GATES[(size_t)(t0 + ta) * 8 + h], f0 = GATES[(size_t)(t0 + ta) * 8 + 4 + h];
        const float i1 = GATES[(size_t)(t0 + tb) * 8 + h], f1 = GATES[(size_t)(t0 + tb) * 8 + 4 + h];
        const float lf0 = fminf(f0, 0.f) - log1pf(__expf(-fabsf(f0))), lf1 = fminf(f1, 0.f) - log1pf(__expf(-fabsf(f1)));
        float incl = lf0 + lf1;
#pragma unroll
        for (int o = 1; o < 64; o <<= 1) { const float t = __shfl_up(incl, o); if (l >= o) incl += t; }
        const float excl = incl - (lf0 + lf1);
        const float b0 = excl + lf0, b1 = excl + lf0 + lf1;
        const float u0 = i0 - b0, u1 = i1 - b1;
        float pm = fmaxf(u0, u1);
#pragma unroll
        for (int o = 1; o < 64; o <<= 1) { const float t = __shfl_up(pm, o); if (l >= o) pm = fmaxf(pm, t); }
        float pme = __shfl_up(pm, 1); if (l == 0) pme = -INFINITY;
        const float p0 = fmaxf(pme, u0), p1 = pm;
        const float ptot = __shfl(pm, 63), gtot = __shfl(b1, 63);
        BV[h * S + t0 + ta] = b0; BV[h * S + t0 + tb] = b1; UV[h * S + t0 + ta] = u0; UV[h * S + t0 + tb] = u1; PMX[h * S + t0 + ta] = p0; PMX[h * S + t0 + tb] = p1;
        sc_w[ta] = __expf(u0 - ptot); sc_w[tb] = __expf(u1 - ptot);
        if (l == 63) { GC[h * 64 + ch] = gtot; AMAX[h * 64 + ch] = gtot + ptot; }
    }
    __syncthreads();
    {
        const float* cw = INF(6); const float* cb = INF(7);
        bf16_t* QC = (bf16_t*)(ws + WS_QC); bf16_t* KC = (bf16_t*)(ws + WS_KC);
        const int t = c.tid >> 2, qt = c.tid & 3; const float ws_ = sc_w[t];
#pragma unroll
        for (int qk = 0; qk < 2; ++qk)
#pragma unroll
            for (int gq = 0; gq < 4; ++gq) {
                const int ch0 = qt * 32 + 8 * gq; const int cch = qk * 512 + h * 128 + ch0; const int pcol = (qk ? PC_MK : PC_MQ) + h * 128 + ch0;
                float y[8];
#pragma unroll
                for (int i = 0; i < 8; ++i) y[i] = cb[cch + i];
#pragma unroll
                for (int j = 0; j < 4; ++j) { const int tr = t0 + t - 3 + j; const float msk = tr >= 0 ? 1.f : 0.f;
                    float xv[8]; unpack8(*(const u32x4*)(PROJ + (size_t)(tr < 0 ? 0 : tr) * NPROJ + pcol), xv);
#pragma unroll
                    for (int i = 0; i < 8; ++i) y[i] += cw[j * 1024 + cch + i] * (xv[i] * msk); }
#pragma unroll
                for (int i = 0; i < 8; ++i) y[i] = y[i] / (1.f + __expf(-y[i]));
                if (qk == 0) {
#pragma unroll
                    for (int i = 0; i < 8; ++i) y[i] *= 0.08838834764831845f;
                    *(u32x4*)(QC + ((size_t)(h * S + t0 + t)) * 128 + ch0) = pack8(y);
                } else {
                    *(u32x4*)(KC + ((size_t)(h * S + t0 + t)) * 128 + ch0) = pack8(y);
#pragma unroll
                    for (int i = 0; i < 8; ++i) kws[t * 130 + ch0 + i] = f2bf(y[i] * ws_);
                }
            }
        const int part = c.tid & 3;
#pragma unroll
        for (int q = 0; q < 8; ++q) { const int dv0 = part * 64 + 8 * q;
            *(LAS u32x4*)(vs + t * 264 + dv0) = *(const u32x4*)(PROJ + (size_t)(t0 + t) * NPROJ + PC_MV + h * 256 + dv0); }
    }
    __syncthreads();
    {
        bf16_t* KWT = (bf16_t*)(ws + WS_KWT); bf16_t* VT = (bf16_t*)(ws + WS_VT);
        const int d = c.tid >> 2, sq = c.tid & 3;
#pragma unroll
        for (int gq = 0; gq < 4; ++gq) { const int s0 = sq * 32 + 8 * gq; u32x4 o;
            o.x = (unsigned)kws[(s0 + 0) * 130 + d] | ((unsigned)kws[(s0 + 1) * 130 + d] << 16); o.y = (unsigned)kws[(s0 + 2) * 130 + d] | ((unsigned)kws[(s0 + 3) * 130 + d] << 16);
            o.z = (unsigned)kws[(s0 + 4) * 130 + d] | ((unsigned)kws[(s0 + 5) * 130 + d] << 16); o.w = (unsigned)kws[(s0 + 6) * 130 + d] | ((unsigned)kws[(s0 + 7) * 130 + d] << 16);
            *(u32x4*)(KWT + ((size_t)((h * 64 + ch) * 128 + d)) * 128 + s0) = o; }
        const int dv = c.tid >> 1, hf = c.tid & 1;
#pragma unroll
        for (int gq = 0; gq < 8; ++gq) { const int s0 = hf * 64 + 8 * gq; u32x4 o;
            o.x = (unsigned)vs[(s0 + 0) * 264 + dv] | ((unsigned)vs[(s0 + 1) * 264 + dv] << 16); o.y = (unsigned)vs[(s0 + 2) * 264 + dv] | ((unsigned)vs[(s0 + 3) * 264 + dv] << 16);
            o.z = (unsigned)vs[(s0 + 4) * 264 + dv] | ((unsigned)vs[(s0 + 5) * 264 + dv] << 16); o.w = (unsigned)vs[(s0 + 6) * 264 + dv] | ((unsigned)vs[(s0 + 7) * 264 + dv] << 16);
            *(u32x4*)(VT + ((size_t)((h * 64 + ch) * DVP + dv)) * 128 + s0) = o; }
        if (c.tid < 256) { const int row = 256 + (c.tid >> 4), ck = c.tid & 15; const unsigned val = (row == 256) ? 0x3F803F80u : 0u;
            *(u32x4*)(VT + ((size_t)((h * 64 + ch) * DVP + row)) * 128 + 8 * ck) = (u32x4){val, val, val, val}; }
    }
    __syncthreads();
}

__device__ __forceinline__ void prep_moba(const Args& a, const Ctx& c, int h, int jb) {
    unsigned char* ws = c.ws; const int t0 = jb * 256;
    const bf16_t* PROJ = (const bf16_t*)(ws + WS_PROJ); const int* pos = (const int*)a.in[2];
    bf16_t* QP = (bf16_t*)(ws + WS_QP); bf16_t* KP = (bf16_t*)(ws + WS_KP); bf16_t* VTP = (bf16_t*)(ws + WS_VTP); float* KMEAN = (float*)(ws + WS_MISC + MO_KMEAN);
    LAS float* red = (LAS float*)c.lds;
    LAS bf16_t* vs = (LAS bf16_t*)(c.lds + 16384);
    const int li = c.tid & 15, rg = c.tid >> 4, d0 = 8 * li;
    float qg[8], kg[8], kacc[8];
#pragma unroll
    for (int i = 0; i < 8; ++i) { qg[i] = INF(9)[d0 + i]; kg[i] = INF(10)[d0 + i]; kacc[i] = 0.f; }
    float invf[8];
#pragma unroll
    for (int i = 0; i < 8; ++i) { const int fi = (li & 1) * 8 + i; invf[i] = exp2f(-(float)fi * (18.931568569324174f / 16.f)); }
    for (int p = 0; p < 8; ++p) {
        const int row = p * 32 + rg; const size_t prow = (size_t)(t0 + row) * NPROJ + h * 128 + d0;
        const float fpos = (float)pos[t0 + row];
        float cs[8], sn[8];
        if (li < 4) {
#pragma unroll
            for (int i = 0; i < 8; ++i) { float s_, c_; sincosf(fpos * invf[i], &s_, &c_); cs[i] = c_; sn[i] = s_; }
        } else {
#pragma unroll
            for (int i = 0; i < 8; ++i) { cs[i] = 1.f; sn[i] = 0.f; }
        }
#pragma unroll
        for (int qk = 0; qk < 2; ++qk) {
            float x[8]; unpack8(*(const u32x4*)(PROJ + prow + (qk ? PC_AK : PC_AQ)), x);
            float ss = 0.f;
#pragma unroll
            for (int i = 0; i < 8; ++i) ss += x[i] * x[i];
            ss += __shfl_xor(ss, 1); ss += __shfl_xor(ss, 2); ss += __shfl_xor(ss, 4); ss += __shfl_xor(ss, 8);
            const float rstd = rsqrtf(ss * (1.f / 128.f) + EPS);
            float y[8];
#pragma unroll
            for (int i = 0; i < 8; ++i) y[i] = x[i] * rstd * (qk ? kg[i] : qg[i]);
            float o[8];
#pragma unroll
            for (int i = 0; i < 8; ++i) { const float ot = __shfl_xor(y[i], 2); o[i] = (li < 2) ? (y[i] * cs[i] - ot * sn[i]) : (li < 4 ? (y[i] * cs[i] + ot * sn[i]) : y[i]); }
            if (qk == 0) *(u32x4*)(QP + ((size_t)(h * S + t0 + row)) * 128 + d0) = pack8(o);
            else { *(u32x4*)(KP + ((size_t)(h * S + t0 + row)) * 128 + d0) = pack8(o);
#pragma unroll
                for (int i = 0; i < 8; ++i) kacc[i] += o[i]; }
        }
        *(LAS u32x4*)(vs + row * 136 + d0) = *(const u32x4*)(PROJ + prow + PC_AV);
    }
#pragma unroll
    for (int i = 0; i < 8; ++i) red[rg * 128 + d0 + i] = kacc[i];
    __syncthreads();
    if (c.tid < 128) { float s = 0.f;
#pragma unroll 8
        for (int r = 0; r < 32; ++r) s += red[r * 128 + c.tid];
        KMEAN[(h * 32 + jb) * 128 + c.tid] = s * (1.f / 256.f); }
    {
        const int d = c.tid >> 2, sq = c.tid & 3;
#pragma unroll
        for (int gq = 0; gq < 8; ++gq) { const int s0 = sq * 64 + 8 * gq; u32x4 o;
            o.x = (unsigned)vs[(s0 + 0) * 136 + d] | ((unsigned)vs[(s0 + 1) * 136 + d] << 16); o.y = (unsigned)vs[(s0 + 2) * 136 + d] | ((unsigned)vs[(s0 + 3) * 136 + d] << 16);
            o.z = (unsigned)vs[(s0 + 4) * 136 + d] | ((unsigned)vs[(s0 + 5) * 136 + d] << 16); o.w = (unsigned)vs[(s0 + 6) * 136 + d] | ((unsigned)vs[(s0 + 7) * 136 + d] << 16);
            *(u32x4*)(VTP + ((size_t)((h * 32 + jb) * 128 + d)) * 256 + s0) = o; }
    }
    __syncthreads();
}

__device__ __forceinline__ void prep_xamem(const Args& a, const Ctx& c) {
    unsigned char* ws = c.ws; const bf16_t* KVMEM = (const bf16_t*)(ws + WS_KVMEM);
    bf16_t* KM = (bf16_t*)(ws + WS_KM); bf16_t* VTM = (bf16_t*)(ws + WS_VTM); const float* kg = INF(17);
    for (int it = c.gw; it < 1024; it += c.NGW) { const int m = it >> 2, h = it & 3;
        float x[8]; unpack8(*(const u32x4*)(KVMEM + (size_t)m * 4096 + h * 512 + 8 * c.lane), x);
        float ss = 0.f;
#pragma unroll
        for (int i = 0; i < 8; ++i) ss += x[i] * x[i];
        ss = wave_sum(ss); const float rstd = rsqrtf(ss * (1.f / 512.f) + EPS);
#pragma unroll
        for (int i = 0; i < 8; ++i) x[i] = x[i] * rstd * kg[8 * c.lane + i];
        *(u32x4*)(KM + ((size_t)(h * 256 + m)) * 512 + 8 * c.lane) = pack8(x); }
    for (int idx = c.bid * 512 + c.tid; idx < 65536; idx += c.G * 512) { const int d = idx & 511, mg = (idx >> 9) & 31, h = idx >> 14;
        unsigned short v[8];
#pragma unroll
        for (int j = 0; j < 8; ++j) v[j] = KVMEM[(size_t)(8 * mg + j) * 4096 + 2048 + h * 512 + d];
        u32x4 o; o.x = v[0] | ((unsigned)v[1] << 16); o.y = v[2] | ((unsigned)v[3] << 16); o.z = v[4] | ((unsigned)v[5] << 16); o.w = v[6] | ((unsigned)v[7] << 16);
        *(u32x4*)(VTM + ((size_t)(h * 512 + d)) * 256 + 8 * mg) = o; }
}

__device__ __forceinline__ void tile256_load(LAS unsigned char* dst, const bf16_t* src, size_t src_ld, int nrows, int tid) {
    for (int idx = tid; idx < nrows * 16; idx += 512) { const int row = idx >> 4, ck = idx & 15;
        *(LAS u32x4*)(dst + row * 256 + ((ck ^ (row & 15)) << 4)) = *(const u32x4*)(src + (size_t)row * src_ld + 8 * ck); }
}
__device__ __forceinline__ bf16x8 tile256_frag(const LAS unsigned char* t, int row, int ck) { return *(const LAS bf16x8*)(t + row * 256 + ((ck ^ (row & 15)) << 4)); }

__device__ __forceinline__ void mlstm_local(const Ctx& c, int h, int ch) {
    unsigned char* ws = c.ws; const bf16_t* KWT = (const bf16_t*)(ws + WS_KWT); const bf16_t* VT = (const bf16_t*)(ws + WS_VT); float* CTL = (float*)(ws + WS_CTL_LOC);
    const int tt = c.lane & 15, g = c.lane >> 4, w = c.wave, t0 = ch * 128;
    tile256_load(c.lds, VT + (size_t)(h * 64 + ch) * DVP * 128, 128, DVP, c.tid);
    bf16x8 bfr[4];
#pragma unroll
    for (int ks = 0; ks < 4; ++ks) bfr[ks] = *(const bf16x8*)(KWT + ((size_t)((h * 64 + ch) * 128 + 16 * w + tt)) * 128 + 32 * ks + 8 * g);
    __syncthreads();
#pragma unroll
    for (int mt = 0; mt < 17; ++mt) {
        f32x4 acc = {0.f, 0.f, 0.f, 0.f};
#pragma unroll
        for (int ks = 0; ks < 4; ++ks) acc = mfma16(tile256_frag(c.lds, 16 * mt + tt, 4 * ks + g), bfr[ks], acc);
#pragma unroll
        for (int r = 0; r < 4; ++r) CTL[((size_t)((h * 64 + ch) * DVP + 16 * mt + 4 * g + r)) * 128 + 16 * w + tt] = acc[r];
    }
    __syncthreads();
}

#define MOBA_LOAD_KV(jb, K_, V_) do { const int kb_ = (jb) * 256; \
        _Pragma("unroll") for (int tq = 0; tq < 2; ++tq) _Pragma("unroll") for (int ks = 0; ks < 4; ++ks) \
            K_[tq][ks] = *(const bf16x8*)(KP + ((size_t)(h * S + kb_ + 32 * w + pi32(tq, tt))) * 128 + 32 * ks + 8 * g); \
        _Pragma("unroll") for (int ks = 0; ks < 8; ++ks) V_[ks] = *(const bf16x8*)(VTP + ((size_t)((h * 32 + (jb)) * 128 + 16 * w + tt)) * 256 + 32 * ks + 8 * g); } while (0)

__device__ __forceinline__ void moba_select(const Ctx& c, int h, int cb, int half) {
    unsigned char* ws = c.ws;
    const bf16_t* QP = (const bf16_t*)(ws + WS_QP); const float* KMEAN = (const float*)(ws + WS_MISC + MO_KMEAN);
    unsigned* BCNT = (unsigned*)(ws + WS_CTL) + CW_BCNT; unsigned short* BLIST = (unsigned short*)(ws + WS_BLIST); int* PSLOT = (int*)(ws + WS_PSLOT);
    LAS unsigned char* Qs = c.lds;
    LAS float* km = (LAS float*)(c.lds + 34816);
    LAS int* cnt = (LAS int*)(c.lds + 34816 + 16384);
    LAS int* gbase = cnt + 32;
    const int tid = c.tid, q0 = cb * 256 + half * 128;
    const int q = tid >> 2, sub = tid & 3;
    if (cb == 0) { if (sub == 0) { int* ps = PSLOT + ((size_t)(h * S + q0 + q)) * 3; ps[0] = -1; ps[1] = -1; ps[2] = -1; } return; }
    for (int i = tid; i < 128 * 16; i += 512) { const int r = i >> 4, ck = i & 15; *(LAS u32x4*)(Qs + r * 272 + ck * 16) = *(const u32x4*)(QP + ((size_t)(h * S + q0 + r)) * 128 + 8 * ck); }
    if (tid < 32) cnt[tid] = 0;
    { const f32x4* src = (const f32x4*)(KMEAN + (size_t)h * 32 * 128); for (int i = tid; i < cb * 32; i += 512) ((LAS f32x4*)km)[i] = src[i]; }
    __syncthreads();
    float bv0 = -INFINITY, bv1 = -INFINITY, bv2 = -INFINITY; int bi0 = 255, bi1 = 255, bi2 = 255;
    {
        float qv[128];
#pragma unroll
        for (int ck = 0; ck < 16; ++ck) { float t8[8]; unpack8(*(const LAS u32x4*)(Qs + q * 272 + ck * 16), t8);
#pragma unroll
            for (int i = 0; i < 8; ++i) qv[ck * 8 + i] = t8[i]; }
        for (int j = sub; j < cb; j += 4) {
            float s = 0.f;
#pragma unroll
            for (int d4 = 0; d4 < 32; ++d4) { const f32x4 kv = *(const LAS f32x4*)(km + j * 128 + 4 * d4); s += qv[4 * d4] * kv[0] + qv[4 * d4 + 1] * kv[1] + qv[4 * d4 + 2] * kv[2] + qv[4 * d4 + 3] * kv[3]; }
            if (s > bv0) { bv2 = bv1; bi2 = bi1; bv1 = bv0; bi1 = bi0; bv0 = s; bi0 = j; }
            else if (s > bv1) { bv2 = bv1; bi2 = bi1; bv1 = s; bi1 = j; }
            else if (s > bv2) { bv2 = s; bi2 = j; }
        }
    }
#pragma unroll
    for (int o = 1; o <= 2; o <<= 1) {
        const float ov0 = __shfl_xor(bv0, o), ov1 = __shfl_xor(bv1, o), ov2 = __shfl_xor(bv2, o);
        const int oi0 = __shfl_xor(bi0, o), oi1 = __shfl_xor(bi1, o), oi2 = __shfl_xor(bi2, o);
        float nv[3] = {ov0, ov1, ov2}; int ni[3] = {oi0, oi1, oi2};
#pragma unroll
        for (int k = 0; k < 3; ++k) { const float sv = nv[k]; const int j = ni[k];
            const bool b0 = (sv > bv0) || (sv == bv0 && j < bi0), b1 = (sv > bv1) || (sv == bv1 && j < bi1), b2 = (sv > bv2) || (sv == bv2 && j < bi2);
            if (b0) { bv2 = bv1; bi2 = bi1; bv1 = bv0; bi1 = bi0; bv0 = sv; bi0 = j; }
            else if (b1) { bv2 = bv1; bi2 = bi1; bv1 = sv; bi1 = j; }
            else if (b2) { bv2 = sv; bi2 = j; } }
    }
    int p0 = -1, p1 = -1, p2 = -1;
    if (sub == 0) {
        if (bi0 < cb) p0 = __hip_atomic_fetch_add(cnt + bi0, 1, __ATOMIC_RELAXED, __HIP_MEMORY_SCOPE_WORKGROUP);
        if (bi1 < cb) p1 = __hip_atomic_fetch_add(cnt + bi1, 1, __ATOMIC_RELAXED, __HIP_MEMORY_SCOPE_WORKGROUP);
        if (bi2 < cb) p2 = __hip_atomic_fetch_add(cnt + bi2, 1, __ATOMIC_RELAXED, __HIP_MEMORY_SCOPE_WORKGROUP);
    }
    __syncthreads();
    if (tid < cb) { const int cn = cnt[tid]; gbase[tid] = cn > 0 ? (int)__hip_atomic_fetch_add(BCNT + h * 32 + tid, (unsigned)cn, __ATOMIC_RELAXED, __HIP_MEMORY_SCOPE_AGENT) : 0; }
    __syncthreads();
    if (sub == 0) {
        int* ps = PSLOT + ((size_t)(h * S + q0 + q)) * 3; const unsigned short qq = (unsigned short)(q0 + q);
        if (p0 >= 0) { const int pos = gbase[bi0] + p0; BLIST[(size_t)(h * 32 + bi0) * 8192 + pos] = qq; ps[0] = (bi0 << 16) | pos; } else ps[0] = -1;
        if (p1 >= 0) { const int pos = gbase[bi1] + p1; BLIST[(size_t)(h * 32 + bi1) * 8192 + pos] = qq; ps[1] = (bi1 << 16) | pos; } else ps[1] = -1;
        if (p2 >= 0) { const int pos = gbase[bi2] + p2; BLIST[(size_t)(h * 32 + bi2) * 8192 + pos] = qq; ps[2] = (bi2 << 16) | pos; } else ps[2] = -1;
    }
    __syncthreads();
}

#define MOBA_TILE_PAIR(two, qrA, qrB, okA, okB, own, qlocA, qlocB, nkw) \
    f32x4 oA0 = {0.f, 0.f, 0.f, 0.f}, oA1 = oA0, oB0 = oA0, oB1 = oA0; float ltA = 0.f, ltB = 0.f; \
    { if (w < (nkw)) { \
        f32x4 sA0 = {0.f, 0.f, 0.f, 0.f}, sA1 = sA0, sB0 = sA0, sB1 = sA0; \
        _Pragma("unroll") for (int ks = 0; ks < 4; ++ks) { const bf16x8 qf = *(const LAS bf16x8*)(Qs + (qrA) * 272 + (32 * ks + 8 * g) * 2); sA0 = mfma16(Kc[0][ks], qf, sA0); sA1 = mfma16(Kc[1][ks], qf, sA1); } \
        if (two) { _Pragma("unroll") for (int ks = 0; ks < 4; ++ks) { const bf16x8 qf = *(const LAS bf16x8*)(Qs + (qrB) * 272 + (32 * ks + 8 * g) * 2); sB0 = mfma16(Kc[0][ks], qf, sB0); sB1 = mfma16(Kc[1][ks], qf, sB1); } } \
        const int kloc = 32 * w + 8 * g; \
        { float p[8]; float lsum = 0.f; \
          _Pragma("unroll") for (int r = 0; r < 4; ++r) { p[r] = __expf(sA0[r] * 0.08838834764831845f); p[4 + r] = __expf(sA1[r] * 0.08838834764831845f); } \
          _Pragma("unroll") for (int i = 0; i < 8; ++i) { const bool ok = (okA) && (!(own) || (kloc + i <= (qlocA))); p[i] = ok ? p[i] : 0.f; lsum += p[i]; } \
          lsum += __shfl_xor(lsum, 16); lsum += __shfl_xor(lsum, 32); \
          *(LAS u32x4*)(Pb + (buf * 2 + 0) * 8192 + w * 1024 + lane * 16) = pack8(p); \
          if (g == 0) lpart[((buf * 2 + 0) * 8 + w) * 16 + tt] = lsum; } \
        if (two) { float p[8]; float lsum = 0.f; \
          _Pragma("unroll") for (int r = 0; r < 4; ++r) { p[r] = __expf(sB0[r] * 0.08838834764831845f); p[4 + r] = __expf(sB1[r] * 0.08838834764831845f); } \
          _Pragma("unroll") for (int i = 0; i < 8; ++i) { const bool ok = (okB) && (!(own) || (kloc + i <= (qlocB))); p[i] = ok ? p[i] : 0.f; lsum += p[i]; } \
          lsum += __shfl_xor(lsum, 16); lsum += __shfl_xor(lsum, 32); \
          *(LAS u32x4*)(Pb + (buf * 2 + 1) * 8192 + w * 1024 + lane * 16) = pack8(p); \
          if (g == 0) lpart[((buf * 2 + 1) * 8 + w) * 16 + tt] = lsum; } \
      } \
      LDS_WAIT(); __builtin_amdgcn_s_barrier(); asm volatile("" ::: "memory"); \
      _Pragma("unroll") for (int ks = 0; ks < 8; ks += 2) if (ks < (nkw)) { \
          const bf16x8 pa = *(const LAS bf16x8*)(Pb + (buf * 2 + 0) * 8192 + ks * 1024 + lane * 16), pb = *(const LAS bf16x8*)(Pb + (buf * 2 + 0) * 8192 + (ks + 1) * 1024 + lane * 16); \
          oA0 = mfma16(Vc[ks], pa, oA0); oA1 = mfma16(Vc[ks + 1], pb, oA1); } \
      _Pragma("unroll") for (int ww = 0; ww < 8; ++ww) if (ww < (nkw)) ltA += lpart[((buf * 2 + 0) * 8 + ww) * 16 + tt]; \
      if (two) { \
          _Pragma("unroll") for (int ks = 0; ks < 8; ks += 2) if (ks < (nkw)) { \
              const bf16x8 pa = *(const LAS bf16x8*)(Pb + (buf * 2 + 1) * 8192 + ks * 1024 + lane * 16), pb = *(const LAS bf16x8*)(Pb + (buf * 2 + 1) * 8192 + (ks + 1) * 1024 + lane * 16); \
              oB0 = mfma16(Vc[ks], pa, oB0); oB1 = mfma16(Vc[ks + 1], pb, oB1); } \
          _Pragma("unroll") for (int ww = 0; ww < 8; ++ww) if (ww < (nkw)) ltB += lpart[((buf * 2 + 1) * 8 + ww) * 16 + tt]; } \
      oA0 = oA0 + oA1; oB0 = oB0 + oB1; buf ^= 1; }

__device__ __forceinline__ void moba_bucket_phase(const Ctx& c) {
    unsigned char* ws = c.ws;
    const bf16_t* QP = (const bf16_t*)(ws + WS_QP); const bf16_t* KP = (const bf16_t*)(ws + WS_KP); const bf16_t* VTP = (const bf16_t*)(ws + WS_VTP);
    unsigned* BCNT = (unsigned*)(ws + WS_CTL) + CW_BCNT; const unsigned short* BLIST = (const unsigned short*)(ws + WS_BLIST);
    bf16_t* PART = (bf16_t*)(ws + WS_PART); float* LPART = (float*)(ws + WS_LPART); int* POFF = (int*)(ws + WS_POFF);
    LAS unsigned char* Qs = c.lds;
    LAS unsigned char* Pb = c.lds + 34816;
    LAS float* lpart = (LAS float*)(c.lds + 34816 + 32768);
    LAS int* cnts = (LAS int*)(c.lds + 34816 + 32768 + 2048);
    LAS int* ipre = cnts + 256;
    LAS int* ppre = ipre + 260;
    LAS int* wsum = ppre + 260;
    LAS int* selb = wsum + 16;
    const int tid = c.tid, lane = c.lane, w = c.wave, tt = lane & 15, g = lane >> 4;
    {
        int cn = 0, nch = 0, pp = 0;
        if (tid < 256) { cn = (int)__hip_atomic_load(BCNT + tid, __ATOMIC_RELAXED, __HIP_MEMORY_SCOPE_AGENT); nch = (cn + 127) >> 7; pp = (cn + 15) & ~15; cnts[tid] = cn; }
        int i1 = nch, i2 = pp;
#pragma unroll
        for (int o = 1; o < 64; o <<= 1) { const int t1 = __shfl_up(i1, o), t2 = __shfl_up(i2, o); if (lane >= o) { i1 += t1; i2 += t2; } }
        if (lane == 63 && w < 4) { wsum[w] = i1; wsum[8 + w] = i2; }
        __syncthreads();
        if (tid < 256) { int a1 = 0, a2 = 0;
#pragma unroll
            for (int k = 0; k < 4; ++k) if (k < w) { a1 += wsum[k]; a2 += wsum[8 + k]; }
            ipre[tid + 1] = a1 + i1; ppre[tid + 1] = a2 + i2; if (tid == 0) { ipre[0] = 0; ppre[0] = 0; } }
        __syncthreads();
        if (c.bid == 0 && tid <= 256) POFF[tid] = ppre[tid];
    }
    const int total = ipre[256];
    int buf = 0;
    for (int it = c.bid; it < total; it += c.G) {
        if (tid < 256 && ipre[tid] <= it && it < ipre[tid + 1]) selb[0] = tid;
        __syncthreads();
        const int b = selb[0], h = b >> 5, jb = b & 31, chunk = it - ipre[b];
        const int n = min(128, cnts[b] - 128 * chunk), ntile = (n + 15) >> 4;
        const int pbase = ppre[b] + 128 * chunk;
        bf16x8 Kc[2][4], Vc[8];
        MOBA_LOAD_KV(jb, Kc, Vc);
        { int qq[4]; u32x4 qv4[4];
#pragma unroll
          for (int k = 0; k < 4; ++k) { const int r = (tid + 512 * k) >> 4; qq[k] = BLIST[(size_t)b * 8192 + 128 * chunk + (r < n ? r : n - 1)]; }
#pragma unroll
          for (int k = 0; k < 4; ++k) qv4[k] = *(const u32x4*)(QP + ((size_t)(h * S + qq[k])) * 128 + 8 * (tid & 15));
#pragma unroll
          for (int k = 0; k < 4; ++k) { const int r = (tid + 512 * k) >> 4; if (r >= n) qv4[k] = (u32x4){0u, 0u, 0u, 0u}; *(LAS u32x4*)(Qs + r * 272 + (tid & 15) * 16) = qv4[k]; } }
        __syncthreads();
        for (int tl = 0; tl < ntile; tl += 2) {
            const bool two = (tl + 1 < ntile);
            const int rA = 16 * tl + tt, rB = two ? rA + 16 : rA;
            MOBA_TILE_PAIR(two, rA, rB, (rA < n), (two && rB < n), 0, 0, 0, 8)
            { u32x2 wv; wv.x = cvt_pk_bf16(oA0[0], oA0[1]); wv.y = cvt_pk_bf16(oA0[2], oA0[3]); *(u32x2*)(PART + (size_t)(pbase + rA) * 128 + 16 * w + 4 * g) = wv;
              if (w == 0 && g == 0) LPART[pbase + rA] = ltA; }
            if (two) { u32x2 wv; wv.x = cvt_pk_bf16(oB0[0], oB0[1]); wv.y = cvt_pk_bf16(oB0[2], oB0[3]); *(u32x2*)(PART + (size_t)(pbase + rB) * 128 + 16 * w + 4 * g) = wv;
              if (w == 0 && g == 0) LPART[pbase + rB] = ltB; }
        }
        __syncthreads();
    }
}

__device__ __forceinline__ void moba_own(const Ctx& c, int h, int cb, int half) {
    unsigned char* ws = c.ws;
    const bf16_t* QP = (const bf16_t*)(ws + WS_QP); const bf16_t* KP = (const bf16_t*)(ws + WS_KP); const bf16_t* VTP = (const bf16_t*)(ws + WS_VTP);
    const bf16_t* PART = (const bf16_t*)(ws + WS_PART); const float* LPART = (const float*)(ws + WS_LPART); const int* POFF = (const int*)(ws + WS_POFF); const int* PSLOT = (const int*)(ws + WS_PSLOT);
    bf16_t* HCAT = (bf16_t*)(ws + WS_HCAT);
    LAS unsigned char* Qs = c.lds; LAS unsigned char* Pb = c.lds + 34816; LAS float* lpart = (LAS float*)(c.lds + 34816 + 32768);
    const int tid = c.tid, lane = c.lane, w = c.wave, tt = lane & 15, g = lane >> 4, q0 = cb * 256 + half * 128;
    bf16x8 Kc[2][4], Vc[8];
    MOBA_LOAD_KV(cb, Kc, Vc);
    for (int i = tid; i < 128 * 16; i += 512) { const int r = i >> 4, ck = i & 15; *(LAS u32x4*)(Qs + r * 272 + ck * 16) = *(const u32x4*)(QP + ((size_t)(h * S + q0 + r)) * 128 + 8 * ck); }
    __syncthreads();
    const int nkw = half ? 8 : 4;
    LAS int* pidx = (LAS int*)(c.lds + 34816 + 32768 + 2048);
    if (tid < 384) { const int qq = tid / 3, k = tid - 3 * qq; const int sl = PSLOT[((size_t)(h * S + q0 + qq)) * 3 + k];
        const int po = POFF[h * 32 + ((sl < 0 ? 0 : sl) >> 16)];
        pidx[qq * 4 + k] = (sl >= 0) ? (po + (sl & 0xffff)) : -1; }
    __syncthreads();
    int buf = 0;
    for (int tl = 0; tl < 8; tl += 2) {
        const int rA = 16 * tl + tt, rB = rA + 16;
        u32x2 pv[2][3]; float pl[2][3];
#pragma unroll
        for (int ab = 0; ab < 2; ++ab)
#pragma unroll
            for (int k = 0; k < 3; ++k) { const int pair = pidx[(ab ? rB : rA) * 4 + k]; const int pc = pair < 0 ? 0 : pair;
                pv[ab][k] = *(const u32x2*)(PART + (size_t)pc * 128 + 16 * w + 4 * g); pl[ab][k] = LPART[pc];
                if (pair < 0) { pv[ab][k] = (u32x2){0u, 0u}; pl[ab][k] = 0.f; } }
        MOBA_TILE_PAIR(true, rA, rB, true, true, 1, (half * 128 + rA), (half * 128 + rB), nkw)
#pragma unroll
        for (int ab = 0; ab < 2; ++ab) {
            const int q = q0 + (ab ? rB : rA); f32x4 o = ab ? oB0 : oA0; float l = ab ? ltB : ltA;
#pragma unroll
            for (int k = 0; k < 3; ++k) { o[0] += bf_lo(pv[ab][k].x); o[1] += bf_hi(pv[ab][k].x); o[2] += bf_lo(pv[ab][k].y); o[3] += bf_hi(pv[ab][k].y); l += pl[ab][k]; }
            const float inv = 1.f / l; u32x2 wv; wv.x = cvt_pk_bf16(o[0] * inv, o[1] * inv); wv.y = cvt_pk_bf16(o[2] * inv, o[3] * inv);
            *(u32x2*)(HCAT + (size_t)q * 2048 + 1024 + h * 128 + 16 * w + 4 * g) = wv;
        }
    }
    __syncthreads();
}

__device__ __forceinline__ void mlstm_scan(const Ctx& c) {
    unsigned char* ws = c.ws; const float* CTL = (const float*)(ws + WS_CTL_LOC); bf16_t* CTP = (bf16_t*)(ws + WS_CTP);
    const float* GC = (const float*)(ws + WS_MISC + MO_GC); const float* AMAX = (const float*)(ws + WS_MISC + MO_AMAX); float* MPREV = (float*)(ws + WS_MISC + MO_MPREV);
    const int e2 = c.bid * 512 + c.tid; constexpr int PER_H = DVP * 128 / 2;
    if (e2 >= 4 * PER_H) return;
    const int h = e2 / PER_H, rem = e2 % PER_H;
    f32x2 st = {0.f, 0.f}; float mprev = 0.f;
    for (int c0 = 0; c0 < 64; c0 += 8) {
        f32x2 loc[8];
#pragma unroll
        for (int k = 0; k < 8; ++k) loc[k] = *(const f32x2*)(CTL + ((size_t)(h * 64 + c0 + k)) * (DVP * 128) + 2 * rem);
#pragma unroll
        for (int k = 0; k < 8; ++k) { const int ch = c0 + k; const float gg = GC[h * 64 + ch], am = AMAX[h * 64 + ch];
            *(unsigned*)(CTP + ((size_t)(h * 64 + ch)) * (DVP * 128) + 2 * rem) = cvt_pk_bf16(st[0], st[1]);
            if (rem == 0) MPREV[h * 64 + ch] = mprev;
            const float mnew = fmaxf(gg + mprev, am), dec = __expf(gg + mprev - mnew), sc = __expf(am - mnew);
            st = st * dec + loc[k] * sc; mprev = mnew; }
    }
}

__device__ __forceinline__ bf16x8 scale_frag(bf16x8 f, float s) { float v[8]; unpack8(as_u4(f), v);
#pragma unroll
    for (int i = 0; i < 8; ++i) v[i] *= s;
    return as_frag(pack8(v)); }

__device__ __forceinline__ void mlstm_out(const Args& a, const Ctx& c, int h, int ch) {
    unsigned char* ws = c.ws;
    const bf16_t* QC = (const bf16_t*)(ws + WS_QC); const bf16_t* KC = (const bf16_t*)(ws + WS_KC); const bf16_t* VT = (const bf16_t*)(ws + WS_VT); const bf16_t* CTP = (const bf16_t*)(ws + WS_CTP);
    const float* BV = (const float*)(ws + WS_MISC + MO_BV); const float* UV = (const float*)(ws + WS_MISC + MO_UV); const float* PMX = (const float*)(ws + WS_MISC + MO_PMX);
    const float* MPREV = (const float*)(ws + WS_MISC + MO_MPREV); const bf16_t* PROJ = (const bf16_t*)(ws + WS_PROJ); bf16_t* HCAT = (bf16_t*)(ws + WS_HCAT);
    const int tt = c.lane & 15, g = c.lane >> 4, w = c.wave, t0 = ch * 128, trow = t0 + 16 * w + tt, tid = c.tid;
    LAS unsigned char* RA = c.lds; LAS unsigned char* RB = c.lds + 69632;
    tile256_load(RA, KC + ((size_t)(h * S + t0)) * 128, 128, 128, tid);
    tile256_load(RB, CTP + ((size_t)(h * 64 + ch)) * DVP * 128, 128, DVP, tid);
    const float b_t = BV[h * S + trow], pm_t = PMX[h * S + trow], mprev = MPREV[h * 64 + ch];
    const float m_t = b_t + fmaxf(mprev, pm_t), w_inter = __expf((b_t + mprev) - m_t), bm = b_t - m_t;
    bf16x8 qf[4], qs[4], pf[4];
#pragma unroll
    for (int kd = 0; kd < 4; ++kd) { qf[kd] = *(const bf16x8*)(QC + ((size_t)(h * S + trow)) * 128 + 32 * kd + 8 * g); qs[kd] = scale_frag(qf[kd], w_inter); }
    __syncthreads();
    u32x4 vst[9];
#pragma unroll
    for (int i = 0; i < 9; ++i) { const int idx = tid + 512 * i; if (idx < DVP * 16) vst[i] = *(const u32x4*)(VT + ((size_t)((h * 64 + ch) * DVP + (idx >> 4))) * 128 + 8 * (idx & 15)); }
    const int nsg = (w >> 1) + 1;
#pragma unroll
    for (int sg = 0; sg < 4; ++sg) {
        if (sg < nsg) {
            f32x4 s0 = {0.f, 0.f, 0.f, 0.f}, s1 = {0.f, 0.f, 0.f, 0.f};
#pragma unroll
            for (int kd = 0; kd < 4; ++kd) {
                s0 = mfma16(tile256_frag(RA, 32 * sg + pi32(0, tt), 4 * kd + g), qf[kd], s0);
                s1 = mfma16(tile256_frag(RA, 32 * sg + pi32(1, tt), 4 * kd + g), qf[kd], s1); }
            const f32x4 ua = *(const f32x4*)(UV + h * S + t0 + 32 * sg + 8 * g), ub = *(const f32x4*)(UV + h * S + t0 + 32 * sg + 8 * g + 4);
            float p[8]; const int sl = 32 * sg + 8 * g, tl = 16 * w + tt;
#pragma unroll
            for (int r = 0; r < 4; ++r) { p[r] = (sl + r <= tl) ? s0[r] * __expf(bm + ua[r]) : 0.f; p[4 + r] = (sl + 4 + r <= tl) ? s1[r] * __expf(bm + ub[r]) : 0.f; }
            pf[sg] = as_frag(pack8(p));
        } else pf[sg] = (bf16x8){0, 0, 0, 0, 0, 0, 0, 0};
    }
    f32x4 oacc[17];
#pragma unroll
    for (int mt = 0; mt < 17; ++mt) {
        f32x4 o = {0.f, 0.f, 0.f, 0.f};
#pragma unroll
        for (int kd = 0; kd < 4; ++kd) o = mfma16(tile256_frag(RB, 16 * mt + tt, 4 * kd + g), qs[kd], o);
        oacc[mt] = o;
    }
    __syncthreads();
#pragma unroll
    for (int i = 0; i < 9; ++i) { const int idx = tid + 512 * i; if (idx < DVP * 16) { const int row = idx >> 4, ck = idx & 15; *(LAS u32x4*)(RA + row * 256 + ((ck ^ (row & 15)) << 4)) = vst[i]; } }
    __syncthreads();
#pragma unroll
    for (int mt = 0; mt < 17; ++mt) {
#pragma unroll
        for (int sg = 0; sg < 4; ++sg) if (sg < nsg) oacc[mt] = mfma16(tile256_frag(RA, 16 * mt + tt, 4 * sg + g), pf[sg], oacc[mt]);
    }
    const float den = __shfl(oacc[16][0], tt);
    const float inv = 1.f / fmaxf(fabsf(den), __expf(-m_t));
    float ss = 0.f;
#pragma unroll
    for (int mt = 0; mt < 16; ++mt) { oacc[mt] = oacc[mt] * inv; ss += (oacc[mt][0] * oacc[mt][0] + oacc[mt][1] * oacc[mt][1]) + (oacc[mt][2] * oacc[mt][2] + oacc[mt][3] * oacc[mt][3]); }
    ss += __shfl_xor(ss, 16); ss += __shfl_xor(ss, 32);
    const float rstd = rsqrtf(ss * (1.f / 256.f) + EPS);
    const float* og = INF(8);
#pragma unroll
    for (int mt = 0; mt < 16; ++mt) { const int dv = 16 * mt + 4 * g;
        const f32x4 o4 = *(const f32x4*)(og + h * 256 + dv); const u32x2 mo = *(const u32x2*)(PROJ + (size_t)trow * NPROJ + PC_MO + h * 256 + dv);
        const float v0 = oacc[mt][0] * rstd * o4[0] * sigmoidf_(bf_lo(mo.x)), v1 = oacc[mt][1] * rstd * o4[1] * sigmoidf_(bf_hi(mo.x));
        const float v2 = oacc[mt][2] * rstd * o4[2] * sigmoidf_(bf_lo(mo.y)), v3 = oacc[mt][3] * rstd * o4[3] * sigmoidf_(bf_hi(mo.y));
        u32x2 wv; wv.x = cvt_pk_bf16(v0, v1); wv.y = cvt_pk_bf16(v2, v3);
        *(u32x2*)(HCAT + (size_t)trow * 2048 + h * 256 + dv) = wv; }
    __syncthreads();
}

__device__ __forceinline__ void xattn_item(const Args& a, const Ctx& c, int h, int tile) {
    unsigned char* ws = c.ws; const bf16_t* QX = (const bf16_t*)(ws + WS_QX); const bf16_t* KM = (const bf16_t*)(ws + WS_KM); const bf16_t* VTM = (const bf16_t*)(ws + WS_VTM); bf16_t* OX = (bf16_t*)(ws + WS_OX);
    const int tt = c.lane & 15, g = c.lane >> 4, w = c.wave, trow = tile * 128 + 16 * w + tt, tid = c.tid;
    const float* qg = INF(16);
    u32x4 st[4];
#define XA_LOAD(ci) do { if ((ci) < 8) { _Pragma("unroll") for (int i = 0; i < 4; ++i) { const int idx = tid + 512 * i, row = idx >> 3, ck = idx & 7; \
            st[i] = *(const u32x4*)(KM + ((size_t)(h * 256 + row)) * 512 + 64 * (ci) + 8 * ck); } } \
        else { _Pragma("unroll") for (int i = 0; i < 4; ++i) { const int idx = tid + 512 * i, row = idx >> 5, ck = idx & 31; \
            st[i] = *(const u32x4*)(VTM + ((size_t)(h * 512 + 64 * ((ci) - 8) + row)) * 256 + 8 * ck); } } } while (0)
#define XA_WRITE(ci) do { LAS unsigned char* bb = c.lds + ((ci) & 1) * 32768; if ((ci) < 8) { _Pragma("unroll") for (int i = 0; i < 4; ++i) { const int idx = tid + 512 * i, row = idx >> 3, ck = idx & 7; \
            *(LAS u32x4*)(bb + row * 128 + ((ck ^ (row & 7)) << 4)) = st[i]; } } \
        else { _Pragma("unroll") for (int i = 0; i < 4; ++i) { const int idx = tid + 512 * i, row = idx >> 5, ck = idx & 31; \
            *(LAS u32x4*)(bb + row * 512 + ((ck ^ (row & 7)) << 4)) = st[i]; } } } while (0)
    XA_LOAD(0);
    bf16x8 qf[16]; float ss = 0.f;
#pragma unroll
    for (int ks = 0; ks < 16; ++ks) { qf[ks] = *(const bf16x8*)(QX + (size_t)trow * 2048 + h * 512 + 32 * ks + 8 * g); float v[8]; unpack8(as_u4(qf[ks]), v);
#pragma unroll
        for (int i = 0; i < 8; ++i) ss += v[i] * v[i]; }
    ss += __shfl_xor(ss, 16); ss += __shfl_xor(ss, 32);
    const float rs = rsqrtf(ss * (1.f / 512.f) + EPS) * 0.04419417382415922f;
#pragma unroll
    for (int ks = 0; ks < 16; ++ks) { float v[8]; unpack8(as_u4(qf[ks]), v); const f32x4 g0 = *(const f32x4*)(qg + 32 * ks + 8 * g), g1 = *(const f32x4*)(qg + 32 * ks + 8 * g + 4);
        v[0] *= rs * g0[0]; v[1] *= rs * g0[1]; v[2] *= rs * g0[2]; v[3] *= rs * g0[3]; v[4] *= rs * g1[0]; v[5] *= rs * g1[1]; v[6] *= rs * g1[2]; v[7] *= rs * g1[3];
        qf[ks] = as_frag(pack8(v)); }
    XA_WRITE(0);
    __syncthreads();
    f32x4 sacc[16];
#pragma unroll
    for (int mt = 0; mt < 16; ++mt) sacc[mt] = (f32x4){0.f, 0.f, 0.f, 0.f};
#pragma unroll
    for (int ci = 0; ci < 8; ++ci) {
        XA_LOAD(ci + 1);
        const LAS unsigned char* bb = c.lds + (ci & 1) * 32768;
#pragma unroll
        for (int mt = 0; mt < 16; ++mt) { const int key = 32 * (mt >> 1) + pi32(mt & 1, tt);
#pragma unroll
            for (int k2 = 0; k2 < 2; ++k2) { const bf16x8 af = *(const LAS bf16x8*)(bb + key * 128 + (((4 * k2 + g) ^ (key & 7)) << 4)); sacc[mt] = mfma16(af, qf[2 * ci + k2], sacc[mt]); } }
        XA_WRITE(ci + 1);
        __syncthreads();
    }
    float mx = -INFINITY;
#pragma unroll
    for (int mt = 0; mt < 16; ++mt) mx = fmaxf(mx, fmaxf(fmaxf(sacc[mt][0], sacc[mt][1]), fmaxf(sacc[mt][2], sacc[mt][3])));
    mx = fmaxf(mx, __shfl_xor(mx, 16)); mx = fmaxf(mx, __shfl_xor(mx, 32));
    float l = 0.f; bf16x8 pf[8];
#pragma unroll
    for (int kk = 0; kk < 8; ++kk) { float p[8];
#pragma unroll
        for (int r = 0; r < 4; ++r) { p[r] = __expf(sacc[2 * kk][r] - mx); p[4 + r] = __expf(sacc[2 * kk + 1][r] - mx); }
#pragma unroll
        for (int i = 0; i < 8; ++i) l += p[i];
        pf[kk] = as_frag(pack8(p)); }
    l += __shfl_xor(l, 16); l += __shfl_xor(l, 32);
    const float inv = 1.f / l;
#pragma unroll
    for (int ci = 8; ci < 16; ++ci) {
        if (ci < 15) XA_LOAD(ci + 1);
        const LAS unsigned char* bb = c.lds + (ci & 1) * 32768;
#pragma unroll
        for (int m4 = 0; m4 < 4; ++m4) { f32x4 o0 = {0.f, 0.f, 0.f, 0.f}, o1 = o0; const int row = 16 * m4 + tt;
#pragma unroll
            for (int kk = 0; kk < 8; kk += 2) {
                const bf16x8 a0 = *(const LAS bf16x8*)(bb + row * 512 + (((4 * kk + g) ^ (row & 7)) << 4)), a1 = *(const LAS bf16x8*)(bb + row * 512 + (((4 * kk + 4 + g) ^ (row & 7)) << 4));
                o0 = mfma16(a0, pf[kk], o0); o1 = mfma16(a1, pf[kk + 1], o1); }
            const f32x4 o = (o0 + o1) * inv; u32x2 wv; wv.x = cvt_pk_bf16(o[0], o[1]); wv.y = cvt_pk_bf16(o[2], o[3]);
            *(u32x2*)(OX + (size_t)trow * 2048 + h * 512 + 64 * (ci - 8) + 16 * m4 + 4 * g) = wv; }
        if (ci < 15) XA_WRITE(ci + 1);
        __syncthreads();
    }
#undef XA_LOAD
#undef XA_WRITE
}

__device__ __forceinline__ void route_block(const Args& a, const Ctx& c) {
    unsigned char* ws = c.ws; const float* WR = (const float*)(ws + WS_MISC + MO_WR); const float* H2 = c.out;
    unsigned* ECNT = (unsigned*)(ws + WS_CTL) + CW_ECNT; float* PAIR_W = (float*)(ws + WS_MISC + MO_PAIR_W); int* ELIST = (int*)(ws + WS_ELIST);
    bf16_t* HNB = (bf16_t*)(ws + WS_HNB);
    LAS float* lg = (LAS float*)c.lds;
    LAS float* ssqp = lg + 8 * 16 * 80;
    LAS float* rsd = ssqp + 128;
    const int w = c.wave, lane = c.lane, n = lane & 15, g = lane >> 4, tw = w >> 2, kq = w & 3;
    const int r0 = (c.bid * 2 + tw) * 16;
    f32x4 acc[5];
#pragma unroll
    for (int i = 0; i < 5; ++i) acc[i] = (f32x4){0.f, 0.f, 0.f, 0.f};
    float ssq = 0.f;
    const float* arow = H2 + (size_t)(r0 + n) * 2048 + 512 * kq + 4 * g;
    const float* brow = WR + (size_t)(512 * kq + 4 * g) * 80 + n;
    for (int kk = 0; kk < 32; ++kk) {
        const f32x4 a4 = *(const f32x4*)(arow + 16 * kk);
        ssq += (a4[0] * a4[0] + a4[1] * a4[1]) + (a4[2] * a4[2] + a4[3] * a4[3]);
#pragma unroll
        for (int j = 0; j < 4; ++j)
#pragma unroll
            for (int nt = 0; nt < 5; ++nt) { const float bv = brow[(size_t)(16 * kk + j) * 80 + 16 * nt]; acc[nt] = __builtin_amdgcn_mfma_f32_16x16x4f32(a4[j], bv, acc[nt], 0, 0, 0); }
    }
    ssq += __shfl_xor(ssq, 16); ssq += __shfl_xor(ssq, 32);
#pragma unroll
    for (int nt = 0; nt < 5; ++nt)
#pragma unroll
        for (int r = 0; r < 4; ++r) lg[(w * 16 + 4 * g + r) * 80 + 16 * nt + n] = acc[nt][r];
    if (g == 0) ssqp[w * 16 + n] = ssq;
    __syncthreads();
    if (kq == 0 && lane < 16) {
        const int rr = lane; const int t = r0 + rr;
        const float sq = ssqp[(tw * 4 + 0) * 16 + rr] + ssqp[(tw * 4 + 1) * 16 + rr] + ssqp[(tw * 4 + 2) * 16 + rr] + ssqp[(tw * 4 + 3) * 16 + rr];
        const float rstd = rsqrtf(sq * (1.f / 2048.f) + EPS); rsd[tw * 16 + rr] = rstd;
        const float* bg = INF(21); const float* be = INF(23);
        float gl[8]; float gm = -INFINITY; int gs = 0;
#pragma unroll
        for (int j = 0; j < 8; ++j) { float v = 0.f;
#pragma unroll
            for (int q = 0; q < 4; ++q) v += lg[((tw * 4 + q) * 16 + rr) * 80 + j];
            gl[j] = v * rstd + bg[j]; if (gl[j] > gm) { gm = gl[j]; gs = j; } }
        float gsum = 0.f;
#pragma unroll
        for (int j = 0; j < 8; ++j) gsum += __expf(gl[j] - gm);
        const float pg = 1.f / gsum;
        float el[8]; float m0 = -INFINITY; int i0 = 0;
#pragma unroll
        for (int j = 0; j < 8; ++j) { float v = 0.f;
#pragma unroll
            for (int q = 0; q < 4; ++q) v += lg[((tw * 4 + q) * 16 + rr) * 80 + 8 + 8 * gs + j];
            el[j] = v * rstd + be[8 * gs + j]; if (el[j] > m0) { m0 = el[j]; i0 = j; } }
        float m1 = -INFINITY; int i1 = 0;
#pragma unroll
        for (int j = 0; j < 8; ++j) if (j != i0 && el[j] > m1) { m1 = el[j]; i1 = j; }
        const float e1 = __expf(m1 - m0); const float w0 = pg / (1.f + e1), w1 = pg * e1 / (1.f + e1);
        const int ea = 8 * gs + i0, eb = 8 * gs + i1;
        const int sa = (int)__hip_atomic_fetch_add(ECNT + ea, 1u, __ATOMIC_RELAXED, __HIP_MEMORY_SCOPE_AGENT);
        const int sb = (int)__hip_atomic_fetch_add(ECNT + eb, 1u, __ATOMIC_RELAXED, __HIP_MEMORY_SCOPE_AGENT);
        PAIR_W[2 * t] = w0; PAIR_W[2 * t + 1] = w1; ELIST[(size_t)ea * 8192 + sa] = 2 * t; ELIST[(size_t)eb * 8192 + sb] = 2 * t + 1;
    }
    __syncthreads();
    const float* gf = INF(19);
#pragma unroll
    for (int i = 0; i < 4; ++i) { const int rl = 4 * w + i; const int t = c.bid * 32 + rl; const float rstd = rsd[rl];
        const f32x4* xr = (const f32x4*)(H2 + (size_t)t * 2048) + lane; u32x2* o8 = (u32x2*)(HNB + (size_t)t * 2048) + lane;
#pragma unroll
        for (int j = 0; j < 8; ++j) { const f32x4 gg = *(const f32x4*)(gf + 256 * j + 4 * lane); const f32x4 y = xr[64 * j] * rstd * gg; u32x2 wv; wv.x = cvt_pk_bf16(y[0], y[1]); wv.y = cvt_pk_bf16(y[2], y[3]); o8[64 * j] = wv; } }
    __syncthreads();
}

__device__ __forceinline__ void moe_gather(const Ctx& c) {
    unsigned char* ws = c.ws; unsigned* CTLW = (unsigned*)(ws + WS_CTL); const unsigned* ECNT = CTLW + CW_ECNT;
    const int* PAIR_E = (const int*)(ws + WS_MISC + MO_PAIR_E); const int* PAIR_SLOT = (const int*)(ws + WS_MISC + MO_PAIR_SLOT); int* ROWPAIR = (int*)(ws + WS_MISC + MO_ROWPAIR);
    int* TILE_E = (int*)(ws + WS_MISC + MO_TILE_E); int* TOFF = (int*)(ws + WS_MISC + MO_TOFF);
    const bf16_t* HNB = (const bf16_t*)(ws + WS_HNB); bf16_t* XG = (bf16_t*)(ws + WS_XG);
    LAS int* toffs = (LAS int*)c.lds;
    if (c.tid < 64) { const int cn = (int)ECNT[c.tid]; const int nt = (cn + 255) >> 8; int incl = nt;
#pragma unroll
        for (int o = 1; o < 64; o <<= 1) { const int t = __shfl_up(incl, o); if (c.lane >= o) incl += t; }
        toffs[c.tid] = incl - nt; if (c.tid == 63) toffs[64] = incl;
        if (c.bid == 0) { TOFF[c.tid] = incl - nt; for (int k = 0; k < nt; ++k) TILE_E[incl - nt + k] = c.tid; if (c.tid == 63) CTLW[CW_NTILES] = (unsigned)incl; } }
    __syncthreads();
    for (int p = c.gw; p < 16384; p += c.NGW) { const int e = PAIR_E[p], sl = PAIR_SLOT[p]; const int row = toffs[e] * 256 + sl;
        const u32x4* src = (const u32x4*)(HNB + (size_t)(p >> 1) * 2048) + c.lane; u32x4* dst = (u32x4*)(XG + (size_t)row * 2048) + c.lane;
#pragma unroll
        for (int j = 0; j < 4; ++j) dst[64 * j] = src[64 * j];
        if (c.lane == 0) ROWPAIR[row] = p; }
    __syncthreads();
}

__device__ __forceinline__ void wait_vm(int n) {
    switch (n) {
        case 0: asm volatile("s_waitcnt vmcnt(0)" ::: "memory"); break;
        case 1: asm volatile("s_waitcnt vmcnt(1)" ::: "memory"); break;
        case 2: asm volatile("s_waitcnt vmcnt(2)" ::: "memory"); break;
        case 3: asm volatile("s_waitcnt vmcnt(3)" ::: "memory"); break;
        case 4: asm volatile("s_waitcnt vmcnt(4)" ::: "memory"); break;
        case 5: asm volatile("s_waitcnt vmcnt(5)" ::: "memory"); break;
        case 6: asm volatile("s_waitcnt vmcnt(6)" ::: "memory"); break;
        default: asm volatile("s_waitcnt vmcnt(7)" ::: "memory"); break;
    }
}
template <int MODE, int VAR = 0>
__device__ __forceinline__ void moe_direct(const Args& a, const Ctx& c) {
    unsigned char* ws = c.ws;
    constexpr int K = (MODE == 1) ? 2048 : 512, LDW = (MODE == 1) ? 512 : 2048, UPE = (MODE == 1) ? 8 : 16, NCH = K / 32, MAXT = 24, MROWS = MAXT * 16;
    constexpr int XBUF = MROWS * 64, WOFF = 3 * XBUF, TOFF = WOFF + 4 * 16384;
    const unsigned* ECNT = (const unsigned*)(ws + WS_CTL) + CW_ECNT; const int* ELIST = (const int*)(ws + WS_ELIST); const float* PAIR_W = (const float*)(ws + WS_MISC + MO_PAIR_W);
    const bf16_t* XSRC = (const bf16_t*)(ws + (MODE == 1 ? WS_HNB : WS_ACT)); bf16_t* ACT = (bf16_t*)(ws + (VAR ? WS_XG : WS_ACT)); bf16_t* YB = (bf16_t*)(ws + (VAR ? WS_XG : WS_YB));
    LAS unsigned char* xb = c.lds;
    LAS unsigned char* wb = c.lds + WOFF;
    LAS int* rowoff = (LAS int*)(c.lds + TOFF);
    LAS int* rowpair = rowoff + MROWS;
    LAS float* rowwt = (LAS float*)(rowpair + MROWS);
    const int tid = c.tid, lane = c.lane, w = c.wave, tt = lane & 15, g = lane >> 4;
    const int hh = w >> 2, cgp = w & 3;
    const int xcd_ = c.bid & 7, idx_ = c.bid >> 3, EPX = 32 / UPE;
    for (int r = 0; r < (64 * UPE) / 256; ++r) {
        int e, sl;
        if (c.G == 256) { e = r * (8 * EPX) + xcd_ * EPX + idx_ / UPE; sl = idx_ % UPE; } else { const int u = r * c.G + c.bid; if (u >= 64 * UPE) break; e = u / UPE; sl = u % UPE; }
        const int ne = (int)ECNT[e];
        const float* wsrc[2];
#pragma unroll
        for (int i = 0; i < 2; ++i) { const int k = 4 * w + 2 * i + (lane >> 5), q = w >> 1, sidx = lane & 31;
            if (MODE == 1) { const int h = sidx >> 4, cgs = ((sidx & 15) - 2 * q - 4 * h) & 15;
                wsrc[i] = (h ? INF(25) : INF(24)) + (size_t)e * 2048 * 512 + (size_t)k * LDW + sl * 64 + 4 * cgs; }
            else { const int cgs = (sidx - 4 * q) & 31; wsrc[i] = INF(26) + (size_t)e * 512 * 2048 + (size_t)k * LDW + sl * 128 + 4 * cgs; } }
        int wrd[2];
#pragma unroll
        for (int t = 0; t < 2; ++t) { const int wq = 2 * cgp + t;
            if (MODE == 1) { const int h = tt >> 3, cc = 8 * wq + (tt & 7); wrd[t] = ((8 * g) * 128 + 64 * h + ((cc + 8 * g + 16 * h) & 63)) * 4; }
            else { const int col = 16 * wq + tt; wrd[t] = ((8 * g) * 128 + ((col + 16 * g) & 127)) * 4; } }
        for (int m0 = 0; m0 < ne; m0 += MROWS) {
            const int mrows = min(MROWS, ne - m0), nt = (mrows + 15) >> 4;
            if (tid < MROWS) { const int rr = tid < mrows ? tid : mrows - 1; const int p = ELIST[(size_t)e * 8192 + m0 + rr];
              rowoff[tid] = (MODE == 1) ? (p >> 1) * 2048 : p * 512; rowpair[tid] = p; rowwt[tid] = PAIR_W[p]; }
            __syncthreads();
            f32x4 acc[2][12];
#pragma unroll
            for (int t = 0; t < 2; ++t)
#pragma unroll
                for (int i = 0; i < 12; ++i) acc[t][i] = (f32x4){0.f, 0.f, 0.f, 0.f};
            int roff[3];
#pragma unroll
            for (int i = 0; i < 3; ++i) roff[i] = rowoff[16 * (8 * i + w) + (lane >> 2)] + 8 * (lane & 3);
            const int nx = (VAR & 1) ? 0 : ((nt - w + 7) >> 3);
            const int nw = (VAR & 2) ? 0 : 2;
            const int xrd = tt * 64 + g * 16 + 1024 * hh;
#define MD_XDMA(ch) do { LAS unsigned char* bb = xb + ((ch) % 3) * XBUF; _Pragma("unroll") for (int i = 0; i < 3; ++i) if (i < nx) \
                __builtin_amdgcn_global_load_lds((const unsigned*)(XSRC + (size_t)roff[i] + 32 * (ch)), (LAS unsigned*)(bb + (8 * i + w) * 1024), 16, 0, 0); } while (0)
#define MD_WDMA(ch) do { LAS unsigned char* bb = wb + ((ch) & 3) * 16384; _Pragma("unroll") for (int i = 0; i < 2; ++i) if (i < nw) \
                __builtin_amdgcn_global_load_lds((const unsigned*)(wsrc[i] + (size_t)(32 * (ch)) * LDW), (LAS unsigned*)(bb + (2 * w + i) * 1024), 16, 0, 0); } while (0)
            asm volatile("s_waitcnt vmcnt(0)" ::: "memory");
            MD_WDMA(0); MD_XDMA(0); MD_WDMA(1); MD_XDMA(1); MD_WDMA(2);
            const int nmi = (nt - hh + 1) >> 1;
            for (int ch = 0; ch < NCH; ++ch) {
                wait_vm((ch + 1 < NCH ? nw + nx : 0) + (ch + 2 < NCH ? nw : 0));
                __builtin_amdgcn_s_barrier(); asm volatile("" ::: "memory");
                if (ch + 2 < NCH) MD_XDMA(ch + 2);
                if (ch + 3 < NCH) MD_WDMA(ch + 3);
                const LAS unsigned char* wsl = wb + (ch & 3) * 16384;
                float wr0[8], wr1[8];
#pragma unroll
                for (int j = 0; j < 8; ++j) { wr0[j] = *(const LAS float*)(wsl + wrd[0] + 512 * j); wr1[j] = *(const LAS float*)(wsl + wrd[1] + 512 * j); }
                u32x4 t0, t1; t0.x = cvt_pk_bf16(wr0[0], wr0[1]); t0.y = cvt_pk_bf16(wr0[2], wr0[3]); t0.z = cvt_pk_bf16(wr0[4], wr0[5]); t0.w = cvt_pk_bf16(wr0[6], wr0[7]);
                t1.x = cvt_pk_bf16(wr1[0], wr1[1]); t1.y = cvt_pk_bf16(wr1[2], wr1[3]); t1.z = cvt_pk_bf16(wr1[4], wr1[5]); t1.w = cvt_pk_bf16(wr1[6], wr1[7]);
                const bf16x8 wf0 = as_frag(t0), wf1 = as_frag(t1);
                const LAS unsigned char* bb = xb + (ch % 3) * XBUF + xrd;
#define MD_RD(X_, bq) do { _Pragma("unroll") for (int q = 0; q < 4; ++q) X_[q] = *(const LAS bf16x8*)(bb + 2048 * (4 * (bq) + q)); } while (0)
#define MD_MM(X_, bq) do { _Pragma("unroll") for (int q = 0; q < 4; ++q) { acc[0][4 * (bq) + q] = mfma16(wf0, X_[q], acc[0][4 * (bq) + q]); acc[1][4 * (bq) + q] = mfma16(wf1, X_[q], acc[1][4 * (bq) + q]); } } while (0)
                { bf16x8 xa[4], xc[4]; const bool b1 = nmi > 4, b2 = nmi > 8;
                  MD_RD(xa, 0); if (b1) MD_RD(xc, 1);
                  MD_MM(xa, 0); asm volatile("" ::: "memory");
                  if (b2) MD_RD(xa, 2);
                  if (b1) MD_MM(xc, 1);
                  if (b2) MD_MM(xa, 2); }
#undef MD_RD
#undef MD_MM
                LDS_WAIT();
            }
#undef MD_XDMA
#undef MD_WDMA
            const LAS int* rp_ = rowpair + tt + 16 * hh; const LAS float* rw_ = rowwt + tt + 16 * hh;
            asm volatile("" : "+v"(rp_), "+v"(rw_));
#pragma unroll
            for (int mi = 0; mi < 12; ++mi) if (mi < nmi) { const int row = 16 * (2 * mi + hh) + tt; const bool valid = row < mrows; const int p = rp_[32 * mi];
#pragma unroll
                for (int t = 0; t < 2; ++t) { const int wq = 2 * cgp + t;
                    if (MODE == 1) {
                        const float u0 = __shfl_xor(acc[t][mi][0], 32), u1 = __shfl_xor(acc[t][mi][1], 32), u2 = __shfl_xor(acc[t][mi][2], 32), u3 = __shfl_xor(acc[t][mi][3], 32);
                        if (valid && g < 2) { const float g0 = acc[t][mi][0], g1 = acc[t][mi][1], g2 = acc[t][mi][2], g3 = acc[t][mi][3];
                            u32x2 wv; wv.x = cvt_pk_bf16(g0 / (1.f + __expf(-g0)) * u0, g1 / (1.f + __expf(-g1)) * u1); wv.y = cvt_pk_bf16(g2 / (1.f + __expf(-g2)) * u2, g3 / (1.f + __expf(-g3)) * u3);
                            *(u32x2*)(ACT + (size_t)p * 512 + sl * 64 + 8 * wq + 4 * g) = wv; }
                    } else {
                        if (valid) { const float pw = rw_[32 * mi]; u32x2 wv; wv.x = cvt_pk_bf16(acc[t][mi][0] * pw, acc[t][mi][1] * pw); wv.y = cvt_pk_bf16(acc[t][mi][2] * pw, acc[t][mi][3] * pw);
                            *(u32x2*)(YB + (size_t)p * 2048 + sl * 128 + 16 * wq + 4 * g) = wv; }
                    }
                }
            }
            __syncthreads();
        }
    }
}

__device__ __forceinline__ void moe_combine(const Ctx& c) {
    const bf16_t* YB = (const bf16_t*)(c.ws + WS_YB);
    for (int t = c.gw; t < S; t += c.NGW) {
        f32x4* orow = (f32x4*)(c.out + (size_t)t * 2048); const u32x4* y0 = (const u32x4*)(YB + (size_t)(2 * t) * 2048); const u32x4* y1 = (const u32x4*)(YB + (size_t)(2 * t + 1) * 2048);
#pragma unroll
        for (int j = 0; j < 4; ++j) { const int ck = 64 * j + c.lane; float a8[8], b8[8]; unpack8(y0[ck], a8); unpack8(y1[ck], b8);
            f32x4 o0 = orow[2 * ck], o1 = orow[2 * ck + 1];
            o0[0] += a8[0] + b8[0]; o0[1] += a8[1] + b8[1]; o0[2] += a8[2] + b8[2]; o0[3] += a8[3] + b8[3]; o1[0] += a8[4] + b8[4]; o1[1] += a8[5] + b8[5]; o1[2] += a8[6] + b8[6]; o1[3] += a8[7] + b8[7];
            orow[2 * ck] = o0; orow[2 * ck + 1] = o1; }
    }
}

__global__ void __launch_bounds__(512, 2) mega(Args a) {
    extern __shared__ __attribute__((aligned(16))) unsigned char lds_raw[];
    Ctx c; c.lds = (LAS unsigned char*)lds_raw; c.tid = threadIdx.x; c.lane = c.tid & 63; c.wave = __builtin_amdgcn_readfirstlane(c.tid >> 6);
    c.bid = blockIdx.x; c.G = gridDim.x; c.gw = c.bid * 8 + c.wave; c.NGW = c.G * 8; c.ws = a.ws; c.out = a.out;
    unsigned char* ws = a.ws;
    const int lo = a.ph_lo, hi = a.ph_hi;
#ifdef ONLY_PH
#define IN(k) ((k) == ONLY_PH)
#else
#define IN(k) (lo <= (k) && (k) < hi)
#endif
    volatile LAS unsigned* bst = (volatile LAS unsigned*)(c.lds + 147392);
    if (c.tid < 2) bst[c.tid] = 0u;
    __syncthreads();
    XcdBarrier xbar; xbar.bar = (unsigned*)(ws + WS_CTL) + CW_BAR; xbar.x = 0; xbar.st = bst;
    if (a.single) xbar = xcd_barrier_post((unsigned*)(ws + WS_CTL) + CW_BAR, bst);
#define GSYNC(k) do { if ((k) == 0) cg::this_grid().sync(); else xcd_barrier(xbar); } while (0)
#define SEAM(k) do { if (IN(k) && IN((k) + 1)) { GSYNC(k); } } while (0)

    if (IN(0)) { phase0(a, c); __syncthreads(); }
    SEAM(0);
    if (IN(1)) {
        { pg8::Gemm g{(const bf16_t*)(ws + WS_XN), (const bf16_t*)(ws + WS_WIN), 2048}; pg8::StaticOrder So; So.init(S, NPROJ, c.G, c.bid);
          pg8::EpiBf16 E{(bf16_t*)(ws + WS_PROJ), NPROJ, nullptr};
          pg8::gemm_phase<pg8::EpiBf16, pg8::StaticOrder, true, true>(c.lds, g, So, E); }
        { pg8::Gemm g{(const bf16_t*)(ws + WS_MEMN), (const bf16_t*)(ws + WS_WKV), 2048}; pg8::StaticOrder So; So.init(MEML, 4096, c.G, c.bid);
          pg8::EpiBf16 E{(bf16_t*)(ws + WS_KVMEM), 4096, nullptr};
          pg8::gemm_phase<pg8::EpiBf16, pg8::StaticOrder, true, true>(c.lds, g, So, E); }
    }
    SEAM(1);
    if (IN(2)) {
        for (int it = c.bid; it < 256; it += c.G) prep_mlstm(a, c, it >> 6, it & 63);
        for (int it = c.bid; it < 256; it += c.G) prep_moba(a, c, it >> 5, it & 31);
        prep_xamem(a, c);
    }
    SEAM(2);
    if (IN(3)) {
        for (int it = c.bid; it < 256; it += c.G) mlstm_local(c, it >> 6, it & 63);
        for (int it = c.bid; it < 512; it += c.G) { const int cb = (it < 256) ? (31 - (it >> 4)) : ((it - 256) >> 4); moba_select(c, (it & 15) >> 1, cb, it & 1); }
    }
    SEAM(3);
    if (IN(4)) { if (c.G * 512 >= 4 * DVP * 64) mlstm_scan(c); moba_bucket_phase(c); }
    SEAM(4);
    if (IN(5)) {
        for (int it = c.bid; it < 256; it += c.G) mlstm_out(a, c, it >> 6, it & 63);
        for (int it = c.bid; it < 512; it += c.G) { const int cb = (it < 256) ? (31 - (it >> 4)) : ((it - 256) >> 4); moba_own(c, (it & 15) >> 1, cb, it & 1); }
    }
    SEAM(5);
    if (IN(6)) {
        pg8::Gemm g{(const bf16_t*)(ws + WS_HCAT), (const bf16_t*)(ws + WS_WOUT), 2048}; pg8::StaticOrder So; So.init(S, 2048, c.G, c.bid);
        pg8::EpiResid E{INF(0), a.out, (bf16_t*)(ws + WS_H1B), (float*)(ws + WS_MISC + MO_SSQ)};
        pg8::gemm_phase<pg8::EpiResid, pg8::StaticOrder, false, true>(c.lds, g, So, E);
    }
    SEAM(6);
    if (IN(7)) {
        pg8::Gemm g{(const bf16_t*)(ws + WS_H1B), (const bf16_t*)(ws + WS_WQ), 2048}; pg8::StaticOrder So; So.init(S, 2048, c.G, c.bid);
        pg8::EpiBf16 E{(bf16_t*)(ws + WS_QX), 2048, (const float*)(ws + WS_MISC + MO_SSQ)};
        pg8::gemm_phase<pg8::EpiBf16, pg8::StaticOrder, false, true>(c.lds, g, So, E);
    }
    SEAM(7);
    if (IN(8)) { for (int it = c.bid; it < 256; it += c.G) xattn_item(a, c, it & 3, it >> 2); }
    SEAM(8);
    if (IN(9)) {
        pg8::Gemm g{(const bf16_t*)(ws + WS_OX), (const bf16_t*)(ws + WS_WO), 2048}; pg8::StaticOrder So; So.init(S, 2048, c.G, c.bid);
        pg8::EpiResid E{a.out, a.out, nullptr, nullptr};
        pg8::gemm_phase<pg8::EpiResid, pg8::StaticOrder, false, true>(c.lds, g, So, E);
    }
    SEAM(9);
    if (IN(10)) { if (c.G == 256) route_block(a, c); }
    do { if (IN(10) && IN(12)) { GSYNC(10); } } while (0);
#ifdef PROBE_VAR
    if (IN(11)) moe_direct<1, PROBE_VAR>(a, c);
#endif
    if (IN(12)) moe_direct<1>(a, c);
    SEAM(12);
    if (IN(13)) moe_direct<2>(a, c);
    SEAM(13);
    if (IN(14)) moe_combine(c);
#undef IN
#undef SEAM
}

constexpr int LDS_BYTES = 147456;
extern "C" void kernel_launch(void* const* d_in, const int* in_sizes, int n_in, void* d_out, int out_size, void* d_ws, size_t ws_size, hipStream_t stream) {
    static int grid = 0;
    if (grid == 0) {
        if (n_in != 27 || out_size != S * D || ws_size < WS_END2) { fprintf(stderr, "kernel_launch: unexpected shapes (n_in %d out %d ws %zu)\n", n_in, out_size, ws_size); grid = -1; return; }
        int dev = 0, cus = 0, per_cu = 0;
        hipGetDevice(&dev); hipDeviceGetAttribute(&cus, hipDeviceAttributeMultiprocessorCount, dev);
        hipFuncSetAttribute((const void*)mega, hipFuncAttributeMaxDynamicSharedMemorySize, LDS_BYTES);
        hipOccupancyMaxActiveBlocksPerMultiprocessor(&per_cu, (const void*)mega, 512, LDS_BYTES);
        (void)hipGetLastError();
        grid = (per_cu >= 1) ? cus : -1;
        if (grid != 256) { fprintf(stderr, "kernel_launch: needs a 256-CU device with one resident block per CU (cus %d per_cu %d)\n", cus, per_cu); grid = -1; return; }
    }
    if (grid < 0) return;
    (void)hipMemsetAsync((char*)d_ws + WS_CTL, 0, CTL_ZERO_BYTES, stream);
    Args a{};
    for (int i = 0; i < 27; ++i) a.in[i] = d_in[i];
    a.out = (float*)d_out; a.ws = (unsigned char*)d_ws; a.single = MK_SINGLE; a.pad = 0;
#if MK_SINGLE
    a.ph_lo = 0; a.ph_hi = NPH;
    void* args[] = {&a};
    hipError_t e = hipLaunchCooperativeKernel((const void*)mega, dim3(grid), dim3(512), args, LDS_BYTES, stream);
    if (e != hipSuccess) fprintf(stderr, "cooperative launch failed: %s\n", hipGetErrorString(e));
#else
    for (int p = 0; p < NPH; ++p) { a.ph_lo = p; a.ph_hi = p + 1;
#ifdef REP_MASK
        const int reps = ((REP_MASK >> p) & 1) ? 3 : 1;
#else
        const int reps = 1;
#endif
        for (int r = 0; r < reps; ++r) hipLaunchKernelGGL(mega, dim3(grid), dim3(512), LDS_BYTES, stream, a); }
#endif
}
```

```cpp
#include <hip/hip_runtime.h>
#include <hip/hip_cooperative_groups.h>
#include <cstdio>
#include <cstdint>
namespace cg = cooperative_groups;

#ifndef MK_SINGLE
#define MK_SINGLE 1
#endif

#define LAS __attribute__((address_space(3)))
typedef unsigned short bf16_t;
typedef short bf16x8 __attribute__((ext_vector_type(8)));
typedef float f32x4 __attribute__((ext_vector_type(4)));
typedef float f32x2 __attribute__((ext_vector_type(2)));
typedef unsigned u32x4 __attribute__((ext_vector_type(4)));
typedef unsigned u32x2 __attribute__((ext_vector_type(2)));

constexpr int S = 8192, D = 2048, DIN = 6152, NPROJ = 6144, MEML = 256;
constexpr int NPH = 15;
constexpr float EPS = 1e-6f;
constexpr int PC_MQ = 0, PC_MK = 512, PC_MV = 1024, PC_MO = 2048, PC_AQ = 3072, PC_AK = 4096, PC_AV = 5120;
constexpr int DVP = 272;

constexpr size_t MiB = 1u << 20;
constexpr size_t WS_CTL = 0;
constexpr size_t WS_WIN = 1 * MiB;
constexpr size_t WS_WOUT = 25 * MiB;
constexpr size_t WS_WQ = 33 * MiB;
constexpr size_t WS_WKV = 41 * MiB;
constexpr size_t WS_WO = 57 * MiB;
constexpr size_t WS_WGU = 65 * MiB;
constexpr size_t WS_WD = 321 * MiB;
constexpr size_t WS_XN = 449 * MiB;
constexpr size_t WS_MEMN = 481 * MiB;
constexpr size_t WS_PROJ = 482 * MiB;
constexpr size_t WS_KVMEM = 578 * MiB;
constexpr size_t WS_QC = 580 * MiB;
constexpr size_t WS_KC = 588 * MiB;
constexpr size_t WS_KWT = 596 * MiB;
constexpr size_t WS_VT = 604 * MiB;
constexpr size_t WS_CTL_LOC = 621 * MiB;
constexpr size_t WS_CTP = 655 * MiB;
constexpr size_t WS_QP = 672 * MiB;
constexpr size_t WS_KP = 688 * MiB;
constexpr size_t WS_VTP = 704 * MiB;
constexpr size_t WS_KM = 720 * MiB;
constexpr size_t WS_VTM = 721 * MiB;
constexpr size_t WS_HCAT = 722 * MiB;
constexpr size_t WS_H1B = 754 * MiB;
constexpr size_t WS_QX = 786 * MiB;
constexpr size_t WS_OX = 818 * MiB;
constexpr size_t WS_MISC = 850 * MiB;
constexpr size_t WS_ACT = 854 * MiB;
constexpr size_t WS_YB = 886 * MiB;
constexpr size_t WS_END = 950 * MiB;
constexpr size_t WS_PART = WS_END;
constexpr size_t WS_BLIST = WS_END + 48 * MiB;
constexpr size_t WS_LPART = WS_END + 52 * MiB;
constexpr size_t WS_PSLOT = WS_END + 53 * MiB;
constexpr size_t WS_POFF = WS_END + 54 * MiB;
constexpr size_t WS_ELIST = WS_END + 56 * MiB;
constexpr size_t WS_END2 = WS_END + 58 * MiB;
constexpr size_t WS_KVSLAB = WS_ACT;
constexpr size_t WS_H1F = WS_PROJ;
constexpr size_t WS_XG = WS_PROJ;
constexpr size_t WS_HNB = WS_XN;
constexpr size_t MO_GATES = 0;
constexpr size_t MO_BV = 256 * 1024;
constexpr size_t MO_UV = 384 * 1024;
constexpr size_t MO_PMX = 512 * 1024;
constexpr size_t MO_GC = 640 * 1024;
constexpr size_t MO_AMAX = 641 * 1024;
constexpr size_t MO_MPREV = 642 * 1024;
constexpr size_t MO_KMEAN = 648 * 1024;
constexpr size_t MO_SSQ = 1024 * 1024;
constexpr size_t MO_WR = 2048 * 1024;
constexpr size_t MO_PAIR_E = 2752 * 1024;
constexpr size_t MO_PAIR_SLOT = 2816 * 1024;
constexpr size_t MO_PAIR_W = 2880 * 1024;
constexpr size_t MO_ROWPAIR = 2944 * 1024;
constexpr size_t MO_TILE_E = 3072 * 1024;
constexpr size_t MO_TOFF = 3073 * 1024;
constexpr int CW_ECNT = 1024;
constexpr int CW_NTILES = 1100;
constexpr int CW_BCNT = 1280;
constexpr int CW_BAR = 4096;
constexpr size_t CTL_ZERO_BYTES = 65536;

struct Args { const void* in[27]; float* out; unsigned char* ws; int ph_lo, ph_hi; int single, pad; };

__device__ __forceinline__ unsigned cvt_pk_bf16(float lo, float hi) { unsigned r; asm("v_cvt_pk_bf16_f32 %0, %1, %2" : "=v"(r) : "v"(lo), "v"(hi)); return r; }
__device__ __forceinline__ float bf_lo(unsigned u) { return __uint_as_float(u << 16); }
__device__ __forceinline__ float bf_hi(unsigned u) { return __uint_as_float(u & 0xffff0000u); }
__device__ __forceinline__ float bf1(bf16_t h) { return __uint_as_float(((unsigned)h) << 16); }
__device__ __forceinline__ bf16_t f2bf(float f) { return (bf16_t)(cvt_pk_bf16(f, 0.f) & 0xffffu); }
__device__ __forceinline__ void unpack8(u32x4 v, float (&f)[8]) {
    f[0] = bf_lo(v.x); f[1] = bf_hi(v.x); f[2] = bf_lo(v.y); f[3] = bf_hi(v.y); f[4] = bf_lo(v.z); f[5] = bf_hi(v.z); f[6] = bf_lo(v.w); f[7] = bf_hi(v.w);
}
__device__ __forceinline__ u32x4 pack8(const float (&f)[8]) {
    u32x4 v; v.x = cvt_pk_bf16(f[0], f[1]); v.y = cvt_pk_bf16(f[2], f[3]); v.z = cvt_pk_bf16(f[4], f[5]); v.w = cvt_pk_bf16(f[6], f[7]); return v;
}
__device__ __forceinline__ bf16x8 as_frag(u32x4 v) { return __builtin_bit_cast(bf16x8, v); }
__device__ __forceinline__ u32x4 as_u4(bf16x8 v) { return __builtin_bit_cast(u32x4, v); }
__device__ __forceinline__ float wave_sum(float v) {
#pragma unroll
    for (int o = 1; o < 64; o <<= 1) v += __shfl_xor(v, o);
    return v;
}
__device__ __forceinline__ float sigmoidf_(float x) { return 1.f / (1.f + __expf(-x)); }
__device__ __forceinline__ f32x4 mfma16(bf16x8 a, bf16x8 b, f32x4 c) { return __builtin_amdgcn_mfma_f32_16x16x32_bf16(a, b, c, 0, 0, 0); }
__device__ __forceinline__ int pi32(int tq, int i) { return 8 * (i >> 2) + 4 * tq + (i & 3); }
#define LDS_WAIT() asm volatile("s_waitcnt lgkmcnt(0)" ::: "memory")

namespace pg8 {
constexpr int BM = 256, BK = 64, HALF = 128, HTB = HALF * BK * 2, STAGE_BYTES = 8 * HTB, NXCD = 8, WGM = 8;
__device__ __forceinline__ int lds_byte(int r, int c) { const int st = (r >> 4) * 2 + (c >> 5), rr = r & 15, cc = c & 31, ob = rr * 64 + cc * 2; return st * 1024 + (ob ^ (((ob >> 9) & 1) << 5)); }
__device__ __forceinline__ void stage_rc(int b, int& R, int& C) { const int st = b / 1024, sb = b % 1024, swz = sb ^ (((sb >> 9) & 1) << 5); R = (st >> 1) * 16 + swz / 64; C = (st & 1) * 32 + (swz % 64) / 2; }
__device__ __forceinline__ int perm32(int rho) { const int n = rho >> 4, i = rho & 15; return 8 * (i >> 2) + 4 * n + (i & 3); }
struct Unit { int pm, pn, ks; };
struct Gemm { const bf16_t* A; const bf16_t* Bt; int K; int ld; };
struct StaticOrder {
    int nM, nN, nwg, G, c;
    __device__ void init(int M, int N, int G_, int c_) { nM = M / BM; nN = N / BM; nwg = nM * nN; G = G_; c = c_; }
    __device__ bool next(int i, Unit& u) const {
        const long L = (long)i * G + c; if (L >= nwg) return false;
        int wgid = (int)L; { const int q = nwg / NXCD, r = nwg % NXCD, xcd = wgid % NXCD, off = wgid / NXCD; wgid = (xcd < r ? xcd * (q + 1) : r * (q + 1) + (xcd - r) * q) + off; }
        const int nig = WGM * nN, gid = wgid / nig, fm = gid * WGM, gsz = (nM - fm) < WGM ? (nM - fm) : WGM;
        u.pm = fm + ((wgid % nig) % gsz); u.pn = (wgid % nig) / gsz; u.ks = 0; return true;
    }
};
struct SplitOrder {
    int nN, nS, G, c;
    __device__ bool next(int i, Unit& u) const { const long L = (long)i * G + c; if (L >= (long)nN * nS) return false; u.pm = 0; u.pn = (int)(L / nS); u.ks = (int)(L % nS); return true; }
};
struct GroupedOrder {
    const int* tile_e; int ntiles, nN, G, c;
    __device__ bool next(int i, Unit& u) const {
        const long L = (long)i * G + c; if (L >= (long)ntiles * nN) return false;
        const int pm = (int)(L / nN), pl = (int)(L % nN);
        const int e = __builtin_amdgcn_readfirstlane(__hip_atomic_load(tile_e + pm, __ATOMIC_RELAXED, __HIP_MEMORY_SCOPE_AGENT));
        u.pm = pm; u.pn = e * nN + pl; u.ks = 0; return true;
    }
};

template <class Epi, class Sched, bool ALIGN_EPI, bool SP2>
__device__ __forceinline__ void gemm_phase(LAS unsigned char* lds, const Gemm g, const Sched& S, const Epi& E) {
    const int tid = threadIdx.x, wid = __builtin_amdgcn_readfirstlane(tid >> 6), lane = tid & 63, wr = wid >> 2, wc = wid & 3, fr = lane & 15, fq = lane >> 4;
    const int K = g.ld, nt = g.K / BK;
    unsigned voffA[2], voffB[2];
#pragma unroll
    for (int i = 0; i < 2; ++i) { int R, C; stage_rc(tid * 16 + i * 8192, R, C); const int Rb = Epi::PERM ? ((R & ~31) + perm32(R & 31)) : R;
        voffA[i] = (unsigned)(R * K + C) * 2u; voffB[i] = (unsigned)(Rb * K + C) * 2u; }
    const size_t kstep = (size_t)(BK * 2);
    const size_t hstep = (size_t)HALF * K * 2;
    const size_t tstep = 2 * hstep;
    const unsigned ldsw = (unsigned)wid * 1024u;
    const int aoff = lds_byte(wr * 64 + fr, fq * 8), boff = lds_byte(wc * 32 + fr, fq * 8);
#define PG8_SA(b, h) (((b) * 2 + (h)) * HTB)
#define PG8_SB(b, h) ((4 + (b) * 2 + (h)) * HTB)
#define PG8_STAGE(bufoff, gbase, voff) do { _Pragma("unroll") for (int _i = 0; _i < 2; ++_i) \
        __builtin_amdgcn_global_load_lds((const unsigned*)((const char*)(gbase) + (voff)[_i]), (LAS unsigned*)(lds + (bufoff) + ldsw + _i * 8192), 16, 0, 0); } while (0)
#define PG8_LDA(dst, b, h) do { _Pragma("unroll") for (int m = 0; m < 4; ++m) _Pragma("unroll") for (int k = 0; k < 2; ++k) dst[m][k] = *(const LAS bf16x8*)(lds + PG8_SA(b, h) + aoff + m * 2048 + k * 1024); } while (0)
#define PG8_LDB(dst, b, h) do { _Pragma("unroll") for (int n = 0; n < 2; ++n) _Pragma("unroll") for (int k = 0; k < 2; ++k) dst[n][k] = *(const LAS bf16x8*)(lds + PG8_SB(b, h) + boff + n * 2048 + k * 1024); } while (0)
#define PG8_MMA(ai, bj, At, Bt) do { __builtin_amdgcn_s_setprio(1); _Pragma("unroll") for (int m = 0; m < 4; ++m) _Pragma("unroll") for (int n = 0; n < 2; ++n) _Pragma("unroll") for (int k = 0; k < 2; ++k) \
        acc[ai][bj][m][n] = __builtin_amdgcn_mfma_f32_16x16x32_bf16(Bt[n][k], At[m][k], acc[ai][bj][m][n], 0, 0, 0); __builtin_amdgcn_s_setprio(0); } while (0)
#define PG8_WAIT_V(n) asm volatile("s_waitcnt vmcnt(" #n ")" ::: "memory")
#define PG8_WAIT_L(n) asm volatile("s_waitcnt lgkmcnt(" #n ")" ::: "memory")
#define PG8_BAR __builtin_amdgcn_s_barrier()
#define PG8_SCHED __builtin_amdgcn_sched_barrier(0)
    Unit cur, nxt; int ui = 0;
    if (!S.next(0, cur)) return;
    f32x4 acc[2][2][4][2];
#pragma unroll
    for (int a = 0; a < 2; ++a)
#pragma unroll
        for (int b = 0; b < 2; ++b)
#pragma unroll
            for (int m = 0; m < 4; ++m)
#pragma unroll
                for (int n = 0; n < 2; ++n) acc[a][b][m][n] = (f32x4){0.f, 0.f, 0.f, 0.f};
    bf16x8 At[4][2], B0[2][2], B1[2][2];
    const char* cA = (const char*)g.A + (size_t)cur.pm * tstep + (size_t)cur.ks * g.K * 2; const char* cB = (const char*)g.Bt + (size_t)cur.pn * tstep + (size_t)cur.ks * g.K * 2;
    if constexpr (SP2) {
        PG8_STAGE(PG8_SB(0, 0), cB, voffB); PG8_STAGE(PG8_SB(0, 1), cB + hstep, voffB); PG8_STAGE(PG8_SA(0, 0), cA, voffA); PG8_STAGE(PG8_SA(0, 1), cA + hstep, voffA);
        if (wr == 1) PG8_BAR;
        PG8_WAIT_V(2); PG8_BAR;
        PG8_STAGE(PG8_SB(1, 0), cB + kstep, voffB); PG8_STAGE(PG8_SA(1, 0), cA + kstep, voffA); PG8_STAGE(PG8_SB(1, 1), cB + hstep + kstep, voffB);
        PG8_WAIT_V(6); PG8_BAR;
    } else {
        PG8_STAGE(PG8_SB(0, 0), cB, voffB); PG8_STAGE(PG8_SA(0, 0), cA, voffA); PG8_STAGE(PG8_SB(0, 1), cB + hstep, voffB); PG8_STAGE(PG8_SA(0, 1), cA + hstep, voffA);
        if (wr == 1) PG8_BAR;
        PG8_WAIT_V(4); PG8_BAR;
        PG8_STAGE(PG8_SB(1, 0), cB + kstep, voffB); PG8_STAGE(PG8_SA(1, 0), cA + kstep, voffA); PG8_STAGE(PG8_SB(1, 1), cB + hstep + kstep, voffB);
        PG8_WAIT_V(6); PG8_BAR;
    }
    for (;;) {
        const bool has_next = S.next(ui + 1, nxt);
        const char* nA = has_next ? (const char*)g.A + (size_t)nxt.pm * tstep + (size_t)nxt.ks * g.K * 2 : cA; const char* nB = has_next ? (const char*)g.Bt + (size_t)nxt.pn * tstep + (size_t)nxt.ks * g.K * 2 : cB;
        for (int t = 0; t < nt; t += 2) {
            const bool last = (t == nt - 2);
            const char* a1 = cA + (size_t)(t + 1) * kstep;
            const char* a2 = last ? nA : cA + (size_t)(t + 2) * kstep; const char* b2 = last ? nB : cB + (size_t)(t + 2) * kstep;
            const char* a3 = a2 + kstep; const char* b3 = b2 + kstep;
            if constexpr (SP2) {
            PG8_LDB(B0, 0, 0); PG8_LDB(B1, 0, 1); PG8_SCHED; PG8_LDA(At, 0, 0); PG8_STAGE(PG8_SA(1, 1), a1 + hstep, voffA);
            PG8_WAIT_V(8); PG8_WAIT_L(0); PG8_BAR; PG8_MMA(0, 0, At, B0); PG8_MMA(0, 1, At, B1); PG8_BAR; PG8_SCHED;
            PG8_LDA(At, 0, 1); PG8_STAGE(PG8_SB(0, 0), b2, voffB); PG8_STAGE(PG8_SB(0, 1), b2 + hstep, voffB); PG8_STAGE(PG8_SA(0, 0), a2, voffA);
            PG8_WAIT_V(8); PG8_WAIT_L(0); PG8_BAR; PG8_MMA(1, 0, At, B0); PG8_MMA(1, 1, At, B1); PG8_BAR; PG8_SCHED;
            PG8_LDB(B0, 1, 0); PG8_LDB(B1, 1, 1); PG8_SCHED; PG8_LDA(At, 1, 0); PG8_STAGE(PG8_SA(0, 1), a2 + hstep, voffA);
            PG8_WAIT_V(8); PG8_WAIT_L(0); PG8_BAR; PG8_MMA(0, 0, At, B0); PG8_MMA(0, 1, At, B1); PG8_BAR; PG8_SCHED;
            PG8_LDA(At, 1, 1); PG8_STAGE(PG8_SB(1, 0), b3, voffB); PG8_STAGE(PG8_SB(1, 1), b3 + hstep, voffB); PG8_STAGE(PG8_SA(1, 0), a3, voffA);
            PG8_WAIT_V(8); PG8_WAIT_L(0); PG8_BAR; PG8_MMA(1, 0, At, B0); PG8_MMA(1, 1, At, B1); PG8_BAR; PG8_SCHED;
            } else {
            PG8_LDB(B0, 0, 0); PG8_SCHED; PG8_LDA(At, 0, 0); PG8_STAGE(PG8_SA(1, 1), a1 + hstep, voffA);
            PG8_WAIT_L(8); PG8_BAR; PG8_WAIT_L(0); PG8_MMA(0, 0, At, B0); PG8_BAR; PG8_SCHED;
            PG8_LDB(B1, 0, 1); PG8_STAGE(PG8_SB(0, 0), b2, voffB);
            PG8_BAR; PG8_WAIT_L(0); PG8_MMA(0, 1, At, B1); PG8_BAR;
            PG8_LDA(At, 0, 1); PG8_STAGE(PG8_SA(0, 0), a2, voffA);
            PG8_BAR; PG8_WAIT_L(0); PG8_MMA(1, 0, At, B0); PG8_BAR; PG8_SCHED;
            PG8_STAGE(PG8_SB(0, 1), b2 + hstep, voffB);
            PG8_WAIT_V(6); PG8_BAR; PG8_MMA(1, 1, At, B1); PG8_BAR;
            PG8_LDB(B0, 1, 0); PG8_SCHED; PG8_LDA(At, 1, 0); PG8_STAGE(PG8_SA(0, 1), a2 + hstep, voffA);
            PG8_WAIT_L(8); PG8_BAR; PG8_WAIT_L(0); PG8_MMA(0, 0, At, B0); PG8_BAR; PG8_SCHED;
            PG8_LDB(B1, 1, 1); PG8_STAGE(PG8_SB(1, 0), b3, voffB);
            PG8_BAR; PG8_WAIT_L(0); PG8_MMA(0, 1, At, B1); PG8_BAR;
            PG8_LDA(At, 1, 1); PG8_STAGE(PG8_SA(1, 0), a3, voffA);
            PG8_BAR; PG8_WAIT_L(0); PG8_MMA(1, 0, At, B0); PG8_BAR; PG8_SCHED;
            PG8_STAGE(PG8_SB(1, 1), b3 + hstep, voffB);
            PG8_WAIT_V(6); PG8_BAR; PG8_MMA(1, 1, At, B1); PG8_BAR;
            }
        }
        if constexpr (ALIGN_EPI) { if (wr == 0) PG8_BAR; }
        E(acc, cur, wr, wc, fr, fq);
        if (!has_next) break;
#pragma unroll
        for (int a = 0; a < 2; ++a)
#pragma unroll
            for (int b = 0; b < 2; ++b)
#pragma unroll
                for (int m = 0; m < 4; ++m)
#pragma unroll
                    for (int n = 0; n < 2; ++n) acc[a][b][m][n] = (f32x4){0.f, 0.f, 0.f, 0.f};
        cur = nxt; cA = nA; cB = nB; ++ui;
        if constexpr (ALIGN_EPI) { if (wr == 1) PG8_BAR; }
    }
    PG8_WAIT_V(0);
    if constexpr (!ALIGN_EPI) { if (wr == 0) PG8_BAR; }
    PG8_BAR;
#undef PG8_SA
#undef PG8_SB
#undef PG8_STAGE
#undef PG8_LDA
#undef PG8_LDB
#undef PG8_MMA
#undef PG8_WAIT_V
#undef PG8_WAIT_L
#undef PG8_BAR
#undef PG8_SCHED
}

struct EpiBf16 {
    static constexpr bool PERM = true;
    bf16_t* O; int ldc; const float* ssq;
    __device__ __forceinline__ void operator()(const f32x4 (&acc)[2][2][4][2], const Unit& u, int wr, int wc, int fr, int fq) const {
        const int row0 = u.pm * BM + wr * 64 + fr, col0 = u.pn * BM + wc * 32 + 8 * fq;
#pragma unroll
        for (int ai = 0; ai < 2; ++ai)
#pragma unroll
            for (int m = 0; m < 4; ++m) {
                const int row = row0 + ai * HALF + m * 16; float sc = 1.f;
                if (ssq) { const f32x4* p = (const f32x4*)(ssq + (size_t)row * 32); float s = 0.f;
#pragma unroll
                    for (int q = 0; q < 8; ++q) { const f32x4 v = p[q]; s += (v[0] + v[1]) + (v[2] + v[3]); }
                    sc = rsqrtf(s * (1.f / 2048.f) + EPS); }
                bf16_t* rowp = O + (size_t)row * ldc + col0;
#pragma unroll
                for (int bj = 0; bj < 2; ++bj) { const f32x4 v0 = acc[ai][bj][m][0] * sc, v1 = acc[ai][bj][m][1] * sc;
                    u32x4 w; w.x = cvt_pk_bf16(v0[0], v0[1]); w.y = cvt_pk_bf16(v0[2], v0[3]); w.z = cvt_pk_bf16(v1[0], v1[1]); w.w = cvt_pk_bf16(v1[2], v1[3]);
                    *(u32x4*)(rowp + bj * HALF) = w; }
            }
    }
};
struct EpiResid {
    static constexpr bool PERM = false;
    const float* base; float* out; bf16_t* hb; float* ssq;
    __device__ __forceinline__ void operator()(const f32x4 (&acc)[2][2][4][2], const Unit& u, int wr, int wc, int fr, int fq) const {
        const int row0 = u.pm * BM + wr * 64 + fr, col0 = u.pn * BM + wc * 32 + 4 * fq;
#pragma unroll
        for (int ai = 0; ai < 2; ++ai)
#pragma unroll
            for (int m = 0; m < 4; ++m) {
                const int row = row0 + ai * HALF + m * 16; const size_t off = (size_t)row * 2048 + col0; float s = 0.f;
#pragma unroll
                for (int bj = 0; bj < 2; ++bj)
#pragma unroll
                    for (int n = 0; n < 2; ++n) {
                        const f32x4 b = *(const f32x4*)(base + off + bj * HALF + n * 16); const f32x4 o = b + acc[ai][bj][m][n];
                        *(f32x4*)(out + off + bj * HALF + n * 16) = o;
                        if (hb) { u32x2 w; w.x = cvt_pk_bf16(o[0], o[1]); w.y = cvt_pk_bf16(o[2], o[3]); *(u32x2*)(hb + off + bj * HALF + n * 16) = w;
                            s += (o[0] * o[0] + o[1] * o[1]) + (o[2] * o[2] + o[3] * o[3]); }
                    }
                if (hb) { s += __shfl_xor(s, 16); s += __shfl_xor(s, 32); if (fq == 0) ssq[(size_t)row * 32 + u.pn * 4 + wc] = s; }
            }
    }
};
struct EpiSlab {
    static constexpr bool PERM = false;
    float* slab; int ldc; size_t slab_stride;
    __device__ __forceinline__ void operator()(const f32x4 (&acc)[2][2][4][2], const Unit& u, int wr, int wc, int fr, int fq) const {
        float* base = slab + (size_t)u.ks * slab_stride; unsigned off = (unsigned)((u.pm * BM + wr * 64 + fr) * ldc + u.pn * BM + wc * 32 + 4 * fq);
#pragma unroll
        for (int ai = 0; ai < 2; ++ai)
#pragma unroll
            for (int m = 0; m < 4; ++m) { float* rowp = base + off + (unsigned)((ai * HALF + m * 16) * ldc);
#pragma unroll
                for (int bj = 0; bj < 2; ++bj)
#pragma unroll
                    for (int n = 0; n < 2; ++n) *(f32x4*)(rowp + bj * HALF + n * 16) = acc[ai][bj][m][n];
                asm volatile("" ::: "memory"); }
    }
};
struct EpiMoe1 {
    static constexpr bool PERM = true;
    bf16_t* act;
    __device__ __forceinline__ void operator()(const f32x4 (&acc)[2][2][4][2], const Unit& u, int wr, int wc, int fr, int fq) const {
        const int row0 = u.pm * BM + wr * 64 + fr, col0 = (u.pn & 3) * 128 + wc * 32 + 8 * fq;
#pragma unroll
        for (int ai = 0; ai < 2; ++ai)
#pragma unroll
            for (int m = 0; m < 4; ++m) {
                const int row = row0 + ai * HALF + m * 16; float v[8];
#pragma unroll
                for (int n = 0; n < 2; ++n)
#pragma unroll
                    for (int i = 0; i < 4; ++i) { const float gt = acc[ai][0][m][n][i], up = acc[ai][1][m][n][i]; v[n * 4 + i] = gt / (1.f + __expf(-gt)) * up; }
                *(u32x4*)(act + (size_t)row * 512 + col0) = pack8(v);
            }
    }
};
struct EpiMoe2 {
    static constexpr bool PERM = true;
    bf16_t* yb; const int* rowpair; const float* pair_w; const int* tile_e; const int* toff; const unsigned* ecnt;
    __device__ __forceinline__ void operator()(const f32x4 (&acc)[2][2][4][2], const Unit& u, int wr, int wc, int fr, int fq) const {
        const int e = tile_e[u.pm]; const int base_slot = (u.pm - toff[e]) * 256; const int cnt = (int)ecnt[e];
        const int col0 = (u.pn & 7) * 256 + wc * 32 + 8 * fq;
        int prs[8]; float pws[8];
#pragma unroll
        for (int q = 0; q < 8; ++q) { const int rr = wr * 64 + fr + (q >> 2) * HALF + (q & 3) * 16; const int rc = (base_slot + rr < cnt) ? rr : 0; prs[q] = rowpair[u.pm * 256 + rc]; }
#pragma unroll
        for (int q = 0; q < 8; ++q) pws[q] = pair_w[prs[q]];
#pragma unroll
        for (int ai = 0; ai < 2; ++ai)
#pragma unroll
            for (int m = 0; m < 4; ++m) {
                const int rr = wr * 64 + fr + ai * HALF + m * 16;
                if (base_slot + rr < cnt) {
                    const int pr = prs[ai * 4 + m]; const float w = pws[ai * 4 + m];
                    bf16_t* rowp = yb + (size_t)pr * 2048 + col0;
#pragma unroll
                    for (int bj = 0; bj < 2; ++bj) { const f32x4 v0 = acc[ai][bj][m][0] * w, v1 = acc[ai][bj][m][1] * w;
                        u32x4 x; x.x = cvt_pk_bf16(v0[0], v0[1]); x.y = cvt_pk_bf16(v0[2], v0[3]); x.z = cvt_pk_bf16(v1[0], v1[1]); x.w = cvt_pk_bf16(v1[2], v1[3]);
                        *(u32x4*)(rowp + bj * HALF) = x; }
                }
            }
    }
};
}

#define XB_TMO      128
#define XB_XCNT(j)  (256  + 64 * (j))
#define XB_XSUB(j)  (1280 + 64 * (j))
#define XB_XGEN(j)  (2304 + 64 * (j))
#define XB_TOP      3328
#define XB_TOPGEN   3392
#define XCD_BAR_WORDS 3456
#define XB_SPIN_CAP (1u << 18)
__device__ __forceinline__ unsigned xb_ld(unsigned* p)              { return __hip_atomic_load(p, __ATOMIC_RELAXED, __HIP_MEMORY_SCOPE_AGENT); }
__device__ __forceinline__ unsigned xb_add(unsigned* p, unsigned v) { return __hip_atomic_fetch_add(p, v, __ATOMIC_RELAXED, __HIP_MEMORY_SCOPE_AGENT); }
__device__ __forceinline__ unsigned xb_xcc_id() { return (unsigned)__builtin_amdgcn_s_getreg((3 << 11) | 20) & 0xFu; }
#define XB_SPIN(cond, bar) do { unsigned _sp = 0; while (cond) { __builtin_amdgcn_s_sleep(1); \
    if ((++_sp & 255u) == 0u) { if (xb_ld(&(bar)[XB_TMO])) break; if (_sp > XB_SPIN_CAP) { atomicAdd(&(bar)[XB_TMO], 1u); break; } } } } while (0)
struct XcdBarrier { unsigned* bar; unsigned x; volatile LAS unsigned* st; };
__device__ __forceinline__ XcdBarrier xcd_barrier_post(unsigned* bar, volatile LAS unsigned* st) {
    XcdBarrier b; b.bar = bar; b.x = xb_xcc_id(); b.st = st;
    if (threadIdx.x == 0) (void)xb_add(&bar[XB_XCNT(b.x)], 1u);
    return b;
}
__device__ __forceinline__ void xcd_barrier_complete(unsigned* bar, unsigned x, unsigned& nloc, unsigned& nx) {
    const unsigned G = gridDim.x * gridDim.y * gridDim.z;
    unsigned sum, cnt, mine, sp = 0u;
    for (;;) {
        sum = 0u; cnt = 0u; mine = 0u;
#pragma unroll
        for (unsigned j = 0; j < 16; ++j) { const unsigned cc = xb_ld(&bar[XB_XCNT(j)]); sum += cc; cnt += (cc > 0u) ? 1u : 0u; mine = (j == x) ? cc : mine; }
        if (sum == G) break;
        __builtin_amdgcn_s_sleep(1);
        if ((++sp & 255u) == 0u) { if (xb_ld(&bar[XB_TMO])) break; if (sp > XB_SPIN_CAP) { atomicAdd(&bar[XB_TMO], 1u); break; } }
    }
    nloc = mine > 0u ? mine : 1u; nx = cnt > 0u ? cnt : 1u;
}
__device__ __forceinline__ void xcd_barrier(const XcdBarrier& b) {
    asm volatile("s_waitcnt vmcnt(0)" ::: "memory");
    __syncthreads();
    if (threadIdx.x == 0) {
        unsigned* bar = b.bar;
        __builtin_amdgcn_s_waitcnt(0);
        unsigned nloc = b.st[0], nx = b.st[1];
        if (nloc == 0u) { xcd_barrier_complete(bar, b.x, nloc, nx); b.st[0] = nloc; b.st[1] = nx; }
        const unsigned old = xb_add(&bar[XB_XSUB(b.x)], 1u);
        const unsigned gen = old / nloc;
        if (old + 1u == (gen + 1u) * nloc) {
            __builtin_amdgcn_fence(__ATOMIC_RELEASE, "agent");
            asm volatile("s_waitcnt vmcnt(0)" ::: "memory");
            const unsigned og = xb_add(&bar[XB_TOP], 1u);
            const unsigned tg = og / nx;
            if (og + 1u == (tg + 1u) * nx) xb_add(&bar[XB_TOPGEN], 1u);
            else XB_SPIN(xb_ld(&bar[XB_TOPGEN]) == tg, bar);
            __builtin_amdgcn_fence(__ATOMIC_ACQUIRE, "agent");
            xb_add(&bar[XB_XGEN(b.x)], 1u);
            asm volatile("s_waitcnt vmcnt(0)" ::: "memory");
        } else {
            XB_SPIN(xb_ld(&bar[XB_XGEN(b.x)]) == gen, bar);
            __builtin_amdgcn_fence(__ATOMIC_ACQUIRE, "agent");
            asm volatile("s_waitcnt vmcnt(0)" ::: "memory");
        }
    }
    __syncthreads();
}

struct Ctx {
    LAS unsigned char* lds;
    int tid, lane, wave, bid, G, gw, NGW;
    unsigned char* ws; float* out;
};
#define INF(i) ((const float*)a.in[i])

__device__ __forceinline__ void transpose_item(const float* __restrict__ W, int ldw, int k0, int n_src0, bf16_t* WT, int K_dst, LAS float* scr, int lane, const float* kscale) {
#pragma unroll 8
    for (int i = 0; i < 32; ++i) { const int kk = 2 * i + (lane >> 5); float v = W[(size_t)(k0 + kk) * ldw + n_src0 + (lane & 31)]; if (kscale) v *= kscale[k0 + kk]; scr[kk * 33 + (lane & 31)] = v; }
    LDS_WAIT();
    const int c = lane & 7;
#pragma unroll
    for (int j = 0; j < 4; ++j) { const int n = (lane >> 3) + 8 * j; const LAS float* s = scr + (8 * c) * 33 + n;
        u32x4 o; o.x = cvt_pk_bf16(s[0 * 33], s[1 * 33]); o.y = cvt_pk_bf16(s[2 * 33], s[3 * 33]); o.z = cvt_pk_bf16(s[4 * 33], s[5 * 33]); o.w = cvt_pk_bf16(s[6 * 33], s[7 * 33]);
        *(u32x4*)(WT + (size_t)n * K_dst + k0 + 8 * c) = o; }
    LDS_WAIT();
}

__device__ __forceinline__ void phase0(const Args& a, const Ctx& c) {
    unsigned char* ws = c.ws;
    LAS float* scr = (LAS float*)(c.lds + c.wave * 16384);
    constexpr int N_DENSE = 16384, N_EXP = 64 * 1536;
    for (int it = c.gw; it < N_DENSE; it += c.NGW) {
        if (it < N_DENSE) {
            int r = it;
            if (r < 6144) {
                const int seg = r / 3072; r -= seg * 3072; const int kb = r / 96, nb = r % 96;
                transpose_item(INF(4), DIN, 64 * kb, (seg ? 3080 : 0) + 32 * nb, (bf16_t*)(ws + WS_WIN) + (size_t)(seg * 3072 + 32 * nb) * 2048, 2048, scr, c.lane, nullptr);
            } else if (r < 8192) { r -= 6144; const int kb = r / 64, nb = r % 64;
                transpose_item(INF(11), 2048, 64 * kb, 32 * nb, (bf16_t*)(ws + WS_WOUT) + (size_t)(32 * nb) * 2048, 2048, scr, c.lane, nullptr);
            } else if (r < 10240) { r -= 8192; const int kb = r / 64, nb = r % 64;
                transpose_item(INF(14), 2048, 64 * kb, 32 * nb, (bf16_t*)(ws + WS_WQ) + (size_t)(32 * nb) * 2048, 2048, scr, c.lane, INF(12));
            } else if (r < 14336) { r -= 10240; const int kb = r / 128, nb = r % 128;
                transpose_item(INF(15), 4096, 64 * kb, 32 * nb, (bf16_t*)(ws + WS_WKV) + (size_t)(32 * nb) * 2048, 2048, scr, c.lane, nullptr);
            } else { r -= 14336; const int kb = r / 64, nb = r % 64;
                transpose_item(INF(18), 2048, 64 * kb, 32 * nb, (bf16_t*)(ws + WS_WO) + (size_t)(32 * nb) * 2048, 2048, scr, c.lane, nullptr);
            }
        } else {
            const int r = it - N_DENSE; const int e = r / 1536, q = r % 1536, type = q / 512, idx = q % 512;
            if (type < 2) { const int kb = idx / 16, nb = idx % 16, f0 = 32 * nb;
                const float* W = INF(type == 0 ? 24 : 25) + (size_t)e * 2048 * 512;
                const int drow = e * 1024 + (f0 >> 7) * 256 + (type ? 128 : 0) + (f0 & 127);
                transpose_item(W, 512, 64 * kb, f0, (bf16_t*)(ws + WS_WGU) + (size_t)drow * 2048, 2048, scr, c.lane, nullptr);
            } else { const int kb = idx / 64, nb = idx % 64;
                const float* W = INF(26) + (size_t)e * 512 * 2048;
                transpose_item(W, 2048, 64 * kb, 32 * nb, (bf16_t*)(ws + WS_WD) + (size_t)(e * 2048 + 32 * nb) * 512, 512, scr, c.lane, nullptr);
            }
        }
    }
    {
        bf16_t* WR = (bf16_t*)(ws + WS_MISC + MO_WR);
        const float* gf = INF(19); const float* wg = INF(20); const float* we = INF(22);
        for (int i = c.bid * 512 + c.tid; i < 2048 * 80; i += c.G * 512) { const int j = i / 2048, k = i % 2048;
            float v = 0.f; if (j < 8) v = wg[k * 8 + j]; else if (j < 72) v = we[k * 64 + (j - 8)];
            v *= gf[k]; const bf16_t hi = f2bf(v); const bf16_t lo = f2bf(v - bf1(hi));
            WR[i] = hi; WR[80 * 2048 + i] = lo; }
        if (c.bid == 0 && c.tid < 128) ((unsigned*)(ws + WS_CTL))[CW_ECNT + c.tid] = 0u;
        if (c.bid == 0 && c.tid < 256) ((unsigned*)(ws + WS_CTL))[CW_BCNT + c.tid] = 0u;
    }
    __syncthreads();
    {
        LAS float* wgl = (LAS float*)c.lds; const float* win = INF(4); const float* gm = INF(3);
        for (int idx = c.tid; idx < 4096; idx += 512) { const int k = idx >> 1, hf = idx & 1;
            f32x4 v = *(const f32x4*)(win + (size_t)k * DIN + 3072 + 4 * hf); v = v * gm[k];
            const int j = k >> 8, l = (k >> 2) & 63, i = k & 3;
            *(LAS f32x4*)(wgl + (((i * 8 + j) * 64 + l) * 8 + 4 * hf)) = v; }
    }
    __syncthreads();
    {
        const LAS float* wgl = (const LAS float*)c.lds; const float* gm = INF(3); const float* x = INF(0); const float* gb = INF(5);
        bf16_t* XN = (bf16_t*)(ws + WS_XN); float* GATES = (float*)(ws + WS_MISC + MO_GATES);
        f32x4 g4[8];
#pragma unroll
        for (int j = 0; j < 8; ++j) g4[j] = *(const f32x4*)(gm + 256 * j + 4 * c.lane);
        for (int m = c.gw; m < S; m += c.NGW) {
            const f32x4* xr = (const f32x4*)(x + (size_t)m * D) + c.lane;
            f32x4 v[8]; float ss = 0.f; float ga[8];
#pragma unroll
            for (int q = 0; q < 8; ++q) ga[q] = 0.f;
#pragma unroll
            for (int j = 0; j < 8; ++j) { v[j] = xr[64 * j]; ss += (v[j][0] * v[j][0] + v[j][1] * v[j][1]) + (v[j][2] * v[j][2] + v[j][3] * v[j][3]); }
#pragma unroll
            for (int j = 0; j < 8; ++j) {
                asm volatile("" ::: "memory");
#pragma unroll
                for (int i = 0; i < 4; ++i) { const LAS f32x4* wp = (const LAS f32x4*)(wgl + ((i * 8 + j) * 64 + c.lane) * 8); const f32x4 w0 = wp[0], w1 = wp[1]; const float xv = v[j][i];
                    ga[0] += xv * w0[0]; ga[1] += xv * w0[1]; ga[2] += xv * w0[2]; ga[3] += xv * w0[3]; ga[4] += xv * w1[0]; ga[5] += xv * w1[1]; ga[6] += xv * w1[2]; ga[7] += xv * w1[3]; }
            }
            ss = wave_sum(ss); const float rstd = rsqrtf(ss * (1.f / D) + EPS);
#pragma unroll
            for (int q = 0; q < 8; ++q) ga[q] = wave_sum(ga[q]);
            if (c.lane < 8) { float gv = ga[0];
#pragma unroll
                for (int q = 1; q < 8; ++q) gv = (c.lane == q) ? ga[q] : gv;
                GATES[(size_t)m * 8 + c.lane] = gv * rstd + gb[c.lane]; }
            u32x2* o8 = (u32x2*)(XN + (size_t)m * D) + c.lane;
#pragma unroll
            for (int j = 0; j < 8; ++j) { const f32x4 y = v[j] * rstd * g4[j]; u32x2 w; w.x = cvt_pk_bf16(y[0], y[1]); w.y = cvt_pk_bf16(y[2], y[3]); o8[64 * j] = w; }
        }
        const float* mem = INF(1); const float* gmem = INF(13); bf16_t* MEMN = (bf16_t*)(ws + WS_MEMN);
        for (int m = c.gw; m < MEML; m += c.NGW) {
            const f32x4* xr = (const f32x4*)(mem + (size_t)m * D) + c.lane; f32x4 v[8]; float ss = 0.f;
#pragma unroll
            for (int j = 0; j < 8; ++j) { v[j] = xr[64 * j]; ss += (v[j][0] * v[j][0] + v[j][1] * v[j][1]) + (v[j][2] * v[j][2] + v[j][3] * v[j][3]); }
            ss = wave_sum(ss); const float rstd = rsqrtf(ss * (1.f / D) + EPS);
            u32x2* o8 = (u32x2*)(MEMN + (size_t)m * D) + c.lane;
#pragma unroll
            for (int j = 0; j < 8; ++j) { const f32x4 gg = *(const f32x4*)(gmem + 256 * j + 4 * c.lane); const f32x4 y = v[j] * rstd * gg; u32x2 w; w.x = cvt_pk_bf16(y[0], y[1]); w.y = cvt_pk_bf16(y[2], y[3]); o8[64 * j] = w; }
        }
    }
}

__device__ __forceinline__ void prep_mlstm(const Args& a, const Ctx& c, int h, int ch) {
    unsigned char* ws = c.ws; const int t0 = ch * 128;
    const float* GATES = (const float*)(ws + WS_MISC + MO_GATES);
    float* BV = (float*)(ws + WS_MISC + MO_BV); float* UV = (float*)(ws + WS_MISC + MO_UV); float* PMX = (float*)(ws + WS_MISC + MO_PMX);
    float* GC = (float*)(ws + WS_MISC + MO_GC); float* AMAX = (float*)(ws + WS_MISC + MO_AMAX);
    const bf16_t* PROJ = (const bf16_t*)(ws + WS_PROJ);
    LAS float* sc_w = (LAS float*)c.lds;
    LAS bf16_t* kws = (LAS bf16_t*)(c.lds + 1024);
    LAS bf16_t* vs = (LAS bf16_t*)(c.lds + 1024 + 128 * 260);
    if (c.wave == 0) {
        const int l = c.lane; const int ta = 2 * l, tb = 2 * l + 1;
        const float i0 = GATES[(size_t)(t0 + ta) * 8 + h], f0 = GATES[(size_t)(t0 + ta) * 8 + 4 + h];
        const float i1 = GATES[(size_t)(t0 + tb) * 8 + h], f1 = GATES[(size_t)(t0 + tb) * 8 + 4 + h];
        const float lf0 = fminf(f0, 0.f) - log1pf(__expf(-fabsf(f0))), lf1 = fminf(f1, 0.f) - log1pf(__expf(-fabsf(f1)));
        float incl = lf0 + lf1;
#pragma unroll
        for (int o = 1; o < 64; o <<= 1) { const float t = __shfl_up(incl, o); if (l >= o) incl += t; }
        const float excl = incl - (lf0 + lf1);
        const float b0 = excl + lf0, b1 = excl + lf0 + lf1;
        const float u0 = i0 - b0, u1 = i1 - b1;
        float pm = fmaxf(u0, u1);
#pragma unroll
        for (int o = 1; o < 64; o <<= 1) { const float t = __shfl_up(pm, o); if (l >= o) pm = fmaxf(pm, t); }
        float pme = __shfl_up(pm, 1); if (l == 0) pme = -INFINITY;
        const float p0 = fmaxf(pme, u0), p1 = pm;
        const float ptot = __shfl(pm, 63), gtot = __shfl(b1, 63);
        BV[h * S + t0 + ta] = b0; BV[h * S + t0 + tb] = b1; UV[h * S + t0 + ta] = u0; UV[h * S + t0 + tb] = u1; PMX[h * S + t0 + ta] = p0; PMX[h * S + t0 + tb] = p1;
        sc_w[ta] = __expf(u0 - ptot); sc_w[tb] = __expf(u1 - ptot);
        if (l == 63) { GC[h * 64 + ch] = gtot; AMAX[h * 64 + ch] = gtot + ptot; }
    }
    __syncthreads();
    {
        const float* cw = INF(6); const float* cb = INF(7);
        bf16_t* QC = (bf16_t*)(ws + WS_QC); bf16_t* KC = (bf16_t*)(ws + WS_KC);
        const int t = c.tid >> 2, qt = c.tid & 3; const float ws_ = sc_w[t];
#pragma unroll
        for (int qk = 0; qk < 2; ++qk)
#pragma unroll
            for (int gq = 0; gq < 4; ++gq) {
                const int ch0 = qt * 32 + 8 * gq; const int cch = qk * 512 + h * 128 + ch0; const int pcol = (qk ? PC_MK : PC_MQ) + h * 128 + ch0;
                float y[8];
#pragma unroll
                for (int i = 0; i < 8; ++i) y[i] = cb[cch + i];
#pragma unroll
                for (int j = 0; j < 4; ++j) { const int tr = t0 + t - 3 + j; const float msk = tr >= 0 ? 1.f : 0.f;
                    float xv[8]; unpack8(*(const u32x4*)(PROJ + (size_t)(tr < 0 ? 0 : tr) * NPROJ + pcol), xv);
#pragma unroll
                    for (int i = 0; i < 8; ++i) y[i] += cw[j * 1024 + cch + i] * (xv[i] * msk); }
#pragma unroll
                for (int i = 0; i < 8; ++i) y[i] = y[i] / (1.f + __expf(-y[i]));
                if (qk == 0) {
#pragma unroll
                    for (int i = 0; i < 8; ++i) y[i] *= 0.08838834764831845f;
                    *(u32x4*)(QC + ((size_t)(h * S + t0 + t)) * 128 + ch0) = pack8(y);
                } else {
                    *(u32x4*)(KC + ((size_t)(h * S + t0 + t)) * 128 + ch0) = pack8(y);
#pragma unroll
                    for (int i = 0; i < 8; ++i) kws[t * 130 + ch0 + i] = f2bf(y[i] * ws_);
                }
            }
        const int part = c.tid & 3;
#pragma unroll
        for (int q = 0; q < 8; ++q) { const int dv0 = part * 64 + 8 * q;
            *(LAS u32x4*)(vs + t * 264 + dv0) = *(const u32x4*)(PROJ + (size_t)(t0 + t) * NPROJ + PC_MV + h * 256 + dv0); }
    }
    __syncthreads();
    {
        bf16_t* KWT = (bf16_t*)(ws + WS_KWT); bf16_t* VT = (bf16_t*)(ws + WS_VT);
        const int d = c.tid >> 2, sq = c.tid & 3;
#pragma unroll
        for (int gq = 0; gq < 4; ++gq) { const int s0 = sq * 32 + 8 * gq; u32x4 o;
            o.x = (unsigned)kws[(s0 + 0) * 130 + d] | ((unsigned)kws[(s0 + 1) * 130 + d] << 16); o.y = (unsigned)kws[(s0 + 2) * 130 + d] | ((unsigned)kws[(s0 + 3) * 130 + d] << 16);
            o.z = (unsigned)kws[(s0 + 4) * 130 + d] | ((unsigned)kws[(s0 + 5) * 130 + d] << 16); o.w = (unsigned)kws[(s0 + 6) * 130 + d] | ((unsigned)kws[(s0 + 7) * 130 + d] << 16);
            *(u32x4*)(KWT + ((size_t)((h * 64 + ch) * 128 + d)) * 128 + s0) = o; }
        const int dv = c.tid >> 1, hf = c.tid & 1;
#pragma unroll
        for (int gq = 0; gq < 8; ++gq) { const int s0 = hf * 64 + 8 * gq; u32x4 o;
            o.x = (unsigned)vs[(s0 + 0) * 264 + dv] | ((unsigned)vs[(s0 + 1) * 264 + dv] << 16); o.y = (unsigned)vs[(s0 + 2) * 264 + dv] | ((unsigned)vs[(s0 + 3) * 264 + dv] << 16);
            o.z = (unsigned)vs[(s0 + 4) * 264 + dv] | ((unsigned)vs[(s0 + 5) * 264 + dv] << 16); o.w = (unsigned)vs[(s0 + 6) * 264 + dv] | ((unsigned)vs[(s0 + 7) * 264 + dv] << 16);
            *(u32x4*)(VT + ((size_t)((h * 64 + ch) * DVP + dv)) * 128 + s0) = o; }
        if (c.tid < 256) { const int row = 256 + (c.tid >> 4), ck = c.tid & 15; const unsigned val = (row == 256) ? 0x3F803F80u : 0u;
            *(u32x4*)(VT + ((size_t)((h * 64 + ch) * DVP + row)) * 128 + 8 * ck) = (u32x4){val, val, val, val}; }
    }
    __syncthreads();
}

__device__ __forceinline__ void prep_moba(const Args& a, const Ctx& c, int h, int jb) {
    unsigned char* ws = c.ws; const int t0 = jb * 256;
    const bf16_t* PROJ = (const bf16_t*)(ws + WS_PROJ); const int* pos = (const int*)a.in[2];
    bf16_t* QP = (bf16_t*)(ws + WS_QP); bf16_t* KP = (bf16_t*)(ws + WS_KP); bf16_t* VTP = (bf16_t*)(ws + WS_VTP); float* KMEAN = (float*)(ws + WS_MISC + MO_KMEAN);
    LAS float* red = (LAS float*)c.lds;
    LAS bf16_t* vs = (LAS bf16_t*)(c.lds + 16384);
    const int li = c.tid & 15, rg = c.tid >> 4, d0 = 8 * li;
    float qg[8], kg[8], kacc[8];
#pragma unroll
    for (int i = 0; i < 8; ++i) { qg[i] = INF(9)[d0 + i]; kg[i] = INF(10)[d0 + i]; kacc[i] = 0.f; }
    float invf[8];
#pragma unroll
    for (int i = 0; i < 8; ++i) { const int fi = (li & 1) * 8 + i; invf[i] = exp2f(-(float)fi * (18.931568569324174f / 16.f)); }
    for (int p = 0; p < 8; ++p) {
        const int row = p * 32 + rg; const size_t prow = (size_t)(t0 + row) * NPROJ + h * 128 + d0;
        const float fpos = (float)pos[t0 + row];
        float cs[8], sn[8];
        if (li < 4) {
#pragma unroll
            for (int i = 0; i < 8; ++i) { float s_, c_; sincosf(fpos * invf[i], &s_, &c_); cs[i] = c_; sn[i] = s_; }
        } else {
#pragma unroll
            for (int i = 0; i < 8; ++i) { cs[i] = 1.f; sn[i] = 0.f; }
        }
#pragma unroll
        for (int qk = 0; qk < 2; ++qk) {
            float x[8]; unpack8(*(const u32x4*)(PROJ + prow + (qk ? PC_AK : PC_AQ)), x);
            float ss = 0.f;
#pragma unroll
            for (int i = 0; i < 8; ++i) ss += x[i] * x[i];
            ss += __shfl_xor(ss, 1); ss += __shfl_xor(ss, 2); ss += __shfl_xor(ss, 4); ss += __shfl_xor(ss, 8);
            const float rstd = rsqrtf(ss * (1.f / 128.f) + EPS);
            float y[8];
#pragma unroll
            for (int i = 0; i < 8; ++i) y[i] = x[i] * rstd * (qk ? kg[i] : qg[i]);
            float o[8];
#pragma unroll
            for (int i = 0; i < 8; ++i) { const float ot = __shfl_xor(y[i], 2); o[i] = (li < 2) ? (y[i] * cs[i] - ot * sn[i]) : (li < 4 ? (y[i] * cs[i] + ot * sn[i]) : y[i]); }
            if (qk == 0) *(u32x4*)(QP + ((size_t)(h * S + t0 + row)) * 128 + d0) = pack8(o);
            else { *(u32x4*)(KP + ((size_t)(h * S + t0 + row)) * 128 + d0) = pack8(o);
#pragma unroll
                for (int i = 0; i < 8; ++i) kacc[i] += o[i]; }
        }
        *(LAS u32x4*)(vs + row * 136 + d0) = *(const u32x4*)(PROJ + prow + PC_AV);
    }
#pragma unroll
    for (int i = 0; i < 8; ++i) red[rg * 128 + d0 + i] = kacc[i];
    __syncthreads();
    if (c.tid < 128) { float s = 0.f;
#pragma unroll 8
        for (int r = 0; r < 32; ++r) s += red[r * 128 + c.tid];
        KMEAN[(h * 32 + jb) * 128 + c.tid] = s * (1.f / 256.f); }
    {
        const int d = c.tid >> 2, sq = c.tid & 3;
#pragma unroll
        for (int gq = 0; gq < 8; ++gq) { const int s0 = sq * 64 + 8 * gq; u32x4 o;
            o.x = (unsigned)vs[(s0 + 0) * 136 + d] | ((unsigned)vs[(s0 + 1) * 136 + d] << 16); o.y = (unsigned)vs[(s0 + 2) * 136 + d] | ((unsigned)vs[(s0 + 3) * 136 + d] << 16);
            o.z = (unsigned)vs[(s0 + 4) * 136 + d] | ((unsigned)vs[(s0 + 5) * 136 + d] << 16); o.w = (unsigned)vs[(s0 + 6) * 136 + d] | ((unsigned)vs[(s0 + 7) * 136 + d] << 16);
            *(u32x4*)(VTP + ((size_t)((h * 32 + jb) * 128 + d)) * 256 + s0) = o; }
    }
    __syncthreads();
}

__device__ __forceinline__ void prep_xamem(const Args& a, const Ctx& c) {
    unsigned char* ws = c.ws; const float* SL = (const float*)(ws + WS_KVSLAB);
    bf16_t* KM = (bf16_t*)(ws + WS_KM); bf16_t* VTM = (bf16_t*)(ws + WS_VTM); const float* kg = INF(17);
    for (int it = c.gw; it < 1024; it += c.NGW) { const int m = it >> 2, h = it & 3;
        float x[8];
#pragma unroll
        for (int i = 0; i < 8; ++i) x[i] = 0.f;
#pragma unroll
        for (int sp = 0; sp < 8; ++sp) { const f32x4* p = (const f32x4*)(SL + ((size_t)(sp * 256 + m)) * 4096 + h * 512 + 8 * c.lane); const f32x4 v0 = p[0], v1 = p[1];
            x[0] += v0[0]; x[1] += v0[1]; x[2] += v0[2]; x[3] += v0[3]; x[4] += v1[0]; x[5] += v1[1]; x[6] += v1[2]; x[7] += v1[3]; }
        float ss = 0.f;
#pragma unroll
        for (int i = 0; i < 8; ++i) ss += x[i] * x[i];
        ss = wave_sum(ss); const float rstd = rsqrtf(ss * (1.f / 512.f) + EPS);
#pragma unroll
        for (int i = 0; i < 8; ++i) x[i] = x[i] * rstd * kg[8 * c.lane + i];
        *(u32x4*)(KM + ((size_t)(h * 256 + m)) * 512 + 8 * c.lane) = pack8(x); }
    for (int idx = c.bid * 512 + c.tid; idx < 65536; idx += c.G * 512) { const int d = idx & 511, mg = (idx >> 9) & 31, h = idx >> 14;
        float v[8];
#pragma unroll
        for (int j = 0; j < 8; ++j) { float t = 0.f;
#pragma unroll
            for (int sp = 0; sp < 8; ++sp) t += SL[((size_t)(sp * 256 + 8 * mg + j)) * 4096 + 2048 + h * 512 + d];
            v[j] = t; }
        *(u32x4*)(VTM + ((size_t)(h * 512 + d)) * 256 + 8 * mg) = pack8(v); }
}

__device__ __forceinline__ void tile256_load(LAS unsigned char* dst, const bf16_t* src, size_t src_ld, int nrows, int tid) {
    for (int idx = tid; idx < nrows * 16; idx += 512) { const int row = idx >> 4, ck = idx & 15;
        *(LAS u32x4*)(dst + row * 256 + ((ck ^ (row & 15)) << 4)) = *(const u32x4*)(src + (size_t)row * src_ld + 8 * ck); }
}
__device__ __forceinline__ bf16x8 tile256_frag(const LAS unsigned char* t, int row, int ck) { return *(const LAS bf16x8*)(t + row * 256 + ((ck ^ (row & 15)) << 4)); }

__device__ __forceinline__ void mlstm_local(const Ctx& c, int h, int ch) {
    unsigned char* ws = c.ws; const bf16_t* KWT = (const bf16_t*)(ws + WS_KWT); const bf16_t* VT = (const bf16_t*)(ws + WS_VT); float* CTL = (float*)(ws + WS_CTL_LOC);
    const int tt = c.lane & 15, g = c.lane >> 4, w = c.wave, t0 = ch * 128;
    tile256_load(c.lds, VT + (size_t)(h * 64 + ch) * DVP * 128, 128, DVP, c.tid);
    bf16x8 bfr[4];
#pragma unroll
    for (int ks = 0; ks < 4; ++ks) bfr[ks] = *(const bf16x8*)(KWT + ((size_t)((h * 64 + ch) * 128 + 16 * w + tt)) * 128 + 32 * ks + 8 * g);
    __syncthreads();
#pragma unroll
    for (int mt = 0; mt < 17; ++mt) {
        f32x4 acc = {0.f, 0.f, 0.f, 0.f};
#pragma unroll
        for (int ks = 0; ks < 4; ++ks) acc = mfma16(tile256_frag(c.lds, 16 * mt + tt, 4 * ks + g), bfr[ks], acc);
#pragma unroll
        for (int r = 0; r < 4; ++r) CTL[((size_t)((h * 64 + ch) * DVP + 16 * mt + 4 * g + r)) * 128 + 16 * w + tt] = acc[r];
    }
    __syncthreads();
}

#define MOBA_LOAD_KV(jb, K_, V_) do { const int kb_ = (jb) * 256; \
        _Pragma("unroll") for (int tq = 0; tq < 2; ++tq) _Pragma("unroll") for (int ks = 0; ks < 4; ++ks) \
            K_[tq][ks] = *(const bf16x8*)(KP + ((size_t)(h * S + kb_ + 32 * w + pi32(tq, tt))) * 128 + 32 * ks + 8 * g); \
        _Pragma("unroll") for (int ks = 0; ks < 8; ++ks) V_[ks] = *(const bf16x8*)(VTP + ((size_t)((h * 32 + (jb)) * 128 + 16 * w + tt)) * 256 + 32 * ks + 8 * g); } while (0)

#define MOBA_TOUCH_KV(K_, V_) do { _Pragma("unroll") for (int tq = 0; tq < 2; ++tq) _Pragma("unroll") for (int ks = 0; ks < 4; ++ks) asm volatile("" : "+v"(K_[tq][ks])); \
        _Pragma("unroll") for (int ks = 0; ks < 8; ++ks) asm volatile("" : "+v"(V_[ks])); } while (0)
__device__ __forceinline__ void moba_select(const Ctx& c, int h, int cb, int half) {
    unsigned char* ws = c.ws;
    const bf16_t* QP = (const bf16_t*)(ws + WS_QP); const float* KMEAN = (const float*)(ws + WS_MISC + MO_KMEAN);
    unsigned* BCNT = (unsigned*)(ws + WS_CTL) + CW_BCNT; unsigned short* BLIST = (unsigned short*)(ws + WS_BLIST); int* PSLOT = (int*)(ws + WS_PSLOT);
    LAS unsigned char* Qs = c.lds;
    LAS float* km = (LAS float*)(c.lds + 34816);
    LAS int* cnt = (LAS int*)(c.lds + 34816 + 16384);
    LAS int* gbase = cnt + 32;
    const int tid = c.tid, q0 = cb * 256 + half * 128;
    const int q = tid >> 2, sub = tid & 3;
    if (cb == 0) { if (sub == 0) { int* ps = PSLOT + ((size_t)(h * S + q0 + q)) * 3; ps[0] = -1; ps[1] = -1; ps[2] = -1; } return; }
    for (int i = tid; i < 128 * 16; i += 512) { const int r = i >> 4, ck = i & 15; *(LAS u32x4*)(Qs + r * 272 + ck * 16) = *(const u32x4*)(QP + ((size_t)(h * S + q0 + r)) * 128 + 8 * ck); }
    if (tid < 32) cnt[tid] = 0;
    { const f32x4* src = (const f32x4*)(KMEAN + (size_t)h * 32 * 128); for (int i = tid; i < cb * 32; i += 512) ((LAS f32x4*)km)[i] = src[i]; }
    __syncthreads();
    float bv0 = -INFINITY, bv1 = -INFINITY, bv2 = -INFINITY; int bi0 = 255, bi1 = 255, bi2 = 255;
    {
        float qv[128];
#pragma unroll
        for (int ck = 0; ck < 16; ++ck) { float t8[8]; unpack8(*(const LAS u32x4*)(Qs + q * 272 + ck * 16), t8);
#pragma unroll
            for (int i = 0; i < 8; ++i) qv[ck * 8 + i] = t8[i]; }
        for (int j = sub; j < cb; j += 4) {
            float s = 0.f;
#pragma unroll
            for (int d4 = 0; d4 < 32; ++d4) { const f32x4 kv = *(const LAS f32x4*)(km + j * 128 + 4 * d4); s += qv[4 * d4] * kv[0] + qv[4 * d4 + 1] * kv[1] + qv[4 * d4 + 2] * kv[2] + qv[4 * d4 + 3] * kv[3]; }
            if (s > bv0) { bv2 = bv1; bi2 = bi1; bv1 = bv0; bi1 = bi0; bv0 = s; bi0 = j; }
            else if (s > bv1) { bv2 = bv1; bi2 = bi1; bv1 = s; bi1 = j; }
            else if (s > bv2) { bv2 = s; bi2 = j; }
        }
    }
#pragma unroll
    for (int o = 1; o <= 2; o <<= 1) {
        const float ov0 = __shfl_xor(bv0, o), ov1 = __shfl_xor(bv1, o), ov2 = __shfl_xor(bv2, o);
        const int oi0 = __shfl_xor(bi0, o), oi1 = __shfl_xor(bi1, o), oi2 = __shfl_xor(bi2, o);
        float nv[3] = {ov0, ov1, ov2}; int ni[3] = {oi0, oi1, oi2};
#pragma unroll
        for (int k = 0; k < 3; ++k) { const float sv = nv[k]; const int j = ni[k];
            const bool b0 = (sv > bv0) || (sv == bv0 && j < bi0), b1 = (sv > bv1) || (sv == bv1 && j < bi1), b2 = (sv > bv2) || (sv == bv2 && j < bi2);
            if (b0) { bv2 = bv1; bi2 = bi1; bv1 = bv0; bi1 = bi0; bv0 = sv; bi0 = j; }
            else if (b1) { bv2 = bv1; bi2 = bi1; bv1 = sv; bi1 = j; }
            else if (b2) { bv2 = sv; bi2 = j; } }
    }
    int p0 = -1, p1 = -1, p2 = -1;
    if (sub == 0) {
        if (bi0 < cb) p0 = __hip_atomic_fetch_add(cnt + bi0, 1, __ATOMIC_RELAXED, __HIP_MEMORY_SCOPE_WORKGROUP);
        if (bi1 < cb) p1 = __hip_atomic_fetch_add(cnt + bi1, 1, __ATOMIC_RELAXED, __HIP_MEMORY_SCOPE_WORKGROUP);
        if (bi2 < cb) p2 = __hip_atomic_fetch_add(cnt + bi2, 1, __ATOMIC_RELAXED, __HIP_MEMORY_SCOPE_WORKGROUP);
    }
    __syncthreads();
    if (tid < cb) { const int cn = cnt[tid]; gbase[tid] = cn > 0 ? (int)__hip_atomic_fetch_add(BCNT + h * 32 + tid, (unsigned)cn, __ATOMIC_RELAXED, __HIP_MEMORY_SCOPE_AGENT) : 0; }
    __syncthreads();
    if (sub == 0) {
        int* ps = PSLOT + ((size_t)(h * S + q0 + q)) * 3; const unsigned short qq = (unsigned short)(q0 + q);
        if (p0 >= 0) { const int pos = gbase[bi0] + p0; BLIST[(size_t)(h * 32 + bi0) * 8192 + pos] = qq; ps[0] = (bi0 << 16) | pos; } else ps[0] = -1;
        if (p1 >= 0) { const int pos = gbase[bi1] + p1; BLIST[(size_t)(h * 32 + bi1) * 8192 + pos] = qq; ps[1] = (bi1 << 16) | pos; } else ps[1] = -1;
        if (p2 >= 0) { const int pos = gbase[bi2] + p2; BLIST[(size_t)(h * 32 + bi2) * 8192 + pos] = qq; ps[2] = (bi2 << 16) | pos; } else ps[2] = -1;
    }
    __syncthreads();
}

#define MOBA_TILE_PAIR(two, qrA, qrB, okA, okB, own, qlocA, qlocB, nkw) \
    f32x4 oA0 = {0.f, 0.f, 0.f, 0.f}, oA1 = oA0, oB0 = oA0, oB1 = oA0; float ltA = 0.f, ltB = 0.f; \
    { if (w < (nkw)) { \
        f32x4 sA0 = {0.f, 0.f, 0.f, 0.f}, sA1 = sA0, sB0 = sA0, sB1 = sA0; \
        _Pragma("unroll") for (int ks = 0; ks < 4; ++ks) { const bf16x8 qf = *(const LAS bf16x8*)(Qs + (qrA) * 272 + (32 * ks + 8 * g) * 2); sA0 = mfma16(Kc[0][ks], qf, sA0); sA1 = mfma16(Kc[1][ks], qf, sA1); } \
        if (two) { _Pragma("unroll") for (int ks = 0; ks < 4; ++ks) { const bf16x8 qf = *(const LAS bf16x8*)(Qs + (qrB) * 272 + (32 * ks + 8 * g) * 2); sB0 = mfma16(Kc[0][ks], qf, sB0); sB1 = mfma16(Kc[1][ks], qf, sB1); } } \
        const int kloc = 32 * w + 8 * g; \
        { float p[8]; float lsum = 0.f; \
          _Pragma("unroll") for (int r = 0; r < 4; ++r) { p[r] = __expf(sA0[r] * 0.08838834764831845f); p[4 + r] = __expf(sA1[r] * 0.08838834764831845f); } \
          _Pragma("unroll") for (int i = 0; i < 8; ++i) { const bool ok = (okA) && (!(own) || (kloc + i <= (qlocA))); p[i] = ok ? p[i] : 0.f; lsum += p[i]; } \
          lsum += __shfl_xor(lsum, 16); lsum += __shfl_xor(lsum, 32); \
          *(LAS u32x4*)(Pb + (buf * 2 + 0) * 8192 + w * 1024 + lane * 16) = pack8(p); \
          if (g == 0) lpart[((buf * 2 + 0) * 8 + w) * 16 + tt] = lsum; } \
        if (two) { float p[8]; float lsum = 0.f; \
          _Pragma("unroll") for (int r = 0; r < 4; ++r) { p[r] = __expf(sB0[r] * 0.08838834764831845f); p[4 + r] = __expf(sB1[r] * 0.08838834764831845f); } \
          _Pragma("unroll") for (int i = 0; i < 8; ++i) { const bool ok = (okB) && (!(own) || (kloc + i <= (qlocB))); p[i] = ok ? p[i] : 0.f; lsum += p[i]; } \
          lsum += __shfl_xor(lsum, 16); lsum += __shfl_xor(lsum, 32); \
          *(LAS u32x4*)(Pb + (buf * 2 + 1) * 8192 + w * 1024 + lane * 16) = pack8(p); \
          if (g == 0) lpart[((buf * 2 + 1) * 8 + w) * 16 + tt] = lsum; } \
      } \
      LDS_WAIT(); __builtin_amdgcn_s_barrier(); asm volatile("" ::: "memory"); \
      _Pragma("unroll") for (int ks = 0; ks < 8; ks += 2) if (ks < (nkw)) { \
          const bf16x8 pa = *(const LAS bf16x8*)(Pb + (buf * 2 + 0) * 8192 + ks * 1024 + lane * 16), pb = *(const LAS bf16x8*)(Pb + (buf * 2 + 0) * 8192 + (ks + 1) * 1024 + lane * 16); \
          oA0 = mfma16(Vc[ks], pa, oA0); oA1 = mfma16(Vc[ks + 1], pb, oA1); } \
      _Pragma("unroll") for (int ww = 0; ww < 8; ++ww) if (ww < (nkw)) ltA += lpart[((buf * 2 + 0) * 8 + ww) * 16 + tt]; \
      if (two) { \
          _Pragma("unroll") for (int ks = 0; ks < 8; ks += 2) if (ks < (nkw)) { \
              const bf16x8 pa = *(const LAS bf16x8*)(Pb + (buf * 2 + 1) * 8192 + ks * 1024 + lane * 16), pb = *(const LAS bf16x8*)(Pb + (buf * 2 + 1) * 8192 + (ks + 1) * 1024 + lane * 16); \
              oB0 = mfma16(Vc[ks], pa, oB0); oB1 = mfma16(Vc[ks + 1], pb, oB1); } \
          _Pragma("unroll") for (int ww = 0; ww < 8; ++ww) if (ww < (nkw)) ltB += lpart[((buf * 2 + 1) * 8 + ww) * 16 + tt]; } \
      oA0 = oA0 + oA1; oB0 = oB0 + oB1; buf ^= 1; }

__device__ __forceinline__ void moba_bucket_phase(const Ctx& c) {
    unsigned char* ws = c.ws;
    const bf16_t* QP = (const bf16_t*)(ws + WS_QP); const bf16_t* KP = (const bf16_t*)(ws + WS_KP); const bf16_t* VTP = (const bf16_t*)(ws + WS_VTP);
    unsigned* BCNT = (unsigned*)(ws + WS_CTL) + CW_BCNT; const unsigned short* BLIST = (const unsigned short*)(ws + WS_BLIST);
    bf16_t* PART = (bf16_t*)(ws + WS_PART); float* LPART = (float*)(ws + WS_LPART); int* POFF = (int*)(ws + WS_POFF);
    LAS unsigned char* Qs = c.lds;
    LAS unsigned char* Pb = c.lds + 34816;
    LAS float* lpart = (LAS float*)(c.lds + 34816 + 32768);
    LAS int* cnts = (LAS int*)(c.lds + 34816 + 32768 + 2048);
    LAS int* ipre = cnts + 256;
    LAS int* ppre = ipre + 260;
    LAS int* wsum = ppre + 260;
    LAS int* selb = wsum + 16;
    const int tid = c.tid, lane = c.lane, w = c.wave, tt = lane & 15, g = lane >> 4;
    {
        int cn = 0, nch = 0, pp = 0;
        if (tid < 256) { cn = (int)__hip_atomic_load(BCNT + tid, __ATOMIC_RELAXED, __HIP_MEMORY_SCOPE_AGENT); nch = (cn + 127) >> 7; pp = (cn + 15) & ~15; cnts[tid] = cn; }
        int i1 = nch, i2 = pp;
#pragma unroll
        for (int o = 1; o < 64; o <<= 1) { const int t1 = __shfl_up(i1, o), t2 = __shfl_up(i2, o); if (lane >= o) { i1 += t1; i2 += t2; } }
        if (lane == 63 && w < 4) { wsum[w] = i1; wsum[8 + w] = i2; }
        __syncthreads();
        if (tid < 256) { int a1 = 0, a2 = 0;
#pragma unroll
            for (int k = 0; k < 4; ++k) if (k < w) { a1 += wsum[k]; a2 += wsum[8 + k]; }
            ipre[tid + 1] = a1 + i1; ppre[tid + 1] = a2 + i2; if (tid == 0) { ipre[0] = 0; ppre[0] = 0; } }
        __syncthreads();
        if (c.bid == 0 && tid <= 256) POFF[tid] = ppre[tid];
    }
    const int total = ipre[256];
    int buf = 0;
    LAS unsigned char* Qs1 = c.lds + 34816 + 32768 + 2048 + 4096;
#define BK_FIND(it_, b_, ch_, n_) do { int lo_ = 0, hi_ = 256; while (hi_ - lo_ > 1) { const int md_ = (lo_ + hi_) >> 1; if (ipre[md_] <= (it_)) lo_ = md_; else hi_ = md_; } \
        b_ = lo_; ch_ = (it_) - ipre[lo_]; n_ = min(128, cnts[lo_] - 128 * ch_); } while (0)
#define BK_IDX(b_, ch_, n_, Q_) do { _Pragma("unroll") for (int k = 0; k < 4; ++k) { const int r_ = (tid + 512 * k) >> 4; Q_[k] = BLIST[(size_t)(b_) * 8192 + 128 * (ch_) + (r_ < (n_) ? r_ : (n_) - 1)]; } } while (0)
#define BK_ROWS(b_, Q_, R_) do { _Pragma("unroll") for (int k = 0; k < 4; ++k) R_[k] = *(const u32x4*)(QP + ((size_t)(((b_) >> 5) * S + Q_[k])) * 128 + 8 * (tid & 15)); } while (0)
#define BK_WRITE(n_, R_, QB_) do { _Pragma("unroll") for (int k = 0; k < 4; ++k) { const int r_ = (tid + 512 * k) >> 4; u32x4 v_ = R_[k]; if (r_ >= (n_)) v_ = (u32x4){0u, 0u, 0u, 0u}; *(LAS u32x4*)((QB_) + r_ * 272 + (tid & 15) * 16) = v_; } } while (0)
    int it = c.bid;
    if (it < total) {
        int bC, chC, nC, bN = 0, chN = 0, nN = 0; int qiN[4], qiNN[4]; u32x4 rowsN[4];
        bf16x8 Kc[2][4], Vc[8], Kn[2][4], Vn[8];
        BK_FIND(it, bC, chC, nC);
        { int qi0[4]; BK_IDX(bC, chC, nC, qi0); u32x4 r0[4]; BK_ROWS(bC, qi0, r0); const int h = bC >> 5; MOBA_LOAD_KV(bC & 31, Kc, Vc); BK_WRITE(nC, r0, Qs); }
        bool hasN = (it + c.G < total);
        if (hasN) { BK_FIND(it + c.G, bN, chN, nN); BK_IDX(bN, chN, nN, qiN); }
        LDS_WAIT(); __builtin_amdgcn_s_barrier(); asm volatile("" ::: "memory");
        int par = 0;
        for (;;) {
            LAS unsigned char* Qs = par ? Qs1 : c.lds;
            const int h = bC >> 5, ntile = (nC + 15) >> 4, n = nC; const int pbase = ppre[bC] + 128 * chC;
            const bool hasNN = (it + 2 * c.G < total); int bNN = 0, chNN = 0, nNN = 0;
            if (hasN) { BK_ROWS(bN, qiN, rowsN); { const int h = bN >> 5; MOBA_LOAD_KV(bN & 31, Kn, Vn); } }
            if (hasNN) { BK_FIND(it + 2 * c.G, bNN, chNN, nNN); BK_IDX(bNN, chNN, nNN, qiNN); }
            MOBA_TOUCH_KV(Kc, Vc);
            for (int tl = 0; tl < ntile; tl += 2) {
                const bool two = (tl + 1 < ntile);
                const int rA = 16 * tl + tt, rB = two ? rA + 16 : rA;
                MOBA_TILE_PAIR(two, rA, rB, (rA < n), (two && rB < n), 0, 0, 0, 8)
                { u32x2 wv; wv.x = cvt_pk_bf16(oA0[0], oA0[1]); wv.y = cvt_pk_bf16(oA0[2], oA0[3]); *(u32x2*)(PART + (size_t)(pbase + rA) * 128 + 16 * w + 4 * g) = wv;
                  if (w == 0 && g == 0) LPART[pbase + rA] = ltA; }
                if (two) { u32x2 wv; wv.x = cvt_pk_bf16(oB0[0], oB0[1]); wv.y = cvt_pk_bf16(oB0[2], oB0[3]); *(u32x2*)(PART + (size_t)(pbase + rB) * 128 + 16 * w + 4 * g) = wv;
                  if (w == 0 && g == 0) LPART[pbase + rB] = ltB; }
            }
            if (!hasN) break;
            BK_WRITE(nN, rowsN, (par ? c.lds : Qs1));
#pragma unroll
            for (int tq = 0; tq < 2; ++tq)
#pragma unroll
                for (int ks = 0; ks < 4; ++ks) Kc[tq][ks] = Kn[tq][ks];
#pragma unroll
            for (int ks = 0; ks < 8; ++ks) Vc[ks] = Vn[ks];
#pragma unroll
            for (int k = 0; k < 4; ++k) qiN[k] = qiNN[k];
            bC = bN; chC = chN; nC = nN; bN = bNN; chN = chNN; nN = nNN; hasN = hasNN; it += c.G; par ^= 1;
            LDS_WAIT(); __builtin_amdgcn_s_barrier(); asm volatile("" ::: "memory");
        }
    }
#undef BK_FIND
#undef BK_IDX
#undef BK_ROWS
#undef BK_WRITE
    __syncthreads();
}

__device__ __forceinline__ void moba_own(const Ctx& c, int h, int cb, int half) {
    unsigned char* ws = c.ws;
    const bf16_t* QP = (const bf16_t*)(ws + WS_QP); const bf16_t* KP = (const bf16_t*)(ws + WS_KP); const bf16_t* VTP = (const bf16_t*)(ws + WS_VTP);
    const bf16_t* PART = (const bf16_t*)(ws + WS_PART); const float* LPART = (const float*)(ws + WS_LPART); const int* POFF = (const int*)(ws + WS_POFF); const int* PSLOT = (const int*)(ws + WS_PSLOT);
    bf16_t* HCAT = (bf16_t*)(ws + WS_HCAT);
    LAS unsigned char* Qs = c.lds; LAS unsigned char* Pb = c.lds + 34816; LAS float* lpart = (LAS float*)(c.lds + 34816 + 32768);
    LAS float* Os = (LAS float*)(c.lds + 34816 + 32768 + 2048);
    LAS float* Ls = Os + 128 * 132;
    const int tid = c.tid, lane = c.lane, w = c.wave, tt = lane & 15, g = lane >> 4, q0 = cb * 256 + half * 128;
    bf16x8 Kc[2][4], Vc[8];
    MOBA_LOAD_KV(cb, Kc, Vc);
    const int cq = tid >> 2, cpart = tid & 3;
    int pr[3]; u32x4 prow[3][4]; float plv[3];
#pragma unroll
    for (int k = 0; k < 3; ++k) { const int sl = PSLOT[((size_t)(h * S + q0 + cq)) * 3 + k]; const int po = POFF[h * 32 + ((sl < 0 ? 0 : sl) >> 16)]; pr[k] = (sl >= 0) ? (po + (sl & 0xffff)) : -1; }
    for (int i = tid; i < 128 * 16; i += 512) { const int r = i >> 4, ck = i & 15; *(LAS u32x4*)(Qs + r * 272 + ck * 16) = *(const u32x4*)(QP + ((size_t)(h * S + q0 + r)) * 128 + 8 * ck); }
#pragma unroll
    for (int k = 0; k < 3; ++k) { const int pc = pr[k] < 0 ? 0 : pr[k]; plv[k] = LPART[pc];
#pragma unroll
        for (int j = 0; j < 4; ++j) prow[k][j] = *(const u32x4*)(PART + (size_t)pc * 128 + cpart * 32 + 8 * j); }
    MOBA_TOUCH_KV(Kc, Vc);
    __syncthreads();
    const int nkw = half ? 8 : 4;
    int buf = 0;
    for (int tl = 0; tl < 8; tl += 2) {
        const int rA = 16 * tl + tt, rB = rA + 16;
        MOBA_TILE_PAIR(true, rA, rB, true, true, 1, (half * 128 + rA), (half * 128 + rB), nkw)
        *(LAS f32x4*)(Os + rA * 132 + 16 * w + 4 * g) = oA0; *(LAS f32x4*)(Os + rB * 132 + 16 * w + 4 * g) = oB0;
        if (w == 0 && g == 0) { Ls[rA] = ltA; Ls[rB] = ltB; }
    }
    __syncthreads();
    { float l = Ls[cq];
#pragma unroll
      for (int k = 0; k < 3; ++k) if (pr[k] >= 0) l += plv[k];
      const float inv = 1.f / l;
#pragma unroll
      for (int j = 0; j < 4; ++j) { float v[8];
#pragma unroll
          for (int i = 0; i < 8; ++i) v[i] = Os[cq * 132 + cpart * 32 + 8 * j + i];
#pragma unroll
          for (int k = 0; k < 3; ++k) if (pr[k] >= 0) { float t8[8]; unpack8(prow[k][j], t8);
#pragma unroll
              for (int i = 0; i < 8; ++i) v[i] += t8[i]; }
#pragma unroll
          for (int i = 0; i < 8; ++i) v[i] *= inv;
          *(u32x4*)(HCAT + (size_t)(q0 + cq) * 2048 + 1024 + h * 128 + cpart * 32 + 8 * j) = pack8(v); } }
    __syncthreads();
}

__device__ __forceinline__ void mlstm_scan(const Ctx& c) {
    unsigned char* ws = c.ws; const float* CTL = (const float*)(ws + WS_CTL_LOC); bf16_t* CTP = (bf16_t*)(ws + WS_CTP);
    const float* GC = (const float*)(ws + WS_MISC + MO_GC); const float* AMAX = (const float*)(ws + WS_MISC + MO_AMAX); float* MPREV = (float*)(ws + WS_MISC + MO_MPREV);
    const int e2 = c.bid * 512 + c.tid; constexpr int PER_H = DVP * 128 / 2;
    if (e2 >= 4 * PER_H) return;
    const int h = e2 / PER_H, rem = e2 % PER_H;
    f32x2 st = {0.f, 0.f}; float mprev = 0.f;
    for (int c0 = 0; c0 < 64; c0 += 8) {
        f32x2 loc[8];
#pragma unroll
        for (int k = 0; k < 8; ++k) loc[k] = *(const f32x2*)(CTL + ((size_t)(h * 64 + c0 + k)) * (DVP * 128) + 2 * rem);
#pragma unroll
        for (int k = 0; k < 8; ++k) { const int ch = c0 + k; const float gg = GC[h * 64 + ch], am = AMAX[h * 64 + ch];
            *(unsigned*)(CTP + ((size_t)(h * 64 + ch)) * (DVP * 128) + 2 * rem) = cvt_pk_bf16(st[0], st[1]);
            if (rem == 0) MPREV[h * 64 + ch] = mprev;
            const float mnew = fmaxf(gg + mprev, am), dec = __expf(gg + mprev - mnew), sc = __expf(am - mnew);
            st = st * dec + loc[k] * sc; mprev = mnew; }
    }
}

__device__ __forceinline__ bf16x8 scale_frag(bf16x8 f, float s) { float v[8]; unpack8(as_u4(f), v);
#pragma unroll
    for (int i = 0; i < 8; ++i) v[i] *= s;
    return as_frag(pack8(v)); }

__device__ __forceinline__ void mlstm_out(const Args& a, const Ctx& c, int h, int ch) {
    unsigned char* ws = c.ws;
    const bf16_t* QC = (const bf16_t*)(ws + WS_QC); const bf16_t* KC = (const bf16_t*)(ws + WS_KC); const bf16_t* VT = (const bf16_t*)(ws + WS_VT); const bf16_t* CTP = (const bf16_t*)(ws + WS_CTP);
    const float* BV = (const float*)(ws + WS_MISC + MO_BV); const float* UV = (const float*)(ws + WS_MISC + MO_UV); const float* PMX = (const float*)(ws + WS_MISC + MO_PMX);
    const float* MPREV = (const float*)(ws + WS_MISC + MO_MPREV); const bf16_t* PROJ = (const bf16_t*)(ws + WS_PROJ); bf16_t* HCAT = (bf16_t*)(ws + WS_HCAT);
    const int tt = c.lane & 15, g = c.lane >> 4, w = c.wave, t0 = ch * 128, trow = t0 + 16 * w + tt, tid = c.tid;
    LAS unsigned char* RA = c.lds; LAS unsigned char* RB = c.lds + 69632;
    tile256_load(RA, KC + ((size_t)(h * S + t0)) * 128, 128, 128, tid);
    tile256_load(RB, CTP + ((size_t)(h * 64 + ch)) * DVP * 128, 128, DVP, tid);
    const float b_t = BV[h * S + trow], pm_t = PMX[h * S + trow], mprev = MPREV[h * 64 + ch];
    const float m_t = b_t + fmaxf(mprev, pm_t), w_inter = __expf((b_t + mprev) - m_t), bm = b_t - m_t;
    bf16x8 qf[4], qs[4], pf[4];
#pragma unroll
    for (int kd = 0; kd < 4; ++kd) { qf[kd] = *(const bf16x8*)(QC + ((size_t)(h * S + trow)) * 128 + 32 * kd + 8 * g); qs[kd] = scale_frag(qf[kd], w_inter); }
    __syncthreads();
    u32x4 vst[9];
#pragma unroll
    for (int i = 0; i < 9; ++i) { const int idx = tid + 512 * i; if (idx < DVP * 16) vst[i] = *(const u32x4*)(VT + ((size_t)((h * 64 + ch) * DVP + (idx >> 4))) * 128 + 8 * (idx & 15)); }
    const int nsg = (w >> 1) + 1;
#pragma unroll
    for (int sg = 0; sg < 4; ++sg) {
        if (sg < nsg) {
            f32x4 s0 = {0.f, 0.f, 0.f, 0.f}, s1 = {0.f, 0.f, 0.f, 0.f};
#pragma unroll
            for (int kd = 0; kd < 4; ++kd) {
                s0 = mfma16(tile256_frag(RA, 32 * sg + pi32(0, tt), 4 * kd + g), qf[kd], s0);
                s1 = mfma16(tile256_frag(RA, 32 * sg + pi32(1, tt), 4 * kd + g), qf[kd], s1); }
            const f32x4 ua = *(const f32x4*)(UV + h * S + t0 + 32 * sg + 8 * g), ub = *(const f32x4*)(UV + h * S + t0 + 32 * sg + 8 * g + 4);
            float p[8]; const int sl = 32 * sg + 8 * g, tl = 16 * w + tt;
#pragma unroll
            for (int r = 0; r < 4; ++r) { p[r] = (sl + r <= tl) ? s0[r] * __expf(bm + ua[r]) : 0.f; p[4 + r] = (sl + 4 + r <= tl) ? s1[r] * __expf(bm + ub[r]) : 0.f; }
            pf[sg] = as_frag(pack8(p));
        } else pf[sg] = (bf16x8){0, 0, 0, 0, 0, 0, 0, 0};
    }
    f32x4 oacc[17];
#pragma unroll
    for (int mt = 0; mt < 17; ++mt) {
        f32x4 o = {0.f, 0.f, 0.f, 0.f};
#pragma unroll
        for (int kd = 0; kd < 4; ++kd) o = mfma16(tile256_frag(RB, 16 * mt + tt, 4 * kd + g), qs[kd], o);
        oacc[mt] = o;
    }
    __syncthreads();
#pragma unroll
    for (int i = 0; i < 9; ++i) { const int idx = tid + 512 * i; if (idx < DVP * 16) { const int row = idx >> 4, ck = idx & 15; *(LAS u32x4*)(RA + row * 256 + ((ck ^ (row & 15)) << 4)) = vst[i]; } }
    __syncthreads();
#pragma unroll
    for (int mt = 0; mt < 17; ++mt) {
#pragma unroll
        for (int sg = 0; sg < 4; ++sg) if (sg < nsg) oacc[mt] = mfma16(tile256_frag(RA, 16 * mt + tt, 4 * sg + g), pf[sg], oacc[mt]);
    }
    const float den = __shfl(oacc[16][0], tt);
    const float inv = 1.f / fmaxf(fabsf(den), __expf(-m_t));
    float ss = 0.f;
#pragma unroll
    for (int mt = 0; mt < 16; ++mt) { oacc[mt] = oacc[mt] * inv; ss += (oacc[mt][0] * oacc[mt][0] + oacc[mt][1] * oacc[mt][1]) + (oacc[mt][2] * oacc[mt][2] + oacc[mt][3] * oacc[mt][3]); }
    ss += __shfl_xor(ss, 16); ss += __shfl_xor(ss, 32);
    const float rstd = rsqrtf(ss * (1.f / 256.f) + EPS);
    const float* og = INF(8);
#pragma unroll
    for (int mt = 0; mt < 16; ++mt) { const int dv = 16 * mt + 4 * g;
        const f32x4 o4 = *(const f32x4*)(og + h * 256 + dv); const u32x2 mo = *(const u32x2*)(PROJ + (size_t)trow * NPROJ + PC_MO + h * 256 + dv);
        const float v0 = oacc[mt][0] * rstd * o4[0] * sigmoidf_(bf_lo(mo.x)), v1 = oacc[mt][1] * rstd * o4[1] * sigmoidf_(bf_hi(mo.x));
        const float v2 = oacc[mt][2] * rstd * o4[2] * sigmoidf_(bf_lo(mo.y)), v3 = oacc[mt][3] * rstd * o4[3] * sigmoidf_(bf_hi(mo.y));
        u32x2 wv; wv.x = cvt_pk_bf16(v0, v1); wv.y = cvt_pk_bf16(v2, v3);
        *(u32x2*)(HCAT + (size_t)trow * 2048 + h * 256 + dv) = wv; }
    __syncthreads();
}

__device__ __forceinline__ void xattn_item(const Args& a, const Ctx& c, int h, int tile) {
    unsigned char* ws = c.ws; const bf16_t* QX = (const bf16_t*)(ws + WS_QX); const bf16_t* KM = (const bf16_t*)(ws + WS_KM); const bf16_t* VTM = (const bf16_t*)(ws + WS_VTM); bf16_t* OX = (bf16_t*)(ws + WS_OX);
    const int tt = c.lane & 15, g = c.lane >> 4, w = c.wave, trow = tile * 128 + 16 * w + tt, tid = c.tid;
    const float* qg = INF(16);
    u32x4 st[4];
#define XA_LOAD(ci) do { if ((ci) < 8) { _Pragma("unroll") for (int i = 0; i < 4; ++i) { const int idx = tid + 512 * i, row = idx >> 3, ck = idx & 7; \
            st[i] = *(const u32x4*)(KM + ((size_t)(h * 256 + row)) * 512 + 64 * (ci) + 8 * ck); } } \
        else { _Pragma("unroll") for (int i = 0; i < 4; ++i) { const int idx = tid + 512 * i, row = idx >> 5, ck = idx & 31; \
            st[i] = *(const u32x4*)(VTM + ((size_t)(h * 512 + 64 * ((ci) - 8) + row)) * 256 + 8 * ck); } } } while (0)
#define XA_WRITE(ci) do { LAS unsigned char* bb = c.lds + ((ci) & 1) * 32768; if ((ci) < 8) { _Pragma("unroll") for (int i = 0; i < 4; ++i) { const int idx = tid + 512 * i, row = idx >> 3, ck = idx & 7; \
            *(LAS u32x4*)(bb + row * 128 + ((ck ^ (row & 7)) << 4)) = st[i]; } } \
        else { _Pragma("unroll") for (int i = 0; i < 4; ++i) { const int idx = tid + 512 * i, row = idx >> 5, ck = idx & 31; \
            *(LAS u32x4*)(bb + row * 512 + ((ck ^ (row & 7)) << 4)) = st[i]; } } } while (0)
    XA_LOAD(0);
    bf16x8 qf[16]; float ss = 0.f;
#pragma unroll
    for (int ks = 0; ks < 16; ++ks) { qf[ks] = *(const bf16x8*)(QX + (size_t)trow * 2048 + h * 512 + 32 * ks + 8 * g); float v[8]; unpack8(as_u4(qf[ks]), v);
#pragma unroll
        for (int i = 0; i < 8; ++i) ss += v[i] * v[i]; }
    ss += __shfl_xor(ss, 16); ss += __shfl_xor(ss, 32);
    const float rs = rsqrtf(ss * (1.f / 512.f) + EPS) * 0.04419417382415922f;
#pragma unroll
    for (int ks = 0; ks < 16; ++ks) { float v[8]; unpack8(as_u4(qf[ks]), v); const f32x4 g0 = *(const f32x4*)(qg + 32 * ks + 8 * g), g1 = *(const f32x4*)(qg + 32 * ks + 8 * g + 4);
        v[0] *= rs * g0[0]; v[1] *= rs * g0[1]; v[2] *= rs * g0[2]; v[3] *= rs * g0[3]; v[4] *= rs * g1[0]; v[5] *= rs * g1[1]; v[6] *= rs * g1[2]; v[7] *= rs * g1[3];
        qf[ks] = as_frag(pack8(v)); }
    XA_WRITE(0);
    __syncthreads();
    f32x4 sacc[16];
#pragma unroll
    for (int mt = 0; mt < 16; ++mt) sacc[mt] = (f32x4){0.f, 0.f, 0.f, 0.f};
#pragma unroll
    for (int ci = 0; ci < 8; ++ci) {
        XA_LOAD(ci + 1);
        const LAS unsigned char* bb = c.lds + (ci & 1) * 32768;
#pragma unroll
        for (int mt = 0; mt < 16; ++mt) { const int key = 32 * (mt >> 1) + pi32(mt & 1, tt);
#pragma unroll
            for (int k2 = 0; k2 < 2; ++k2) { const bf16x8 af = *(const LAS bf16x8*)(bb + key * 128 + (((4 * k2 + g) ^ (key & 7)) << 4)); sacc[mt] = mfma16(af, qf[2 * ci + k2], sacc[mt]); } }
        XA_WRITE(ci + 1);
        __syncthreads();
    }
    float mx = -INFINITY;
#pragma unroll
    for (int mt = 0; mt < 16; ++mt) mx = fmaxf(mx, fmaxf(fmaxf(sacc[mt][0], sacc[mt][1]), fmaxf(sacc[mt][2], sacc[mt][3])));
    mx = fmaxf(mx, __shfl_xor(mx, 16)); mx = fmaxf(mx, __shfl_xor(mx, 32));
    float l = 0.f; bf16x8 pf[8];
#pragma unroll
    for (int kk = 0; kk < 8; ++kk) { float p[8];
#pragma unroll
        for (int r = 0; r < 4; ++r) { p[r] = __expf(sacc[2 * kk][r] - mx); p[4 + r] = __expf(sacc[2 * kk + 1][r] - mx); }
#pragma unroll
        for (int i = 0; i < 8; ++i) l += p[i];
        pf[kk] = as_frag(pack8(p)); }
    l += __shfl_xor(l, 16); l += __shfl_xor(l, 32);
    const float inv = 1.f / l;
#pragma unroll
    for (int ci = 8; ci < 16; ++ci) {
        if (ci < 15) XA_LOAD(ci + 1);
        const LAS unsigned char* bb = c.lds + (ci & 1) * 32768;
#pragma unroll
        for (int m4 = 0; m4 < 4; ++m4) { f32x4 o0 = {0.f, 0.f, 0.f, 0.f}, o1 = o0; const int row = 16 * m4 + tt;
#pragma unroll
            for (int kk = 0; kk < 8; kk += 2) {
                const bf16x8 a0 = *(const LAS bf16x8*)(bb + row * 512 + (((4 * kk + g) ^ (row & 7)) << 4)), a1 = *(const LAS bf16x8*)(bb + row * 512 + (((4 * kk + 4 + g) ^ (row & 7)) << 4));
                o0 = mfma16(a0, pf[kk], o0); o1 = mfma16(a1, pf[kk + 1], o1); }
            const f32x4 o = (o0 + o1) * inv; u32x2 wv; wv.x = cvt_pk_bf16(o[0], o[1]); wv.y = cvt_pk_bf16(o[2], o[3]);
            *(u32x2*)(OX + (size_t)trow * 2048 + h * 512 + 64 * (ci - 8) + 16 * m4 + 4 * g) = wv; }
        if (ci < 15) XA_WRITE(ci + 1);
        __syncthreads();
    }
#undef XA_LOAD
#undef XA_WRITE
}

__device__ __forceinline__ void split_frag(const f32x4 v0, const f32x4 v1, bf16x8& fh, bf16x8& fl) {
    float x[8] = {v0[0], v0[1], v0[2], v0[3], v1[0], v1[1], v1[2], v1[3]}; float r[8]; u32x4 h = pack8(x); float hf[8]; unpack8(h, hf);
#pragma unroll
    for (int i = 0; i < 8; ++i) r[i] = x[i] - hf[i];
    fh = as_frag(h); fl = as_frag(pack8(r));
}
__device__ __forceinline__ void route_block(const Args& a, const Ctx& c) {
    unsigned char* ws = c.ws; const bf16_t* WRH = (const bf16_t*)(ws + WS_MISC + MO_WR); const bf16_t* WRL = WRH + 80 * 2048; const float* H2 = c.out;
    unsigned* ECNT = (unsigned*)(ws + WS_CTL) + CW_ECNT; float* PAIR_W = (float*)(ws + WS_MISC + MO_PAIR_W); int* ELIST = (int*)(ws + WS_ELIST);
    bf16_t* HNB = (bf16_t*)(ws + WS_HNB);
    LAS float* lg = (LAS float*)c.lds;
    LAS float* ssqp = lg + 8 * 32 * 80;
    LAS float* lgf = ssqp + 256;
    LAS float* rsd = lgf + 32 * 80;
    const int w = c.wave, lane = c.lane, n = lane & 15, g = lane >> 4, tid = c.tid;
    const int r0 = c.bid * 32;
    f32x4 acc[2][5];
#pragma unroll
    for (int t = 0; t < 2; ++t)
#pragma unroll
        for (int i = 0; i < 5; ++i) acc[t][i] = (f32x4){0.f, 0.f, 0.f, 0.f};
    float ssq0 = 0.f, ssq1 = 0.f;
    const float* a0p = H2 + (size_t)(r0 + n) * 2048 + 256 * w + 8 * g; const float* a1p = a0p + (size_t)16 * 2048;
    const bf16_t* bhp = WRH + (size_t)n * 2048 + 256 * w + 8 * g; const bf16_t* blp = WRL + (size_t)n * 2048 + 256 * w + 8 * g;
    f32x4 A0[2][2], A1[2][2]; bf16x8 Bh[2][5], Bl[2][5];
#define RT_LOAD(sb, ks) do { A0[sb][0] = *(const f32x4*)(a0p + 32 * (ks)); A0[sb][1] = *(const f32x4*)(a0p + 32 * (ks) + 4); A1[sb][0] = *(const f32x4*)(a1p + 32 * (ks)); A1[sb][1] = *(const f32x4*)(a1p + 32 * (ks) + 4); \
        _Pragma("unroll") for (int nt = 0; nt < 5; ++nt) { Bh[sb][nt] = *(const bf16x8*)(bhp + (size_t)(16 * nt) * 2048 + 32 * (ks)); Bl[sb][nt] = *(const bf16x8*)(blp + (size_t)(16 * nt) * 2048 + 32 * (ks)); } } while (0)
#define RT_COMP(sb) do { bf16x8 h0, l0, h1, l1; split_frag(A0[sb][0], A0[sb][1], h0, l0); split_frag(A1[sb][0], A1[sb][1], h1, l1); \
        _Pragma("unroll") for (int q = 0; q < 2; ++q) { const f32x4 v = A0[sb][q], u = A1[sb][q]; ssq0 += (v[0] * v[0] + v[1] * v[1]) + (v[2] * v[2] + v[3] * v[3]); ssq1 += (u[0] * u[0] + u[1] * u[1]) + (u[2] * u[2] + u[3] * u[3]); } \
        _Pragma("unroll") for (int nt = 0; nt < 5; ++nt) { \
            acc[0][nt] = mfma16(h0, Bh[sb][nt], acc[0][nt]); acc[0][nt] = mfma16(l0, Bh[sb][nt], acc[0][nt]); acc[0][nt] = mfma16(h0, Bl[sb][nt], acc[0][nt]); \
            acc[1][nt] = mfma16(h1, Bh[sb][nt], acc[1][nt]); acc[1][nt] = mfma16(l1, Bh[sb][nt], acc[1][nt]); acc[1][nt] = mfma16(h1, Bl[sb][nt], acc[1][nt]); } } while (0)
    RT_LOAD(0, 0);
#pragma unroll
    for (int ks = 0; ks < 8; ks += 2) {
        RT_LOAD(1, ks + 1);
        RT_COMP(0);
        if (ks + 2 < 8) RT_LOAD(0, ks + 2);
        RT_COMP(1);
    }
#undef RT_LOAD
#undef RT_COMP
    ssq0 += __shfl_xor(ssq0, 16); ssq0 += __shfl_xor(ssq0, 32); ssq1 += __shfl_xor(ssq1, 16); ssq1 += __shfl_xor(ssq1, 32);
#pragma unroll
    for (int t = 0; t < 2; ++t)
#pragma unroll
        for (int nt = 0; nt < 5; ++nt)
#pragma unroll
            for (int r = 0; r < 4; ++r) lg[(w * 32 + 16 * t + 4 * g + r) * 80 + 16 * nt + n] = acc[t][nt][r];
    if (g == 0) { ssqp[w * 32 + n] = ssq0; ssqp[w * 32 + 16 + n] = ssq1; }
    __syncthreads();
    for (int i = tid; i < 32 * 80; i += 512) { float v = 0.f;
#pragma unroll
        for (int q = 0; q < 8; ++q) v += lg[q * 32 * 80 + i];
        lgf[i] = v; }
    __syncthreads();
    if (tid < 32) {
        const int rr = tid; const int t = r0 + rr;
        float sq = 0.f;
#pragma unroll
        for (int q = 0; q < 8; ++q) sq += ssqp[q * 32 + rr];
        const float rstd = rsqrtf(sq * (1.f / 2048.f) + EPS); rsd[rr] = rstd;
        const float* bg = INF(21); const float* be = INF(23);
        float gl[8]; float gm = -INFINITY; int gs = 0;
#pragma unroll
        for (int j = 0; j < 8; ++j) { gl[j] = lgf[rr * 80 + j] * rstd + bg[j]; if (gl[j] > gm) { gm = gl[j]; gs = j; } }
        float gsum = 0.f;
#pragma unroll
        for (int j = 0; j < 8; ++j) gsum += __expf(gl[j] - gm);
        const float pg = 1.f / gsum;
        float el[8]; float m0 = -INFINITY; int i0 = 0;
#pragma unroll
        for (int j = 0; j < 8; ++j) { el[j] = lgf[rr * 80 + 8 + 8 * gs + j] * rstd + be[8 * gs + j]; if (el[j] > m0) { m0 = el[j]; i0 = j; } }
        float m1 = -INFINITY; int i1 = 0;
#pragma unroll
        for (int j = 0; j < 8; ++j) if (j != i0 && el[j] > m1) { m1 = el[j]; i1 = j; }
        const float e1 = __expf(m1 - m0); const float w0 = pg / (1.f + e1), w1 = pg * e1 / (1.f + e1);
        const int ea = 8 * gs + i0, eb = 8 * gs + i1;
        const int sa = (int)__hip_atomic_fetch_add(ECNT + ea, 1u, __ATOMIC_RELAXED, __HIP_MEMORY_SCOPE_AGENT);
        const int sb = (int)__hip_atomic_fetch_add(ECNT + eb, 1u, __ATOMIC_RELAXED, __HIP_MEMORY_SCOPE_AGENT);
        PAIR_W[2 * t] = w0; PAIR_W[2 * t + 1] = w1; ELIST[(size_t)ea * 8192 + sa] = 2 * t; ELIST[(size_t)eb * 8192 + sb] = 2 * t + 1;
    }
    __syncthreads();
    const float* gf = INF(19);
    f32x4 gg[8];
#pragma unroll
    for (int j = 0; j < 8; ++j) gg[j] = *(const f32x4*)(gf + 256 * j + 4 * lane);
    f32x4 xv[4][8];
#pragma unroll
    for (int i = 0; i < 4; ++i) { const f32x4* xr = (const f32x4*)(H2 + (size_t)(r0 + 4 * w + i) * 2048) + lane;
#pragma unroll
        for (int j = 0; j < 8; ++j) xv[i][j] = xr[64 * j]; }
#pragma unroll
    for (int i = 0; i < 4; ++i) { const int rl = 4 * w + i; const float rstd = rsd[rl]; u32x2* o8 = (u32x2*)(HNB + (size_t)(r0 + rl) * 2048) + lane;
#pragma unroll
        for (int j = 0; j < 8; ++j) { const f32x4 y = xv[i][j] * rstd * gg[j]; u32x2 wv; wv.x = cvt_pk_bf16(y[0], y[1]); wv.y = cvt_pk_bf16(y[2], y[3]); o8[64 * j] = wv; } }
    __syncthreads();
}

__device__ __forceinline__ void moe_gather(const Ctx& c) {
    unsigned char* ws = c.ws; unsigned* CTLW = (unsigned*)(ws + WS_CTL); const unsigned* ECNT = CTLW + CW_ECNT;
    const int* PAIR_E = (const int*)(ws + WS_MISC + MO_PAIR_E); const int* PAIR_SLOT = (const int*)(ws + WS_MISC + MO_PAIR_SLOT); int* ROWPAIR = (int*)(ws + WS_MISC + MO_ROWPAIR);
    int* TILE_E = (int*)(ws + WS_MISC + MO_TILE_E); int* TOFF = (int*)(ws + WS_MISC + MO_TOFF);
    const bf16_t* HNB = (const bf16_t*)(ws + WS_HNB); bf16_t* XG = (bf16_t*)(ws + WS_XG);
    LAS int* toffs = (LAS int*)c.lds;
    if (c.tid < 64) { const int cn = (int)ECNT[c.tid]; const int nt = (cn + 255) >> 8; int incl = nt;
#pragma unroll
        for (int o = 1; o < 64; o <<= 1) { const int t = __shfl_up(incl, o); if (c.lane >= o) incl += t; }
        toffs[c.tid] = incl - nt; if (c.tid == 63) toffs[64] = incl;
        if (c.bid == 0) { TOFF[c.tid] = incl - nt; for (int k = 0; k < nt; ++k) TILE_E[incl - nt + k] = c.tid; if (c.tid == 63) CTLW[CW_NTILES] = (unsigned)incl; } }
    __syncthreads();
    for (int p = c.gw; p < 16384; p += c.NGW) { const int e = PAIR_E[p], sl = PAIR_SLOT[p]; const int row = toffs[e] * 256 + sl;
        const u32x4* src = (const u32x4*)(HNB + (size_t)(p >> 1) * 2048) + c.lane; u32x4* dst = (u32x4*)(XG + (size_t)row * 2048) + c.lane;
#pragma unroll
        for (int j = 0; j < 4; ++j) dst[64 * j] = src[64 * j];
        if (c.lane == 0) ROWPAIR[row] = p; }
    __syncthreads();
}

__device__ __forceinline__ void wait_vm(int n) {
    switch (n) {
        case 0: asm volatile("s_waitcnt vmcnt(0)" ::: "memory"); break;
        case 1: asm volatile("s_waitcnt vmcnt(1)" ::: "memory"); break;
        case 2: asm volatile("s_waitcnt vmcnt(2)" ::: "memory"); break;
        case 3: asm volatile("s_waitcnt vmcnt(3)" ::: "memory"); break;
        case 4: asm volatile("s_waitcnt vmcnt(4)" ::: "memory"); break;
        case 5: asm volatile("s_waitcnt vmcnt(5)" ::: "memory"); break;
        case 6: asm volatile("s_waitcnt vmcnt(6)" ::: "memory"); break;
        default: asm volatile("s_waitcnt vmcnt(7)" ::: "memory"); break;
    }
}
template <int MODE, int VAR = 0>
__device__ __forceinline__ void moe_direct(const Args& a, const Ctx& c) {
    unsigned char* ws = c.ws;
    constexpr int K = (MODE == 1) ? 2048 : 512, LDW = (MODE == 1) ? 512 : 2048, UPE = (MODE == 1) ? 8 : 16, NCH = K / 32, MAXT = 24, MROWS = MAXT * 16;
    constexpr int XBUF = MROWS * 64, WOFF = 3 * XBUF, TOFF = WOFF + 4 * 16384;
    const unsigned* ECNT = (const unsigned*)(ws + WS_CTL) + CW_ECNT; const int* ELIST = (const int*)(ws + WS_ELIST); const float* PAIR_W = (const float*)(ws + WS_MISC + MO_PAIR_W);
    const bf16_t* XSRC = (const bf16_t*)(ws + (MODE == 1 ? WS_HNB : WS_ACT)); bf16_t* ACT = (bf16_t*)(ws + (VAR ? WS_XG : WS_ACT)); bf16_t* YB = (bf16_t*)(ws + (VAR ? WS_XG : WS_YB));
    LAS unsigned char* xb = c.lds;
    LAS unsigned char* wb = c.lds + WOFF;
    LAS int* rowoff = (LAS int*)(c.lds + TOFF);
    LAS int* rowpair = rowoff + MROWS;
    LAS float* rowwt = (LAS float*)(rowpair + MROWS);
    const int tid = c.tid, lane = c.lane, w = c.wave, tt = lane & 15, g = lane >> 4;
    const int hh = w >> 2, cgp = w & 3;
    const int xcd_ = c.bid & 7, idx_ = c.bid >> 3, EPX = 32 / UPE;
    for (int r = 0; r < (64 * UPE) / 256; ++r) {
        int e, sl;
        if (c.G == 256) { e = r * (8 * EPX) + xcd_ * EPX + idx_ / UPE; sl = idx_ % UPE; } else { const int u = r * c.G + c.bid; if (u >= 64 * UPE) break; e = u / UPE; sl = u % UPE; }
        const int ne = (int)ECNT[e];
        const float* wsrc[2];
#pragma unroll
        for (int i = 0; i < 2; ++i) { const int k = 4 * w + 2 * i + (lane >> 5), q = w >> 1, sidx = lane & 31;
            if (MODE == 1) { const int h = sidx >> 4, cgs = ((sidx & 15) - 2 * q - 4 * h) & 15;
                wsrc[i] = (h ? INF(25) : INF(24)) + (size_t)e * 2048 * 512 + (size_t)k * LDW + sl * 64 + 4 * cgs; }
            else { const int cgs = (sidx - 4 * q) & 31; wsrc[i] = INF(26) + (size_t)e * 512 * 2048 + (size_t)k * LDW + sl * 128 + 4 * cgs; } }
        int wrd[2];
#pragma unroll
        for (int t = 0; t < 2; ++t) { const int wq = 2 * cgp + t;
            if (MODE == 1) { const int h = tt >> 3, cc = 8 * wq + (tt & 7); wrd[t] = ((8 * g) * 128 + 64 * h + ((cc + 8 * g + 16 * h) & 63)) * 4; }
            else { const int col = 16 * wq + tt; wrd[t] = ((8 * g) * 128 + ((col + 16 * g) & 127)) * 4; } }
        for (int m0 = 0; m0 < ne; m0 += MROWS) {
            const int mrows = min(MROWS, ne - m0), nt = (mrows + 15) >> 4;
            if (tid < MROWS) { const int rr = tid < mrows ? tid : mrows - 1; const int p = ELIST[(size_t)e * 8192 + m0 + rr];
              rowoff[tid] = (MODE == 1) ? (p >> 1) * 2048 : p * 512; rowpair[tid] = p; rowwt[tid] = PAIR_W[p]; }
            __syncthreads();
            f32x4 acc[2][12];
#pragma unroll
            for (int t = 0; t < 2; ++t)
#pragma unroll
                for (int i = 0; i < 12; ++i) acc[t][i] = (f32x4){0.f, 0.f, 0.f, 0.f};
            int roff[3];
#pragma unroll
            for (int i = 0; i < 3; ++i) roff[i] = rowoff[16 * (8 * i + w) + (lane >> 2)] + 8 * (lane & 3);
            const int nx = (VAR & 1) ? 0 : ((nt - w + 7) >> 3);
            const int nw = (VAR & 2) ? 0 : 2;
            const int xrd = tt * 64 + g * 16 + 1024 * hh;
#define MD_XDMA(ch) do { LAS unsigned char* bb = xb + ((ch) % 3) * XBUF; _Pragma("unroll") for (int i = 0; i < 3; ++i) if (i < nx) \
                __builtin_amdgcn_global_load_lds((const unsigned*)(XSRC + (size_t)roff[i] + 32 * (ch)), (LAS unsigned*)(bb + (8 * i + w) * 1024), 16, 0, 0); } while (0)
#define MD_WDMA(ch) do { LAS unsigned char* bb = wb + ((ch) & 3) * 16384; _Pragma("unroll") for (int i = 0; i < 2; ++i) if (i < nw) \
                __builtin_amdgcn_global_load_lds((const unsigned*)(wsrc[i] + (size_t)(32 * (ch)) * LDW), (LAS unsigned*)(bb + (2 * w + i) * 1024), 16, 0, 0); } while (0)
            asm volatile("s_waitcnt vmcnt(0)" ::: "memory");
            MD_WDMA(0); MD_XDMA(0); MD_WDMA(1); MD_XDMA(1); MD_WDMA(2);
            const int nmi = (nt - hh + 1) >> 1;
            for (int ch = 0; ch < NCH; ++ch) {
                wait_vm((ch + 1 < NCH ? nw + nx : 0) + (ch + 2 < NCH ? nw : 0));
                __builtin_amdgcn_s_barrier(); asm volatile("" ::: "memory");
                if (ch + 2 < NCH) MD_XDMA(ch + 2);
                if (ch + 3 < NCH) MD_WDMA(ch + 3);
                const LAS unsigned char* wsl = wb + (ch & 3) * 16384;
                float wr0[8], wr1[8];
#pragma unroll
                for (int j = 0; j < 8; ++j) { wr0[j] = *(const LAS float*)(wsl + wrd[0] + 512 * j); wr1[j] = *(const LAS float*)(wsl + wrd[1] + 512 * j); }
                u32x4 t0, t1; t0.x = cvt_pk_bf16(wr0[0], wr0[1]); t0.y = cvt_pk_bf16(wr0[2], wr0[3]); t0.z = cvt_pk_bf16(wr0[4], wr0[5]); t0.w = cvt_pk_bf16(wr0[6], wr0[7]);
                t1.x = cvt_pk_bf16(wr1[0], wr1[1]); t1.y = cvt_pk_bf16(wr1[2], wr1[3]); t1.z = cvt_pk_bf16(wr1[4], wr1[5]); t1.w = cvt_pk_bf16(wr1[6], wr1[7]);
                const bf16x8 wf0 = as_frag(t0), wf1 = as_frag(t1);
                const LAS unsigned char* bb = xb + (ch % 3) * XBUF + xrd;
#define MD_RD(X_, bq) do { _Pragma("unroll") for (int q = 0; q < 4; ++q) X_[q] = *(const LAS bf16x8*)(bb + 2048 * (4 * (bq) + q)); } while (0)
#define MD_MM(X_, bq) do { _Pragma("unroll") for (int q = 0; q < 4; ++q) { acc[0][4 * (bq) + q] = mfma16(wf0, X_[q], acc[0][4 * (bq) + q]); acc[1][4 * (bq) + q] = mfma16(wf1, X_[q], acc[1][4 * (bq) + q]); } } while (0)
                { bf16x8 xa[4], xc[4]; const bool b1 = nmi > 4, b2 = nmi > 8;
                  MD_RD(xa, 0); if (b1) MD_RD(xc, 1);
                  MD_MM(xa, 0); asm volatile("" ::: "memory");
                  if (b2) MD_RD(xa, 2);
                  if (b1) MD_MM(xc, 1);
                  if (b2) MD_MM(xa, 2); }
#undef MD_RD
#undef MD_MM
                LDS_WAIT();
            }
#undef MD_XDMA
#undef MD_WDMA
            const LAS int* rp_ = rowpair + tt + 16 * hh; const LAS float* rw_ = rowwt + tt + 16 * hh;
            asm volatile("" : "+v"(rp_), "+v"(rw_));
#pragma unroll
            for (int mi = 0; mi < 12; ++mi) if (mi < nmi) { const int row = 16 * (2 * mi + hh) + tt; const bool valid = row < mrows; const int p = rp_[32 * mi];
#pragma unroll
                for (int t = 0; t < 2; ++t) { const int wq = 2 * cgp + t;
                    if (MODE == 1) {
                        const float u0 = __shfl_xor(acc[t][mi][0], 32), u1 = __shfl_xor(acc[t][mi][1], 32), u2 = __shfl_xor(acc[t][mi][2], 32), u3 = __shfl_xor(acc[t][mi][3], 32);
                        if (valid && g < 2) { const float g0 = acc[t][mi][0], g1 = acc[t][mi][1], g2 = acc[t][mi][2], g3 = acc[t][mi][3];
                            u32x2 wv; wv.x = cvt_pk_bf16(g0 / (1.f + __expf(-g0)) * u0, g1 / (1.f + __expf(-g1)) * u1); wv.y = cvt_pk_bf16(g2 / (1.f + __expf(-g2)) * u2, g3 / (1.f + __expf(-g3)) * u3);
                            *(u32x2*)(ACT + (size_t)p * 512 + sl * 64 + 8 * wq + 4 * g) = wv; }
                    } else {
                        if (valid) { const float pw = rw_[32 * mi]; u32x2 wv; wv.x = cvt_pk_bf16(acc[t][mi][0] * pw, acc[t][mi][1] * pw); wv.y = cvt_pk_bf16(acc[t][mi][2] * pw, acc[t][mi][3] * pw);
                            *(u32x2*)(YB + (size_t)p * 2048 + sl * 128 + 16 * wq + 4 * g) = wv; }
                    }
                }
            }
            __syncthreads();
        }
    }
}

__device__ __forceinline__ void moe_combine(const Ctx& c) {
    const bf16_t* YB = (const bf16_t*)(c.ws + WS_YB);
    for (int t = c.gw; t < S; t += c.NGW) {
        f32x4* orow = (f32x4*)(c.out + (size_t)t * 2048); const u32x4* y0 = (const u32x4*)(YB + (size_t)(2 * t) * 2048); const u32x4* y1 = (const u32x4*)(YB + (size_t)(2 * t + 1) * 2048);
#pragma unroll
        for (int j = 0; j < 4; ++j) { const int ck = 64 * j + c.lane; float a8[8], b8[8]; unpack8(y0[ck], a8); unpack8(y1[ck], b8);
            f32x4 o0 = orow[2 * ck], o1 = orow[2 * ck + 1];
            o0[0] += a8[0] + b8[0]; o0[1] += a8[1] + b8[1]; o0[2] += a8[2] + b8[2]; o0[3] += a8[3] + b8[3]; o1[0] += a8[4] + b8[4]; o1[1] += a8[5] + b8[5]; o1[2] += a8[6] + b8[6]; o1[3] += a8[7] + b8[7];
            orow[2 * ck] = o0; orow[2 * ck + 1] = o1; }
    }
}

__global__ void __launch_bounds__(512, 2) mega(Args a) {
    extern __shared__ __attribute__((aligned(16))) unsigned char lds_raw[];
    Ctx c; c.lds = (LAS unsigned char*)lds_raw; c.tid = threadIdx.x; c.lane = c.tid & 63; c.wave = __builtin_amdgcn_readfirstlane(c.tid >> 6);
    c.bid = blockIdx.x; c.G = gridDim.x; c.gw = c.bid * 8 + c.wave; c.NGW = c.G * 8; c.ws = a.ws; c.out = a.out;
    unsigned char* ws = a.ws;
    const int lo = a.ph_lo, hi = a.ph_hi;
#ifdef ONLY_PH
#define IN(k) ((k) == ONLY_PH)
#else
#define IN(k) (lo <= (k) && (k) < hi)
#endif
    volatile LAS unsigned* bst = (volatile LAS unsigned*)(c.lds + 147392);
    if (c.tid < 2) bst[c.tid] = 0u;
    __syncthreads();
    XcdBarrier xbar; xbar.bar = (unsigned*)(ws + WS_CTL) + CW_BAR; xbar.x = 0; xbar.st = bst;
    if (a.single) xbar = xcd_barrier_post((unsigned*)(ws + WS_CTL) + CW_BAR, bst);
#define GSYNC(k) do { if ((k) == 0) cg::this_grid().sync(); else xcd_barrier(xbar); } while (0)
#define SEAM(k) do { if (IN(k) && IN((k) + 1)) { GSYNC(k); } } while (0)

    if (IN(0)) { phase0(a, c); __syncthreads(); }
    SEAM(0);
    if (IN(1)) {
        { pg8::Gemm g{(const bf16_t*)(ws + WS_XN), (const bf16_t*)(ws + WS_WIN), 2048, 2048}; pg8::StaticOrder So; So.init(S, NPROJ, c.G, c.bid);
          pg8::EpiBf16 E{(bf16_t*)(ws + WS_PROJ), NPROJ, nullptr};
          pg8::gemm_phase<pg8::EpiBf16, pg8::StaticOrder, true, true>(c.lds, g, So, E); }
        { pg8::Gemm g{(const bf16_t*)(ws + WS_MEMN), (const bf16_t*)(ws + WS_WKV), 256, 2048}; pg8::SplitOrder So{16, 8, c.G, c.bid};
          pg8::EpiSlab E{(float*)(ws + WS_KVSLAB), 4096, (size_t)256 * 4096};
          pg8::gemm_phase<pg8::EpiSlab, pg8::SplitOrder, true, true>(c.lds, g, So, E); }
    }
    SEAM(1);
    if (IN(2)) {
        for (int it = c.bid; it < 256; it += c.G) prep_mlstm(a, c, it >> 6, it & 63);
        for (int it = c.bid; it < 256; it += c.G) prep_moba(a, c, it >> 5, it & 31);
        prep_xamem(a, c);
        if (c.bid == 0 && c.tid < 256) ((unsigned*)(ws + WS_CTL))[CW_BCNT + c.tid] = 0u;
    }
    SEAM(2);
    if (IN(3)) {
        for (int it = c.bid; it < 256; it += c.G) mlstm_local(c, it >> 6, it & 63);
        for (int it = c.bid; it < 512; it += c.G) { const int cb = (it < 256) ? (31 - (it >> 4)) : ((it - 256) >> 4); moba_select(c, (it & 15) >> 1, cb, it & 1); }
    }
    SEAM(3);
    if (IN(4)) { if (c.G * 512 >= 4 * DVP * 64) mlstm_scan(c); moba_bucket_phase(c); }
    SEAM(4);
    if (IN(5)) {
        for (int it = c.bid; it < 256; it += c.G) mlstm_out(a, c, it >> 6, it & 63);
        for (int it = c.bid; it < 512; it += c.G) { const int cb = (it < 256) ? (31 - (it >> 4)) : ((it - 256) >> 4); moba_own(c, (it & 15) >> 1, cb, it & 1); }
    }
    SEAM(5);
    if (IN(6)) {
        pg8::Gemm g{(const bf16_t*)(ws + WS_HCAT), (const bf16_t*)(ws + WS_WOUT), 2048, 2048}; pg8::StaticOrder So; So.init(S, 2048, c.G, c.bid);
        pg8::EpiResid E{INF(0), (float*)(ws + WS_H1F), (bf16_t*)(ws + WS_H1B), (float*)(ws + WS_MISC + MO_SSQ)};
        pg8::gemm_phase<pg8::EpiResid, pg8::StaticOrder, false, true>(c.lds, g, So, E);
    }
    SEAM(6);
    if (IN(7)) {
        pg8::Gemm g{(const bf16_t*)(ws + WS_H1B), (const bf16_t*)(ws + WS_WQ), 2048, 2048}; pg8::StaticOrder So; So.init(S, 2048, c.G, c.bid);
        pg8::EpiBf16 E{(bf16_t*)(ws + WS_QX), 2048, (const float*)(ws + WS_MISC + MO_SSQ)};
        pg8::gemm_phase<pg8::EpiBf16, pg8::StaticOrder, false, true>(c.lds, g, So, E);
    }
    SEAM(7);
    if (IN(8)) { for (int it = c.bid; it < 256; it += c.G) xattn_item(a, c, it & 3, it >> 2); }
    SEAM(8);
    if (IN(9)) {
        pg8::Gemm g{(const bf16_t*)(ws + WS_OX), (const bf16_t*)(ws + WS_WO), 2048, 2048}; pg8::StaticOrder So; So.init(S, 2048, c.G, c.bid);
        pg8::EpiResid E{(const float*)(ws + WS_H1F), a.out, nullptr, nullptr};
        if (c.bid == 0 && c.tid < 128) ((unsigned*)(ws + WS_CTL))[CW_ECNT + c.tid] = 0u;
        pg8::gemm_phase<pg8::EpiResid, pg8::StaticOrder, false, true>(c.lds, g, So, E);
    }
    SEAM(9);
    if (IN(10)) { if (c.G == 256) route_block(a, c); }
    do { if (IN(10) && IN(12)) { GSYNC(10); } } while (0);
#ifdef PROBE_VAR
#if PROBE_VAR < 10
    if (IN(11)) moe_direct<1, PROBE_VAR>(a, c);
#elif PROBE_VAR == 10
    if (IN(11)) mlstm_scan(c);
#elif PROBE_VAR == 11
    if (IN(11)) moba_bucket_phase(c);
#elif PROBE_VAR == 12
    if (IN(11)) { for (int it = c.bid; it < 256; it += c.G) mlstm_out(a, c, it >> 6, it & 63); }
#elif PROBE_VAR == 13
    if (IN(11)) { for (int it = c.bid; it < 512; it += c.G) { const int cb = (it < 256) ? (31 - (it >> 4)) : ((it - 256) >> 4); moba_own(c, (it & 15) >> 1, cb, it & 1); } }
#elif PROBE_VAR == 14
    if (IN(11)) { for (int it = c.bid; it < 256; it += c.G) mlstm_local(c, it >> 6, it & 63); }
#endif
#endif
    if (IN(12)) moe_direct<1>(a, c);
    SEAM(12);
    if (IN(13)) moe_direct<2>(a, c);
    SEAM(13);
    if (IN(14)) moe_combine(c);
#undef IN
#undef SEAM
}

constexpr int LDS_BYTES = 147456;
extern "C" void kernel_launch(void* const* d_in, const int* in_sizes, int n_in, void* d_out, int out_size, void* d_ws, size_t ws_size, hipStream_t stream) {
    static int grid = 0;
    if (grid == 0) {
        if (n_in != 27 || out_size != S * D || ws_size < WS_END2) { fprintf(stderr, "kernel_launch: unexpected shapes (n_in %d out %d ws %zu)\n", n_in, out_size, ws_size); grid = -1; return; }
        int dev = 0, cus = 0, per_cu = 0;
        hipGetDevice(&dev); hipDeviceGetAttribute(&cus, hipDeviceAttributeMultiprocessorCount, dev);
        hipFuncSetAttribute((const void*)mega, hipFuncAttributeMaxDynamicSharedMemorySize, LDS_BYTES);
        hipOccupancyMaxActiveBlocksPerMultiprocessor(&per_cu, (const void*)mega, 512, LDS_BYTES);
        (void)hipGetLastError();
        grid = (per_cu >= 1) ? cus : -1;
        if (grid != 256) { fprintf(stderr, "kernel_launch: needs a 256-CU device with one resident block per CU (cus %d per_cu %d)\n", cus, per_cu); grid = -1; return; }
    }
    if (grid < 0) return;
    (void)hipMemsetAsync((char*)d_ws + WS_CTL, 0, CTL_ZERO_BYTES, stream);
    Args a{};
    for (int i = 0; i < 27; ++i) a.in[i] = d_in[i];
    a.out = (float*)d_out; a.ws = (unsigned char*)d_ws; a.single = MK_SINGLE; a.pad = 0;
#if MK_SINGLE
    a.ph_lo = 0; a.ph_hi = NPH;
    void* args[] = {&a};
    hipError_t e = hipLaunchCooperativeKernel((const void*)mega, dim3(grid), dim3(512), args, LDS_BYTES, stream);
    if (e != hipSuccess) fprintf(stderr, "cooperative launch failed: %s\n", hipGetErrorString(e));
#else
    for (int p = 0; p < NPH; ++p) {
#ifdef REP_GROUP_LO
        if (p == REP_GROUP_LO) { for (int r = 0; r < 2; ++r) for (int q = REP_GROUP_LO; q <= REP_GROUP_HI; ++q) { a.ph_lo = q; a.ph_hi = q + 1; hipLaunchKernelGGL(mega, dim3(grid), dim3(512), LDS_BYTES, stream, a); } }
#endif
        a.ph_lo = p; a.ph_hi = p + 1;
#ifdef REP_MASK
        const int reps = ((REP_MASK >> p) & 1) ? 3 : 1;
#else
        const int reps = 1;
#endif
        for (int r = 0; r < reps; ++r) hipLaunchKernelGGL(mega, dim3(grid), dim3(512), LDS_BYTES, stream, a); }
#endif
}
```

```cpp
#include <hip/hip_runtime.h>
#include <hip/hip_cooperative_groups.h>
#include <cstdio>
#include <cstdint>
namespace cg = cooperative_groups;

#ifndef MK_SINGLE
#define MK_SINGLE 1
#endif

#define LAS __attribute__((address_space(3)))
typedef unsigned short bf16_t;
typedef short bf16x8 __attribute__((ext_vector_type(8)));
typedef float f32x4 __attribute__((ext_vector_type(4)));
typedef float f32x2 __attribute__((ext_vector_type(2)));
typedef unsigned u32x4 __attribute__((ext_vector_type(4)));
typedef unsigned u32x2 __attribute__((ext_vector_type(2)));

constexpr int S = 8192, D = 2048, DIN = 6152, NPROJ = 6144, MEML = 256;
constexpr int NPH = 15;
constexpr float EPS = 1e-6f;
constexpr int PC_MQ = 0, PC_MK = 512, PC_MV = 1024, PC_MO = 2048, PC_AQ = 3072, PC_AK = 4096, PC_AV = 5120;
constexpr int DVP = 272;

constexpr size_t MiB = 1u << 20;
constexpr size_t WS_CTL = 0;
constexpr size_t WS_WIN = 1 * MiB;
constexpr size_t WS_WOUT = 25 * MiB;
constexpr size_t WS_WQ = 33 * MiB;
constexpr size_t WS_WKV = 41 * MiB;
constexpr size_t WS_WO = 57 * MiB;
constexpr size_t WS_WGU = 65 * MiB;
constexpr size_t WS_WD = 321 * MiB;
constexpr size_t WS_XN = 449 * MiB;
constexpr size_t WS_MEMN = 481 * MiB;
constexpr size_t WS_PROJ = 482 * MiB;
constexpr size_t WS_KVMEM = 578 * MiB;
constexpr size_t WS_QC = 580 * MiB;
constexpr size_t WS_KC = 588 * MiB;
constexpr size_t WS_KWT = 596 * MiB;
constexpr size_t WS_VT = 604 * MiB;
constexpr size_t WS_CTL_LOC = 621 * MiB;
constexpr size_t WS_CTP = 655 * MiB;
constexpr size_t WS_QP = 672 * MiB;
constexpr size_t WS_KP = 688 * MiB;
constexpr size_t WS_VTP = 704 * MiB;
constexpr size_t WS_KM = 720 * MiB;
constexpr size_t WS_VTM = 721 * MiB;
constexpr size_t WS_HCAT = 722 * MiB;
constexpr size_t WS_H1B = 754 * MiB;
constexpr size_t WS_QX = 786 * MiB;
constexpr size_t WS_OX = 818 * MiB;
constexpr size_t WS_MISC = 850 * MiB;
constexpr size_t WS_ACT = 854 * MiB;
constexpr size_t WS_YB = 886 * MiB;
constexpr size_t WS_END = 950 * MiB;
constexpr size_t WS_PART = WS_END;
constexpr size_t WS_BLIST = WS_END + 48 * MiB;
constexpr size_t WS_LPART = WS_END + 52 * MiB;
constexpr size_t WS_PSLOT = WS_END + 53 * MiB;
constexpr size_t WS_POFF = WS_END + 54 * MiB;
constexpr size_t WS_ELIST = WS_END + 56 * MiB;
constexpr size_t WS_END2 = WS_END + 58 * MiB;
constexpr size_t WS_KVSLAB = WS_ACT;
constexpr size_t WS_H1F = WS_PROJ;
constexpr size_t WS_XG = WS_PROJ;
constexpr size_t WS_HNB = WS_XN;
constexpr size_t MO_GATES = 0;
constexpr size_t MO_BV = 256 * 1024;
constexpr size_t MO_UV = 384 * 1024;
constexpr size_t MO_PMX = 512 * 1024;
constexpr size_t MO_GC = 640 * 1024;
constexpr size_t MO_AMAX = 641 * 1024;
constexpr size_t MO_MPREV = 642 * 1024;
constexpr size_t MO_KMEAN = 648 * 1024;
constexpr size_t MO_SSQ = 1024 * 1024;
constexpr size_t MO_WR = 2048 * 1024;
constexpr size_t MO_PAIR_E = 2752 * 1024;
constexpr size_t MO_PAIR_SLOT = 2816 * 1024;
constexpr size_t MO_PAIR_W = 2880 * 1024;
constexpr size_t MO_ROWPAIR = 2944 * 1024;
constexpr size_t MO_TILE_E = 3072 * 1024;
constexpr size_t MO_TOFF = 3073 * 1024;
constexpr int CW_ECNT = 1024;
constexpr int CW_NTILES = 1100;
constexpr int CW_BCNT = 1280;
constexpr int CW_BAR = 4096;
constexpr size_t CTL_ZERO_BYTES = 65536;

struct Args { const void* in[27]; float* out; unsigned char* ws; int ph_lo, ph_hi; int single, pad; };

__device__ __forceinline__ unsigned cvt_pk_bf16(float lo, float hi) { unsigned r; asm("v_cvt_pk_bf16_f32 %0, %1, %2" : "=v"(r) : "v"(lo), "v"(hi)); return r; }
__device__ __forceinline__ float bf_lo(unsigned u) { return __uint_as_float(u << 16); }
__device__ __forceinline__ float bf_hi(unsigned u) { return __uint_as_float(u & 0xffff0000u); }
__device__ __forceinline__ float bf1(bf16_t h) { return __uint_as_float(((unsigned)h) << 16); }
__device__ __forceinline__ bf16_t f2bf(float f) { return (bf16_t)(cvt_pk_bf16(f, 0.f) & 0xffffu); }
__device__ __forceinline__ void unpack8(u32x4 v, float (&f)[8]) {
    f[0] = bf_lo(v.x); f[1] = bf_hi(v.x); f[2] = bf_lo(v.y); f[3] = bf_hi(v.y); f[4] = bf_lo(v.z); f[5] = bf_hi(v.z); f[6] = bf_lo(v.w); f[7] = bf_hi(v.w);
}
__device__ __forceinline__ u32x4 pack8(const float (&f)[8]) {
    u32x4 v; v.x = cvt_pk_bf16(f[0], f[1]); v.y = cvt_pk_bf16(f[2], f[3]); v.z = cvt_pk_bf16(f[4], f[5]); v.w = cvt_pk_bf16(f[6], f[7]); return v;
}
__device__ __forceinline__ bf16x8 as_frag(u32x4 v) { return __builtin_bit_cast(bf16x8, v); }
__device__ __forceinline__ u32x4 as_u4(bf16x8 v) { return __builtin_bit_cast(u32x4, v); }
__device__ __forceinline__ float wave_sum(float v) {
#pragma unroll
    for (int o = 1; o < 64; o <<= 1) v += __shfl_xor(v, o);
    return v;
}
__device__ __forceinline__ float sigmoidf_(float x) { return 1.f / (1.f + __expf(-x)); }
__device__ __forceinline__ f32x4 mfma16(bf16x8 a, bf16x8 b, f32x4 c) { return __builtin_amdgcn_mfma_f32_16x16x32_bf16(a, b, c, 0, 0, 0); }
__device__ __forceinline__ int pi32(int tq, int i) { return 8 * (i >> 2) + 4 * tq + (i & 3); }
#define LDS_WAIT() asm volatile("s_waitcnt lgkmcnt(0)" ::: "memory")

namespace pg8 {
constexpr int BM = 256, BK = 64, HALF = 128, HTB = HALF * BK * 2, STAGE_BYTES = 8 * HTB, NXCD = 8, WGM = 8;
__device__ __forceinline__ int lds_byte(int r, int c) { const int st = (r >> 4) * 2 + (c >> 5), rr = r & 15, cc = c & 31, ob = rr * 64 + cc * 2; return st * 1024 + (ob ^ (((ob >> 9) & 1) << 5)); }
__device__ __forceinline__ void stage_rc(int b, int& R, int& C) { const int st = b / 1024, sb = b % 1024, swz = sb ^ (((sb >> 9) & 1) << 5); R = (st >> 1) * 16 + swz / 64; C = (st & 1) * 32 + (swz % 64) / 2; }
__device__ __forceinline__ int perm32(int rho) { const int n = rho >> 4, i = rho & 15; return 8 * (i >> 2) + 4 * n + (i & 3); }
struct Unit { int pm, pn, ks; };
struct Gemm { const bf16_t* A; const bf16_t* Bt; int K; int ld; };
struct StaticOrder {
    int nM, nN, nwg, G, c;
    __device__ void init(int M, int N, int G_, int c_) { nM = M / BM; nN = N / BM; nwg = nM * nN; G = G_; c = c_; }
    __device__ bool next(int i, Unit& u) const {
        const long L = (long)i * G + c; if (L >= nwg) return false;
        int wgid = (int)L; { const int q = nwg / NXCD, r = nwg % NXCD, xcd = wgid % NXCD, off = wgid / NXCD; wgid = (xcd < r ? xcd * (q + 1) : r * (q + 1) + (xcd - r) * q) + off; }
        const int nig = WGM * nN, gid = wgid / nig, fm = gid * WGM, gsz = (nM - fm) < WGM ? (nM - fm) : WGM;
        u.pm = fm + ((wgid % nig) % gsz); u.pn = (wgid % nig) / gsz; u.ks = 0; return true;
    }
};
struct SplitOrder {
    int nN, nS, G, c;
    __device__ bool next(int i, Unit& u) const { const long L = (long)i * G + c; if (L >= (long)nN * nS) return false; u.pm = 0; u.pn = (int)(L / nS); u.ks = (int)(L % nS); return true; }
};
struct GroupedOrder {
    const int* tile_e; int ntiles, nN, G, c;
    __device__ bool next(int i, Unit& u) const {
        const long L = (long)i * G + c; if (L >= (long)ntiles * nN) return false;
        const int pm = (int)(L / nN), pl = (int)(L % nN);
        const int e = __builtin_amdgcn_readfirstlane(__hip_atomic_load(tile_e + pm, __ATOMIC_RELAXED, __HIP_MEMORY_SCOPE_AGENT));
        u.pm = pm; u.pn = e * nN + pl; u.ks = 0; return true;
    }
};

template <class Epi, class Sched, bool ALIGN_EPI, bool SP2>
__device__ __forceinline__ void gemm_phase(LAS unsigned char* lds, const Gemm g, const Sched& S, const Epi& E) {
    const int tid = threadIdx.x, wid = __builtin_amdgcn_readfirstlane(tid >> 6), lane = tid & 63, wr = wid >> 2, wc = wid & 3, fr = lane & 15, fq = lane >> 4;
    const int K = g.ld, nt = g.K / BK;
    unsigned voffA[2], voffB[2];
#pragma unroll
    for (int i = 0; i < 2; ++i) { int R, C; stage_rc(tid * 16 + i * 8192, R, C); const int Rb = Epi::PERM ? ((R & ~31) + perm32(R & 31)) : R;
        voffA[i] = (unsigned)(R * K + C) * 2u; voffB[i] = (unsigned)(Rb * K + C) * 2u; }
    const size_t kstep = (size_t)(BK * 2);
    const size_t hstep = (size_t)HALF * K * 2;
    const size_t tstep = 2 * hstep;
    const unsigned ldsw = (unsigned)wid * 1024u;
    const int aoff = lds_byte(wr * 64 + fr, fq * 8), boff = lds_byte(wc * 32 + fr, fq * 8);
#define PG8_SA(b, h) (((b) * 2 + (h)) * HTB)
#define PG8_SB(b, h) ((4 + (b) * 2 + (h)) * HTB)
#define PG8_STAGE(bufoff, gbase, voff) do { _Pragma("unroll") for (int _i = 0; _i < 2; ++_i) \
        __builtin_amdgcn_global_load_lds((const unsigned*)((const char*)(gbase) + (voff)[_i]), (LAS unsigned*)(lds + (bufoff) + ldsw + _i * 8192), 16, 0, 0); } while (0)
#define PG8_LDA(dst, b, h) do { _Pragma("unroll") for (int m = 0; m < 4; ++m) _Pragma("unroll") for (int k = 0; k < 2; ++k) dst[m][k] = *(const LAS bf16x8*)(lds + PG8_SA(b, h) + aoff + m * 2048 + k * 1024); } while (0)
#define PG8_LDB(dst, b, h) do { _Pragma("unroll") for (int n = 0; n < 2; ++n) _Pragma("unroll") for (int k = 0; k < 2; ++k) dst[n][k] = *(const LAS bf16x8*)(lds + PG8_SB(b, h) + boff + n * 2048 + k * 1024); } while (0)
#define PG8_MMA(ai, bj, At, Bt) do { __builtin_amdgcn_s_setprio(1); _Pragma("unroll") for (int m = 0; m < 4; ++m) _Pragma("unroll") for (int n = 0; n < 2; ++n) _Pragma("unroll") for (int k = 0; k < 2; ++k) \
        acc[ai][bj][m][n] = __builtin_amdgcn_mfma_f32_16x16x32_bf16(Bt[n][k], At[m][k], acc[ai][bj][m][n], 0, 0, 0); __builtin_amdgcn_s_setprio(0); } while (0)
#define PG8_WAIT_V(n) asm volatile("s_waitcnt vmcnt(" #n ")" ::: "memory")
#define PG8_WAIT_L(n) asm volatile("s_waitcnt lgkmcnt(" #n ")" ::: "memory")
#define PG8_BAR __builtin_amdgcn_s_barrier()
#define PG8_SCHED __builtin_amdgcn_sched_barrier(0)
    Unit cur, nxt; int ui = 0;
    if (!S.next(0, cur)) return;
    f32x4 acc[2][2][4][2];
#pragma unroll
    for (int a = 0; a < 2; ++a)
#pragma unroll
        for (int b = 0; b < 2; ++b)
#pragma unroll
            for (int m = 0; m < 4; ++m)
#pragma unroll
                for (int n = 0; n < 2; ++n) acc[a][b][m][n] = (f32x4){0.f, 0.f, 0.f, 0.f};
    bf16x8 At[4][2], B0[2][2], B1[2][2];
    const char* cA = (const char*)g.A + (size_t)cur.pm * tstep + (size_t)cur.ks * g.K * 2; const char* cB = (const char*)g.Bt + (size_t)cur.pn * tstep + (size_t)cur.ks * g.K * 2;
    if constexpr (SP2) {
        PG8_STAGE(PG8_SB(0, 0), cB, voffB); PG8_STAGE(PG8_SB(0, 1), cB + hstep, voffB); PG8_STAGE(PG8_SA(0, 0), cA, voffA); PG8_STAGE(PG8_SA(0, 1), cA + hstep, voffA);
        if (wr == 1) PG8_BAR;
        PG8_WAIT_V(2); PG8_BAR;
        PG8_STAGE(PG8_SB(1, 0), cB + kstep, voffB); PG8_STAGE(PG8_SA(1, 0), cA + kstep, voffA); PG8_STAGE(PG8_SB(1, 1), cB + hstep + kstep, voffB);
        PG8_WAIT_V(6); PG8_BAR;
    } else {
        PG8_STAGE(PG8_SB(0, 0), cB, voffB); PG8_STAGE(PG8_SA(0, 0), cA, voffA); PG8_STAGE(PG8_SB(0, 1), cB + hstep, voffB); PG8_STAGE(PG8_SA(0, 1), cA + hstep, voffA);
        if (wr == 1) PG8_BAR;
        PG8_WAIT_V(4); PG8_BAR;
        PG8_STAGE(PG8_SB(1, 0), cB + kstep, voffB); PG8_STAGE(PG8_SA(1, 0), cA + kstep, voffA); PG8_STAGE(PG8_SB(1, 1), cB + hstep + kstep, voffB);
        PG8_WAIT_V(6); PG8_BAR;
    }
    for (;;) {
        const bool has_next = S.next(ui + 1, nxt);
        const char* nA = has_next ? (const char*)g.A + (size_t)nxt.pm * tstep + (size_t)nxt.ks * g.K * 2 : cA; const char* nB = has_next ? (const char*)g.Bt + (size_t)nxt.pn * tstep + (size_t)nxt.ks * g.K * 2 : cB;
        for (int t = 0; t < nt; t += 2) {
            const bool last = (t == nt - 2);
            const char* a1 = cA + (size_t)(t + 1) * kstep;
            const char* a2 = last ? nA : cA + (size_t)(t + 2) * kstep; const char* b2 = last ? nB : cB + (size_t)(t + 2) * kstep;
            const char* a3 = a2 + kstep; const char* b3 = b2 + kstep;
            if constexpr (SP2) {
            PG8_LDB(B0, 0, 0); PG8_LDB(B1, 0, 1); PG8_SCHED; PG8_LDA(At, 0, 0); PG8_STAGE(PG8_SA(1, 1), a1 + hstep, voffA);
            PG8_WAIT_V(8); PG8_WAIT_L(0); PG8_BAR; PG8_MMA(0, 0, At, B0); PG8_MMA(0, 1, At, B1); PG8_BAR; PG8_SCHED;
            PG8_LDA(At, 0, 1); PG8_STAGE(PG8_SB(0, 0), b2, voffB); PG8_STAGE(PG8_SB(0, 1), b2 + hstep, voffB); PG8_STAGE(PG8_SA(0, 0), a2, voffA);
            PG8_WAIT_V(8); PG8_WAIT_L(0); PG8_BAR; PG8_MMA(1, 0, At, B0); PG8_MMA(1, 1, At, B1); PG8_BAR; PG8_SCHED;
            PG8_LDB(B0, 1, 0); PG8_LDB(B1, 1, 1); PG8_SCHED; PG8_LDA(At, 1, 0); PG8_STAGE(PG8_SA(0, 1), a2 + hstep, voffA);
            PG8_WAIT_V(8); PG8_WAIT_L(0); PG8_BAR; PG8_MMA(0, 0, At, B0); PG8_MMA(0, 1, At, B1); PG8_BAR; PG8_SCHED;
            PG8_LDA(At, 1, 1); PG8_STAGE(PG8_SB(1, 0), b3, voffB); PG8_STAGE(PG8_SB(1, 1), b3 + hstep, voffB); PG8_STAGE(PG8_SA(1, 0), a3, voffA);
            PG8_WAIT_V(8); PG8_WAIT_L(0); PG8_BAR; PG8_MMA(1, 0, At, B0); PG8_MMA(1, 1, At, B1); PG8_BAR; PG8_SCHED;
            } else {
            PG8_LDB(B0, 0, 0); PG8_SCHED; PG8_LDA(At, 0, 0); PG8_STAGE(PG8_SA(1, 1), a1 + hstep, voffA);
            PG8_WAIT_L(8); PG8_BAR; PG8_WAIT_L(0); PG8_MMA(0, 0, At, B0); PG8_BAR; PG8_SCHED;
            PG8_LDB(B1, 0, 1); PG8_STAGE(PG8_SB(0, 0), b2, voffB);
            PG8_BAR; PG8_WAIT_L(0); PG8_MMA(0, 1, At, B1); PG8_BAR;
            PG8_LDA(At, 0, 1); PG8_STAGE(PG8_SA(0, 0), a2, voffA);
            PG8_BAR; PG8_WAIT_L(0); PG8_MMA(1, 0, At, B0); PG8_BAR; PG8_SCHED;
            PG8_STAGE(PG8_SB(0, 1), b2 + hstep, voffB);
            PG8_WAIT_V(6); PG8_BAR; PG8_MMA(1, 1, At, B1); PG8_BAR;
            PG8_LDB(B0, 1, 0); PG8_SCHED; PG8_LDA(At, 1, 0); PG8_STAGE(PG8_SA(0, 1), a2 + hstep, voffA);
            PG8_WAIT_L(8); PG8_BAR; PG8_WAIT_L(0); PG8_MMA(0, 0, At, B0); PG8_BAR; PG8_SCHED;
            PG8_LDB(B1, 1, 1); PG8_STAGE(PG8_SB(1, 0), b3, voffB);
            PG8_BAR; PG8_WAIT_L(0); PG8_MMA(0, 1, At, B1); PG8_BAR;
            PG8_LDA(At, 1, 1); PG8_STAGE(PG8_SA(1, 0), a3, voffA);
            PG8_BAR; PG8_WAIT_L(0); PG8_MMA(1, 0, At, B0); PG8_BAR; PG8_SCHED;
            PG8_STAGE(PG8_SB(1, 1), b3 + hstep, voffB);
            PG8_WAIT_V(6); PG8_BAR; PG8_MMA(1, 1, At, B1); PG8_BAR;
            }
        }
        if constexpr (ALIGN_EPI) { if (wr == 0) PG8_BAR; }
        E(acc, cur, wr, wc, fr, fq);
        if (!has_next) break;
#pragma unroll
        for (int a = 0; a < 2; ++a)
#pragma unroll
            for (int b = 0; b < 2; ++b)
#pragma unroll
                for (int m = 0; m < 4; ++m)
#pragma unroll
                    for (int n = 0; n < 2; ++n) acc[a][b][m][n] = (f32x4){0.f, 0.f, 0.f, 0.f};
        cur = nxt; cA = nA; cB = nB; ++ui;
        if constexpr (ALIGN_EPI) { if (wr == 1) PG8_BAR; }
    }
    PG8_WAIT_V(0);
    if constexpr (!ALIGN_EPI) { if (wr == 0) PG8_BAR; }
    PG8_BAR;
#undef PG8_SA
#undef PG8_SB
#undef PG8_STAGE
#undef PG8_LDA
#undef PG8_LDB
#undef PG8_MMA
#undef PG8_WAIT_V
#undef PG8_WAIT_L
#undef PG8_BAR
#undef PG8_SCHED
}

struct EpiBf16 {
    static constexpr bool PERM = true;
    bf16_t* O; int ldc; const float* ssq;
    __device__ __forceinline__ void operator()(const f32x4 (&acc)[2][2][4][2], const Unit& u, int wr, int wc, int fr, int fq) const {
        const int row0 = u.pm * BM + wr * 64 + fr, col0 = u.pn * BM + wc * 32 + 8 * fq;
#pragma unroll
        for (int ai = 0; ai < 2; ++ai)
#pragma unroll
            for (int m = 0; m < 4; ++m) {
                const int row = row0 + ai * HALF + m * 16; float sc = 1.f;
                if (ssq) { const f32x4* p = (const f32x4*)(ssq + (size_t)row * 32); float s = 0.f;
#pragma unroll
                    for (int q = 0; q < 8; ++q) { const f32x4 v = p[q]; s += (v[0] + v[1]) + (v[2] + v[3]); }
                    sc = rsqrtf(s * (1.f / 2048.f) + EPS); }
                bf16_t* rowp = O + (size_t)row * ldc + col0;
#pragma unroll
                for (int bj = 0; bj < 2; ++bj) { const f32x4 v0 = acc[ai][bj][m][0] * sc, v1 = acc[ai][bj][m][1] * sc;
                    u32x4 w; w.x = cvt_pk_bf16(v0[0], v0[1]); w.y = cvt_pk_bf16(v0[2], v0[3]); w.z = cvt_pk_bf16(v1[0], v1[1]); w.w = cvt_pk_bf16(v1[2], v1[3]);
                    *(u32x4*)(rowp + bj * HALF) = w; }
            }
    }
};
struct EpiResid {
    static constexpr bool PERM = false;
    const float* basef; const bf16_t* baseb; float* out; bf16_t* hb; float* ssq;
    __device__ __forceinline__ void operator()(const f32x4 (&acc)[2][2][4][2], const Unit& u, int wr, int wc, int fr, int fq) const {
        const int row0 = u.pm * BM + wr * 64 + fr, col0 = u.pn * BM + wc * 32 + 4 * fq;
#pragma unroll
        for (int ai = 0; ai < 2; ++ai)
#pragma unroll
            for (int m = 0; m < 4; ++m) {
                const int row = row0 + ai * HALF + m * 16; const size_t off = (size_t)row * 2048 + col0; float s = 0.f;
#pragma unroll
                for (int bj = 0; bj < 2; ++bj)
#pragma unroll
                    for (int n = 0; n < 2; ++n) {
                        f32x4 b;
                        if (basef) b = *(const f32x4*)(basef + off + bj * HALF + n * 16);
                        else { const u32x2 t = *(const u32x2*)(baseb + off + bj * HALF + n * 16); b = (f32x4){bf_lo(t.x), bf_hi(t.x), bf_lo(t.y), bf_hi(t.y)}; }
                        const f32x4 o = b + acc[ai][bj][m][n];
                        if (out) *(f32x4*)(out + off + bj * HALF + n * 16) = o;
                        if (hb) { u32x2 w; w.x = cvt_pk_bf16(o[0], o[1]); w.y = cvt_pk_bf16(o[2], o[3]); *(u32x2*)(hb + off + bj * HALF + n * 16) = w;
                            s += (o[0] * o[0] + o[1] * o[1]) + (o[2] * o[2] + o[3] * o[3]); }
                    }
                if (hb) { s += __shfl_xor(s, 16); s += __shfl_xor(s, 32); if (fq == 0) ssq[(size_t)row * 32 + u.pn * 4 + wc] = s; }
            }
    }
};
struct EpiSlab {
    static constexpr bool PERM = false;
    float* slab; int ldc; size_t slab_stride;
    __device__ __forceinline__ void operator()(const f32x4 (&acc)[2][2][4][2], const Unit& u, int wr, int wc, int fr, int fq) const {
        float* base = slab + (size_t)u.ks * slab_stride; unsigned off = (unsigned)((u.pm * BM + wr * 64 + fr) * ldc + u.pn * BM + wc * 32 + 4 * fq);
#pragma unroll
        for (int ai = 0; ai < 2; ++ai)
#pragma unroll
            for (int m = 0; m < 4; ++m) { float* rowp = base + off + (unsigned)((ai * HALF + m * 16) * ldc);
#pragma unroll
                for (int bj = 0; bj < 2; ++bj)
#pragma unroll
                    for (int n = 0; n < 2; ++n) *(f32x4*)(rowp + bj * HALF + n * 16) = acc[ai][bj][m][n];
                asm volatile("" ::: "memory"); }
    }
};
struct EpiMoe1 {
    static constexpr bool PERM = true;
    bf16_t* act;
    __device__ __forceinline__ void operator()(const f32x4 (&acc)[2][2][4][2], const Unit& u, int wr, int wc, int fr, int fq) const {
        const int row0 = u.pm * BM + wr * 64 + fr, col0 = (u.pn & 3) * 128 + wc * 32 + 8 * fq;
#pragma unroll
        for (int ai = 0; ai < 2; ++ai)
#pragma unroll
            for (int m = 0; m < 4; ++m) {
                const int row = row0 + ai * HALF + m * 16; float v[8];
#pragma unroll
                for (int n = 0; n < 2; ++n)
#pragma unroll
                    for (int i = 0; i < 4; ++i) { const float gt = acc[ai][0][m][n][i], up = acc[ai][1][m][n][i]; v[n * 4 + i] = gt / (1.f + __expf(-gt)) * up; }
                *(u32x4*)(act + (size_t)row * 512 + col0) = pack8(v);
            }
    }
};
struct EpiMoe2 {
    static constexpr bool PERM = true;
    bf16_t* yb; const int* rowpair; const float* pair_w; const int* tile_e; const int* toff; const unsigned* ecnt;
    __device__ __forceinline__ void operator()(const f32x4 (&acc)[2][2][4][2], const Unit& u, int wr, int wc, int fr, int fq) const {
        const int e = tile_e[u.pm]; const int base_slot = (u.pm - toff[e]) * 256; const int cnt = (int)ecnt[e];
        const int col0 = (u.pn & 7) * 256 + wc * 32 + 8 * fq;
        int prs[8]; float pws[8];
#pragma unroll
        for (int q = 0; q < 8; ++q) { const int rr = wr * 64 + fr + (q >> 2) * HALF + (q & 3) * 16; const int rc = (base_slot + rr < cnt) ? rr : 0; prs[q] = rowpair[u.pm * 256 + rc]; }
#pragma unroll
        for (int q = 0; q < 8; ++q) pws[q] = pair_w[prs[q]];
#pragma unroll
        for (int ai = 0; ai < 2; ++ai)
#pragma unroll
            for (int m = 0; m < 4; ++m) {
                const int rr = wr * 64 + fr + ai * HALF + m * 16;
                if (base_slot + rr < cnt) {
                    const int pr = prs[ai * 4 + m]; const float w = pws[ai * 4 + m];
                    bf16_t* rowp = yb + (size_t)pr * 2048 + col0;
#pragma unroll
                    for (int bj = 0; bj < 2; ++bj) { const f32x4 v0 = acc[ai][bj][m][0] * w, v1 = acc[ai][bj][m][1] * w;
                        u32x4 x; x.x = cvt_pk_bf16(v0[0], v0[1]); x.y = cvt_pk_bf16(v0[2], v0[3]); x.z = cvt_pk_bf16(v1[0], v1[1]); x.w = cvt_pk_bf16(v1[2], v1[3]);
                        *(u32x4*)(rowp + bj * HALF) = x; }
                }
            }
    }
};
}

#define XB_TMO      128
#define XB_XCNT(j)  (256  + 64 * (j))
#define XB_XSUB(j)  (1280 + 64 * (j))
#define XB_XGEN(j)  (2304 + 64 * (j))
#define XB_TOP      3328
#define XB_TOPGEN   3392
#define XCD_BAR_WORDS 3456
#define XB_SPIN_CAP (1u << 18)
__device__ __forceinline__ unsigned xb_ld(unsigned* p)              { return __hip_atomic_load(p, __ATOMIC_RELAXED, __HIP_MEMORY_SCOPE_AGENT); }
__device__ __forceinline__ unsigned xb_add(unsigned* p, unsigned v) { return __hip_atomic_fetch_add(p, v, __ATOMIC_RELAXED, __HIP_MEMORY_SCOPE_AGENT); }
__device__ __forceinline__ unsigned xb_xcc_id() { return (unsigned)__builtin_amdgcn_s_getreg((3 << 11) | 20) & 0xFu; }
#define XB_SPIN(cond, bar) do { unsigned _sp = 0; while (cond) { __builtin_amdgcn_s_sleep(1); \
    if ((++_sp & 255u) == 0u) { if (xb_ld(&(bar)[XB_TMO])) break; if (_sp > XB_SPIN_CAP) { atomicAdd(&(bar)[XB_TMO], 1u); break; } } } } while (0)
struct XcdBarrier { unsigned* bar; unsigned x; volatile LAS unsigned* st; };
__device__ __forceinline__ XcdBarrier xcd_barrier_post(unsigned* bar, volatile LAS unsigned* st) {
    XcdBarrier b; b.bar = bar; b.x = xb_xcc_id(); b.st = st;
    if (threadIdx.x == 0) (void)xb_add(&bar[XB_XCNT(b.x)], 1u);
    return b;
}
__device__ __forceinline__ void xcd_barrier_complete(unsigned* bar, unsigned x, unsigned& nloc, unsigned& nx) {
    const unsigned G = gridDim.x * gridDim.y * gridDim.z;
    unsigned sum, cnt, mine, sp = 0u;
    for (;;) {
        sum = 0u; cnt = 0u; mine = 0u;
#pragma unroll
        for (unsigned j = 0; j < 16; ++j) { const unsigned cc = xb_ld(&bar[XB_XCNT(j)]); sum += cc; cnt += (cc > 0u) ? 1u : 0u; mine = (j == x) ? cc : mine; }
        if (sum == G) break;
        __builtin_amdgcn_s_sleep(1);
        if ((++sp & 255u) == 0u) { if (xb_ld(&bar[XB_TMO])) break; if (sp > XB_SPIN_CAP) { atomicAdd(&bar[XB_TMO], 1u); break; } }
    }
    nloc = mine > 0u ? mine : 1u; nx = cnt > 0u ? cnt : 1u;
}
__device__ __forceinline__ void xcd_barrier(const XcdBarrier& b) {
    asm volatile("s_waitcnt vmcnt(0)" ::: "memory");
    __syncthreads();
    if (threadIdx.x == 0) {
        unsigned* bar = b.bar;
        __builtin_amdgcn_s_waitcnt(0);
        unsigned nloc = b.st[0], nx = b.st[1];
        if (nloc == 0u) { xcd_barrier_complete(bar, b.x, nloc, nx); b.st[0] = nloc; b.st[1] = nx; }
        const unsigned old = xb_add(&bar[XB_XSUB(b.x)], 1u);
        const unsigned gen = old / nloc;
        if (old + 1u == (gen + 1u) * nloc) {
            __builtin_amdgcn_fence(__ATOMIC_RELEASE, "agent");
            asm volatile("s_waitcnt vmcnt(0)" ::: "memory");
            const unsigned og = xb_add(&bar[XB_TOP], 1u);
            const unsigned tg = og / nx;
            if (og + 1u == (tg + 1u) * nx) xb_add(&bar[XB_TOPGEN], 1u);
            else XB_SPIN(xb_ld(&bar[XB_TOPGEN]) == tg, bar);
            __builtin_amdgcn_fence(__ATOMIC_ACQUIRE, "agent");
            xb_add(&bar[XB_XGEN(b.x)], 1u);
            asm volatile("s_waitcnt vmcnt(0)" ::: "memory");
        } else {
            XB_SPIN(xb_ld(&bar[XB_XGEN(b.x)]) == gen, bar);
            __builtin_amdgcn_fence(__ATOMIC_ACQUIRE, "agent");
            asm volatile("s_waitcnt vmcnt(0)" ::: "memory");
        }
    }
    __syncthreads();
}

struct Ctx {
    LAS unsigned char* lds;
    int tid, lane, wave, bid, G, gw, NGW;
    unsigned char* ws; float* out;
};
#define INF(i) ((const float*)a.in[i])

__device__ __forceinline__ void transpose_item(const float* __restrict__ W, int ldw, int k0, int n_src0, bf16_t* WT, int K_dst, LAS float* scr, int lane, const float* kscale) {
#pragma unroll 8
    for (int i = 0; i < 32; ++i) { const int kk = 2 * i + (lane >> 5); float v = W[(size_t)(k0 + kk) * ldw + n_src0 + (lane & 31)]; if (kscale) v *= kscale[k0 + kk]; scr[kk * 33 + (lane & 31)] = v; }
    LDS_WAIT();
    const int c = lane & 7;
#pragma unroll
    for (int j = 0; j < 4; ++j) { const int n = (lane >> 3) + 8 * j; const LAS float* s = scr + (8 * c) * 33 + n;
        u32x4 o; o.x = cvt_pk_bf16(s[0 * 33], s[1 * 33]); o.y = cvt_pk_bf16(s[2 * 33], s[3 * 33]); o.z = cvt_pk_bf16(s[4 * 33], s[5 * 33]); o.w = cvt_pk_bf16(s[6 * 33], s[7 * 33]);
        *(u32x4*)(WT + (size_t)n * K_dst + k0 + 8 * c) = o; }
    LDS_WAIT();
}

__device__ __forceinline__ void phase0(const Args& a, const Ctx& c) {
    unsigned char* ws = c.ws;
    LAS float* scr = (LAS float*)(c.lds + c.wave * 16384);
    constexpr int N_DENSE = 16384, N_EXP = 64 * 1536;
    for (int it = c.gw; it < N_DENSE; it += c.NGW) {
        if (it < N_DENSE) {
            int r = it;
            if (r < 6144) {
                const int seg = r / 3072; r -= seg * 3072; const int kb = r / 96, nb = r % 96;
                transpose_item(INF(4), DIN, 64 * kb, (seg ? 3080 : 0) + 32 * nb, (bf16_t*)(ws + WS_WIN) + (size_t)(seg * 3072 + 32 * nb) * 2048, 2048, scr, c.lane, nullptr);
            } else if (r < 8192) { r -= 6144; const int kb = r / 64, nb = r % 64;
                transpose_item(INF(11), 2048, 64 * kb, 32 * nb, (bf16_t*)(ws + WS_WOUT) + (size_t)(32 * nb) * 2048, 2048, scr, c.lane, nullptr);
            } else if (r < 10240) { r -= 8192; const int kb = r / 64, nb = r % 64;
                transpose_item(INF(14), 2048, 64 * kb, 32 * nb, (bf16_t*)(ws + WS_WQ) + (size_t)(32 * nb) * 2048, 2048, scr, c.lane, INF(12));
            } else if (r < 14336) { r -= 10240; const int kb = r / 128, nb = r % 128;
                transpose_item(INF(15), 4096, 64 * kb, 32 * nb, (bf16_t*)(ws + WS_WKV) + (size_t)(32 * nb) * 2048, 2048, scr, c.lane, nullptr);
            } else { r -= 14336; const int kb = r / 64, nb = r % 64;
                transpose_item(INF(18), 2048, 64 * kb, 32 * nb, (bf16_t*)(ws + WS_WO) + (size_t)(32 * nb) * 2048, 2048, scr, c.lane, nullptr);
            }
        } else {
            const int r = it - N_DENSE; const int e = r / 1536, q = r % 1536, type = q / 512, idx = q % 512;
            if (type < 2) { const int kb = idx / 16, nb = idx % 16, f0 = 32 * nb;
                const float* W = INF(type == 0 ? 24 : 25) + (size_t)e * 2048 * 512;
                const int drow = e * 1024 + (f0 >> 7) * 256 + (type ? 128 : 0) + (f0 & 127);
                transpose_item(W, 512, 64 * kb, f0, (bf16_t*)(ws + WS_WGU) + (size_t)drow * 2048, 2048, scr, c.lane, nullptr);
            } else { const int kb = idx / 64, nb = idx % 64;
                const float* W = INF(26) + (size_t)e * 512 * 2048;
                transpose_item(W, 2048, 64 * kb, 32 * nb, (bf16_t*)(ws + WS_WD) + (size_t)(e * 2048 + 32 * nb) * 512, 512, scr, c.lane, nullptr);
            }
        }
    }
    {
        bf16_t* WR = (bf16_t*)(ws + WS_MISC + MO_WR);
        const float* gf = INF(19); const float* wg = INF(20); const float* we = INF(22);
        for (int i = c.bid * 512 + c.tid; i < 2048 * 80; i += c.G * 512) { const int j = i / 2048, k = i % 2048;
            float v = 0.f; if (j < 8) v = wg[k * 8 + j]; else if (j < 72) v = we[k * 64 + (j - 8)];
            v *= gf[k]; const bf16_t hi = f2bf(v); const bf16_t lo = f2bf(v - bf1(hi));
            WR[i] = hi; WR[80 * 2048 + i] = lo; }
        if (c.bid == 0 && c.tid < 128) ((unsigned*)(ws + WS_CTL))[CW_ECNT + c.tid] = 0u;
        if (c.bid == 0 && c.tid < 256) ((unsigned*)(ws + WS_CTL))[CW_BCNT + c.tid] = 0u;
    }
    __syncthreads();
    {
        LAS float* wgl = (LAS float*)c.lds; const float* win = INF(4); const float* gm = INF(3);
        for (int idx = c.tid; idx < 4096; idx += 512) { const int k = idx >> 1, hf = idx & 1;
            f32x4 v = *(const f32x4*)(win + (size_t)k * DIN + 3072 + 4 * hf); v = v * gm[k];
            const int j = k >> 8, l = (k >> 2) & 63, i = k & 3;
            *(LAS f32x4*)(wgl + (((i * 8 + j) * 64 + l) * 8 + 4 * hf)) = v; }
    }
    __syncthreads();
    {
        const LAS float* wgl = (const LAS float*)c.lds; const float* gm = INF(3); const float* x = INF(0); const float* gb = INF(5);
        bf16_t* XN = (bf16_t*)(ws + WS_XN); float* GATES = (float*)(ws + WS_MISC + MO_GATES);
        f32x4 g4[8];
#pragma unroll
        for (int j = 0; j < 8; ++j) g4[j] = *(const f32x4*)(gm + 256 * j + 4 * c.lane);
        for (int m = c.gw; m < S; m += c.NGW) {
            const f32x4* xr = (const f32x4*)(x + (size_t)m * D) + c.lane;
            f32x4 v[8]; float ss = 0.f; float ga[8];
#pragma unroll
            for (int q = 0; q < 8; ++q) ga[q] = 0.f;
#pragma unroll
            for (int j = 0; j < 8; ++j) { v[j] = xr[64 * j]; ss += (v[j][0] * v[j][0] + v[j][1] * v[j][1]) + (v[j][2] * v[j][2] + v[j][3] * v[j][3]); }
#pragma unroll
            for (int j = 0; j < 8; ++j) {
                asm volatile("" ::: "memory");
#pragma unroll
                for (int i = 0; i < 4; ++i) { const LAS f32x4* wp = (const LAS f32x4*)(wgl + ((i * 8 + j) * 64 + c.lane) * 8); const f32x4 w0 = wp[0], w1 = wp[1]; const float xv = v[j][i];
                    ga[0] += xv * w0[0]; ga[1] += xv * w0[1]; ga[2] += xv * w0[2]; ga[3] += xv * w0[3]; ga[4] += xv * w1[0]; ga[5] += xv * w1[1]; ga[6] += xv * w1[2]; ga[7] += xv * w1[3]; }
            }
            ss = wave_sum(ss); const float rstd = rsqrtf(ss * (1.f / D) + EPS);
#pragma unroll
            for (int q = 0; q < 8; ++q) ga[q] = wave_sum(ga[q]);
            if (c.lane < 8) { float gv = ga[0];
#pragma unroll
                for (int q = 1; q < 8; ++q) gv = (c.lane == q) ? ga[q] : gv;
                GATES[(size_t)m * 8 + c.lane] = gv * rstd + gb[c.lane]; }
            u32x2* o8 = (u32x2*)(XN + (size_t)m * D) + c.lane;
#pragma unroll
            for (int j = 0; j < 8; ++j) { const f32x4 y = v[j] * rstd * g4[j]; u32x2 w; w.x = cvt_pk_bf16(y[0], y[1]); w.y = cvt_pk_bf16(y[2], y[3]); o8[64 * j] = w; }
        }
        const float* mem = INF(1); const float* gmem = INF(13); bf16_t* MEMN = (bf16_t*)(ws + WS_MEMN);
        for (int m = c.gw; m < MEML; m += c.NGW) {
            const f32x4* xr = (const f32x4*)(mem + (size_t)m * D) + c.lane; f32x4 v[8]; float ss = 0.f;
#pragma unroll
            for (int j = 0; j < 8; ++j) { v[j] = xr[64 * j]; ss += (v[j][0] * v[j][0] + v[j][1] * v[j][1]) + (v[j][2] * v[j][2] + v[j][3] * v[j][3]); }
            ss = wave_sum(ss); const float rstd = rsqrtf(ss * (1.f / D) + EPS);
            u32x2* o8 = (u32x2*)(MEMN + (size_t)m * D) + c.lane;
#pragma unroll
            for (int j = 0; j < 8; ++j) { const f32x4 gg = *(const f32x4*)(gmem + 256 * j + 4 * c.lane); const f32x4 y = v[j] * rstd * gg; u32x2 w; w.x = cvt_pk_bf16(y[0], y[1]); w.y = cvt_pk_bf16(y[2], y[3]); o8[64 * j] = w; }
        }
    }
}

__device__ __forceinline__ void prep_mlstm(const Args& a, const Ctx& c, int h, int ch) {
    unsigned char* ws = c.ws; const int t0 = ch * 128;
    const float* GATES = (const float*)(ws + WS_MISC + MO_GATES);
    float* BV = (float*)(ws + WS_MISC + MO_BV); float* UV = (float*)(ws + WS_MISC + MO_UV); float* PMX = (float*)(ws + WS_MISC + MO_PMX);
    float* GC = (float*)(ws + WS_MISC + MO_GC); float* AMAX = (float*)(ws + WS_MISC + MO_AMAX);
    const bf16_t* PROJ = (const bf16_t*)(ws + WS_PROJ);
    LAS float* sc_w = (LAS float*)c.lds;
    LAS bf16_t* kws = (LAS bf16_t*)(c.lds + 1024);
    LAS bf16_t* vs = (LAS bf16_t*)(c.lds + 1024 + 128 * 260);
    if (c.wave == 0) {
        const int l = c.lane; const int ta = 2 * l, tb = 2 * l + 1;
        const float i0 = GATES[(size_t)(t0 + ta) * 8 + h], f0 = GATES[(size_t)(t0 + ta) * 8 + 4 + h];
        const float i1 = GATES[(size_t)(t0 + tb) * 8 + h], f1 = GATES[(size_t)(t0 + tb) * 8 + 4 + h];
        const float lf0 = fminf(f0, 0.f) - log1pf(__expf(-fabsf(f0))), lf1 = fminf(f1, 0.f) - log1pf(__expf(-fabsf(f1)));
        float incl = lf0 + lf1;
#pragma unroll
        for (int o = 1; o < 64; o <<= 1) { const float t = __shfl_up(incl, o); if (l >= o) incl += t; }
        const float excl = incl - (lf0 + lf1);
        const float b0 = excl + lf0, b1 = excl + lf0 + lf1;
        const float u0 = i0 - b0, u1 = i1 - b1;
        float pm = fmaxf(u0, u1);
#pragma unroll
        for (int o = 1; o < 64; o <<= 1) { const float t = __shfl_up(pm, o); if (l >= o) pm = fmaxf(pm, t); }
        float pme = __shfl_up(pm, 1); if (l == 0) pme = -INFINITY;
        const float p0 = fmaxf(pme, u0), p1 = pm;
        const float ptot = __shfl(pm, 63), gtot = __shfl(b1, 63);
        BV[h * S + t0 + ta] = b0; BV[h * S + t0 + tb] = b1; UV[h * S + t0 + ta] = u0; UV[h * S + t0 + tb] = u1; PMX[h * S + t0 + ta] = p0; PMX[h * S + t0 + tb] = p1;
        sc_w[ta] = __expf(u0 - ptot); sc_w[tb] = __expf(u1 - ptot);
        if (l == 63) { GC[h * 64 + ch] = gtot; AMAX[h * 64 + ch] = gtot + ptot; }
    }
    __syncthreads();
    {
        const float* cw = INF(6); const float* cb = INF(7);
        bf16_t* QC = (bf16_t*)(ws + WS_QC); bf16_t* KC = (bf16_t*)(ws + WS_KC);
        const int t = c.tid >> 2, qt = c.tid & 3; const float ws_ = sc_w[t];
#pragma unroll
        for (int qk = 0; qk < 2; ++qk)
#pragma unroll
            for (int gq = 0; gq < 4; ++gq) {
                const int ch0 = qt * 32 + 8 * gq; const int cch = qk * 512 + h * 128 + ch0; const int pcol = (qk ? PC_MK : PC_MQ) + h * 128 + ch0;
                float y[8];
#pragma unroll
                for (int i = 0; i < 8; ++i) y[i] = cb[cch + i];
#pragma unroll
                for (int j = 0; j < 4; ++j) { const int tr = t0 + t - 3 + j; const float msk = tr >= 0 ? 1.f : 0.f;
                    float xv[8]; unpack8(*(const u32x4*)(PROJ + (size_t)(tr < 0 ? 0 : tr) * NPROJ + pcol), xv);
#pragma unroll
                    for (int i = 0; i < 8; ++i) y[i] += cw[j * 1024 + cch + i] * (xv[i] * msk); }
#pragma unroll
                for (int i = 0; i < 8; ++i) y[i] = y[i] / (1.f + __expf(-y[i]));
                if (qk == 0) {
#pragma unroll
                    for (int i = 0; i < 8; ++i) y[i] *= 0.08838834764831845f;
                    *(u32x4*)(QC + ((size_t)(h * S + t0 + t)) * 128 + ch0) = pack8(y);
                } else {
                    *(u32x4*)(KC + ((size_t)(h * S + t0 + t)) * 128 + ch0) = pack8(y);
#pragma unroll
                    for (int i = 0; i < 8; ++i) kws[t * 130 + ch0 + i] = f2bf(y[i] * ws_);
                }
            }
        const int part = c.tid & 3;
#pragma unroll
        for (int q = 0; q < 8; ++q) { const int dv0 = part * 64 + 8 * q;
            *(LAS u32x4*)(vs + t * 264 + dv0) = *(const u32x4*)(PROJ + (size_t)(t0 + t) * NPROJ + PC_MV + h * 256 + dv0); }
    }
    __syncthreads();
    {
        bf16_t* KWT = (bf16_t*)(ws + WS_KWT); bf16_t* VT = (bf16_t*)(ws + WS_VT);
        const int d = c.tid >> 2, sq = c.tid & 3;
#pragma unroll
        for (int gq = 0; gq < 4; ++gq) { const int s0 = sq * 32 + 8 * gq; u32x4 o;
            o.x = (unsigned)kws[(s0 + 0) * 130 + d] | ((unsigned)kws[(s0 + 1) * 130 + d] << 16); o.y = (unsigned)kws[(s0 + 2) * 130 + d] | ((unsigned)kws[(s0 + 3) * 130 + d] << 16);
            o.z = (unsigned)kws[(s0 + 4) * 130 + d] | ((unsigned)kws[(s0 + 5) * 130 + d] << 16); o.w = (unsigned)kws[(s0 + 6) * 130 + d] | ((unsigned)kws[(s0 + 7) * 130 + d] << 16);
            *(u32x4*)(KWT + ((size_t)((h * 64 + ch) * 128 + d)) * 128 + s0) = o; }
        const int dv = c.tid >> 1, hf = c.tid & 1;
#pragma unroll
        for (int gq = 0; gq < 8; ++gq) { const int s0 = hf * 64 + 8 * gq; u32x4 o;
            o.x = (unsigned)vs[(s0 + 0) * 264 + dv] | ((unsigned)vs[(s0 + 1) * 264 + dv] << 16); o.y = (unsigned)vs[(s0 + 2) * 264 + dv] | ((unsigned)vs[(s0 + 3) * 264 + dv] << 16);
            o.z = (unsigned)vs[(s0 + 4) * 264 + dv] | ((unsigned)vs[(s0 + 5) * 264 + dv] << 16); o.w = (unsigned)vs[(s0 + 6) * 264 + dv] | ((unsigned)vs[(s0 + 7) * 264 + dv] << 16);
            *(u32x4*)(VT + ((size_t)((h * 64 + ch) * DVP + dv)) * 128 + s0) = o; }
        if (c.tid < 256) { const int row = 256 + (c.tid >> 4), ck = c.tid & 15; const unsigned val = (row == 256) ? 0x3F803F80u : 0u;
            *(u32x4*)(VT + ((size_t)((h * 64 + ch) * DVP + row)) * 128 + 8 * ck) = (u32x4){val, val, val, val}; }
    }
    __syncthreads();
}

__device__ __forceinline__ void prep_moba(const Args& a, const Ctx& c, int h, int jb) {
    unsigned char* ws = c.ws; const int t0 = jb * 256;
    const bf16_t* PROJ = (const bf16_t*)(ws + WS_PROJ); const int* pos = (const int*)a.in[2];
    bf16_t* QP = (bf16_t*)(ws + WS_QP); bf16_t* KP = (bf16_t*)(ws + WS_KP); bf16_t* VTP = (bf16_t*)(ws + WS_VTP); float* KMEAN = (float*)(ws + WS_MISC + MO_KMEAN);
    LAS float* red = (LAS float*)c.lds;
    LAS bf16_t* vs = (LAS bf16_t*)(c.lds + 16384);
    const int li = c.tid & 15, rg = c.tid >> 4, d0 = 8 * li;
    float qg[8], kg[8], kacc[8];
#pragma unroll
    for (int i = 0; i < 8; ++i) { qg[i] = INF(9)[d0 + i]; kg[i] = INF(10)[d0 + i]; kacc[i] = 0.f; }
    float invf[8];
#pragma unroll
    for (int i = 0; i < 8; ++i) { const int fi = (li & 1) * 8 + i; invf[i] = exp2f(-(float)fi * (18.931568569324174f / 16.f)); }
    for (int p = 0; p < 8; ++p) {
        const int row = p * 32 + rg; const size_t prow = (size_t)(t0 + row) * NPROJ + h * 128 + d0;
        const float fpos = (float)pos[t0 + row];
        float cs[8], sn[8];
        if (li < 4) {
#pragma unroll
            for (int i = 0; i < 8; ++i) { float s_, c_; sincosf(fpos * invf[i], &s_, &c_); cs[i] = c_; sn[i] = s_; }
        } else {
#pragma unroll
            for (int i = 0; i < 8; ++i) { cs[i] = 1.f; sn[i] = 0.f; }
        }
#pragma unroll
        for (int qk = 0; qk < 2; ++qk) {
            float x[8]; unpack8(*(const u32x4*)(PROJ + prow + (qk ? PC_AK : PC_AQ)), x);
            float ss = 0.f;
#pragma unroll
            for (int i = 0; i < 8; ++i) ss += x[i] * x[i];
            ss += __shfl_xor(ss, 1); ss += __shfl_xor(ss, 2); ss += __shfl_xor(ss, 4); ss += __shfl_xor(ss, 8);
            const float rstd = rsqrtf(ss * (1.f / 128.f) + EPS);
            float y[8];
#pragma unroll
            for (int i = 0; i < 8; ++i) y[i] = x[i] * rstd * (qk ? kg[i] : qg[i]);
            float o[8];
#pragma unroll
            for (int i = 0; i < 8; ++i) { const float ot = __shfl_xor(y[i], 2); o[i] = (li < 2) ? (y[i] * cs[i] - ot * sn[i]) : (li < 4 ? (y[i] * cs[i] + ot * sn[i]) : y[i]); }
            if (qk == 0) *(u32x4*)(QP + ((size_t)(h * S + t0 + row)) * 128 + d0) = pack8(o);
            else { *(u32x4*)(KP + ((size_t)(h * S + t0 + row)) * 128 + d0) = pack8(o);
#pragma unroll
                for (int i = 0; i < 8; ++i) kacc[i] += o[i]; }
        }
        *(LAS u32x4*)(vs + row * 136 + d0) = *(const u32x4*)(PROJ + prow + PC_AV);
    }
#pragma unroll
    for (int i = 0; i < 8; ++i) red[rg * 128 + d0 + i] = kacc[i];
    __syncthreads();
    if (c.tid < 128) { float s = 0.f;
#pragma unroll 8
        for (int r = 0; r < 32; ++r) s += red[r * 128 + c.tid];
        KMEAN[(h * 32 + jb) * 128 + c.tid] = s * (1.f / 256.f); }
    {
        const int d = c.tid >> 2, sq = c.tid & 3;
#pragma unroll
        for (int gq = 0; gq < 8; ++gq) { const int s0 = sq * 64 + 8 * gq; u32x4 o;
            o.x = (unsigned)vs[(s0 + 0) * 136 + d] | ((unsigned)vs[(s0 + 1) * 136 + d] << 16); o.y = (unsigned)vs[(s0 + 2) * 136 + d] | ((unsigned)vs[(s0 + 3) * 136 + d] << 16);
            o.z = (unsigned)vs[(s0 + 4) * 136 + d] | ((unsigned)vs[(s0 + 5) * 136 + d] << 16); o.w = (unsigned)vs[(s0 + 6) * 136 + d] | ((unsigned)vs[(s0 + 7) * 136 + d] << 16);
            *(u32x4*)(VTP + ((size_t)((h * 32 + jb) * 128 + d)) * 256 + s0) = o; }
    }
    __syncthreads();
}

__device__ __forceinline__ void prep_xamem(const Args& a, const Ctx& c) {
    unsigned char* ws = c.ws; const float* SL = (const float*)(ws + WS_KVSLAB);
    bf16_t* KM = (bf16_t*)(ws + WS_KM); bf16_t* VTM = (bf16_t*)(ws + WS_VTM); const float* kg = INF(17);
    for (int it = c.gw; it < 1024; it += c.NGW) { const int m = it >> 2, h = it & 3;
        float x[8];
#pragma unroll
        for (int i = 0; i < 8; ++i) x[i] = 0.f;
#pragma unroll
        for (int sp = 0; sp < 8; ++sp) { const f32x4* p = (const f32x4*)(SL + ((size_t)(sp * 256 + m)) * 4096 + h * 512 + 8 * c.lane); const f32x4 v0 = p[0], v1 = p[1];
            x[0] += v0[0]; x[1] += v0[1]; x[2] += v0[2]; x[3] += v0[3]; x[4] += v1[0]; x[5] += v1[1]; x[6] += v1[2]; x[7] += v1[3]; }
        float ss = 0.f;
#pragma unroll
        for (int i = 0; i < 8; ++i) ss += x[i] * x[i];
        ss = wave_sum(ss); const float rstd = rsqrtf(ss * (1.f / 512.f) + EPS);
#pragma unroll
        for (int i = 0; i < 8; ++i) x[i] = x[i] * rstd * kg[8 * c.lane + i];
        *(u32x4*)(KM + ((size_t)(h * 256 + m)) * 512 + 8 * c.lane) = pack8(x); }
    for (int idx = c.bid * 512 + c.tid; idx < 65536; idx += c.G * 512) { const int d = idx & 511, mg = (idx >> 9) & 31, h = idx >> 14;
        float v[8];
#pragma unroll
        for (int j = 0; j < 8; ++j) { float t = 0.f;
#pragma unroll
            for (int sp = 0; sp < 8; ++sp) t += SL[((size_t)(sp * 256 + 8 * mg + j)) * 4096 + 2048 + h * 512 + d];
            v[j] = t; }
        *(u32x4*)(VTM + ((size_t)(h * 512 + d)) * 256 + 8 * mg) = pack8(v); }
}

__device__ __forceinline__ void tile256_load(LAS unsigned char* dst, const bf16_t* src, size_t src_ld, int nrows, int tid) {
    for (int idx = tid; idx < nrows * 16; idx += 512) { const int row = idx >> 4, ck = idx & 15;
        *(LAS u32x4*)(dst + row * 256 + ((ck ^ (row & 15)) << 4)) = *(const u32x4*)(src + (size_t)row * src_ld + 8 * ck); }
}
__device__ __forceinline__ bf16x8 tile256_frag(const LAS unsigned char* t, int row, int ck) { return *(const LAS bf16x8*)(t + row * 256 + ((ck ^ (row & 15)) << 4)); }

__device__ __forceinline__ void mlstm_local(const Ctx& c, int h, int ch) {
    unsigned char* ws = c.ws; const bf16_t* KWT = (const bf16_t*)(ws + WS_KWT); const bf16_t* VT = (const bf16_t*)(ws + WS_VT); float* CTL = (float*)(ws + WS_CTL_LOC);
    const int tt = c.lane & 15, g = c.lane >> 4, w = c.wave, t0 = ch * 128;
    tile256_load(c.lds, VT + (size_t)(h * 64 + ch) * DVP * 128, 128, DVP, c.tid);
    bf16x8 bfr[4];
#pragma unroll
    for (int ks = 0; ks < 4; ++ks) bfr[ks] = *(const bf16x8*)(KWT + ((size_t)((h * 64 + ch) * 128 + 16 * w + tt)) * 128 + 32 * ks + 8 * g);
    __syncthreads();
#pragma unroll
    for (int mt = 0; mt < 17; ++mt) {
        f32x4 acc = {0.f, 0.f, 0.f, 0.f};
#pragma unroll
        for (int ks = 0; ks < 4; ++ks) acc = mfma16(tile256_frag(c.lds, 16 * mt + tt, 4 * ks + g), bfr[ks], acc);
#pragma unroll
        for (int r = 0; r < 4; ++r) CTL[((size_t)((h * 64 + ch) * DVP + 16 * mt + 4 * g + r)) * 128 + 16 * w + tt] = acc[r];
    }
    __syncthreads();
}

#define MOBA_LOAD_KV(jb, K_, V_) do { const int kb_ = (jb) * 256; \
        _Pragma("unroll") for (int tq = 0; tq < 2; ++tq) _Pragma("unroll") for (int ks = 0; ks < 4; ++ks) \
            K_[tq][ks] = *(const bf16x8*)(KP + ((size_t)(h * S + kb_ + 32 * w + pi32(tq, tt))) * 128 + 32 * ks + 8 * g); \
        _Pragma("unroll") for (int ks = 0; ks < 8; ++ks) V_[ks] = *(const bf16x8*)(VTP + ((size_t)((h * 32 + (jb)) * 128 + 16 * w + tt)) * 256 + 32 * ks + 8 * g); } while (0)

#define MOBA_TOUCH_KV(K_, V_) do { _Pragma("unroll") for (int tq = 0; tq < 2; ++tq) _Pragma("unroll") for (int ks = 0; ks < 4; ++ks) asm volatile("" : "+v"(K_[tq][ks])); \
        _Pragma("unroll") for (int ks = 0; ks < 8; ++ks) asm volatile("" : "+v"(V_[ks])); } while (0)
__device__ __forceinline__ void moba_select(const Ctx& c, int h, int cb, int half) {
    unsigned char* ws = c.ws;
    const bf16_t* QP = (const bf16_t*)(ws + WS_QP); const float* KMEAN = (const float*)(ws + WS_MISC + MO_KMEAN);
    unsigned* BCNT = (unsigned*)(ws + WS_CTL) + CW_BCNT; unsigned short* BLIST = (unsigned short*)(ws + WS_BLIST); int* PSLOT = (int*)(ws + WS_PSLOT);
    LAS unsigned char* Qs = c.lds;
    LAS float* km = (LAS float*)(c.lds + 34816);
    LAS int* cnt = (LAS int*)(c.lds + 34816 + 16384);
    LAS int* gbase = cnt + 32;
    const int tid = c.tid, q0 = cb * 256 + half * 128;
    const int q = tid >> 2, sub = tid & 3;
    if (cb == 0) { if (sub == 0) { int* ps = PSLOT + ((size_t)(h * S + q0 + q)) * 3; ps[0] = -1; ps[1] = -1; ps[2] = -1; } return; }
    for (int i = tid; i < 128 * 16; i += 512) { const int r = i >> 4, ck = i & 15; *(LAS u32x4*)(Qs + r * 272 + ck * 16) = *(const u32x4*)(QP + ((size_t)(h * S + q0 + r)) * 128 + 8 * ck); }
    if (tid < 32) cnt[tid] = 0;
    { const f32x4* src = (const f32x4*)(KMEAN + (size_t)h * 32 * 128); for (int i = tid; i < cb * 32; i += 512) ((LAS f32x4*)km)[i] = src[i]; }
    __syncthreads();
    float bv0 = -INFINITY, bv1 = -INFINITY, bv2 = -INFINITY; int bi0 = 255, bi1 = 255, bi2 = 255;
    {
        float qv[128];
#pragma unroll
        for (int ck = 0; ck < 16; ++ck) { float t8[8]; unpack8(*(const LAS u32x4*)(Qs + q * 272 + ck * 16), t8);
#pragma unroll
            for (int i = 0; i < 8; ++i) qv[ck * 8 + i] = t8[i]; }
        for (int j = sub; j < cb; j += 4) {
            float s = 0.f;
#pragma unroll
            for (int d4 = 0; d4 < 32; ++d4) { const f32x4 kv = *(const LAS f32x4*)(km + j * 128 + 4 * d4); s += qv[4 * d4] * kv[0] + qv[4 * d4 + 1] * kv[1] + qv[4 * d4 + 2] * kv[2] + qv[4 * d4 + 3] * kv[3]; }
            if (s > bv0) { bv2 = bv1; bi2 = bi1; bv1 = bv0; bi1 = bi0; bv0 = s; bi0 = j; }
            else if (s > bv1) { bv2 = bv1; bi2 = bi1; bv1 = s; bi1 = j; }
            else if (s > bv2) { bv2 = s; bi2 = j; }
        }
    }
#pragma unroll
    for (int o = 1; o <= 2; o <<= 1) {
        const float ov0 = __shfl_xor(bv0, o), ov1 = __shfl_xor(bv1, o), ov2 = __shfl_xor(bv2, o);
        const int oi0 = __shfl_xor(bi0, o), oi1 = __shfl_xor(bi1, o), oi2 = __shfl_xor(bi2, o);
        float nv[3] = {ov0, ov1, ov2}; int ni[3] = {oi0, oi1, oi2};
#pragma unroll
        for (int k = 0; k < 3; ++k) { const float sv = nv[k]; const int j = ni[k];
            const bool b0 = (sv > bv0) || (sv == bv0 && j < bi0), b1 = (sv > bv1) || (sv == bv1 && j < bi1), b2 = (sv > bv2) || (sv == bv2 && j < bi2);
            if (b0) { bv2 = bv1; bi2 = bi1; bv1 = bv0; bi1 = bi0; bv0 = sv; bi0 = j; }
            else if (b1) { bv2 = bv1; bi2 = bi1; bv1 = sv; bi1 = j; }
            else if (b2) { bv2 = sv; bi2 = j; } }
    }
    int p0 = -1, p1 = -1, p2 = -1;
    if (sub == 0) {
        if (bi0 < cb) p0 = __hip_atomic_fetch_add(cnt + bi0, 1, __ATOMIC_RELAXED, __HIP_MEMORY_SCOPE_WORKGROUP);
        if (bi1 < cb) p1 = __hip_atomic_fetch_add(cnt + bi1, 1, __ATOMIC_RELAXED, __HIP_MEMORY_SCOPE_WORKGROUP);
        if (bi2 < cb) p2 = __hip_atomic_fetch_add(cnt + bi2, 1, __ATOMIC_RELAXED, __HIP_MEMORY_SCOPE_WORKGROUP);
    }
    __syncthreads();
    if (tid < cb) { const int cn = cnt[tid]; gbase[tid] = cn > 0 ? (int)__hip_atomic_fetch_add(BCNT + h * 32 + tid, (unsigned)cn, __ATOMIC_RELAXED, __HIP_MEMORY_SCOPE_AGENT) : 0; }
    __syncthreads();
    if (sub == 0) {
        int* ps = PSLOT + ((size_t)(h * S + q0 + q)) * 3; const unsigned short qq = (unsigned short)(q0 + q);
        if (p0 >= 0) { const int pos = gbase[bi0] + p0; BLIST[(size_t)(h * 32 + bi0) * 8192 + pos] = qq; ps[0] = (bi0 << 16) | pos; } else ps[0] = -1;
        if (p1 >= 0) { const int pos = gbase[bi1] + p1; BLIST[(size_t)(h * 32 + bi1) * 8192 + pos] = qq; ps[1] = (bi1 << 16) | pos; } else ps[1] = -1;
        if (p2 >= 0) { const int pos = gbase[bi2] + p2; BLIST[(size_t)(h * 32 + bi2) * 8192 + pos] = qq; ps[2] = (bi2 << 16) | pos; } else ps[2] = -1;
    }
    __syncthreads();
}

#define MOBA_TILE_PAIR(two, qrA, qrB, okA, okB, own, qlocA, qlocB, nkw) \
    f32x4 oA0 = {0.f, 0.f, 0.f, 0.f}, oA1 = oA0, oB0 = oA0, oB1 = oA0; float ltA = 0.f, ltB = 0.f; \
    { if (w < (nkw)) { \
        f32x4 sA0 = {0.f, 0.f, 0.f, 0.f}, sA1 = sA0, sB0 = sA0, sB1 = sA0; \
        _Pragma("unroll") for (int ks = 0; ks < 4; ++ks) { const bf16x8 qf = *(const LAS bf16x8*)(Qs + (qrA) * 272 + (32 * ks + 8 * g) * 2); sA0 = mfma16(Kc[0][ks], qf, sA0); sA1 = mfma16(Kc[1][ks], qf, sA1); } \
        if (two) { _Pragma("unroll") for (int ks = 0; ks < 4; ++ks) { const bf16x8 qf = *(const LAS bf16x8*)(Qs + (qrB) * 272 + (32 * ks + 8 * g) * 2); sB0 = mfma16(Kc[0][ks], qf, sB0); sB1 = mfma16(Kc[1][ks], qf, sB1); } } \
        const int kloc = 32 * w + 8 * g; \
        { float p[8]; float lsum = 0.f; \
          _Pragma("unroll") for (int r = 0; r < 4; ++r) { p[r] = __expf(sA0[r] * 0.08838834764831845f); p[4 + r] = __expf(sA1[r] * 0.08838834764831845f); } \
          _Pragma("unroll") for (int i = 0; i < 8; ++i) { const bool ok = (okA) && (!(own) || (kloc + i <= (qlocA))); p[i] = ok ? p[i] : 0.f; lsum += p[i]; } \
          lsum += __shfl_xor(lsum, 16); lsum += __shfl_xor(lsum, 32); \
          *(LAS u32x4*)(Pb + (buf * 2 + 0) * 8192 + w * 1024 + lane * 16) = pack8(p); \
          if (g == 0) lpart[((buf * 2 + 0) * 8 + w) * 16 + tt] = lsum; } \
        if (two) { float p[8]; float lsum = 0.f; \
          _Pragma("unroll") for (int r = 0; r < 4; ++r) { p[r] = __expf(sB0[r] * 0.08838834764831845f); p[4 + r] = __expf(sB1[r] * 0.08838834764831845f); } \
          _Pragma("unroll") for (int i = 0; i < 8; ++i) { const bool ok = (okB) && (!(own) || (kloc + i <= (qlocB))); p[i] = ok ? p[i] : 0.f; lsum += p[i]; } \
          lsum += __shfl_xor(lsum, 16); lsum += __shfl_xor(lsum, 32); \
          *(LAS u32x4*)(Pb + (buf * 2 + 1) * 8192 + w * 1024 + lane * 16) = pack8(p); \
          if (g == 0) lpart[((buf * 2 + 1) * 8 + w) * 16 + tt] = lsum; } \
      } \
      LDS_WAIT(); __builtin_amdgcn_s_barrier(); asm volatile("" ::: "memory"); \
      _Pragma("unroll") for (int ks = 0; ks < 8; ks += 2) if (ks < (nkw)) { \
          const bf16x8 pa = *(const LAS bf16x8*)(Pb + (buf * 2 + 0) * 8192 + ks * 1024 + lane * 16), pb = *(const LAS bf16x8*)(Pb + (buf * 2 + 0) * 8192 + (ks + 1) * 1024 + lane * 16); \
          oA0 = mfma16(Vc[ks], pa, oA0); oA1 = mfma16(Vc[ks + 1], pb, oA1); } \
      _Pragma("unroll") for (int ww = 0; ww < 8; ++ww) if (ww < (nkw)) ltA += lpart[((buf * 2 + 0) * 8 + ww) * 16 + tt]; \
      if (two) { \
          _Pragma("unroll") for (int ks = 0; ks < 8; ks += 2) if (ks < (nkw)) { \
              const bf16x8 pa = *(const LAS bf16x8*)(Pb + (buf * 2 + 1) * 8192 + ks * 1024 + lane * 16), pb = *(const LAS bf16x8*)(Pb + (buf * 2 + 1) * 8192 + (ks + 1) * 1024 + lane * 16); \
              oB0 = mfma16(Vc[ks], pa, oB0); oB1 = mfma16(Vc[ks + 1], pb, oB1); } \
          _Pragma("unroll") for (int ww = 0; ww < 8; ++ww) if (ww < (nkw)) ltB += lpart[((buf * 2 + 1) * 8 + ww) * 16 + tt]; } \
      oA0 = oA0 + oA1; oB0 = oB0 + oB1; buf ^= 1; }

__device__ __forceinline__ void moba_bucket_phase(const Ctx& c) {
    unsigned char* ws = c.ws;
    const bf16_t* QP = (const bf16_t*)(ws + WS_QP); const bf16_t* KP = (const bf16_t*)(ws + WS_KP); const bf16_t* VTP = (const bf16_t*)(ws + WS_VTP);
    unsigned* BCNT = (unsigned*)(ws + WS_CTL) + CW_BCNT; const unsigned short* BLIST = (const unsigned short*)(ws + WS_BLIST);
    bf16_t* PART = (bf16_t*)(ws + WS_PART); float* LPART = (float*)(ws + WS_LPART); int* POFF = (int*)(ws + WS_POFF);
    LAS unsigned char* Qs = c.lds;
    LAS unsigned char* Pb = c.lds + 34816;
    LAS float* lpart = (LAS float*)(c.lds + 34816 + 32768);
    LAS int* cnts = (LAS int*)(c.lds + 34816 + 32768 + 2048);
    LAS int* ipre = cnts + 256;
    LAS int* ppre = ipre + 260;
    LAS int* wsum = ppre + 260;
    LAS int* selb = wsum + 16;
    const int tid = c.tid, lane = c.lane, w = c.wave, tt = lane & 15, g = lane >> 4;
    {
        int cn = 0, nch = 0, pp = 0;
        if (tid < 256) { cn = (int)__hip_atomic_load(BCNT + tid, __ATOMIC_RELAXED, __HIP_MEMORY_SCOPE_AGENT); nch = (cn + 127) >> 7; pp = (cn + 15) & ~15; cnts[tid] = cn; }
        int i1 = nch, i2 = pp;
#pragma unroll
        for (int o = 1; o < 64; o <<= 1) { const int t1 = __shfl_up(i1, o), t2 = __shfl_up(i2, o); if (lane >= o) { i1 += t1; i2 += t2; } }
        if (lane == 63 && w < 4) { wsum[w] = i1; wsum[8 + w] = i2; }
        __syncthreads();
        if (tid < 256) { int a1 = 0, a2 = 0;
#pragma unroll
            for (int k = 0; k < 4; ++k) if (k < w) { a1 += wsum[k]; a2 += wsum[8 + k]; }
            ipre[tid + 1] = a1 + i1; ppre[tid + 1] = a2 + i2; if (tid == 0) { ipre[0] = 0; ppre[0] = 0; } }
        __syncthreads();
        if (c.bid == 0 && tid <= 256) POFF[tid] = ppre[tid];
    }
    const int total = ipre[256];
    int buf = 0;
    LAS unsigned char* Qs1 = c.lds + 34816 + 32768 + 2048 + 4096;
#define BK_FIND(it_, b_, ch_, n_) do { int lo_ = 0, hi_ = 256; while (hi_ - lo_ > 1) { const int md_ = (lo_ + hi_) >> 1; if (ipre[md_] <= (it_)) lo_ = md_; else hi_ = md_; } \
        b_ = lo_; ch_ = (it_) - ipre[lo_]; n_ = min(128, cnts[lo_] - 128 * ch_); } while (0)
#define BK_IDX(b_, ch_, n_, Q_) do { _Pragma("unroll") for (int k = 0; k < 4; ++k) { const int r_ = (tid + 512 * k) >> 4; Q_[k] = BLIST[(size_t)(b_) * 8192 + 128 * (ch_) + (r_ < (n_) ? r_ : (n_) - 1)]; } } while (0)
#define BK_ROWS(b_, Q_, R_) do { _Pragma("unroll") for (int k = 0; k < 4; ++k) R_[k] = *(const u32x4*)(QP + ((size_t)(((b_) >> 5) * S + Q_[k])) * 128 + 8 * (tid & 15)); } while (0)
#define BK_WRITE(n_, R_, QB_) do { _Pragma("unroll") for (int k = 0; k < 4; ++k) { const int r_ = (tid + 512 * k) >> 4; u32x4 v_ = R_[k]; if (r_ >= (n_)) v_ = (u32x4){0u, 0u, 0u, 0u}; *(LAS u32x4*)((QB_) + r_ * 272 + (tid & 15) * 16) = v_; } } while (0)
    int it = c.bid;
    if (it < total) {
        int bC, chC, nC, bN = 0, chN = 0, nN = 0; int qiN[4], qiNN[4]; u32x4 rowsN[4];
        bf16x8 Kc[2][4], Vc[8], Kn[2][4], Vn[8];
        BK_FIND(it, bC, chC, nC);
        { int qi0[4]; BK_IDX(bC, chC, nC, qi0); u32x4 r0[4]; BK_ROWS(bC, qi0, r0); const int h = bC >> 5; MOBA_LOAD_KV(bC & 31, Kc, Vc); BK_WRITE(nC, r0, Qs); }
        bool hasN = (it + c.G < total);
        if (hasN) { BK_FIND(it + c.G, bN, chN, nN); BK_IDX(bN, chN, nN, qiN); }
        LDS_WAIT(); __builtin_amdgcn_s_barrier(); asm volatile("" ::: "memory");
        int par = 0;
        for (;;) {
            LAS unsigned char* Qs = par ? Qs1 : c.lds;
            const int h = bC >> 5, ntile = (nC + 15) >> 4, n = nC; const int pbase = ppre[bC] + 128 * chC;
            const bool hasNN = (it + 2 * c.G < total); int bNN = 0, chNN = 0, nNN = 0;
            if (hasN) { BK_ROWS(bN, qiN, rowsN); { const int h = bN >> 5; MOBA_LOAD_KV(bN & 31, Kn, Vn); } }
            if (hasNN) { BK_FIND(it + 2 * c.G, bNN, chNN, nNN); BK_IDX(bNN, chNN, nNN, qiNN); }
            MOBA_TOUCH_KV(Kc, Vc);
            for (int tl = 0; tl < ntile; tl += 2) {
                const bool two = (tl + 1 < ntile);
                const int rA = 16 * tl + tt, rB = two ? rA + 16 : rA;
                MOBA_TILE_PAIR(two, rA, rB, (rA < n), (two && rB < n), 0, 0, 0, 8)
                { u32x2 wv; wv.x = cvt_pk_bf16(oA0[0], oA0[1]); wv.y = cvt_pk_bf16(oA0[2], oA0[3]); *(u32x2*)(PART + (size_t)(pbase + rA) * 128 + 16 * w + 4 * g) = wv;
                  if (w == 0 && g == 0) LPART[pbase + rA] = ltA; }
                if (two) { u32x2 wv; wv.x = cvt_pk_bf16(oB0[0], oB0[1]); wv.y = cvt_pk_bf16(oB0[2], oB0[3]); *(u32x2*)(PART + (size_t)(pbase + rB) * 128 + 16 * w + 4 * g) = wv;
                  if (w == 0 && g == 0) LPART[pbase + rB] = ltB; }
            }
            if (!hasN) break;
            BK_WRITE(nN, rowsN, (par ? c.lds : Qs1));
#pragma unroll
            for (int tq = 0; tq < 2; ++tq)
#pragma unroll
                for (int ks = 0; ks < 4; ++ks) Kc[tq][ks] = Kn[tq][ks];
#pragma unroll
            for (int ks = 0; ks < 8; ++ks) Vc[ks] = Vn[ks];
#pragma unroll
            for (int k = 0; k < 4; ++k) qiN[k] = qiNN[k];
            bC = bN; chC = chN; nC = nN; bN = bNN; chN = chNN; nN = nNN; hasN = hasNN; it += c.G; par ^= 1;
            LDS_WAIT(); __builtin_amdgcn_s_barrier(); asm volatile("" ::: "memory");
        }
    }
#undef BK_FIND
#undef BK_IDX
#undef BK_ROWS
#undef BK_WRITE
    __syncthreads();
}

__device__ __forceinline__ void moba_own(const Ctx& c, int h, int cb, int half) {
    unsigned char* ws = c.ws;
    const bf16_t* QP = (const bf16_t*)(ws + WS_QP); const bf16_t* KP = (const bf16_t*)(ws + WS_KP); const bf16_t* VTP = (const bf16_t*)(ws + WS_VTP);
    const bf16_t* PART = (const bf16_t*)(ws + WS_PART); const float* LPART = (const float*)(ws + WS_LPART); const int* POFF = (const int*)(ws + WS_POFF); const int* PSLOT = (const int*)(ws + WS_PSLOT);
    bf16_t* HCAT = (bf16_t*)(ws + WS_HCAT);
    LAS unsigned char* Qs = c.lds; LAS unsigned char* Pb = c.lds + 34816; LAS float* lpart = (LAS float*)(c.lds + 34816 + 32768);
    LAS float* Os = (LAS float*)(c.lds + 34816 + 32768 + 2048);
    LAS float* Ls = Os + 128 * 132;
    const int tid = c.tid, lane = c.lane, w = c.wave, tt = lane & 15, g = lane >> 4, q0 = cb * 256 + half * 128;
    bf16x8 Kc[2][4], Vc[8];
    MOBA_LOAD_KV(cb, Kc, Vc);
    const int cq = tid >> 2, cpart = tid & 3;
    int pr[3]; u32x4 prow[3][4]; float plv[3];
#pragma unroll
    for (int k = 0; k < 3; ++k) { const int sl = PSLOT[((size_t)(h * S + q0 + cq)) * 3 + k]; const int po = POFF[h * 32 + ((sl < 0 ? 0 : sl) >> 16)]; pr[k] = (sl >= 0) ? (po + (sl & 0xffff)) : -1; }
    for (int i = tid; i < 128 * 16; i += 512) { const int r = i >> 4, ck = i & 15; *(LAS u32x4*)(Qs + r * 272 + ck * 16) = *(const u32x4*)(QP + ((size_t)(h * S + q0 + r)) * 128 + 8 * ck); }
#pragma unroll
    for (int k = 0; k < 3; ++k) { const int pc = pr[k] < 0 ? 0 : pr[k]; plv[k] = LPART[pc];
#pragma unroll
        for (int j = 0; j < 4; ++j) prow[k][j] = *(const u32x4*)(PART + (size_t)pc * 128 + cpart * 32 + 8 * j); }
    MOBA_TOUCH_KV(Kc, Vc);
    __syncthreads();
    const int nkw = half ? 8 : 4;
    int buf = 0;
    for (int tl = 0; tl < 8; tl += 2) {
        const int rA = 16 * tl + tt, rB = rA + 16;
        MOBA_TILE_PAIR(true, rA, rB, true, true, 1, (half * 128 + rA), (half * 128 + rB), nkw)
        *(LAS f32x4*)(Os + rA * 132 + 16 * w + 4 * g) = oA0; *(LAS f32x4*)(Os + rB * 132 + 16 * w + 4 * g) = oB0;
        if (w == 0 && g == 0) { Ls[rA] = ltA; Ls[rB] = ltB; }
    }
    __syncthreads();
    { float l = Ls[cq];
#pragma unroll
      for (int k = 0; k < 3; ++k) if (pr[k] >= 0) l += plv[k];
      const float inv = 1.f / l;
#pragma unroll
      for (int j = 0; j < 4; ++j) { float v[8];
#pragma unroll
          for (int i = 0; i < 8; ++i) v[i] = Os[cq * 132 + cpart * 32 + 8 * j + i];
#pragma unroll
          for (int k = 0; k < 3; ++k) if (pr[k] >= 0) { float t8[8]; unpack8(prow[k][j], t8);
#pragma unroll
              for (int i = 0; i < 8; ++i) v[i] += t8[i]; }
#pragma unroll
          for (int i = 0; i < 8; ++i) v[i] *= inv;
          *(u32x4*)(HCAT + (size_t)(q0 + cq) * 2048 + 1024 + h * 128 + cpart * 32 + 8 * j) = pack8(v); } }
    __syncthreads();
}

__device__ __forceinline__ void mlstm_scan(const Ctx& c) {
    unsigned char* ws = c.ws; const float* CTL = (const float*)(ws + WS_CTL_LOC); bf16_t* CTP = (bf16_t*)(ws + WS_CTP);
    const float* GC = (const float*)(ws + WS_MISC + MO_GC); const float* AMAX = (const float*)(ws + WS_MISC + MO_AMAX); float* MPREV = (float*)(ws + WS_MISC + MO_MPREV);
    const int e2 = c.bid * 512 + c.tid; constexpr int PER_H = DVP * 128 / 2;
    if (e2 >= 4 * PER_H) return;
    const int h = e2 / PER_H, rem = e2 % PER_H;
    f32x2 st = {0.f, 0.f}; float mprev = 0.f;
    for (int c0 = 0; c0 < 64; c0 += 8) {
        f32x2 loc[8];
#pragma unroll
        for (int k = 0; k < 8; ++k) loc[k] = *(const f32x2*)(CTL + ((size_t)(h * 64 + c0 + k)) * (DVP * 128) + 2 * rem);
#pragma unroll
        for (int k = 0; k < 8; ++k) { const int ch = c0 + k; const float gg = GC[h * 64 + ch], am = AMAX[h * 64 + ch];
            *(unsigned*)(CTP + ((size_t)(h * 64 + ch)) * (DVP * 128) + 2 * rem) = cvt_pk_bf16(st[0], st[1]);
            if (rem == 0) MPREV[h * 64 + ch] = mprev;
            const float mnew = fmaxf(gg + mprev, am), dec = __expf(gg + mprev - mnew), sc = __expf(am - mnew);
            st = st * dec + loc[k] * sc; mprev = mnew; }
    }
}

__device__ __forceinline__ bf16x8 scale_frag(bf16x8 f, float s) { float v[8]; unpack8(as_u4(f), v);
#pragma unroll
    for (int i = 0; i < 8; ++i) v[i] *= s;
    return as_frag(pack8(v)); }

__device__ __forceinline__ void mlstm_out(const Args& a, const Ctx& c, int h, int ch) {
    unsigned char* ws = c.ws;
    const bf16_t* QC = (const bf16_t*)(ws + WS_QC); const bf16_t* KC = (const bf16_t*)(ws + WS_KC); const bf16_t* VT = (const bf16_t*)(ws + WS_VT); const bf16_t* CTP = (const bf16_t*)(ws + WS_CTP);
    const float* BV = (const float*)(ws + WS_MISC + MO_BV); const float* UV = (const float*)(ws + WS_MISC + MO_UV); const float* PMX = (const float*)(ws + WS_MISC + MO_PMX);
    const float* MPREV = (const float*)(ws + WS_MISC + MO_MPREV); const bf16_t* PROJ = (const bf16_t*)(ws + WS_PROJ); bf16_t* HCAT = (bf16_t*)(ws + WS_HCAT);
    const int tt = c.lane & 15, g = c.lane >> 4, w = c.wave, t0 = ch * 128, trow = t0 + 16 * w + tt, tid = c.tid;
    LAS unsigned char* RA = c.lds; LAS unsigned char* RB = c.lds + 69632;
    tile256_load(RA, KC + ((size_t)(h * S + t0)) * 128, 128, 128, tid);
    tile256_load(RB, CTP + ((size_t)(h * 64 + ch)) * DVP * 128, 128, DVP, tid);
    const float b_t = BV[h * S + trow], pm_t = PMX[h * S + trow], mprev = MPREV[h * 64 + ch];
    const float m_t = b_t + fmaxf(mprev, pm_t), w_inter = __expf((b_t + mprev) - m_t), bm = b_t - m_t;
    bf16x8 qf[4], qs[4], pf[4];
#pragma unroll
    for (int kd = 0; kd < 4; ++kd) { qf[kd] = *(const bf16x8*)(QC + ((size_t)(h * S + trow)) * 128 + 32 * kd + 8 * g); qs[kd] = scale_frag(qf[kd], w_inter); }
    __syncthreads();
    u32x4 vst[9];
#pragma unroll
    for (int i = 0; i < 9; ++i) { const int idx = tid + 512 * i; if (idx < DVP * 16) vst[i] = *(const u32x4*)(VT + ((size_t)((h * 64 + ch) * DVP + (idx >> 4))) * 128 + 8 * (idx & 15)); }
    const int nsg = (w >> 1) + 1;
#pragma unroll
    for (int sg = 0; sg < 4; ++sg) {
        if (sg < nsg) {
            f32x4 s0 = {0.f, 0.f, 0.f, 0.f}, s1 = {0.f, 0.f, 0.f, 0.f};
#pragma unroll
            for (int kd = 0; kd < 4; ++kd) {
                s0 = mfma16(tile256_frag(RA, 32 * sg + pi32(0, tt), 4 * kd + g), qf[kd], s0);
                s1 = mfma16(tile256_frag(RA, 32 * sg + pi32(1, tt), 4 * kd + g), qf[kd], s1); }
            const f32x4 ua = *(const f32x4*)(UV + h * S + t0 + 32 * sg + 8 * g), ub = *(const f32x4*)(UV + h * S + t0 + 32 * sg + 8 * g + 4);
            float p[8]; const int sl = 32 * sg + 8 * g, tl = 16 * w + tt;
#pragma unroll
            for (int r = 0; r < 4; ++r) { p[r] = (sl + r <= tl) ? s0[r] * __expf(bm + ua[r]) : 0.f; p[4 + r] = (sl + 4 + r <= tl) ? s1[r] * __expf(bm + ub[r]) : 0.f; }
            pf[sg] = as_frag(pack8(p));
        } else pf[sg] = (bf16x8){0, 0, 0, 0, 0, 0, 0, 0};
    }
    f32x4 oacc[17];
#pragma unroll
    for (int mt = 0; mt < 17; ++mt) {
        f32x4 o = {0.f, 0.f, 0.f, 0.f};
#pragma unroll
        for (int kd = 0; kd < 4; ++kd) o = mfma16(tile256_frag(RB, 16 * mt + tt, 4 * kd + g), qs[kd], o);
        oacc[mt] = o;
    }
    __syncthreads();
#pragma unroll
    for (int i = 0; i < 9; ++i) { const int idx = tid + 512 * i; if (idx < DVP * 16) { const int row = idx >> 4, ck = idx & 15; *(LAS u32x4*)(RA + row * 256 + ((ck ^ (row & 15)) << 4)) = vst[i]; } }
    __syncthreads();
#pragma unroll
    for (int mt = 0; mt < 17; ++mt) {
#pragma unroll
        for (int sg = 0; sg < 4; ++sg) if (sg < nsg) oacc[mt] = mfma16(tile256_frag(RA, 16 * mt + tt, 4 * sg + g), pf[sg], oacc[mt]);
    }
    const float den = __shfl(oacc[16][0], tt);
    const float inv = 1.f / fmaxf(fabsf(den), __expf(-m_t));
    float ss = 0.f;
#pragma unroll
    for (int mt = 0; mt < 16; ++mt) { oacc[mt] = oacc[mt] * inv; ss += (oacc[mt][0] * oacc[mt][0] + oacc[mt][1] * oacc[mt][1]) + (oacc[mt][2] * oacc[mt][2] + oacc[mt][3] * oacc[mt][3]); }
    ss += __shfl_xor(ss, 16); ss += __shfl_xor(ss, 32);
    const float rstd = rsqrtf(ss * (1.f / 256.f) + EPS);
    const float* og = INF(8);
#pragma unroll
    for (int mt = 0; mt < 16; ++mt) { const int dv = 16 * mt + 4 * g;
        const f32x4 o4 = *(const f32x4*)(og + h * 256 + dv); const u32x2 mo = *(const u32x2*)(PROJ + (size_t)trow * NPROJ + PC_MO + h * 256 + dv);
        const float v0 = oacc[mt][0] * rstd * o4[0] * sigmoidf_(bf_lo(mo.x)), v1 = oacc[mt][1] * rstd * o4[1] * sigmoidf_(bf_hi(mo.x));
        const float v2 = oacc[mt][2] * rstd * o4[2] * sigmoidf_(bf_lo(mo.y)), v3 = oacc[mt][3] * rstd * o4[3] * sigmoidf_(bf_hi(mo.y));
        u32x2 wv; wv.x = cvt_pk_bf16(v0, v1); wv.y = cvt_pk_bf16(v2, v3);
        *(u32x2*)(HCAT + (size_t)trow * 2048 + h * 256 + dv) = wv; }
    __syncthreads();
}

__device__ __forceinline__ void xattn_item(const Args& a, const Ctx& c, int h, int tile) {
    unsigned char* ws = c.ws; const bf16_t* QX = (const bf16_t*)(ws + WS_QX); const bf16_t* KM = (const bf16_t*)(ws + WS_KM); const bf16_t* VTM = (const bf16_t*)(ws + WS_VTM); bf16_t* OX = (bf16_t*)(ws + WS_OX);
    const int lane = c.lane, tt = lane & 15, g = lane >> 4, w = c.wave, trow = tile * 128 + 16 * w + tt;
    const float* qg = INF(16);
#ifdef XA_SEG
    unsigned long long ts_[5]; ts_[0] = __builtin_amdgcn_s_memrealtime();
#define XA_STAMP(i) do { asm volatile("s_waitcnt vmcnt(0) lgkmcnt(0)" ::: "memory"); ts_[i] = __builtin_amdgcn_s_memrealtime(); } while (0)
#else
#define XA_STAMP(i) do {} while (0)
#endif
    const bf16_t* kbase = KM + (size_t)h * 256 * 512; const bf16_t* vbase = VTM + (size_t)h * 512 * 256;
    int koff[4], voff[4];
#pragma unroll
    for (int i = 0; i < 4; ++i) { const int kr = 32 * w + 8 * i + (lane >> 3), fk = ((kr >> 1) & 1) | (((kr >> 3) & 3) << 1); koff[i] = kr * 512 + 8 * ((lane & 7) ^ fk);
        const int vr = 2 * (4 * w + i) + (lane >> 5), vc = (lane & 31) ^ (vr & 15); voff[i] = vr * 256 + 8 * vc; }
#define XA_DMA(ci) do { LAS unsigned char* bb = c.lds + ((ci) & 3) * 32768; _Pragma("unroll") for (int i = 0; i < 4; ++i) \
        __builtin_amdgcn_global_load_lds((const unsigned*)((ci) < 8 ? kbase + (koff[i] + 64 * (ci)) : vbase + (voff[i] + 64 * ((ci) - 8) * 256)), (LAS unsigned*)(bb + (4 * w + i) * 1024), 16, 0, 0); } while (0)
    asm volatile("s_waitcnt vmcnt(0)" ::: "memory");
    XA_DMA(0); XA_DMA(1); XA_DMA(2);
    bf16x8 qf[16]; float ss = 0.f;
#pragma unroll
    for (int ks = 0; ks < 16; ++ks) { qf[ks] = *(const bf16x8*)(QX + (size_t)trow * 2048 + h * 512 + 32 * ks + 8 * g); float v[8]; unpack8(as_u4(qf[ks]), v);
#pragma unroll
        for (int i = 0; i < 8; ++i) ss += v[i] * v[i]; }
    ss += __shfl_xor(ss, 16); ss += __shfl_xor(ss, 32);
    const float rs = rsqrtf(ss * (1.f / 512.f) + EPS) * 0.04419417382415922f;
#pragma unroll
    for (int ks = 0; ks < 16; ++ks) { float v[8]; unpack8(as_u4(qf[ks]), v); const f32x4 g0 = *(const f32x4*)(qg + 32 * ks + 8 * g), g1 = *(const f32x4*)(qg + 32 * ks + 8 * g + 4);
        v[0] *= rs * g0[0]; v[1] *= rs * g0[1]; v[2] *= rs * g0[2]; v[3] *= rs * g0[3]; v[4] *= rs * g1[0]; v[5] *= rs * g1[1]; v[6] *= rs * g1[2]; v[7] *= rs * g1[3];
        qf[ks] = as_frag(pack8(v)); }
    int kof[2][2], vof[8];
#pragma unroll
    for (int tq = 0; tq < 2; ++tq)
#pragma unroll
        for (int k2 = 0; k2 < 2; ++k2) { const int key = pi32(tq, tt), fk = ((key >> 1) & 1) | (((key >> 3) & 3) << 1); kof[tq][k2] = key * 128 + (((4 * k2 + g) ^ fk) << 4); }
#pragma unroll
    for (int kk = 0; kk < 8; ++kk) vof[kk] = tt * 512 + (((4 * kk + g) ^ tt) << 4);
    asm volatile("" : "+v"(kof[0][0]), "+v"(kof[0][1]), "+v"(kof[1][0]), "+v"(kof[1][1]));
    asm volatile("s_waitcnt vmcnt(0)" ::: "memory");
    XA_STAMP(1);
    f32x4 sacc[16];
#pragma unroll
    for (int mt = 0; mt < 16; ++mt) sacc[mt] = (f32x4){0.f, 0.f, 0.f, 0.f};
#pragma unroll
    for (int ci = 0; ci < 8; ++ci) {
        asm volatile("s_waitcnt vmcnt(8)" ::: "memory"); __builtin_amdgcn_s_barrier(); asm volatile("" ::: "memory");
        XA_DMA(ci + 3);
        const LAS unsigned char* bb = c.lds + (ci & 3) * 32768;
#pragma unroll
        for (int mt = 0; mt < 16; ++mt) {
#pragma unroll
            for (int k2 = 0; k2 < 2; ++k2) { const bf16x8 af = *(const LAS bf16x8*)(bb + kof[mt & 1][k2] + 4096 * (mt >> 1)); sacc[mt] = mfma16(af, qf[2 * ci + k2], sacc[mt]); } }
        LDS_WAIT();
    }
#ifdef XA_SEG
    ts_[2] = __builtin_amdgcn_s_memrealtime();
#endif
    float mx = -INFINITY;
#pragma unroll
    for (int mt = 0; mt < 16; ++mt) mx = fmaxf(mx, fmaxf(fmaxf(sacc[mt][0], sacc[mt][1]), fmaxf(sacc[mt][2], sacc[mt][3])));
    mx = fmaxf(mx, __shfl_xor(mx, 16)); mx = fmaxf(mx, __shfl_xor(mx, 32));
    float l = 0.f; bf16x8 pf[8];
#pragma unroll
    for (int kk = 0; kk < 8; ++kk) { float p[8];
#pragma unroll
        for (int r = 0; r < 4; ++r) { p[r] = __expf(sacc[2 * kk][r] - mx); p[4 + r] = __expf(sacc[2 * kk + 1][r] - mx); }
#pragma unroll
        for (int i = 0; i < 8; ++i) l += p[i];
        pf[kk] = as_frag(pack8(p)); }
    l += __shfl_xor(l, 16); l += __shfl_xor(l, 32);
    const float inv = 1.f / l;
    u32x2 ost[8][4];
#pragma unroll
    for (int ci = 8; ci < 16; ++ci) {
        if (ci == 13) asm volatile("s_waitcnt vmcnt(8)" ::: "memory"); else if (ci == 14) asm volatile("s_waitcnt vmcnt(4)" ::: "memory"); else if (ci == 15) asm volatile("s_waitcnt vmcnt(0)" ::: "memory"); else asm volatile("s_waitcnt vmcnt(8)" ::: "memory");
        __builtin_amdgcn_s_barrier(); asm volatile("" ::: "memory");
        if (ci + 3 < 16) XA_DMA(ci + 3);
        const LAS unsigned char* bb = c.lds + (ci & 3) * 32768;
#pragma unroll
        for (int m4 = 0; m4 < 4; ++m4) { f32x4 o0 = {0.f, 0.f, 0.f, 0.f}, o1 = o0;
#pragma unroll
            for (int kk = 0; kk < 8; kk += 2) {
                const bf16x8 a0 = *(const LAS bf16x8*)(bb + vof[kk] + 8192 * m4), a1 = *(const LAS bf16x8*)(bb + vof[kk + 1] + 8192 * m4);
                o0 = mfma16(a0, pf[kk], o0); o1 = mfma16(a1, pf[kk + 1], o1); }
            const f32x4 o = (o0 + o1) * inv; ost[ci - 8][m4].x = cvt_pk_bf16(o[0], o[1]); ost[ci - 8][m4].y = cvt_pk_bf16(o[2], o[3]); }
        LDS_WAIT();
    }
#pragma unroll
    for (int cc = 0; cc < 8; ++cc)
#pragma unroll
        for (int m4 = 0; m4 < 4; ++m4) *(u32x2*)(OX + (size_t)trow * 2048 + h * 512 + 64 * cc + 16 * m4 + 4 * g) = ost[cc][m4];
#undef XA_DMA
#ifdef XA_SEG
    ts_[3] = __builtin_amdgcn_s_memrealtime();
    asm volatile("s_waitcnt vmcnt(0)" ::: "memory"); ts_[4] = __builtin_amdgcn_s_memrealtime();
    { const unsigned long long dt = ts_[XA_SEG + 1] - ts_[XA_SEG]; const unsigned long long t_end = ts_[4] + 20ull * dt; if (c.bid == 0 && w == 0) { while (__builtin_amdgcn_s_memrealtime() < t_end) __builtin_amdgcn_s_sleep(8); } }
#endif
#undef XA_STAMP
    __syncthreads();
}

__device__ __forceinline__ void split_frag(const f32x4 v0, const f32x4 v1, bf16x8& fh, bf16x8& fl) {
    float x[8] = {v0[0], v0[1], v0[2], v0[3], v1[0], v1[1], v1[2], v1[3]}; float r[8]; u32x4 h = pack8(x); float hf[8]; unpack8(h, hf);
#pragma unroll
    for (int i = 0; i < 8; ++i) r[i] = x[i] - hf[i];
    fh = as_frag(h); fl = as_frag(pack8(r));
}
__device__ __forceinline__ void route_block(const Args& a, const Ctx& c) {
    unsigned char* ws = c.ws; const bf16_t* WRH = (const bf16_t*)(ws + WS_MISC + MO_WR); const bf16_t* WRL = WRH + 80 * 2048; const float* H2 = c.out;
    unsigned* ECNT = (unsigned*)(ws + WS_CTL) + CW_ECNT; float* PAIR_W = (float*)(ws + WS_MISC + MO_PAIR_W); int* ELIST = (int*)(ws + WS_ELIST);
    bf16_t* HNB = (bf16_t*)(ws + WS_HNB);
    LAS float* lg = (LAS float*)c.lds;
    LAS float* ssqp = lg + 8 * 32 * 80;
    LAS float* lgf = ssqp + 256;
    LAS float* rsd = lgf + 32 * 80;
    const int w = c.wave, lane = c.lane, n = lane & 15, g = lane >> 4, tid = c.tid;
    const int r0 = c.bid * 32;
    f32x4 acc[2][5];
#pragma unroll
    for (int t = 0; t < 2; ++t)
#pragma unroll
        for (int i = 0; i < 5; ++i) acc[t][i] = (f32x4){0.f, 0.f, 0.f, 0.f};
    float ssq0 = 0.f, ssq1 = 0.f;
    const float* a0p = H2 + (size_t)(r0 + n) * 2048 + 256 * w + 8 * g; const float* a1p = a0p + (size_t)16 * 2048;
    const bf16_t* bhp = WRH + (size_t)n * 2048 + 256 * w + 8 * g; const bf16_t* blp = WRL + (size_t)n * 2048 + 256 * w + 8 * g;
    f32x4 A0[2][2], A1[2][2]; bf16x8 Bh[2][5], Bl[2][5];
#define RT_LOAD(sb, ks) do { A0[sb][0] = *(const f32x4*)(a0p + 32 * (ks)); A0[sb][1] = *(const f32x4*)(a0p + 32 * (ks) + 4); A1[sb][0] = *(const f32x4*)(a1p + 32 * (ks)); A1[sb][1] = *(const f32x4*)(a1p + 32 * (ks) + 4); \
        _Pragma("unroll") for (int nt = 0; nt < 5; ++nt) { Bh[sb][nt] = *(const bf16x8*)(bhp + (size_t)(16 * nt) * 2048 + 32 * (ks)); Bl[sb][nt] = *(const bf16x8*)(blp + (size_t)(16 * nt) * 2048 + 32 * (ks)); } } while (0)
#define RT_COMP(sb) do { bf16x8 h0, l0, h1, l1; split_frag(A0[sb][0], A0[sb][1], h0, l0); split_frag(A1[sb][0], A1[sb][1], h1, l1); \
        _Pragma("unroll") for (int q = 0; q < 2; ++q) { const f32x4 v = A0[sb][q], u = A1[sb][q]; ssq0 += (v[0] * v[0] + v[1] * v[1]) + (v[2] * v[2] + v[3] * v[3]); ssq1 += (u[0] * u[0] + u[1] * u[1]) + (u[2] * u[2] + u[3] * u[3]); } \
        _Pragma("unroll") for (int nt = 0; nt < 5; ++nt) { \
            acc[0][nt] = mfma16(h0, Bh[sb][nt], acc[0][nt]); acc[0][nt] = mfma16(l0, Bh[sb][nt], acc[0][nt]); acc[0][nt] = mfma16(h0, Bl[sb][nt], acc[0][nt]); \
            acc[1][nt] = mfma16(h1, Bh[sb][nt], acc[1][nt]); acc[1][nt] = mfma16(l1, Bh[sb][nt], acc[1][nt]); acc[1][nt] = mfma16(h1, Bl[sb][nt], acc[1][nt]); } } while (0)
    RT_LOAD(0, 0);
#pragma unroll 1
    for (int ks = 0; ks < 8; ks += 2) {
        RT_LOAD(1, ks + 1); asm volatile("" ::: "memory");
        RT_COMP(0);
        if (ks + 2 < 8) RT_LOAD(0, ks + 2);
        asm volatile("" ::: "memory");
        RT_COMP(1);
    }
#undef RT_LOAD
#undef RT_COMP
    ssq0 += __shfl_xor(ssq0, 16); ssq0 += __shfl_xor(ssq0, 32); ssq1 += __shfl_xor(ssq1, 16); ssq1 += __shfl_xor(ssq1, 32);
#pragma unroll
    for (int t = 0; t < 2; ++t)
#pragma unroll
        for (int nt = 0; nt < 5; ++nt)
#pragma unroll
            for (int r = 0; r < 4; ++r) lg[(w * 32 + 16 * t + 4 * g + r) * 80 + 16 * nt + n] = acc[t][nt][r];
    if (g == 0) { ssqp[w * 32 + n] = ssq0; ssqp[w * 32 + 16 + n] = ssq1; }
    __syncthreads();
    for (int i = tid; i < 32 * 80; i += 512) { float v = 0.f;
#pragma unroll
        for (int q = 0; q < 8; ++q) v += lg[q * 32 * 80 + i];
        lgf[i] = v; }
    __syncthreads();
    if (tid < 32) {
        const int rr = tid; const int t = r0 + rr;
        float sq = 0.f;
#pragma unroll
        for (int q = 0; q < 8; ++q) sq += ssqp[q * 32 + rr];
        const float rstd = rsqrtf(sq * (1.f / 2048.f) + EPS); rsd[rr] = rstd;
        const float* bg = INF(21); const float* be = INF(23);
        float gl[8]; float gm = -INFINITY; int gs = 0;
#pragma unroll
        for (int j = 0; j < 8; ++j) { gl[j] = lgf[rr * 80 + j] * rstd + bg[j]; if (gl[j] > gm) { gm = gl[j]; gs = j; } }
        float gsum = 0.f;
#pragma unroll
        for (int j = 0; j < 8; ++j) gsum += __expf(gl[j] - gm);
        const float pg = 1.f / gsum;
        float el[8]; float m0 = -INFINITY; int i0 = 0;
#pragma unroll
        for (int j = 0; j < 8; ++j) { el[j] = lgf[rr * 80 + 8 + 8 * gs + j] * rstd + be[8 * gs + j]; if (el[j] > m0) { m0 = el[j]; i0 = j; } }
        float m1 = -INFINITY; int i1 = 0;
#pragma unroll
        for (int j = 0; j < 8; ++j) if (j != i0 && el[j] > m1) { m1 = el[j]; i1 = j; }
        const float e1 = __expf(m1 - m0); const float w0 = pg / (1.f + e1), w1 = pg * e1 / (1.f + e1);
        const int ea = 8 * gs + i0, eb = 8 * gs + i1;
        const int sa = (int)__hip_atomic_fetch_add(ECNT + ea, 1u, __ATOMIC_RELAXED, __HIP_MEMORY_SCOPE_AGENT);
        const int sb = (int)__hip_atomic_fetch_add(ECNT + eb, 1u, __ATOMIC_RELAXED, __HIP_MEMORY_SCOPE_AGENT);
        PAIR_W[2 * t] = w0; PAIR_W[2 * t + 1] = w1; ELIST[(size_t)ea * 8192 + sa] = 2 * t; ELIST[(size_t)eb * 8192 + sb] = 2 * t + 1;
    }
    __syncthreads();
    const float* gf = INF(19);
    f32x4 gg[8];
#pragma unroll
    for (int j = 0; j < 8; ++j) gg[j] = *(const f32x4*)(gf + 256 * j + 4 * lane);
#pragma unroll
    for (int ih = 0; ih < 2; ++ih) {
        f32x4 xv[2][8];
#pragma unroll
        for (int i = 0; i < 2; ++i) { const f32x4* xr = (const f32x4*)(H2 + (size_t)(r0 + 4 * w + 2 * ih + i) * 2048) + lane;
#pragma unroll
            for (int j = 0; j < 8; ++j) xv[i][j] = xr[64 * j]; }
#pragma unroll
        for (int i = 0; i < 2; ++i) { const int rl = 4 * w + 2 * ih + i; const float rstd = rsd[rl]; u32x2* o8 = (u32x2*)(HNB + (size_t)(r0 + rl) * 2048) + lane;
#pragma unroll
            for (int j = 0; j < 8; ++j) { const f32x4 y = xv[i][j] * rstd * gg[j]; u32x2 wv; wv.x = cvt_pk_bf16(y[0], y[1]); wv.y = cvt_pk_bf16(y[2], y[3]); o8[64 * j] = wv; } }
    }
    __syncthreads();
}

__device__ __forceinline__ void moe_gather(const Ctx& c) {
    unsigned char* ws = c.ws; unsigned* CTLW = (unsigned*)(ws + WS_CTL); const unsigned* ECNT = CTLW + CW_ECNT;
    const int* PAIR_E = (const int*)(ws + WS_MISC + MO_PAIR_E); const int* PAIR_SLOT = (const int*)(ws + WS_MISC + MO_PAIR_SLOT); int* ROWPAIR = (int*)(ws + WS_MISC + MO_ROWPAIR);
    int* TILE_E = (int*)(ws + WS_MISC + MO_TILE_E); int* TOFF = (int*)(ws + WS_MISC + MO_TOFF);
    const bf16_t* HNB = (const bf16_t*)(ws + WS_HNB); bf16_t* XG = (bf16_t*)(ws + WS_XG);
    LAS int* toffs = (LAS int*)c.lds;
    if (c.tid < 64) { const int cn = (int)ECNT[c.tid]; const int nt = (cn + 255) >> 8; int incl = nt;
#pragma unroll
        for (int o = 1; o < 64; o <<= 1) { const int t = __shfl_up(incl, o); if (c.lane >= o) incl += t; }
        toffs[c.tid] = incl - nt; if (c.tid == 63) toffs[64] = incl;
        if (c.bid == 0) { TOFF[c.tid] = incl - nt; for (int k = 0; k < nt; ++k) TILE_E[incl - nt + k] = c.tid; if (c.tid == 63) CTLW[CW_NTILES] = (unsigned)incl; } }
    __syncthreads();
    for (int p = c.gw; p < 16384; p += c.NGW) { const int e = PAIR_E[p], sl = PAIR_SLOT[p]; const int row = toffs[e] * 256 + sl;
        const u32x4* src = (const u32x4*)(HNB + (size_t)(p >> 1) * 2048) + c.lane; u32x4* dst = (u32x4*)(XG + (size_t)row * 2048) + c.lane;
#pragma unroll
        for (int j = 0; j < 4; ++j) dst[64 * j] = src[64 * j];
        if (c.lane == 0) ROWPAIR[row] = p; }
    __syncthreads();
}

__device__ __forceinline__ void wait_vm(int n) {
    switch (n) {
        case 0: asm volatile("s_waitcnt vmcnt(0)" ::: "memory"); break;
        case 1: asm volatile("s_waitcnt vmcnt(1)" ::: "memory"); break;
        case 2: asm volatile("s_waitcnt vmcnt(2)" ::: "memory"); break;
        case 3: asm volatile("s_waitcnt vmcnt(3)" ::: "memory"); break;
        case 4: asm volatile("s_waitcnt vmcnt(4)" ::: "memory"); break;
        case 5: asm volatile("s_waitcnt vmcnt(5)" ::: "memory"); break;
        case 6: asm volatile("s_waitcnt vmcnt(6)" ::: "memory"); break;
        default: asm volatile("s_waitcnt vmcnt(7)" ::: "memory"); break;
    }
}
template <int MODE, int VAR = 0>
__device__ __forceinline__ void moe_direct(const Args& a, const Ctx& c) {
    unsigned char* ws = c.ws;
    constexpr int K = (MODE == 1) ? 2048 : 512, LDW = (MODE == 1) ? 512 : 2048, UPE = (MODE == 1) ? 8 : 16, NCH = K / 32, MAXT = 24, MROWS = MAXT * 16;
    constexpr int XBUF = MROWS * 64, WOFF = 3 * XBUF, TOFF = WOFF + 4 * 16384;
    const unsigned* ECNT = (const unsigned*)(ws + WS_CTL) + CW_ECNT; const int* ELIST = (const int*)(ws + WS_ELIST); const float* PAIR_W = (const float*)(ws + WS_MISC + MO_PAIR_W);
    const bf16_t* XSRC = (const bf16_t*)(ws + (MODE == 1 ? WS_HNB : WS_ACT)); bf16_t* ACT = (bf16_t*)(ws + (VAR ? WS_XG : WS_ACT)); bf16_t* YB = (bf16_t*)(ws + (VAR ? WS_XG : WS_YB));
    LAS unsigned char* xb = c.lds;
    LAS unsigned char* wb = c.lds + WOFF;
    LAS int* rowoff = (LAS int*)(c.lds + TOFF);
    LAS int* rowpair = rowoff + MROWS;
    LAS float* rowwt = (LAS float*)(rowpair + MROWS);
    const int tid = c.tid, lane = c.lane, w = c.wave, tt = lane & 15, g = lane >> 4;
    const int hh = w >> 2, cgp = w & 3;
    const int xcd_ = c.bid & 7, idx_ = c.bid >> 3, EPX = 32 / UPE;
    for (int r = 0; r < (64 * UPE) / 256; ++r) {
        int e, sl;
        if (c.G == 256) { e = r * (8 * EPX) + xcd_ * EPX + idx_ / UPE; sl = idx_ % UPE; } else { const int u = r * c.G + c.bid; if (u >= 64 * UPE) break; e = u / UPE; sl = u % UPE; }
        const int ne = (int)ECNT[e];
        const float* wsrc[2];
#pragma unroll
        for (int i = 0; i < 2; ++i) { const int k = 4 * w + 2 * i + (lane >> 5), q = w >> 1, sidx = lane & 31;
            if (MODE == 1) { const int h = sidx >> 4, cgs = ((sidx & 15) - 2 * q - 4 * h) & 15;
                wsrc[i] = (h ? INF(25) : INF(24)) + (size_t)e * 2048 * 512 + (size_t)k * LDW + sl * 64 + 4 * cgs; }
            else { const int cgs = (sidx - 4 * q) & 31; wsrc[i] = INF(26) + (size_t)e * 512 * 2048 + (size_t)k * LDW + sl * 128 + 4 * cgs; } }
        int wrd[2];
#pragma unroll
        for (int t = 0; t < 2; ++t) { const int wq = 2 * cgp + t;
            if (MODE == 1) { const int h = tt >> 3, cc = 8 * wq + (tt & 7); wrd[t] = ((8 * g) * 128 + 64 * h + ((cc + 8 * g + 16 * h) & 63)) * 4; }
            else { const int col = 16 * wq + tt; wrd[t] = ((8 * g) * 128 + ((col + 16 * g) & 127)) * 4; } }
        for (int m0 = 0; m0 < ne; m0 += MROWS) {
            const int mrows = min(MROWS, ne - m0), nt = (mrows + 15) >> 4;
            if (tid < MROWS) { const int rr = tid < mrows ? tid : mrows - 1; const int p = ELIST[(size_t)e * 8192 + m0 + rr];
              rowoff[tid] = (MODE == 1) ? (p >> 1) * 2048 : p * 512; rowpair[tid] = p; rowwt[tid] = PAIR_W[p]; }
            __syncthreads();
            f32x4 acc[2][12];
#pragma unroll
            for (int t = 0; t < 2; ++t)
#pragma unroll
                for (int i = 0; i < 12; ++i) acc[t][i] = (f32x4){0.f, 0.f, 0.f, 0.f};
            int roff[3];
#pragma unroll
            for (int i = 0; i < 3; ++i) roff[i] = rowoff[16 * (8 * i + w) + (lane >> 2)] + 8 * (lane & 3);
            const int nx = (VAR & 1) ? 0 : ((nt - w + 7) >> 3);
            const int nw = (VAR & 2) ? 0 : 2;
            const int xrd = tt * 64 + g * 16 + 1024 * hh;
#define MD_XDMA(ch) do { LAS unsigned char* bb = xb + ((ch) % 3) * XBUF; _Pragma("unroll") for (int i = 0; i < 3; ++i) if (i < nx) \
                __builtin_amdgcn_global_load_lds((const unsigned*)(XSRC + (size_t)roff[i] + 32 * (ch)), (LAS unsigned*)(bb + (8 * i + w) * 1024), 16, 0, 0); } while (0)
#define MD_WDMA(ch) do { LAS unsigned char* bb = wb + ((ch) & 3) * 16384; _Pragma("unroll") for (int i = 0; i < 2; ++i) if (i < nw) \
                __builtin_amdgcn_global_load_lds((const unsigned*)(wsrc[i] + (size_t)(32 * (ch)) * LDW), (LAS unsigned*)(bb + (2 * w + i) * 1024), 16, 0, 0); } while (0)
            asm volatile("s_waitcnt vmcnt(0)" ::: "memory");
            MD_WDMA(0); MD_XDMA(0); MD_WDMA(1); MD_XDMA(1); MD_WDMA(2);
            const int nmi = (nt - hh + 1) >> 1;
            for (int ch = 0; ch < NCH; ++ch) {
                wait_vm((ch + 1 < NCH ? nw + nx : 0) + (ch + 2 < NCH ? nw : 0));
                __builtin_amdgcn_s_barrier(); asm volatile("" ::: "memory");
                if (ch + 2 < NCH) MD_XDMA(ch + 2);
                if (ch + 3 < NCH) MD_WDMA(ch + 3);
                const LAS unsigned char* wsl = wb + (ch & 3) * 16384;
                float wr0[8], wr1[8];
#pragma unroll
                for (int j = 0; j < 8; ++j) { wr0[j] = *(const LAS float*)(wsl + wrd[0] + 512 * j); wr1[j] = *(const LAS float*)(wsl + wrd[1] + 512 * j); }
                u32x4 t0, t1; t0.x = cvt_pk_bf16(wr0[0], wr0[1]); t0.y = cvt_pk_bf16(wr0[2], wr0[3]); t0.z = cvt_pk_bf16(wr0[4], wr0[5]); t0.w = cvt_pk_bf16(wr0[6], wr0[7]);
                t1.x = cvt_pk_bf16(wr1[0], wr1[1]); t1.y = cvt_pk_bf16(wr1[2], wr1[3]); t1.z = cvt_pk_bf16(wr1[4], wr1[5]); t1.w = cvt_pk_bf16(wr1[6], wr1[7]);
                const bf16x8 wf0 = as_frag(t0), wf1 = as_frag(t1);
                const LAS unsigned char* bb = xb + (ch % 3) * XBUF + xrd;
#define MD_RD(X_, bq) do { _Pragma("unroll") for (int q = 0; q < 4; ++q) X_[q] = *(const LAS bf16x8*)(bb + 2048 * (4 * (bq) + q)); } while (0)
#define MD_MM(X_, bq) do { _Pragma("unroll") for (int q = 0; q < 4; ++q) { acc[0][4 * (bq) + q] = mfma16(wf0, X_[q], acc[0][4 * (bq) + q]); acc[1][4 * (bq) + q] = mfma16(wf1, X_[q], acc[1][4 * (bq) + q]); } } while (0)
                { bf16x8 xa[4], xc[4]; const bool b1 = nmi > 4, b2 = nmi > 8;
                  MD_RD(xa, 0); if (b1) MD_RD(xc, 1);
                  MD_MM(xa, 0); asm volatile("" ::: "memory");
                  if (b2) MD_RD(xa, 2);
                  if (b1) MD_MM(xc, 1);
                  if (b2) MD_MM(xa, 2); }
#undef MD_RD
#undef MD_MM
                LDS_WAIT();
            }
#undef MD_XDMA
#undef MD_WDMA
            const LAS int* rp_ = rowpair + tt + 16 * hh; const LAS float* rw_ = rowwt + tt + 16 * hh;
            asm volatile("" : "+v"(rp_), "+v"(rw_));
#pragma unroll
            for (int mi = 0; mi < 12; ++mi) if (mi < nmi) { const int row = 16 * (2 * mi + hh) + tt; const bool valid = row < mrows; const int p = rp_[32 * mi];
#pragma unroll
                for (int t = 0; t < 2; ++t) { const int wq = 2 * cgp + t;
                    if (MODE == 1) {
                        const float u0 = __shfl_xor(acc[t][mi][0], 32), u1 = __shfl_xor(acc[t][mi][1], 32), u2 = __shfl_xor(acc[t][mi][2], 32), u3 = __shfl_xor(acc[t][mi][3], 32);
                        if (valid && g < 2) { const float g0 = acc[t][mi][0], g1 = acc[t][mi][1], g2 = acc[t][mi][2], g3 = acc[t][mi][3];
                            u32x2 wv; wv.x = cvt_pk_bf16(g0 / (1.f + __expf(-g0)) * u0, g1 / (1.f + __expf(-g1)) * u1); wv.y = cvt_pk_bf16(g2 / (1.f + __expf(-g2)) * u2, g3 / (1.f + __expf(-g3)) * u3);
                            *(u32x2*)(ACT + (size_t)p * 512 + sl * 64 + 8 * wq + 4 * g) = wv; }
                    } else {
                        if (valid) { const float pw = rw_[32 * mi]; u32x2 wv; wv.x = cvt_pk_bf16(acc[t][mi][0] * pw, acc[t][mi][1] * pw); wv.y = cvt_pk_bf16(acc[t][mi][2] * pw, acc[t][mi][3] * pw);
                            *(u32x2*)(YB + (size_t)p * 2048 + sl * 128 + 16 * wq + 4 * g) = wv; }
                    }
                }
            }
            __syncthreads();
        }
    }
}

__device__ __forceinline__ void moe_combine(const Ctx& c) {
    const bf16_t* YB = (const bf16_t*)(c.ws + WS_YB);
    for (int t = c.gw; t < S; t += c.NGW) {
        f32x4* orow = (f32x4*)(c.out + (size_t)t * 2048); const u32x4* y0 = (const u32x4*)(YB + (size_t)(2 * t) * 2048); const u32x4* y1 = (const u32x4*)(YB + (size_t)(2 * t + 1) * 2048);
#pragma unroll
        for (int j = 0; j < 4; ++j) { const int ck = 64 * j + c.lane; float a8[8], b8[8]; unpack8(y0[ck], a8); unpack8(y1[ck], b8);
            f32x4 o0 = orow[2 * ck], o1 = orow[2 * ck + 1];
            o0[0] += a8[0] + b8[0]; o0[1] += a8[1] + b8[1]; o0[2] += a8[2] + b8[2]; o0[3] += a8[3] + b8[3]; o1[0] += a8[4] + b8[4]; o1[1] += a8[5] + b8[5]; o1[2] += a8[6] + b8[6]; o1[3] += a8[7] + b8[7];
            orow[2 * ck] = o0; orow[2 * ck + 1] = o1; }
    }
}

__global__ void __launch_bounds__(512, 2) mega(Args a) {
    extern __shared__ __attribute__((aligned(16))) unsigned char lds_raw[];
    Ctx c; c.lds = (LAS unsigned char*)lds_raw; c.tid = threadIdx.x; c.lane = c.tid & 63; c.wave = __builtin_amdgcn_readfirstlane(c.tid >> 6);
    c.bid = blockIdx.x; c.G = gridDim.x; c.gw = c.bid * 8 + c.wave; c.NGW = c.G * 8; c.ws = a.ws; c.out = a.out;
    unsigned char* ws = a.ws;
    const int lo = a.ph_lo, hi = a.ph_hi;
#ifdef ONLY_PH
#define IN(k) ((k) == ONLY_PH)
#elif defined(EXCL_PH)
#define IN(k) ((k) != EXCL_PH && lo <= (k) && (k) < hi)
#else
#define IN(k) (lo <= (k) && (k) < hi)
#endif
    volatile LAS unsigned* bst = (volatile LAS unsigned*)(c.lds + 147392);
    if (c.tid < 2) bst[c.tid] = 0u;
    __syncthreads();
    XcdBarrier xbar; xbar.bar = (unsigned*)(ws + WS_CTL) + CW_BAR; xbar.x = 0; xbar.st = bst;
    if (a.single) xbar = xcd_barrier_post((unsigned*)(ws + WS_CTL) + CW_BAR, bst);
#define GSYNC(k) do { if ((k) == 0) cg::this_grid().sync(); else xcd_barrier(xbar); } while (0)
#define SEAM(k) do { if (IN(k) && IN((k) + 1)) { GSYNC(k); } } while (0)
#define PH_CTX() do { int t_ = threadIdx.x; asm volatile("" : "+v"(t_)); c.tid = t_; c.lane = t_ & 63; } while (0)

    if (IN(0)) { PH_CTX(); phase0(a, c); __syncthreads(); }
    SEAM(0);
    if (IN(1)) { PH_CTX();
        { pg8::Gemm g{(const bf16_t*)(ws + WS_XN), (const bf16_t*)(ws + WS_WIN), 2048, 2048}; pg8::StaticOrder So; So.init(S, NPROJ, c.G, c.bid);
          pg8::EpiBf16 E{(bf16_t*)(ws + WS_PROJ), NPROJ, nullptr};
          pg8::gemm_phase<pg8::EpiBf16, pg8::StaticOrder, true, true>(c.lds, g, So, E); }
        { pg8::Gemm g{(const bf16_t*)(ws + WS_MEMN), (const bf16_t*)(ws + WS_WKV), 256, 2048}; pg8::SplitOrder So{16, 8, c.G, c.bid};
          pg8::EpiSlab E{(float*)(ws + WS_KVSLAB), 4096, (size_t)256 * 4096};
          pg8::gemm_phase<pg8::EpiSlab, pg8::SplitOrder, true, true>(c.lds, g, So, E); }
    }
    SEAM(1);
    if (IN(2)) { PH_CTX();
        for (int it = c.bid; it < 256; it += c.G) prep_mlstm(a, c, it >> 6, it & 63);
        for (int it = c.bid; it < 256; it += c.G) prep_moba(a, c, it >> 5, it & 31);
        prep_xamem(a, c);
        if (c.bid == 0 && c.tid < 256) ((unsigned*)(ws + WS_CTL))[CW_BCNT + c.tid] = 0u;
    }
    SEAM(2);
    if (IN(3)) { PH_CTX();
        for (int it = c.bid; it < 256; it += c.G) mlstm_local(c, it >> 6, it & 63);
        for (int it = c.bid; it < 512; it += c.G) { const int cb = (it < 256) ? (31 - (it >> 4)) : ((it - 256) >> 4); moba_select(c, (it & 15) >> 1, cb, it & 1); }
    }
    SEAM(3);
    if (IN(4)) { PH_CTX(); if (c.G * 512 >= 4 * DVP * 64) mlstm_scan(c); moba_bucket_phase(c); }
    SEAM(4);
    if (IN(5)) { PH_CTX();
        for (int it = c.bid; it < 256; it += c.G) mlstm_out(a, c, it >> 6, it & 63);
        for (int it = c.bid; it < 512; it += c.G) { const int cb = (it < 256) ? (31 - (it >> 4)) : ((it - 256) >> 4); moba_own(c, (it & 15) >> 1, cb, it & 1); }
    }
    SEAM(5);
    if (IN(6)) { PH_CTX();
        pg8::Gemm g{(const bf16_t*)(ws + WS_HCAT), (const bf16_t*)(ws + WS_WOUT), 2048, 2048}; pg8::StaticOrder So; So.init(S, 2048, c.G, c.bid);
        pg8::EpiResid E{INF(0), nullptr, nullptr, (bf16_t*)(ws + WS_H1B), (float*)(ws + WS_MISC + MO_SSQ)};
        pg8::gemm_phase<pg8::EpiResid, pg8::StaticOrder, false, true>(c.lds, g, So, E);
    }
    SEAM(6);
    if (IN(7)) { PH_CTX();
        pg8::Gemm g{(const bf16_t*)(ws + WS_H1B), (const bf16_t*)(ws + WS_WQ), 2048, 2048}; pg8::StaticOrder So; So.init(S, 2048, c.G, c.bid);
        pg8::EpiBf16 E{(bf16_t*)(ws + WS_QX), 2048, (const float*)(ws + WS_MISC + MO_SSQ)};
        pg8::gemm_phase<pg8::EpiBf16, pg8::StaticOrder, false, true>(c.lds, g, So, E);
    }
    SEAM(7);
    if (IN(8)) { PH_CTX(); for (int it = c.bid; it < 256; it += c.G) xattn_item(a, c, it & 3, it >> 2); }
    SEAM(8);
    if (IN(9)) { PH_CTX();
        pg8::Gemm g{(const bf16_t*)(ws + WS_OX), (const bf16_t*)(ws + WS_WO), 2048, 2048}; pg8::StaticOrder So; So.init(S, 2048, c.G, c.bid);
        pg8::EpiResid E{nullptr, (const bf16_t*)(ws + WS_H1B), a.out, nullptr, nullptr};
        if (c.bid == 0 && c.tid < 128) ((unsigned*)(ws + WS_CTL))[CW_ECNT + c.tid] = 0u;
        pg8::gemm_phase<pg8::EpiResid, pg8::StaticOrder, false, true>(c.lds, g, So, E);
    }
    SEAM(9);
    if (IN(10)) { PH_CTX(); if (c.G == 256) route_block(a, c); }
    do { if (IN(10) && IN(12)) { GSYNC(10); } } while (0);
#ifdef PROBE_VAR
#if PROBE_VAR < 10
    if (IN(11)) moe_direct<1, PROBE_VAR>(a, c);
#elif PROBE_VAR == 10
    if (IN(11)) mlstm_scan(c);
#elif PROBE_VAR == 11
    if (IN(11)) moba_bucket_phase(c);
#elif PROBE_VAR == 12
    if (IN(11)) { PH_CTX(); for (int it = c.bid; it < 256; it += c.G) mlstm_out(a, c, it >> 6, it & 63); }
#elif PROBE_VAR == 13
    if (IN(11)) { PH_CTX(); for (int it = c.bid; it < 512; it += c.G) { const int cb = (it < 256) ? (31 - (it >> 4)) : ((it - 256) >> 4); moba_own(c, (it & 15) >> 1, cb, it & 1); } }
#elif PROBE_VAR == 14
    if (IN(11)) { PH_CTX(); for (int it = c.bid; it < 256; it += c.G) mlstm_local(c, it >> 6, it & 63); }
#endif
#endif
    if (IN(12)) { PH_CTX(); moe_direct<1>(a, c); }
    SEAM(12);
    if (IN(13)) { PH_CTX(); moe_direct<2>(a, c); }
    SEAM(13);
    if (IN(14)) { PH_CTX(); moe_combine(c); }
#undef IN
#undef SEAM
}

constexpr int LDS_BYTES = 147456;
extern "C" void kernel_launch(void* const* d_in, const int* in_sizes, int n_in, void* d_out, int out_size, void* d_ws, size_t ws_size, hipStream_t stream) {
    static int grid = 0;
    if (grid == 0) {
        if (n_in != 27 || out_size != S * D || ws_size < WS_END2) { fprintf(stderr, "kernel_launch: unexpected shapes (n_in %d out %d ws %zu)\n", n_in, out_size, ws_size); grid = -1; return; }
        int dev = 0, cus = 0, per_cu = 0;
        hipGetDevice(&dev); hipDeviceGetAttribute(&cus, hipDeviceAttributeMultiprocessorCount, dev);
        hipFuncSetAttribute((const void*)mega, hipFuncAttributeMaxDynamicSharedMemorySize, LDS_BYTES);
        hipOccupancyMaxActiveBlocksPerMultiprocessor(&per_cu, (const void*)mega, 512, LDS_BYTES);
        (void)hipGetLastError();
        grid = (per_cu >= 1) ? cus : -1;
        if (grid != 256) { fprintf(stderr, "kernel_launch: needs a 256-CU device with one resident block per CU (cus %d per_cu %d)\n", cus, per_cu); grid = -1; return; }
    }
    if (grid < 0) return;
    (void)hipMemsetAsync((char*)d_ws + WS_CTL, 0, CTL_ZERO_BYTES, stream);
    Args a{};
    for (int i = 0; i < 27; ++i) a.in[i] = d_in[i];
    a.out = (float*)d_out; a.ws = (unsigned char*)d_ws; a.single = MK_SINGLE; a.pad = 0;
#if MK_SINGLE
    a.ph_lo = 0; a.ph_hi = NPH;
    void* args[] = {&a};
    hipError_t e = hipLaunchCooperativeKernel((const void*)mega, dim3(grid), dim3(512), args, LDS_BYTES, stream);
    if (e != hipSuccess) fprintf(stderr, "cooperative launch failed: %s\n", hipGetErrorString(e));
#else
    for (int p = 0; p < NPH; ++p) {
#ifdef REP_GROUP_LO
        if (p == REP_GROUP_LO) { for (int r = 0; r < 2; ++r) for (int q = REP_GROUP_LO; q <= REP_GROUP_HI; ++q) { a.ph_lo = q; a.ph_hi = q + 1; hipLaunchKernelGGL(mega, dim3(grid), dim3(512), LDS_BYTES, stream, a); } }
#endif
        a.ph_lo = p; a.ph_hi = p + 1;
#ifdef REP_MASK
        const int reps = ((REP_MASK >> p) & 1) ? 3 : 1;
#else
        const int reps = 1;
#endif
        for (int r = 0; r < reps; ++r) hipLaunchKernelGGL(mega, dim3(grid), dim3(512), LDS_BYTES, stream, a); }
#endif
}
```

```cpp
#include <hip/hip_runtime.h>
#include <hip/hip_cooperative_groups.h>
#include <cstdio>
#include <cstdint>
namespace cg = cooperative_groups;

#ifndef MK_SINGLE
#define MK_SINGLE 1
#endif

#define LAS __attribute__((address_space(3)))
typedef unsigned short bf16_t;
typedef short bf16x8 __attribute__((ext_vector_type(8)));
typedef float f32x4 __attribute__((ext_vector_type(4)));
typedef float f32x2 __attribute__((ext_vector_type(2)));
typedef unsigned u32x4 __attribute__((ext_vector_type(4)));
typedef unsigned u32x2 __attribute__((ext_vector_type(2)));

constexpr int S = 8192, D = 2048, DIN = 6152, NPROJ = 6144, MEML = 256;
constexpr int NPH = 15;
constexpr float EPS = 1e-6f;
constexpr int PC_MQ = 0, PC_MK = 512, PC_MV = 1024, PC_MO = 2048, PC_AQ = 3072, PC_AK = 4096, PC_AV = 5120;
constexpr int DVP = 272;

constexpr size_t MiB = 1u << 20;
constexpr size_t WS_CTL = 0;
constexpr size_t WS_WIN = 1 * MiB;
constexpr size_t WS_WOUT = 25 * MiB;
constexpr size_t WS_WQ = 33 * MiB;
constexpr size_t WS_WKV = 41 * MiB;
constexpr size_t WS_WO = 57 * MiB;
constexpr size_t WS_WGU = 65 * MiB;
constexpr size_t WS_WD = 321 * MiB;
constexpr size_t WS_XN = 449 * MiB;
constexpr size_t WS_MEMN = 481 * MiB;
constexpr size_t WS_PROJ = 482 * MiB;
constexpr size_t WS_KVMEM = 578 * MiB;
constexpr size_t WS_QC = 580 * MiB;
constexpr size_t WS_KC = 588 * MiB;
constexpr size_t WS_KWT = 596 * MiB;
constexpr size_t WS_VT = 604 * MiB;
constexpr size_t WS_CTL_LOC = 621 * MiB;
constexpr size_t WS_CTP = 655 * MiB;
constexpr size_t WS_QP = 672 * MiB;
constexpr size_t WS_KP = 688 * MiB;
constexpr size_t WS_VTP = 704 * MiB;
constexpr size_t WS_KM = 720 * MiB;
constexpr size_t WS_VTM = 721 * MiB;
constexpr size_t WS_HCAT = 722 * MiB;
constexpr size_t WS_H1B = 754 * MiB;
constexpr size_t WS_QX = 786 * MiB;
constexpr size_t WS_OX = 818 * MiB;
constexpr size_t WS_MISC = 850 * MiB;
constexpr size_t WS_ACT = 854 * MiB;
constexpr size_t WS_YB = 886 * MiB;
constexpr size_t WS_END = 950 * MiB;
constexpr size_t WS_PART = WS_END;
constexpr size_t WS_BLIST = WS_END + 48 * MiB;
constexpr size_t WS_LPART = WS_END + 52 * MiB;
constexpr size_t WS_PSLOT = WS_END + 53 * MiB;
constexpr size_t WS_POFF = WS_END + 54 * MiB;
constexpr size_t WS_ELIST = WS_END + 56 * MiB;
constexpr size_t WS_END2 = WS_END + 58 * MiB;
constexpr size_t WS_KVSLAB = WS_ACT;
constexpr size_t WS_H1F = WS_PROJ;
constexpr size_t WS_XG = WS_PROJ;
constexpr size_t WS_HNB = WS_XN;
constexpr size_t MO_GATES = 0;
constexpr size_t MO_BV = 256 * 1024;
constexpr size_t MO_UV = 384 * 1024;
constexpr size_t MO_PMX = 512 * 1024;
constexpr size_t MO_GC = 640 * 1024;
constexpr size_t MO_AMAX = 641 * 1024;
constexpr size_t MO_MPREV = 642 * 1024;
constexpr size_t MO_KMEAN = 648 * 1024;
constexpr size_t MO_SSQ = 1024 * 1024;
constexpr size_t MO_WR = 2048 * 1024;
constexpr size_t MO_PAIR_E = 2752 * 1024;
constexpr size_t MO_PAIR_SLOT = 2816 * 1024;
constexpr size_t MO_PAIR_W = 2880 * 1024;
constexpr size_t MO_ROWPAIR = 2944 * 1024;
constexpr size_t MO_TILE_E = 3072 * 1024;
constexpr size_t MO_TOFF = 3073 * 1024;
constexpr int CW_ECNT = 1024;
constexpr int CW_NTILES = 1100;
constexpr int CW_BCNT = 1280;
constexpr int CW_BAR = 4096;
constexpr size_t CTL_ZERO_BYTES = 65536;

struct Args { const void* in[27]; float* out; unsigned char* ws; int ph_lo, ph_hi; int single, pad; };

__device__ __forceinline__ unsigned cvt_pk_bf16(float lo, float hi) { unsigned r; asm("v_cvt_pk_bf16_f32 %0, %1, %2" : "=v"(r) : "v"(lo), "v"(hi)); return r; }
__device__ __forceinline__ float bf_lo(unsigned u) { return __uint_as_float(u << 16); }
__device__ __forceinline__ float bf_hi(unsigned u) { return __uint_as_float(u & 0xffff0000u); }
__device__ __forceinline__ float bf1(bf16_t h) { return __uint_as_float(((unsigned)h) << 16); }
__device__ __forceinline__ bf16_t f2bf(float f) { return (bf16_t)(cvt_pk_bf16(f, 0.f) & 0xffffu); }
__device__ __forceinline__ void unpack8(u32x4 v, float (&f)[8]) {
    f[0] = bf_lo(v.x); f[1] = bf_hi(v.x); f[2] = bf_lo(v.y); f[3] = bf_hi(v.y); f[4] = bf_lo(v.z); f[5] = bf_hi(v.z); f[6] = bf_lo(v.w); f[7] = bf_hi(v.w);
}
__device__ __forceinline__ u32x4 pack8(const float (&f)[8]) {
    u32x4 v; v.x = cvt_pk_bf16(f[0], f[1]); v.y = cvt_pk_bf16(f[2], f[3]); v.z = cvt_pk_bf16(f[4], f[5]); v.w = cvt_pk_bf16(f[6], f[7]); return v;
}
__device__ __forceinline__ bf16x8 as_frag(u32x4 v) { return __builtin_bit_cast(bf16x8, v); }
__device__ __forceinline__ u32x4 as_u4(bf16x8 v) { return __builtin_bit_cast(u32x4, v); }
__device__ __forceinline__ float wave_sum(float v) {
#pragma unroll
    for (int o = 1; o < 64; o <<= 1) v += __shfl_xor(v, o);
    return v;
}
__device__ __forceinline__ float sigmoidf_(float x) { return 1.f / (1.f + __expf(-x)); }
__device__ __forceinline__ f32x4 mfma16(bf16x8 a, bf16x8 b, f32x4 c) { return __builtin_amdgcn_mfma_f32_16x16x32_bf16(a, b, c, 0, 0, 0); }
__device__ __forceinline__ int pi32(int tq, int i) { return 8 * (i >> 2) + 4 * tq + (i & 3); }
#define LDS_WAIT() asm volatile("s_waitcnt lgkmcnt(0)" ::: "memory")

namespace pg8 {
constexpr int BM = 256, BK = 64, HALF = 128, HTB = HALF * BK * 2, STAGE_BYTES = 8 * HTB, NXCD = 8, WGM = 8;
__device__ __forceinline__ int lds_byte(int r, int c) { const int st = (r >> 4) * 2 + (c >> 5), rr = r & 15, cc = c & 31, ob = rr * 64 + cc * 2; return st * 1024 + (ob ^ (((ob >> 9) & 1) << 5)); }
__device__ __forceinline__ void stage_rc(int b, int& R, int& C) { const int st = b / 1024, sb = b % 1024, swz = sb ^ (((sb >> 9) & 1) << 5); R = (st >> 1) * 16 + swz / 64; C = (st & 1) * 32 + (swz % 64) / 2; }
__device__ __forceinline__ int perm32(int rho) { const int n = rho >> 4, i = rho & 15; return 8 * (i >> 2) + 4 * n + (i & 3); }
struct Unit { int pm, pn, ks; };
struct Gemm { const bf16_t* A; const bf16_t* Bt; int K; int ld; };
struct StaticOrder {
    int nM, nN, nwg, G, c;
    __device__ void init(int M, int N, int G_, int c_) { nM = M / BM; nN = N / BM; nwg = nM * nN; G = G_; c = c_; }
    __device__ bool next(int i, Unit& u) const {
        const long L = (long)i * G + c; if (L >= nwg) return false;
        int wgid = (int)L; { const int q = nwg / NXCD, r = nwg % NXCD, xcd = wgid % NXCD, off = wgid / NXCD; wgid = (xcd < r ? xcd * (q + 1) : r * (q + 1) + (xcd - r) * q) + off; }
        const int nig = WGM * nN, gid = wgid / nig, fm = gid * WGM, gsz = (nM - fm) < WGM ? (nM - fm) : WGM;
        u.pm = fm + ((wgid % nig) % gsz); u.pn = (wgid % nig) / gsz; u.ks = 0; return true;
    }
};
struct SplitOrder {
    int nN, nS, G, c;
    __device__ bool next(int i, Unit& u) const { const long L = (long)i * G + c; if (L >= (long)nN * nS) return false; u.pm = 0; u.pn = (int)(L / nS); u.ks = (int)(L % nS); return true; }
};
struct GroupedOrder {
    const int* tile_e; int ntiles, nN, G, c;
    __device__ bool next(int i, Unit& u) const {
        const long L = (long)i * G + c; if (L >= (long)ntiles * nN) return false;
        const int pm = (int)(L / nN), pl = (int)(L % nN);
        const int e = __builtin_amdgcn_readfirstlane(__hip_atomic_load(tile_e + pm, __ATOMIC_RELAXED, __HIP_MEMORY_SCOPE_AGENT));
        u.pm = pm; u.pn = e * nN + pl; u.ks = 0; return true;
    }
};

template <class Epi, class Sched, bool ALIGN_EPI, bool SP2>
__device__ __forceinline__ void gemm_phase(LAS unsigned char* lds, const Gemm g, const Sched& S, const Epi& E) {
    const int tid = threadIdx.x, wid = __builtin_amdgcn_readfirstlane(tid >> 6), lane = tid & 63, wr = wid >> 2, wc = wid & 3, fr = lane & 15, fq = lane >> 4;
    const int K = g.ld, nt = g.K / BK;
    unsigned voffA[2], voffB[2];
#pragma unroll
    for (int i = 0; i < 2; ++i) { int R, C; stage_rc(tid * 16 + i * 8192, R, C); const int Rb = Epi::PERM ? ((R & ~31) + perm32(R & 31)) : R;
        voffA[i] = (unsigned)(R * K + C) * 2u; voffB[i] = (unsigned)(Rb * K + C) * 2u; }
    const size_t kstep = (size_t)(BK * 2);
    const size_t hstep = (size_t)HALF * K * 2;
    const size_t tstep = 2 * hstep;
    const unsigned ldsw = (unsigned)wid * 1024u;
    const int aoff = lds_byte(wr * 64 + fr, fq * 8), boff = lds_byte(wc * 32 + fr, fq * 8);
#define PG8_SA(b, h) (((b) * 2 + (h)) * HTB)
#define PG8_SB(b, h) ((4 + (b) * 2 + (h)) * HTB)
#define PG8_STAGE(bufoff, gbase, voff) do { _Pragma("unroll") for (int _i = 0; _i < 2; ++_i) \
        __builtin_amdgcn_global_load_lds((const unsigned*)((const char*)(gbase) + (voff)[_i]), (LAS unsigned*)(lds + (bufoff) + ldsw + _i * 8192), 16, 0, 0); } while (0)
#define PG8_LDA(dst, b, h) do { _Pragma("unroll") for (int m = 0; m < 4; ++m) _Pragma("unroll") for (int k = 0; k < 2; ++k) dst[m][k] = *(const LAS bf16x8*)(lds + PG8_SA(b, h) + aoff + m * 2048 + k * 1024); } while (0)
#define PG8_LDB(dst, b, h) do { _Pragma("unroll") for (int n = 0; n < 2; ++n) _Pragma("unroll") for (int k = 0; k < 2; ++k) dst[n][k] = *(const LAS bf16x8*)(lds + PG8_SB(b, h) + boff + n * 2048 + k * 1024); } while (0)
#define PG8_MMA(ai, bj, At, Bt) do { __builtin_amdgcn_s_setprio(1); _Pragma("unroll") for (int m = 0; m < 4; ++m) _Pragma("unroll") for (int n = 0; n < 2; ++n) _Pragma("unroll") for (int k = 0; k < 2; ++k) \
        acc[ai][bj][m][n] = __builtin_amdgcn_mfma_f32_16x16x32_bf16(Bt[n][k], At[m][k], acc[ai][bj][m][n], 0, 0, 0); __builtin_amdgcn_s_setprio(0); } while (0)
#define PG8_WAIT_V(n) asm volatile("s_waitcnt vmcnt(" #n ")" ::: "memory")
#define PG8_WAIT_L(n) asm volatile("s_waitcnt lgkmcnt(" #n ")" ::: "memory")
#define PG8_BAR __builtin_amdgcn_s_barrier()
#define PG8_SCHED __builtin_amdgcn_sched_barrier(0)
    Unit cur, nxt; int ui = 0;
    if (!S.next(0, cur)) return;
    f32x4 acc[2][2][4][2];
#pragma unroll
    for (int a = 0; a < 2; ++a)
#pragma unroll
        for (int b = 0; b < 2; ++b)
#pragma unroll
            for (int m = 0; m < 4; ++m)
#pragma unroll
                for (int n = 0; n < 2; ++n) acc[a][b][m][n] = (f32x4){0.f, 0.f, 0.f, 0.f};
    bf16x8 At[4][2], B0[2][2], B1[2][2];
    const char* cA = (const char*)g.A + (size_t)cur.pm * tstep + (size_t)cur.ks * g.K * 2; const char* cB = (const char*)g.Bt + (size_t)cur.pn * tstep + (size_t)cur.ks * g.K * 2;
    if constexpr (SP2) {
        PG8_STAGE(PG8_SB(0, 0), cB, voffB); PG8_STAGE(PG8_SB(0, 1), cB + hstep, voffB); PG8_STAGE(PG8_SA(0, 0), cA, voffA); PG8_STAGE(PG8_SA(0, 1), cA + hstep, voffA);
        if (wr == 1) PG8_BAR;
        PG8_WAIT_V(2); PG8_BAR;
        PG8_STAGE(PG8_SB(1, 0), cB + kstep, voffB); PG8_STAGE(PG8_SA(1, 0), cA + kstep, voffA); PG8_STAGE(PG8_SB(1, 1), cB + hstep + kstep, voffB);
        PG8_WAIT_V(6); PG8_BAR;
    } else {
        PG8_STAGE(PG8_SB(0, 0), cB, voffB); PG8_STAGE(PG8_SA(0, 0), cA, voffA); PG8_STAGE(PG8_SB(0, 1), cB + hstep, voffB); PG8_STAGE(PG8_SA(0, 1), cA + hstep, voffA);
        if (wr == 1) PG8_BAR;
        PG8_WAIT_V(4); PG8_BAR;
        PG8_STAGE(PG8_SB(1, 0), cB + kstep, voffB); PG8_STAGE(PG8_SA(1, 0), cA + kstep, voffA); PG8_STAGE(PG8_SB(1, 1), cB + hstep + kstep, voffB);
        PG8_WAIT_V(6); PG8_BAR;
    }
    for (;;) {
        const bool has_next = S.next(ui + 1, nxt);
        const char* nA = has_next ? (const char*)g.A + (size_t)nxt.pm * tstep + (size_t)nxt.ks * g.K * 2 : cA; const char* nB = has_next ? (const char*)g.Bt + (size_t)nxt.pn * tstep + (size_t)nxt.ks * g.K * 2 : cB;
        for (int t = 0; t < nt; t += 2) {
            const bool last = (t == nt - 2);
            const char* a1 = cA + (size_t)(t + 1) * kstep;
            const char* a2 = last ? nA : cA + (size_t)(t + 2) * kstep; const char* b2 = last ? nB : cB + (size_t)(t + 2) * kstep;
            const char* a3 = a2 + kstep; const char* b3 = b2 + kstep;
            if constexpr (SP2) {
            PG8_LDB(B0, 0, 0); PG8_LDB(B1, 0, 1); PG8_SCHED; PG8_LDA(At, 0, 0); PG8_STAGE(PG8_SA(1, 1), a1 + hstep, voffA);
            PG8_WAIT_V(8); PG8_WAIT_L(0); PG8_BAR; PG8_MMA(0, 0, At, B0); PG8_MMA(0, 1, At, B1); PG8_BAR; PG8_SCHED;
            PG8_LDA(At, 0, 1); PG8_STAGE(PG8_SB(0, 0), b2, voffB); PG8_STAGE(PG8_SB(0, 1), b2 + hstep, voffB); PG8_STAGE(PG8_SA(0, 0), a2, voffA);
            PG8_WAIT_V(8); PG8_WAIT_L(0); PG8_BAR; PG8_MMA(1, 0, At, B0); PG8_MMA(1, 1, At, B1); PG8_BAR; PG8_SCHED;
            PG8_LDB(B0, 1, 0); PG8_LDB(B1, 1, 1); PG8_SCHED; PG8_LDA(At, 1, 0); PG8_STAGE(PG8_SA(0, 1), a2 + hstep, voffA);
            PG8_WAIT_V(8); PG8_WAIT_L(0); PG8_BAR; PG8_MMA(0, 0, At, B0); PG8_MMA(0, 1, At, B1); PG8_BAR; PG8_SCHED;
            PG8_LDA(At, 1, 1); PG8_STAGE(PG8_SB(1, 0), b3, voffB); PG8_STAGE(PG8_SB(1, 1), b3 + hstep, voffB); PG8_STAGE(PG8_SA(1, 0), a3, voffA);
            PG8_WAIT_V(8); PG8_WAIT_L(0); PG8_BAR; PG8_MMA(1, 0, At, B0); PG8_MMA(1, 1, At, B1); PG8_BAR; PG8_SCHED;
            } else {
            PG8_LDB(B0, 0, 0); PG8_SCHED; PG8_LDA(At, 0, 0); PG8_STAGE(PG8_SA(1, 1), a1 + hstep, voffA);
            PG8_WAIT_L(8); PG8_BAR; PG8_WAIT_L(0); PG8_MMA(0, 0, At, B0); PG8_BAR; PG8_SCHED;
            PG8_LDB(B1, 0, 1); PG8_STAGE(PG8_SB(0, 0), b2, voffB);
            PG8_BAR; PG8_WAIT_L(0); PG8_MMA(0, 1, At, B1); PG8_BAR;
            PG8_LDA(At, 0, 1); PG8_STAGE(PG8_SA(0, 0), a2, voffA);
            PG8_BAR; PG8_WAIT_L(0); PG8_MMA(1, 0, At, B0); PG8_BAR; PG8_SCHED;
            PG8_STAGE(PG8_SB(0, 1), b2 + hstep, voffB);
            PG8_WAIT_V(6); PG8_BAR; PG8_MMA(1, 1, At, B1); PG8_BAR;
            PG8_LDB(B0, 1, 0); PG8_SCHED; PG8_LDA(At, 1, 0); PG8_STAGE(PG8_SA(0, 1), a2 + hstep, voffA);
            PG8_WAIT_L(8); PG8_BAR; PG8_WAIT_L(0); PG8_MMA(0, 0, At, B0); PG8_BAR; PG8_SCHED;
            PG8_LDB(B1, 1, 1); PG8_STAGE(PG8_SB(1, 0), b3, voffB);
            PG8_BAR; PG8_WAIT_L(0); PG8_MMA(0, 1, At, B1); PG8_BAR;
            PG8_LDA(At, 1, 1); PG8_STAGE(PG8_SA(1, 0), a3, voffA);
            PG8_BAR; PG8_WAIT_L(0); PG8_MMA(1, 0, At, B0); PG8_BAR; PG8_SCHED;
            PG8_STAGE(PG8_SB(1, 1), b3 + hstep, voffB);
            PG8_WAIT_V(6); PG8_BAR; PG8_MMA(1, 1, At, B1); PG8_BAR;
            }
        }
        if constexpr (ALIGN_EPI) { if (wr == 0) PG8_BAR; }
        E(acc, cur, wr, wc, fr, fq);
        if (!has_next) break;
#pragma unroll
        for (int a = 0; a < 2; ++a)
#pragma unroll
            for (int b = 0; b < 2; ++b)
#pragma unroll
                for (int m = 0; m < 4; ++m)
#pragma unroll
                    for (int n = 0; n < 2; ++n) acc[a][b][m][n] = (f32x4){0.f, 0.f, 0.f, 0.f};
        cur = nxt; cA = nA; cB = nB; ++ui;
        if constexpr (ALIGN_EPI) { if (wr == 1) PG8_BAR; }
    }
    PG8_WAIT_V(0);
    if constexpr (!ALIGN_EPI) { if (wr == 0) PG8_BAR; }
    PG8_BAR;
#undef PG8_SA
#undef PG8_SB
#undef PG8_STAGE
#undef PG8_LDA
#undef PG8_LDB
#undef PG8_MMA
#undef PG8_WAIT_V
#undef PG8_WAIT_L
#undef PG8_BAR
#undef PG8_SCHED
}

struct EpiBf16 {
    static constexpr bool PERM = true;
    bf16_t* O; int ldc; const float* ssq;
    __device__ __forceinline__ void operator()(const f32x4 (&acc)[2][2][4][2], const Unit& u, int wr, int wc, int fr, int fq) const {
        const int row0 = u.pm * BM + wr * 64 + fr, col0 = u.pn * BM + wc * 32 + 8 * fq;
#pragma unroll
        for (int ai = 0; ai < 2; ++ai)
#pragma unroll
            for (int m = 0; m < 4; ++m) {
                const int row = row0 + ai * HALF + m * 16; float sc = 1.f;
                if (ssq) { const f32x4* p = (const f32x4*)(ssq + (size_t)row * 32); float s = 0.f;
#pragma unroll
                    for (int q = 0; q < 8; ++q) { const f32x4 v = p[q]; s += (v[0] + v[1]) + (v[2] + v[3]); }
                    sc = rsqrtf(s * (1.f / 2048.f) + EPS); }
                bf16_t* rowp = O + (size_t)row * ldc + col0;
#pragma unroll
                for (int bj = 0; bj < 2; ++bj) { const f32x4 v0 = acc[ai][bj][m][0] * sc, v1 = acc[ai][bj][m][1] * sc;
                    u32x4 w; w.x = cvt_pk_bf16(v0[0], v0[1]); w.y = cvt_pk_bf16(v0[2], v0[3]); w.z = cvt_pk_bf16(v1[0], v1[1]); w.w = cvt_pk_bf16(v1[2], v1[3]);
                    *(u32x4*)(rowp + bj * HALF) = w; }
            }
    }
};
struct EpiResid {
    static constexpr bool PERM = false;
    const float* basef; const bf16_t* baseb; float* out; bf16_t* hb; float* ssq;
    __device__ __forceinline__ void operator()(const f32x4 (&acc)[2][2][4][2], const Unit& u, int wr, int wc, int fr, int fq) const {
        const int row0 = u.pm * BM + wr * 64 + fr, col0 = u.pn * BM + wc * 32 + 4 * fq;
#pragma unroll
        for (int ai = 0; ai < 2; ++ai)
#pragma unroll
            for (int m = 0; m < 4; ++m) {
                const int row = row0 + ai * HALF + m * 16; const size_t off = (size_t)row * 2048 + col0; float s = 0.f;
#pragma unroll
                for (int bj = 0; bj < 2; ++bj)
#pragma unroll
                    for (int n = 0; n < 2; ++n) {
                        f32x4 b;
                        if (basef) b = *(const f32x4*)(basef + off + bj * HALF + n * 16);
                        else { const u32x2 t = *(const u32x2*)(baseb + off + bj * HALF + n * 16); b = (f32x4){bf_lo(t.x), bf_hi(t.x), bf_lo(t.y), bf_hi(t.y)}; }
                        const f32x4 o = b + acc[ai][bj][m][n];
                        if (out) *(f32x4*)(out + off + bj * HALF + n * 16) = o;
                        if (hb) { u32x2 w; w.x = cvt_pk_bf16(o[0], o[1]); w.y = cvt_pk_bf16(o[2], o[3]); *(u32x2*)(hb + off + bj * HALF + n * 16) = w;
                            s += (o[0] * o[0] + o[1] * o[1]) + (o[2] * o[2] + o[3] * o[3]); }
                    }
                if (hb) { s += __shfl_xor(s, 16); s += __shfl_xor(s, 32); if (fq == 0) ssq[(size_t)row * 32 + u.pn * 4 + wc] = s; }
            }
    }
};
struct EpiSlab {
    static constexpr bool PERM = false;
    float* slab; int ldc; size_t slab_stride;
    __device__ __forceinline__ void operator()(const f32x4 (&acc)[2][2][4][2], const Unit& u, int wr, int wc, int fr, int fq) const {
        float* base = slab + (size_t)u.ks * slab_stride; unsigned off = (unsigned)((u.pm * BM + wr * 64 + fr) * ldc + u.pn * BM + wc * 32 + 4 * fq);
#pragma unroll
        for (int ai = 0; ai < 2; ++ai)
#pragma unroll
            for (int m = 0; m < 4; ++m) { float* rowp = base + off + (unsigned)((ai * HALF + m * 16) * ldc);
#pragma unroll
                for (int bj = 0; bj < 2; ++bj)
#pragma unroll
                    for (int n = 0; n < 2; ++n) *(f32x4*)(rowp + bj * HALF + n * 16) = acc[ai][bj][m][n];
                asm volatile("" ::: "memory"); }
    }
};
struct EpiMoe1 {
    static constexpr bool PERM = true;
    bf16_t* act;
    __device__ __forceinline__ void operator()(const f32x4 (&acc)[2][2][4][2], const Unit& u, int wr, int wc, int fr, int fq) const {
        const int row0 = u.pm * BM + wr * 64 + fr, col0 = (u.pn & 3) * 128 + wc * 32 + 8 * fq;
#pragma unroll
        for (int ai = 0; ai < 2; ++ai)
#pragma unroll
            for (int m = 0; m < 4; ++m) {
                const int row = row0 + ai * HALF + m * 16; float v[8];
#pragma unroll
                for (int n = 0; n < 2; ++n)
#pragma unroll
                    for (int i = 0; i < 4; ++i) { const float gt = acc[ai][0][m][n][i], up = acc[ai][1][m][n][i]; v[n * 4 + i] = gt / (1.f + __expf(-gt)) * up; }
                *(u32x4*)(act + (size_t)row * 512 + col0) = pack8(v);
            }
    }
};
struct EpiMoe2 {
    static constexpr bool PERM = true;
    bf16_t* yb; const int* rowpair; const float* pair_w; const int* tile_e; const int* toff; const unsigned* ecnt;
    __device__ __forceinline__ void operator()(const f32x4 (&acc)[2][2][4][2], const Unit& u, int wr, int wc, int fr, int fq) const {
        const int e = tile_e[u.pm]; const int base_slot = (u.pm - toff[e]) * 256; const int cnt = (int)ecnt[e];
        const int col0 = (u.pn & 7) * 256 + wc * 32 + 8 * fq;
        int prs[8]; float pws[8];
#pragma unroll
        for (int q = 0; q < 8; ++q) { const int rr = wr * 64 + fr + (q >> 2) * HALF + (q & 3) * 16; const int rc = (base_slot + rr < cnt) ? rr : 0; prs[q] = rowpair[u.pm * 256 + rc]; }
#pragma unroll
        for (int q = 0; q < 8; ++q) pws[q] = pair_w[prs[q]];
#pragma unroll
        for (int ai = 0; ai < 2; ++ai)
#pragma unroll
            for (int m = 0; m < 4; ++m) {
                const int rr = wr * 64 + fr + ai * HALF + m * 16;
                if (base_slot + rr < cnt) {
                    const int pr = prs[ai * 4 + m]; const float w = pws[ai * 4 + m];
                    bf16_t* rowp = yb + (size_t)pr * 2048 + col0;
#pragma unroll
                    for (int bj = 0; bj < 2; ++bj) { const f32x4 v0 = acc[ai][bj][m][0] * w, v1 = acc[ai][bj][m][1] * w;
                        u32x4 x; x.x = cvt_pk_bf16(v0[0], v0[1]); x.y = cvt_pk_bf16(v0[2], v0[3]); x.z = cvt_pk_bf16(v1[0], v1[1]); x.w = cvt_pk_bf16(v1[2], v1[3]);
                        *(u32x4*)(rowp + bj * HALF) = x; }
                }
            }
    }
};
}

#define XB_TMO      128
#define XB_XCNT(j)  (256  + 64 * (j))
#define XB_XSUB(j)  (1280 + 64 * (j))
#define XB_XGEN(j)  (2304 + 64 * (j))
#define XB_TOP      3328
#define XB_TOPGEN   3392
#define XCD_BAR_WORDS 3456
#define XB_SPIN_CAP (1u << 18)
__device__ __forceinline__ unsigned xb_ld(unsigned* p)              { return __hip_atomic_load(p, __ATOMIC_RELAXED, __HIP_MEMORY_SCOPE_AGENT); }
__device__ __forceinline__ unsigned xb_add(unsigned* p, unsigned v) { return __hip_atomic_fetch_add(p, v, __ATOMIC_RELAXED, __HIP_MEMORY_SCOPE_AGENT); }
__device__ __forceinline__ unsigned xb_xcc_id() { return (unsigned)__builtin_amdgcn_s_getreg((3 << 11) | 20) & 0xFu; }
#define XB_SPIN(cond, bar) do { unsigned _sp = 0; while (cond) { __builtin_amdgcn_s_sleep(1); \
    if ((++_sp & 255u) == 0u) { if (xb_ld(&(bar)[XB_TMO])) break; if (_sp > XB_SPIN_CAP) { atomicAdd(&(bar)[XB_TMO], 1u); break; } } } } while (0)
struct XcdBarrier { unsigned* bar; unsigned x; volatile LAS unsigned* st; };
__device__ __forceinline__ XcdBarrier xcd_barrier_post(unsigned* bar, volatile LAS unsigned* st) {
    XcdBarrier b; b.bar = bar; b.x = xb_xcc_id(); b.st = st;
    if (threadIdx.x == 0) (void)xb_add(&bar[XB_XCNT(b.x)], 1u);
    return b;
}
__device__ __forceinline__ void xcd_barrier_complete(unsigned* bar, unsigned x, unsigned& nloc, unsigned& nx) {
    const unsigned G = gridDim.x * gridDim.y * gridDim.z;
    unsigned sum, cnt, mine, sp = 0u;
    for (;;) {
        sum = 0u; cnt = 0u; mine = 0u;
#pragma unroll
        for (unsigned j = 0; j < 16; ++j) { const unsigned cc = xb_ld(&bar[XB_XCNT(j)]); sum += cc; cnt += (cc > 0u) ? 1u : 0u; mine = (j == x) ? cc : mine; }
        if (sum == G) break;
        __builtin_amdgcn_s_sleep(1);
        if ((++sp & 255u) == 0u) { if (xb_ld(&bar[XB_TMO])) break; if (sp > XB_SPIN_CAP) { atomicAdd(&bar[XB_TMO], 1u); break; } }
    }
    nloc = mine > 0u ? mine : 1u; nx = cnt > 0u ? cnt : 1u;
}
__device__ __forceinline__ void xcd_barrier(const XcdBarrier& b) {
    asm volatile("s_waitcnt vmcnt(0)" ::: "memory");
    __syncthreads();
    if (threadIdx.x == 0) {
        unsigned* bar = b.bar;
        __builtin_amdgcn_s_waitcnt(0);
        unsigned nloc = b.st[0], nx = b.st[1];
        if (nloc == 0u) { xcd_barrier_complete(bar, b.x, nloc, nx); b.st[0] = nloc; b.st[1] = nx; }
        const unsigned old = xb_add(&bar[XB_XSUB(b.x)], 1u);
        const unsigned gen = old / nloc;
        if (old + 1u == (gen + 1u) * nloc) {
            __builtin_amdgcn_fence(__ATOMIC_RELEASE, "agent");
            asm volatile("s_waitcnt vmcnt(0)" ::: "memory");
            const unsigned og = xb_add(&bar[XB_TOP], 1u);
            const unsigned tg = og / nx;
            if (og + 1u == (tg + 1u) * nx) xb_add(&bar[XB_TOPGEN], 1u);
            else XB_SPIN(xb_ld(&bar[XB_TOPGEN]) == tg, bar);
            __builtin_amdgcn_fence(__ATOMIC_ACQUIRE, "agent");
            xb_add(&bar[XB_XGEN(b.x)], 1u);
            asm volatile("s_waitcnt vmcnt(0)" ::: "memory");
        } else {
            XB_SPIN(xb_ld(&bar[XB_XGEN(b.x)]) == gen, bar);
            __builtin_amdgcn_fence(__ATOMIC_ACQUIRE, "agent");
            asm volatile("s_waitcnt vmcnt(0)" ::: "memory");
        }
    }
    __syncthreads();
}

struct Ctx {
    LAS unsigned char* lds;
    int tid, lane, wave, bid, G, gw, NGW;
    unsigned char* ws; float* out;
};
#define INF(i) ((const float*)a.in[i])

struct TItem { const float* W; int ldw, k0, n0; bf16_t* WT; int K_dst; const float* kscale; };
__device__ __forceinline__ void titem_load(const TItem& t, LAS float* scr, int lane) {
#pragma unroll 8
    for (int i = 0; i < 32; ++i) { const int kk = 2 * i + (lane >> 5); scr[kk * 33 + (lane & 31)] = t.W[(size_t)(t.k0 + kk) * t.ldw + t.n0 + (lane & 31)]; }
}
__device__ __forceinline__ void titem_store(const TItem& t, const LAS float* scr, int lane) {
    const int c = lane & 7;
    f32x4 s0 = {1.f, 1.f, 1.f, 1.f}, s1 = s0;
    if (t.kscale) { s0 = *(const f32x4*)(t.kscale + t.k0 + 8 * c); s1 = *(const f32x4*)(t.kscale + t.k0 + 8 * c + 4); }
#pragma unroll
    for (int j = 0; j < 4; ++j) { const int n = (lane >> 3) + 8 * j; const LAS float* s = scr + (8 * c) * 33 + n;
        u32x4 o; o.x = cvt_pk_bf16(s[0 * 33] * s0[0], s[1 * 33] * s0[1]); o.y = cvt_pk_bf16(s[2 * 33] * s0[2], s[3 * 33] * s0[3]); o.z = cvt_pk_bf16(s[4 * 33] * s1[0], s[5 * 33] * s1[1]); o.w = cvt_pk_bf16(s[6 * 33] * s1[2], s[7 * 33] * s1[3]);
        *(u32x4*)(t.WT + (size_t)n * t.K_dst + t.k0 + 8 * c) = o; }
}
__device__ __forceinline__ TItem dense_item(const Args& a, unsigned char* ws, int it) {
    TItem t; t.kscale = nullptr; t.K_dst = 2048; int r = it;
    if (r < 6144) { const int seg = r / 3072; r -= seg * 3072; const int kb = r / 96, nb = r % 96;
        t.W = INF(4); t.ldw = DIN; t.k0 = 64 * kb; t.n0 = (seg ? 3080 : 0) + 32 * nb; t.WT = (bf16_t*)(ws + WS_WIN) + (size_t)(seg * 3072 + 32 * nb) * 2048;
    } else if (r < 8192) { r -= 6144; const int kb = r / 64, nb = r % 64; t.W = INF(11); t.ldw = 2048; t.k0 = 64 * kb; t.n0 = 32 * nb; t.WT = (bf16_t*)(ws + WS_WOUT) + (size_t)(32 * nb) * 2048;
    } else if (r < 10240) { r -= 8192; const int kb = r / 64, nb = r % 64; t.W = INF(14); t.ldw = 2048; t.k0 = 64 * kb; t.n0 = 32 * nb; t.WT = (bf16_t*)(ws + WS_WQ) + (size_t)(32 * nb) * 2048; t.kscale = INF(12);
    } else if (r < 14336) { r -= 10240; const int kb = r / 128, nb = r % 128; t.W = INF(15); t.ldw = 4096; t.k0 = 64 * kb; t.n0 = 32 * nb; t.WT = (bf16_t*)(ws + WS_WKV) + (size_t)(32 * nb) * 2048;
    } else { r -= 14336; const int kb = r / 64, nb = r % 64; t.W = INF(18); t.ldw = 2048; t.k0 = 64 * kb; t.n0 = 32 * nb; t.WT = (bf16_t*)(ws + WS_WO) + (size_t)(32 * nb) * 2048; }
    return t;
}

__device__ __forceinline__ void phase0(const Args& a, const Ctx& c) {
    unsigned char* ws = c.ws;
    LAS float* scr = (LAS float*)(c.lds + c.wave * 17408);
    constexpr int N_DENSE = 16384;
    for (int it = c.gw; it < N_DENSE; it += 2 * c.NGW) {
        const TItem t0 = dense_item(a, ws, it); const bool two = (it + c.NGW < N_DENSE); const TItem t1 = dense_item(a, ws, two ? it + c.NGW : it);
        titem_load(t0, scr, c.lane); if (two) titem_load(t1, scr + 64 * 33, c.lane);
        LDS_WAIT();
        titem_store(t0, scr, c.lane); if (two) titem_store(t1, scr + 64 * 33, c.lane);
        LDS_WAIT();
    }
    {
        bf16_t* WR = (bf16_t*)(ws + WS_MISC + MO_WR);
        const float* gf = INF(19); const float* wg = INF(20); const float* we = INF(22);
        for (int i = c.bid * 512 + c.tid; i < 2048 * 80; i += c.G * 512) { const int j = i / 2048, k = i % 2048;
            float v = 0.f; if (j < 8) v = wg[k * 8 + j]; else if (j < 72) v = we[k * 64 + (j - 8)];
            v *= gf[k]; const bf16_t hi = f2bf(v); const bf16_t lo = f2bf(v - bf1(hi));
            WR[i] = hi; WR[80 * 2048 + i] = lo; }
        if (c.bid == 0 && c.tid < 128) ((unsigned*)(ws + WS_CTL))[CW_ECNT + c.tid] = 0u;
        if (c.bid == 0 && c.tid < 256) ((unsigned*)(ws + WS_CTL))[CW_BCNT + c.tid] = 0u;
    }
    __syncthreads();
    {
        LAS float* wgl = (LAS float*)c.lds; const float* win = INF(4); const float* gm = INF(3);
        for (int idx = c.tid; idx < 4096; idx += 512) { const int k = idx >> 1, hf = idx & 1;
            f32x4 v = *(const f32x4*)(win + (size_t)k * DIN + 3072 + 4 * hf); v = v * gm[k];
            const int j = k >> 8, l = (k >> 2) & 63, i = k & 3;
            *(LAS f32x4*)(wgl + (((i * 8 + j) * 64 + l) * 8 + 4 * hf)) = v; }
    }
    __syncthreads();
    {
        const LAS float* wgl = (const LAS float*)c.lds; const float* gm = INF(3); const float* x = INF(0); const float* gb = INF(5);
        bf16_t* XN = (bf16_t*)(ws + WS_XN); float* GATES = (float*)(ws + WS_MISC + MO_GATES);
        f32x4 g4[8];
#pragma unroll
        for (int j = 0; j < 8; ++j) g4[j] = *(const f32x4*)(gm + 256 * j + 4 * c.lane);
        for (int m0 = c.gw; m0 < S; m0 += 2 * c.NGW) {
            f32x4 v2[2][8];
#pragma unroll
            for (int rr = 0; rr < 2; ++rr) { const f32x4* xr = (const f32x4*)(x + (size_t)(m0 + rr * c.NGW) * D) + c.lane;
#pragma unroll
                for (int j = 0; j < 8; ++j) v2[rr][j] = xr[64 * j]; }
#pragma unroll
            for (int rr = 0; rr < 2; ++rr) {
                const int m = m0 + rr * c.NGW; float ss = 0.f; float ga[8];
#pragma unroll
                for (int q = 0; q < 8; ++q) ga[q] = 0.f;
#pragma unroll
                for (int j = 0; j < 8; ++j) ss += (v2[rr][j][0] * v2[rr][j][0] + v2[rr][j][1] * v2[rr][j][1]) + (v2[rr][j][2] * v2[rr][j][2] + v2[rr][j][3] * v2[rr][j][3]);
#pragma unroll
                for (int j = 0; j < 8; ++j) {
                    asm volatile("" ::: "memory");
#pragma unroll
                    for (int i = 0; i < 4; ++i) { const LAS f32x4* wp = (const LAS f32x4*)(wgl + ((i * 8 + j) * 64 + c.lane) * 8); const f32x4 w0 = wp[0], w1 = wp[1]; const float xv = v2[rr][j][i];
                        ga[0] += xv * w0[0]; ga[1] += xv * w0[1]; ga[2] += xv * w0[2]; ga[3] += xv * w0[3]; ga[4] += xv * w1[0]; ga[5] += xv * w1[1]; ga[6] += xv * w1[2]; ga[7] += xv * w1[3]; }
                }
                ss = wave_sum(ss); const float rstd = rsqrtf(ss * (1.f / D) + EPS);
#pragma unroll
                for (int q = 0; q < 8; ++q) ga[q] = wave_sum(ga[q]);
                if (c.lane < 8) { float gv = ga[0];
#pragma unroll
                    for (int q = 1; q < 8; ++q) gv = (c.lane == q) ? ga[q] : gv;
                    GATES[(size_t)m * 8 + c.lane] = gv * rstd + gb[c.lane]; }
                u32x2* o8 = (u32x2*)(XN + (size_t)m * D) + c.lane;
#pragma unroll
                for (int j = 0; j < 8; ++j) { const f32x4 y = v2[rr][j] * rstd * g4[j]; u32x2 w; w.x = cvt_pk_bf16(y[0], y[1]); w.y = cvt_pk_bf16(y[2], y[3]); o8[64 * j] = w; }
            }
        }
        const float* mem = INF(1); const float* gmem = INF(13); bf16_t* MEMN = (bf16_t*)(ws + WS_MEMN);
        for (int m = c.gw; m < MEML; m += c.NGW) {
            const f32x4* xr = (const f32x4*)(mem + (size_t)m * D) + c.lane; f32x4 v[8]; float ss = 0.f;
#pragma unroll
            for (int j = 0; j < 8; ++j) { v[j] = xr[64 * j]; ss += (v[j][0] * v[j][0] + v[j][1] * v[j][1]) + (v[j][2] * v[j][2] + v[j][3] * v[j][3]); }
            ss = wave_sum(ss); const float rstd = rsqrtf(ss * (1.f / D) + EPS);
            u32x2* o8 = (u32x2*)(MEMN + (size_t)m * D) + c.lane;
#pragma unroll
            for (int j = 0; j < 8; ++j) { const f32x4 gg = *(const f32x4*)(gmem + 256 * j + 4 * c.lane); const f32x4 y = v[j] * rstd * gg; u32x2 w; w.x = cvt_pk_bf16(y[0], y[1]); w.y = cvt_pk_bf16(y[2], y[3]); o8[64 * j] = w; }
        }
    }
}

__device__ __forceinline__ void prep_mlstm(const Args& a, const Ctx& c, int h, int ch) {
    unsigned char* ws = c.ws; const int t0 = ch * 128;
    const float* GATES = (const float*)(ws + WS_MISC + MO_GATES);
    float* BV = (float*)(ws + WS_MISC + MO_BV); float* UV = (float*)(ws + WS_MISC + MO_UV); float* PMX = (float*)(ws + WS_MISC + MO_PMX);
    float* GC = (float*)(ws + WS_MISC + MO_GC); float* AMAX = (float*)(ws + WS_MISC + MO_AMAX);
    const bf16_t* PROJ = (const bf16_t*)(ws + WS_PROJ);
    LAS float* sc_w = (LAS float*)c.lds;
    LAS bf16_t* kws = (LAS bf16_t*)(c.lds + 1024);
    LAS bf16_t* vs = (LAS bf16_t*)(c.lds + 1024 + 128 * 260);
    u32x4 vraw[8];
    { const int t_ = c.tid >> 2, part_ = c.tid & 3;
#pragma unroll
      for (int q = 0; q < 8; ++q) vraw[q] = *(const u32x4*)(PROJ + (size_t)(t0 + t_) * NPROJ + PC_MV + h * 256 + part_ * 64 + 8 * q); }
    if (c.wave == 0) {
        const int l = c.lane; const int ta = 2 * l, tb = 2 * l + 1;
        const float i0 = GATES[(size_t)(t0 + ta) * 8 + h], f0 = GATES[(size_t)(t0 + ta) * 8 + 4 + h];
        const float i1 = GATES[(size_t)(t0 + tb) * 8 + h], f1 = GATES[(size_t)(t0 + tb) * 8 + 4 + h];
        const float lf0 = fminf(f0, 0.f) - log1pf(__expf(-fabsf(f0))), lf1 = fminf(f1, 0.f) - log1pf(__expf(-fabsf(f1)));
        float incl = lf0 + lf1;
#pragma unroll
        for (int o = 1; o < 64; o <<= 1) { const float t = __shfl_up(incl, o); if (l >= o) incl += t; }
        const float excl = incl - (lf0 + lf1);
        const float b0 = excl + lf0, b1 = excl + lf0 + lf1;
        const float u0 = i0 - b0, u1 = i1 - b1;
        float pm = fmaxf(u0, u1);
#pragma unroll
        for (int o = 1; o < 64; o <<= 1) { const float t = __shfl_up(pm, o); if (l >= o) pm = fmaxf(pm, t); }
        float pme = __shfl_up(pm, 1); if (l == 0) pme = -INFINITY;
        const float p0 = fmaxf(pme, u0), p1 = pm;
        const float ptot = __shfl(pm, 63), gtot = __shfl(b1, 63);
        BV[h * S + t0 + ta] = b0; BV[h * S + t0 + tb] = b1; UV[h * S + t0 + ta] = u0; UV[h * S + t0 + tb] = u1; PMX[h * S + t0 + ta] = p0; PMX[h * S + t0 + tb] = p1;
        sc_w[ta] = __expf(u0 - ptot); sc_w[tb] = __expf(u1 - ptot);
        if (l == 63) { GC[h * 64 + ch] = gtot; AMAX[h * 64 + ch] = gtot + ptot; }
    }
    __syncthreads();
    {
        const float* cw = INF(6); const float* cb = INF(7);
        bf16_t* QC = (bf16_t*)(ws + WS_QC); bf16_t* KC = (bf16_t*)(ws + WS_KC);
        const int t = c.tid >> 2, qt = c.tid & 3; const float ws_ = sc_w[t];
#pragma unroll
        for (int qk = 0; qk < 2; ++qk)
#pragma unroll
            for (int gq = 0; gq < 4; ++gq) {
                const int ch0 = qt * 32 + 8 * gq; const int cch = qk * 512 + h * 128 + ch0; const int pcol = (qk ? PC_MK : PC_MQ) + h * 128 + ch0;
                float y[8];
#pragma unroll
                for (int i = 0; i < 8; ++i) y[i] = cb[cch + i];
#pragma unroll
                for (int j = 0; j < 4; ++j) { const int tr = t0 + t - 3 + j; const float msk = tr >= 0 ? 1.f : 0.f;
                    float xv[8]; unpack8(*(const u32x4*)(PROJ + (size_t)(tr < 0 ? 0 : tr) * NPROJ + pcol), xv);
#pragma unroll
                    for (int i = 0; i < 8; ++i) y[i] += cw[j * 1024 + cch + i] * (xv[i] * msk); }
#pragma unroll
                for (int i = 0; i < 8; ++i) y[i] = y[i] / (1.f + __expf(-y[i]));
                if (qk == 0) {
#pragma unroll
                    for (int i = 0; i < 8; ++i) y[i] *= 0.08838834764831845f;
                    *(u32x4*)(QC + ((size_t)(h * S + t0 + t)) * 128 + ch0) = pack8(y);
                } else {
                    *(u32x4*)(KC + ((size_t)(h * S + t0 + t)) * 128 + ch0) = pack8(y);
#pragma unroll
                    for (int i = 0; i < 8; ++i) kws[t * 130 + ch0 + i] = f2bf(y[i] * ws_);
                }
            }
        const int part = c.tid & 3;
#pragma unroll
        for (int q = 0; q < 8; ++q) { const int dv0 = part * 64 + 8 * q;
            *(LAS u32x4*)(vs + t * 264 + dv0) = vraw[q]; }
    }
    __syncthreads();
    {
        bf16_t* KWT = (bf16_t*)(ws + WS_KWT); bf16_t* VT = (bf16_t*)(ws + WS_VT);
        const int d = c.tid >> 2, sq = c.tid & 3;
#pragma unroll
        for (int gq = 0; gq < 4; ++gq) { const int s0 = sq * 32 + 8 * gq; u32x4 o;
            o.x = (unsigned)kws[(s0 + 0) * 130 + d] | ((unsigned)kws[(s0 + 1) * 130 + d] << 16); o.y = (unsigned)kws[(s0 + 2) * 130 + d] | ((unsigned)kws[(s0 + 3) * 130 + d] << 16);
            o.z = (unsigned)kws[(s0 + 4) * 130 + d] | ((unsigned)kws[(s0 + 5) * 130 + d] << 16); o.w = (unsigned)kws[(s0 + 6) * 130 + d] | ((unsigned)kws[(s0 + 7) * 130 + d] << 16);
            *(u32x4*)(KWT + ((size_t)((h * 64 + ch) * 128 + d)) * 128 + s0) = o; }
        const int dv = c.tid >> 1, hf = c.tid & 1;
#pragma unroll
        for (int gq = 0; gq < 8; ++gq) { const int s0 = hf * 64 + 8 * gq; u32x4 o;
            o.x = (unsigned)vs[(s0 + 0) * 264 + dv] | ((unsigned)vs[(s0 + 1) * 264 + dv] << 16); o.y = (unsigned)vs[(s0 + 2) * 264 + dv] | ((unsigned)vs[(s0 + 3) * 264 + dv] << 16);
            o.z = (unsigned)vs[(s0 + 4) * 264 + dv] | ((unsigned)vs[(s0 + 5) * 264 + dv] << 16); o.w = (unsigned)vs[(s0 + 6) * 264 + dv] | ((unsigned)vs[(s0 + 7) * 264 + dv] << 16);
            *(u32x4*)(VT + ((size_t)((h * 64 + ch) * DVP + dv)) * 128 + s0) = o; }
        if (c.tid < 256) { const int row = 256 + (c.tid >> 4), ck = c.tid & 15; const unsigned val = (row == 256) ? 0x3F803F80u : 0u;
            *(u32x4*)(VT + ((size_t)((h * 64 + ch) * DVP + row)) * 128 + 8 * ck) = (u32x4){val, val, val, val}; }
    }
    __syncthreads();
}

__device__ __forceinline__ void prep_moba(const Args& a, const Ctx& c, int h, int jb) {
    unsigned char* ws = c.ws; const int t0 = jb * 256;
    const bf16_t* PROJ = (const bf16_t*)(ws + WS_PROJ); const int* pos = (const int*)a.in[2];
    bf16_t* QP = (bf16_t*)(ws + WS_QP); bf16_t* KP = (bf16_t*)(ws + WS_KP); bf16_t* VTP = (bf16_t*)(ws + WS_VTP); float* KMEAN = (float*)(ws + WS_MISC + MO_KMEAN);
    LAS float* red = (LAS float*)c.lds;
    LAS bf16_t* vs = (LAS bf16_t*)(c.lds + 16384);
    const int li = c.tid & 15, rg = c.tid >> 4, d0 = 8 * li;
    float qg[8], kg[8], kacc[8];
#pragma unroll
    for (int i = 0; i < 8; ++i) { qg[i] = INF(9)[d0 + i]; kg[i] = INF(10)[d0 + i]; kacc[i] = 0.f; }
    float invf[8];
#pragma unroll
    for (int i = 0; i < 8; ++i) { const int fi = (li & 1) * 8 + i; invf[i] = exp2f(-(float)fi * (18.931568569324174f / 16.f)); }
    u32x4 rawq[8], rawk[8], rawv[8]; float fposa[8];
#pragma unroll
    for (int p = 0; p < 8; ++p) { const int row = p * 32 + rg; const size_t prow = (size_t)(t0 + row) * NPROJ + h * 128 + d0;
        rawq[p] = *(const u32x4*)(PROJ + prow + PC_AQ); rawk[p] = *(const u32x4*)(PROJ + prow + PC_AK); rawv[p] = *(const u32x4*)(PROJ + prow + PC_AV); fposa[p] = (float)pos[t0 + row]; }
#pragma unroll
    for (int p = 0; p < 8; ++p) {
        const int row = p * 32 + rg;
        const float fpos = fposa[p];
        float cs[8], sn[8];
        if (li < 4) {
#pragma unroll
            for (int i = 0; i < 8; ++i) { float s_, c_; sincosf(fpos * invf[i], &s_, &c_); cs[i] = c_; sn[i] = s_; }
        } else {
#pragma unroll
            for (int i = 0; i < 8; ++i) { cs[i] = 1.f; sn[i] = 0.f; }
        }
#pragma unroll
        for (int qk = 0; qk < 2; ++qk) {
            float x[8]; unpack8(qk ? rawk[p] : rawq[p], x);
            float ss = 0.f;
#pragma unroll
            for (int i = 0; i < 8; ++i) ss += x[i] * x[i];
            ss += __shfl_xor(ss, 1); ss += __shfl_xor(ss, 2); ss += __shfl_xor(ss, 4); ss += __shfl_xor(ss, 8);
            const float rstd = rsqrtf(ss * (1.f / 128.f) + EPS);
            float y[8];
#pragma unroll
            for (int i = 0; i < 8; ++i) y[i] = x[i] * rstd * (qk ? kg[i] : qg[i]);
            float o[8];
#pragma unroll
            for (int i = 0; i < 8; ++i) { const float ot = __shfl_xor(y[i], 2); o[i] = (li < 2) ? (y[i] * cs[i] - ot * sn[i]) : (li < 4 ? (y[i] * cs[i] + ot * sn[i]) : y[i]); }
            if (qk == 0) *(u32x4*)(QP + ((size_t)(h * S + t0 + row)) * 128 + d0) = pack8(o);
            else { *(u32x4*)(KP + ((size_t)(h * S + t0 + row)) * 128 + d0) = pack8(o);
#pragma unroll
                for (int i = 0; i < 8; ++i) kacc[i] += o[i]; }
        }
        *(LAS u32x4*)(vs + row * 136 + d0) = rawv[p];
    }
#pragma unroll
    for (int i = 0; i < 8; ++i) red[rg * 128 + d0 + i] = kacc[i];
    __syncthreads();
    if (c.tid < 128) { float s = 0.f;
#pragma unroll 8
        for (int r = 0; r < 32; ++r) s += red[r * 128 + c.tid];
        KMEAN[(h * 32 + jb) * 128 + c.tid] = s * (1.f / 256.f); }
    {
        const int d = c.tid >> 2, sq = c.tid & 3;
#pragma unroll
        for (int gq = 0; gq < 8; ++gq) { const int s0 = sq * 64 + 8 * gq; u32x4 o;
            o.x = (unsigned)vs[(s0 + 0) * 136 + d] | ((unsigned)vs[(s0 + 1) * 136 + d] << 16); o.y = (unsigned)vs[(s0 + 2) * 136 + d] | ((unsigned)vs[(s0 + 3) * 136 + d] << 16);
            o.z = (unsigned)vs[(s0 + 4) * 136 + d] | ((unsigned)vs[(s0 + 5) * 136 + d] << 16); o.w = (unsigned)vs[(s0 + 6) * 136 + d] | ((unsigned)vs[(s0 + 7) * 136 + d] << 16);
            *(u32x4*)(VTP + ((size_t)((h * 32 + jb) * 128 + d)) * 256 + s0) = o; }
    }
    __syncthreads();
}

__device__ __forceinline__ void prep_xamem(const Args& a, const Ctx& c) {
    unsigned char* ws = c.ws; const float* SL = (const float*)(ws + WS_KVSLAB);
    bf16_t* KM = (bf16_t*)(ws + WS_KM); bf16_t* VTM = (bf16_t*)(ws + WS_VTM); const float* kg = INF(17);
    for (int it = c.gw; it < 1024; it += c.NGW) { const int m = it >> 2, h = it & 3;
        float x[8];
#pragma unroll
        for (int i = 0; i < 8; ++i) x[i] = 0.f;
#pragma unroll
        for (int sp = 0; sp < 8; ++sp) { const f32x4* p = (const f32x4*)(SL + ((size_t)(sp * 256 + m)) * 4096 + h * 512 + 8 * c.lane); const f32x4 v0 = p[0], v1 = p[1];
            x[0] += v0[0]; x[1] += v0[1]; x[2] += v0[2]; x[3] += v0[3]; x[4] += v1[0]; x[5] += v1[1]; x[6] += v1[2]; x[7] += v1[3]; }
        float ss = 0.f;
#pragma unroll
        for (int i = 0; i < 8; ++i) ss += x[i] * x[i];
        ss = wave_sum(ss); const float rstd = rsqrtf(ss * (1.f / 512.f) + EPS);
#pragma unroll
        for (int i = 0; i < 8; ++i) x[i] = x[i] * rstd * kg[8 * c.lane + i];
        *(u32x4*)(KM + ((size_t)(h * 256 + m)) * 512 + 8 * c.lane) = pack8(x); }
    for (int idx = c.bid * 512 + c.tid; idx < 65536; idx += c.G * 512) { const int d = idx & 511, mg = (idx >> 9) & 31, h = idx >> 14;
        float v[8];
#pragma unroll
        for (int j = 0; j < 8; ++j) { float t = 0.f;
#pragma unroll
            for (int sp = 0; sp < 8; ++sp) t += SL[((size_t)(sp * 256 + 8 * mg + j)) * 4096 + 2048 + h * 512 + d];
            v[j] = t; }
        *(u32x4*)(VTM + ((size_t)(h * 512 + d)) * 256 + 8 * mg) = pack8(v); }
}

__device__ __forceinline__ void tile256_load(LAS unsigned char* dst, const bf16_t* src, size_t src_ld, int nrows, int tid) {
    for (int idx = tid; idx < nrows * 16; idx += 512) { const int row = idx >> 4, ck = idx & 15;
        *(LAS u32x4*)(dst + row * 256 + ((ck ^ (row & 15)) << 4)) = *(const u32x4*)(src + (size_t)row * src_ld + 8 * ck); }
}
__device__ __forceinline__ bf16x8 tile256_frag(const LAS unsigned char* t, int row, int ck) { return *(const LAS bf16x8*)(t + row * 256 + ((ck ^ (row & 15)) << 4)); }

__device__ __forceinline__ void mlstm_local(const Ctx& c, int h, int ch) {
    unsigned char* ws = c.ws; const bf16_t* KWT = (const bf16_t*)(ws + WS_KWT); const bf16_t* VT = (const bf16_t*)(ws + WS_VT); float* CTL = (float*)(ws + WS_CTL_LOC);
    const int tt = c.lane & 15, g = c.lane >> 4, w = c.wave, t0 = ch * 128;
    tile256_load(c.lds, VT + (size_t)(h * 64 + ch) * DVP * 128, 128, DVP, c.tid);
    bf16x8 bfr[4];
#pragma unroll
    for (int ks = 0; ks < 4; ++ks) bfr[ks] = *(const bf16x8*)(KWT + ((size_t)((h * 64 + ch) * 128 + 16 * w + tt)) * 128 + 32 * ks + 8 * g);
    __syncthreads();
#pragma unroll
    for (int mt = 0; mt < 17; ++mt) {
        f32x4 acc = {0.f, 0.f, 0.f, 0.f};
#pragma unroll
        for (int ks = 0; ks < 4; ++ks) acc = mfma16(tile256_frag(c.lds, 16 * mt + tt, 4 * ks + g), bfr[ks], acc);
#pragma unroll
        for (int r = 0; r < 4; ++r) CTL[((size_t)((h * 64 + ch) * DVP + 16 * mt + 4 * g + r)) * 128 + 16 * w + tt] = acc[r];
    }
    __syncthreads();
}

#define MOBA_LOAD_KV(jb, K_, V_) do { const int kb_ = (jb) * 256; \
        _Pragma("unroll") for (int tq = 0; tq < 2; ++tq) _Pragma("unroll") for (int ks = 0; ks < 4; ++ks) \
            K_[tq][ks] = *(const bf16x8*)(KP + ((size_t)(h * S + kb_ + 32 * w + pi32(tq, tt))) * 128 + 32 * ks + 8 * g); \
        _Pragma("unroll") for (int ks = 0; ks < 8; ++ks) V_[ks] = *(const bf16x8*)(VTP + ((size_t)((h * 32 + (jb)) * 128 + 16 * w + tt)) * 256 + 32 * ks + 8 * g); } while (0)

#define MOBA_TOUCH_KV(K_, V_) do { _Pragma("unroll") for (int tq = 0; tq < 2; ++tq) _Pragma("unroll") for (int ks = 0; ks < 4; ++ks) asm volatile("" : "+v"(K_[tq][ks])); \
        _Pragma("unroll") for (int ks = 0; ks < 8; ++ks) asm volatile("" : "+v"(V_[ks])); } while (0)
__device__ __forceinline__ void moba_select(const Ctx& c, int h, int cb, int half) {
    unsigned char* ws = c.ws;
    const bf16_t* QP = (const bf16_t*)(ws + WS_QP); const float* KMEAN = (const float*)(ws + WS_MISC + MO_KMEAN);
    unsigned* BCNT = (unsigned*)(ws + WS_CTL) + CW_BCNT; unsigned short* BLIST = (unsigned short*)(ws + WS_BLIST); int* PSLOT = (int*)(ws + WS_PSLOT);
    LAS unsigned char* Qs = c.lds;
    LAS float* km = (LAS float*)(c.lds + 34816);
    LAS int* cnt = (LAS int*)(c.lds + 34816 + 16384);
    LAS int* gbase = cnt + 32;
    const int tid = c.tid, q0 = cb * 256 + half * 128;
    const int q = tid >> 2, sub = tid & 3;
    if (cb == 0) { if (sub == 0) { int* ps = PSLOT + ((size_t)(h * S + q0 + q)) * 3; ps[0] = -1; ps[1] = -1; ps[2] = -1; } return; }
    for (int i = tid; i < 128 * 16; i += 512) { const int r = i >> 4, ck = i & 15; *(LAS u32x4*)(Qs + r * 272 + ck * 16) = *(const u32x4*)(QP + ((size_t)(h * S + q0 + r)) * 128 + 8 * ck); }
    if (tid < 32) cnt[tid] = 0;
    { const f32x4* src = (const f32x4*)(KMEAN + (size_t)h * 32 * 128); for (int i = tid; i < cb * 32; i += 512) ((LAS f32x4*)km)[i] = src[i]; }
    __syncthreads();
    float bv0 = -INFINITY, bv1 = -INFINITY, bv2 = -INFINITY; int bi0 = 255, bi1 = 255, bi2 = 255;
    {
        float qv[128];
#pragma unroll
        for (int ck = 0; ck < 16; ++ck) { float t8[8]; unpack8(*(const LAS u32x4*)(Qs + q * 272 + ck * 16), t8);
#pragma unroll
            for (int i = 0; i < 8; ++i) qv[ck * 8 + i] = t8[i]; }
        for (int j = sub; j < cb; j += 4) {
            float s = 0.f;
#pragma unroll
            for (int d4 = 0; d4 < 32; ++d4) { const f32x4 kv = *(const LAS f32x4*)(km + j * 128 + 4 * d4); s += qv[4 * d4] * kv[0] + qv[4 * d4 + 1] * kv[1] + qv[4 * d4 + 2] * kv[2] + qv[4 * d4 + 3] * kv[3]; }
            if (s > bv0) { bv2 = bv1; bi2 = bi1; bv1 = bv0; bi1 = bi0; bv0 = s; bi0 = j; }
            else if (s > bv1) { bv2 = bv1; bi2 = bi1; bv1 = s; bi1 = j; }
            else if (s > bv2) { bv2 = s; bi2 = j; }
        }
    }
#pragma unroll
    for (int o = 1; o <= 2; o <<= 1) {
        const float ov0 = __shfl_xor(bv0, o), ov1 = __shfl_xor(bv1, o), ov2 = __shfl_xor(bv2, o);
        const int oi0 = __shfl_xor(bi0, o), oi1 = __shfl_xor(bi1, o), oi2 = __shfl_xor(bi2, o);
        float nv[3] = {ov0, ov1, ov2}; int ni[3] = {oi0, oi1, oi2};
#pragma unroll
        for (int k = 0; k < 3; ++k) { const float sv = nv[k]; const int j = ni[k];
            const bool b0 = (sv > bv0) || (sv == bv0 && j < bi0), b1 = (sv > bv1) || (sv == bv1 && j < bi1), b2 = (sv > bv2) || (sv == bv2 && j < bi2);
            if (b0) { bv2 = bv1; bi2 = bi1; bv1 = bv0; bi1 = bi0; bv0 = sv; bi0 = j; }
            else if (b1) { bv2 = bv1; bi2 = bi1; bv1 = sv; bi1 = j; }
            else if (b2) { bv2 = sv; bi2 = j; } }
    }
    int p0 = -1, p1 = -1, p2 = -1;
    if (sub == 0) {
        if (bi0 < cb) p0 = __hip_atomic_fetch_add(cnt + bi0, 1, __ATOMIC_RELAXED, __HIP_MEMORY_SCOPE_WORKGROUP);
        if (bi1 < cb) p1 = __hip_atomic_fetch_add(cnt + bi1, 1, __ATOMIC_RELAXED, __HIP_MEMORY_SCOPE_WORKGROUP);
        if (bi2 < cb) p2 = __hip_atomic_fetch_add(cnt + bi2, 1, __ATOMIC_RELAXED, __HIP_MEMORY_SCOPE_WORKGROUP);
    }
    __syncthreads();
    if (tid < cb) { const int cn = cnt[tid]; gbase[tid] = cn > 0 ? (int)__hip_atomic_fetch_add(BCNT + h * 32 + tid, (unsigned)cn, __ATOMIC_RELAXED, __HIP_MEMORY_SCOPE_AGENT) : 0; }
    __syncthreads();
    if (sub == 0) {
        int* ps = PSLOT + ((size_t)(h * S + q0 + q)) * 3; const unsigned short qq = (unsigned short)(q0 + q);
        if (p0 >= 0) { const int pos = gbase[bi0] + p0; BLIST[(size_t)(h * 32 + bi0) * 8192 + pos] = qq; ps[0] = (bi0 << 16) | pos; } else ps[0] = -1;
        if (p1 >= 0) { const int pos = gbase[bi1] + p1; BLIST[(size_t)(h * 32 + bi1) * 8192 + pos] = qq; ps[1] = (bi1 << 16) | pos; } else ps[1] = -1;
        if (p2 >= 0) { const int pos = gbase[bi2] + p2; BLIST[(size_t)(h * 32 + bi2) * 8192 + pos] = qq; ps[2] = (bi2 << 16) | pos; } else ps[2] = -1;
    }
    __syncthreads();
}

#define MOBA_TILE_PAIR(two, qrA, qrB, okA, okB, own, qlocA, qlocB, nkw) \
    f32x4 oA0 = {0.f, 0.f, 0.f, 0.f}, oA1 = oA0, oB0 = oA0, oB1 = oA0; float ltA = 0.f, ltB = 0.f; \
    { if (w < (nkw)) { \
        f32x4 sA0 = {0.f, 0.f, 0.f, 0.f}, sA1 = sA0, sB0 = sA0, sB1 = sA0; \
        _Pragma("unroll") for (int ks = 0; ks < 4; ++ks) { const bf16x8 qf = *(const LAS bf16x8*)(Qs + (qrA) * 272 + (32 * ks + 8 * g) * 2); sA0 = mfma16(Kc[0][ks], qf, sA0); sA1 = mfma16(Kc[1][ks], qf, sA1); } \
        if (two) { _Pragma("unroll") for (int ks = 0; ks < 4; ++ks) { const bf16x8 qf = *(const LAS bf16x8*)(Qs + (qrB) * 272 + (32 * ks + 8 * g) * 2); sB0 = mfma16(Kc[0][ks], qf, sB0); sB1 = mfma16(Kc[1][ks], qf, sB1); } } \
        const int kloc = 32 * w + 8 * g; \
        { float p[8]; float lsum = 0.f; \
          _Pragma("unroll") for (int r = 0; r < 4; ++r) { p[r] = __expf(sA0[r] * 0.08838834764831845f); p[4 + r] = __expf(sA1[r] * 0.08838834764831845f); } \
          _Pragma("unroll") for (int i = 0; i < 8; ++i) { const bool ok = (okA) && (!(own) || (kloc + i <= (qlocA))); p[i] = ok ? p[i] : 0.f; lsum += p[i]; } \
          lsum += __shfl_xor(lsum, 16); lsum += __shfl_xor(lsum, 32); \
          *(LAS u32x4*)(Pb + (buf * 2 + 0) * 8192 + w * 1024 + lane * 16) = pack8(p); \
          if (g == 0) lpart[((buf * 2 + 0) * 8 + w) * 16 + tt] = lsum; } \
        if (two) { float p[8]; float lsum = 0.f; \
          _Pragma("unroll") for (int r = 0; r < 4; ++r) { p[r] = __expf(sB0[r] * 0.08838834764831845f); p[4 + r] = __expf(sB1[r] * 0.08838834764831845f); } \
          _Pragma("unroll") for (int i = 0; i < 8; ++i) { const bool ok = (okB) && (!(own) || (kloc + i <= (qlocB))); p[i] = ok ? p[i] : 0.f; lsum += p[i]; } \
          lsum += __shfl_xor(lsum, 16); lsum += __shfl_xor(lsum, 32); \
          *(LAS u32x4*)(Pb + (buf * 2 + 1) * 8192 + w * 1024 + lane * 16) = pack8(p); \
          if (g == 0) lpart[((buf * 2 + 1) * 8 + w) * 16 + tt] = lsum; } \
      } \
      LDS_WAIT(); __builtin_amdgcn_s_barrier(); asm volatile("" ::: "memory"); \
      _Pragma("unroll") for (int ks = 0; ks < 8; ks += 2) if (ks < (nkw)) { \
          const bf16x8 pa = *(const LAS bf16x8*)(Pb + (buf * 2 + 0) * 8192 + ks * 1024 + lane * 16), pb = *(const LAS bf16x8*)(Pb + (buf * 2 + 0) * 8192 + (ks + 1) * 1024 + lane * 16); \
          oA0 = mfma16(Vc[ks], pa, oA0); oA1 = mfma16(Vc[ks + 1], pb, oA1); } \
      _Pragma("unroll") for (int ww = 0; ww < 8; ++ww) if (ww < (nkw)) ltA += lpart[((buf * 2 + 0) * 8 + ww) * 16 + tt]; \
      if (two) { \
          _Pragma("unroll") for (int ks = 0; ks < 8; ks += 2) if (ks < (nkw)) { \
              const bf16x8 pa = *(const LAS bf16x8*)(Pb + (buf * 2 + 1) * 8192 + ks * 1024 + lane * 16), pb = *(const LAS bf16x8*)(Pb + (buf * 2 + 1) * 8192 + (ks + 1) * 1024 + lane * 16); \
              oB0 = mfma16(Vc[ks], pa, oB0); oB1 = mfma16(Vc[ks + 1], pb, oB1); } \
          _Pragma("unroll") for (int ww = 0; ww < 8; ++ww) if (ww < (nkw)) ltB += lpart[((buf * 2 + 1) * 8 + ww) * 16 + tt]; } \
      oA0 = oA0 + oA1; oB0 = oB0 + oB1; buf ^= 1; }

__device__ __forceinline__ void moba_bucket_phase(const Ctx& c) {
    unsigned char* ws = c.ws;
    const bf16_t* QP = (const bf16_t*)(ws + WS_QP); const bf16_t* KP = (const bf16_t*)(ws + WS_KP); const bf16_t* VTP = (const bf16_t*)(ws + WS_VTP);
    unsigned* BCNT = (unsigned*)(ws + WS_CTL) + CW_BCNT; const unsigned short* BLIST = (const unsigned short*)(ws + WS_BLIST);
    bf16_t* PART = (bf16_t*)(ws + WS_PART); float* LPART = (float*)(ws + WS_LPART); int* POFF = (int*)(ws + WS_POFF);
    LAS unsigned char* Qs = c.lds;
    LAS unsigned char* Pb = c.lds + 34816;
    LAS float* lpart = (LAS float*)(c.lds + 34816 + 32768);
    LAS int* cnts = (LAS int*)(c.lds + 34816 + 32768 + 2048);
    LAS int* ipre = cnts + 256;
    LAS int* ppre = ipre + 260;
    LAS int* wsum = ppre + 260;
    LAS int* selb = wsum + 16;
    const int tid = c.tid, lane = c.lane, w = c.wave, tt = lane & 15, g = lane >> 4;
    {
        int cn = 0, nch = 0, pp = 0;
        if (tid < 256) { cn = (int)__hip_atomic_load(BCNT + tid, __ATOMIC_RELAXED, __HIP_MEMORY_SCOPE_AGENT); nch = (cn + 127) >> 7; pp = (cn + 15) & ~15; cnts[tid] = cn; }
        int i1 = nch, i2 = pp;
#pragma unroll
        for (int o = 1; o < 64; o <<= 1) { const int t1 = __shfl_up(i1, o), t2 = __shfl_up(i2, o); if (lane >= o) { i1 += t1; i2 += t2; } }
        if (lane == 63 && w < 4) { wsum[w] = i1; wsum[8 + w] = i2; }
        __syncthreads();
        if (tid < 256) { int a1 = 0, a2 = 0;
#pragma unroll
            for (int k = 0; k < 4; ++k) if (k < w) { a1 += wsum[k]; a2 += wsum[8 + k]; }
            ipre[tid + 1] = a1 + i1; ppre[tid + 1] = a2 + i2; if (tid == 0) { ipre[0] = 0; ppre[0] = 0; } }
        __syncthreads();
        if (c.bid == 0 && tid <= 256) POFF[tid] = ppre[tid];
    }
    const int total = ipre[256];
    int buf = 0;
    LAS unsigned char* Qs1 = c.lds + 34816 + 32768 + 2048 + 4096;
#define BK_FIND(it_, b_, ch_, n_) do { int lo_ = 0, hi_ = 256; while (hi_ - lo_ > 1) { const int md_ = (lo_ + hi_) >> 1; if (ipre[md_] <= (it_)) lo_ = md_; else hi_ = md_; } \
        b_ = lo_; ch_ = (it_) - ipre[lo_]; n_ = min(128, cnts[lo_] - 128 * ch_); } while (0)
#define BK_IDX(b_, ch_, n_, Q_) do { _Pragma("unroll") for (int k = 0; k < 4; ++k) { const int r_ = (tid + 512 * k) >> 4; Q_[k] = BLIST[(size_t)(b_) * 8192 + 128 * (ch_) + (r_ < (n_) ? r_ : (n_) - 1)]; } } while (0)
#define BK_ROWS(b_, Q_, R_) do { _Pragma("unroll") for (int k = 0; k < 4; ++k) R_[k] = *(const u32x4*)(QP + ((size_t)(((b_) >> 5) * S + Q_[k])) * 128 + 8 * (tid & 15)); } while (0)
#define BK_WRITE(n_, R_, QB_) do { _Pragma("unroll") for (int k = 0; k < 4; ++k) { const int r_ = (tid + 512 * k) >> 4; u32x4 v_ = R_[k]; if (r_ >= (n_)) v_ = (u32x4){0u, 0u, 0u, 0u}; *(LAS u32x4*)((QB_) + r_ * 272 + (tid & 15) * 16) = v_; } } while (0)
    int it = c.bid;
    if (it < total) {
        int bC, chC, nC, bN = 0, chN = 0, nN = 0; int qiN[4], qiNN[4]; u32x4 rowsN[4];
        bf16x8 Kc[2][4], Vc[8], Kn[2][4], Vn[8];
        BK_FIND(it, bC, chC, nC);
        { int qi0[4]; BK_IDX(bC, chC, nC, qi0); u32x4 r0[4]; BK_ROWS(bC, qi0, r0); const int h = bC >> 5; MOBA_LOAD_KV(bC & 31, Kc, Vc); BK_WRITE(nC, r0, Qs); }
        bool hasN = (it + c.G < total);
        if (hasN) { BK_FIND(it + c.G, bN, chN, nN); BK_IDX(bN, chN, nN, qiN); }
        LDS_WAIT(); __builtin_amdgcn_s_barrier(); asm volatile("" ::: "memory");
        int par = 0;
        for (;;) {
            LAS unsigned char* Qs = par ? Qs1 : c.lds;
            const int h = bC >> 5, ntile = (nC + 15) >> 4, n = nC; const int pbase = ppre[bC] + 128 * chC;
            const bool hasNN = (it + 2 * c.G < total); int bNN = 0, chNN = 0, nNN = 0;
            if (hasN) { BK_ROWS(bN, qiN, rowsN); { const int h = bN >> 5; MOBA_LOAD_KV(bN & 31, Kn, Vn); } }
            if (hasNN) { BK_FIND(it + 2 * c.G, bNN, chNN, nNN); BK_IDX(bNN, chNN, nNN, qiNN); }
            MOBA_TOUCH_KV(Kc, Vc);
            for (int tl = 0; tl < ntile; tl += 2) {
                const bool two = (tl + 1 < ntile);
                const int rA = 16 * tl + tt, rB = two ? rA + 16 : rA;
                MOBA_TILE_PAIR(two, rA, rB, (rA < n), (two && rB < n), 0, 0, 0, 8)
                { u32x2 wv; wv.x = cvt_pk_bf16(oA0[0], oA0[1]); wv.y = cvt_pk_bf16(oA0[2], oA0[3]); *(u32x2*)(PART + (size_t)(pbase + rA) * 128 + 16 * w + 4 * g) = wv;
                  if (w == 0 && g == 0) LPART[pbase + rA] = ltA; }
                if (two) { u32x2 wv; wv.x = cvt_pk_bf16(oB0[0], oB0[1]); wv.y = cvt_pk_bf16(oB0[2], oB0[3]); *(u32x2*)(PART + (size_t)(pbase + rB) * 128 + 16 * w + 4 * g) = wv;
                  if (w == 0 && g == 0) LPART[pbase + rB] = ltB; }
            }
            if (!hasN) break;
            BK_WRITE(nN, rowsN, (par ? c.lds : Qs1));
#pragma unroll
            for (int tq = 0; tq < 2; ++tq)
#pragma unroll
                for (int ks = 0; ks < 4; ++ks) Kc[tq][ks] = Kn[tq][ks];
#pragma unroll
            for (int ks = 0; ks < 8; ++ks) Vc[ks] = Vn[ks];
#pragma unroll
            for (int k = 0; k < 4; ++k) qiN[k] = qiNN[k];
            bC = bN; chC = chN; nC = nN; bN = bNN; chN = chNN; nN = nNN; hasN = hasNN; it += c.G; par ^= 1;
            LDS_WAIT(); __builtin_amdgcn_s_barrier(); asm volatile("" ::: "memory");
        }
    }
#undef BK_FIND
#undef BK_IDX
#undef BK_ROWS
#undef BK_WRITE
    __syncthreads();
}

__device__ __forceinline__ void moba_own(const Ctx& c, int h, int cb, int half) {
    unsigned char* ws = c.ws;
    const bf16_t* QP = (const bf16_t*)(ws + WS_QP); const bf16_t* KP = (const bf16_t*)(ws + WS_KP); const bf16_t* VTP = (const bf16_t*)(ws + WS_VTP);
    const bf16_t* PART = (const bf16_t*)(ws + WS_PART); const float* LPART = (const float*)(ws + WS_LPART); const int* POFF = (const int*)(ws + WS_POFF); const int* PSLOT = (const int*)(ws + WS_PSLOT);
    bf16_t* HCAT = (bf16_t*)(ws + WS_HCAT);
    LAS unsigned char* Qs = c.lds; LAS unsigned char* Pb = c.lds + 34816; LAS float* lpart = (LAS float*)(c.lds + 34816 + 32768);
    LAS float* Os = (LAS float*)(c.lds + 34816 + 32768 + 2048);
    LAS float* Ls = Os + 128 * 132;
    const int tid = c.tid, lane = c.lane, w = c.wave, tt = lane & 15, g = lane >> 4, q0 = cb * 256 + half * 128;
    bf16x8 Kc[2][4], Vc[8];
    MOBA_LOAD_KV(cb, Kc, Vc);
    const int cq = tid >> 2, cpart = tid & 3;
    int pr[3]; u32x4 prow[3][4]; float plv[3];
#pragma unroll
    for (int k = 0; k < 3; ++k) { const int sl = PSLOT[((size_t)(h * S + q0 + cq)) * 3 + k]; const int po = POFF[h * 32 + ((sl < 0 ? 0 : sl) >> 16)]; pr[k] = (sl >= 0) ? (po + (sl & 0xffff)) : -1; }
    for (int i = tid; i < 128 * 16; i += 512) { const int r = i >> 4, ck = i & 15; *(LAS u32x4*)(Qs + r * 272 + ck * 16) = *(const u32x4*)(QP + ((size_t)(h * S + q0 + r)) * 128 + 8 * ck); }
#pragma unroll
    for (int k = 0; k < 3; ++k) { const int pc = pr[k] < 0 ? 0 : pr[k]; plv[k] = LPART[pc];
#pragma unroll
        for (int j = 0; j < 4; ++j) prow[k][j] = *(const u32x4*)(PART + (size_t)pc * 128 + cpart * 32 + 8 * j); }
    MOBA_TOUCH_KV(Kc, Vc);
    __syncthreads();
    const int nkw = half ? 8 : 4;
    int buf = 0;
    for (int tl = 0; tl < 8; tl += 2) {
        const int rA = 16 * tl + tt, rB = rA + 16;
        MOBA_TILE_PAIR(true, rA, rB, true, true, 1, (half * 128 + rA), (half * 128 + rB), nkw)
        *(LAS f32x4*)(Os + rA * 132 + 16 * w + 4 * g) = oA0; *(LAS f32x4*)(Os + rB * 132 + 16 * w + 4 * g) = oB0;
        if (w == 0 && g == 0) { Ls[rA] = ltA; Ls[rB] = ltB; }
    }
    __syncthreads();
    { float l = Ls[cq];
#pragma unroll
      for (int k = 0; k < 3; ++k) if (pr[k] >= 0) l += plv[k];
      const float inv = 1.f / l;
#pragma unroll
      for (int j = 0; j < 4; ++j) { float v[8];
#pragma unroll
          for (int i = 0; i < 8; ++i) v[i] = Os[cq * 132 + cpart * 32 + 8 * j + i];
#pragma unroll
          for (int k = 0; k < 3; ++k) if (pr[k] >= 0) { float t8[8]; unpack8(prow[k][j], t8);
#pragma unroll
              for (int i = 0; i < 8; ++i) v[i] += t8[i]; }
#pragma unroll
          for (int i = 0; i < 8; ++i) v[i] *= inv;
          *(u32x4*)(HCAT + (size_t)(q0 + cq) * 2048 + 1024 + h * 128 + cpart * 32 + 8 * j) = pack8(v); } }
    __syncthreads();
}

__device__ __forceinline__ void mlstm_scan(const Ctx& c) {
    unsigned char* ws = c.ws; const float* CTL = (const float*)(ws + WS_CTL_LOC); bf16_t* CTP = (bf16_t*)(ws + WS_CTP);
    const float* GC = (const float*)(ws + WS_MISC + MO_GC); const float* AMAX = (const float*)(ws + WS_MISC + MO_AMAX); float* MPREV = (float*)(ws + WS_MISC + MO_MPREV);
    const int e2 = c.bid * 512 + c.tid; constexpr int PER_H = DVP * 128 / 2;
    if (e2 >= 4 * PER_H) return;
    const int h = e2 / PER_H, rem = e2 % PER_H;
    f32x2 st = {0.f, 0.f}; float mprev = 0.f;
    for (int c0 = 0; c0 < 64; c0 += 8) {
        f32x2 loc[8];
#pragma unroll
        for (int k = 0; k < 8; ++k) loc[k] = *(const f32x2*)(CTL + ((size_t)(h * 64 + c0 + k)) * (DVP * 128) + 2 * rem);
#pragma unroll
        for (int k = 0; k < 8; ++k) { const int ch = c0 + k; const float gg = GC[h * 64 + ch], am = AMAX[h * 64 + ch];
            *(unsigned*)(CTP + ((size_t)(h * 64 + ch)) * (DVP * 128) + 2 * rem) = cvt_pk_bf16(st[0], st[1]);
            if (rem == 0) MPREV[h * 64 + ch] = mprev;
            const float mnew = fmaxf(gg + mprev, am), dec = __expf(gg + mprev - mnew), sc = __expf(am - mnew);
            st = st * dec + loc[k] * sc; mprev = mnew; }
    }
}

__device__ __forceinline__ bf16x8 scale_frag(bf16x8 f, float s) { float v[8]; unpack8(as_u4(f), v);
#pragma unroll
    for (int i = 0; i < 8; ++i) v[i] *= s;
    return as_frag(pack8(v)); }

__device__ __forceinline__ void mlstm_out(const Args& a, const Ctx& c, int h, int ch) {
    unsigned char* ws = c.ws;
    const bf16_t* QC = (const bf16_t*)(ws + WS_QC); const bf16_t* KC = (const bf16_t*)(ws + WS_KC); const bf16_t* VT = (const bf16_t*)(ws + WS_VT); const bf16_t* CTP = (const bf16_t*)(ws + WS_CTP);
    const float* BV = (const float*)(ws + WS_MISC + MO_BV); const float* UV = (const float*)(ws + WS_MISC + MO_UV); const float* PMX = (const float*)(ws + WS_MISC + MO_PMX);
    const float* MPREV = (const float*)(ws + WS_MISC + MO_MPREV); const bf16_t* PROJ = (const bf16_t*)(ws + WS_PROJ); bf16_t* HCAT = (bf16_t*)(ws + WS_HCAT);
    const int tt = c.lane & 15, g = c.lane >> 4, w = c.wave, t0 = ch * 128, trow = t0 + 16 * w + tt, tid = c.tid;
    LAS unsigned char* RA = c.lds; LAS unsigned char* RB = c.lds + 69632;
    tile256_load(RA, KC + ((size_t)(h * S + t0)) * 128, 128, 128, tid);
    tile256_load(RB, CTP + ((size_t)(h * 64 + ch)) * DVP * 128, 128, DVP, tid);
    const float b_t = BV[h * S + trow], pm_t = PMX[h * S + trow], mprev = MPREV[h * 64 + ch];
    const float m_t = b_t + fmaxf(mprev, pm_t), w_inter = __expf((b_t + mprev) - m_t), bm = b_t - m_t;
    bf16x8 qf[4], qs[4], pf[4];
#pragma unroll
    for (int kd = 0; kd < 4; ++kd) { qf[kd] = *(const bf16x8*)(QC + ((size_t)(h * S + trow)) * 128 + 32 * kd + 8 * g); qs[kd] = scale_frag(qf[kd], w_inter); }
    __syncthreads();
    u32x4 vst[9];
#pragma unroll
    for (int i = 0; i < 9; ++i) { const int idx = tid + 512 * i; if (idx < DVP * 16) vst[i] = *(const u32x4*)(VT + ((size_t)((h * 64 + ch) * DVP + (idx >> 4))) * 128 + 8 * (idx & 15)); }
    const int nsg = (w >> 1) + 1;
#pragma unroll
    for (int sg = 0; sg < 4; ++sg) {
        if (sg < nsg) {
            f32x4 s0 = {0.f, 0.f, 0.f, 0.f}, s1 = {0.f, 0.f, 0.f, 0.f};
#pragma unroll
            for (int kd = 0; kd < 4; ++kd) {
                s0 = mfma16(tile256_frag(RA, 32 * sg + pi32(0, tt), 4 * kd + g), qf[kd], s0);
                s1 = mfma16(tile256_frag(RA, 32 * sg + pi32(1, tt), 4 * kd + g), qf[kd], s1); }
            const f32x4 ua = *(const f32x4*)(UV + h * S + t0 + 32 * sg + 8 * g), ub = *(const f32x4*)(UV + h * S + t0 + 32 * sg + 8 * g + 4);
            float p[8]; const int sl = 32 * sg + 8 * g, tl = 16 * w + tt;
#pragma unroll
            for (int r = 0; r < 4; ++r) { p[r] = (sl + r <= tl) ? s0[r] * __expf(bm + ua[r]) : 0.f; p[4 + r] = (sl + 4 + r <= tl) ? s1[r] * __expf(bm + ub[r]) : 0.f; }
            pf[sg] = as_frag(pack8(p));
        } else pf[sg] = (bf16x8){0, 0, 0, 0, 0, 0, 0, 0};
    }
    f32x4 oacc[17];
#pragma unroll
    for (int mt = 0; mt < 17; ++mt) {
        f32x4 o = {0.f, 0.f, 0.f, 0.f};
#pragma unroll
        for (int kd = 0; kd < 4; ++kd) o = mfma16(tile256_frag(RB, 16 * mt + tt, 4 * kd + g), qs[kd], o);
        oacc[mt] = o;
    }
    __syncthreads();
#pragma unroll
    for (int i = 0; i < 9; ++i) { const int idx = tid + 512 * i; if (idx < DVP * 16) { const int row = idx >> 4, ck = idx & 15; *(LAS u32x4*)(RA + row * 256 + ((ck ^ (row & 15)) << 4)) = vst[i]; } }
    __syncthreads();
#pragma unroll
    for (int mt = 0; mt < 17; ++mt) {
#pragma unroll
        for (int sg = 0; sg < 4; ++sg) if (sg < nsg) oacc[mt] = mfma16(tile256_frag(RA, 16 * mt + tt, 4 * sg + g), pf[sg], oacc[mt]);
    }
    const float den = __shfl(oacc[16][0], tt);
    const float inv = 1.f / fmaxf(fabsf(den), __expf(-m_t));
    float ss = 0.f;
#pragma unroll
    for (int mt = 0; mt < 16; ++mt) { oacc[mt] = oacc[mt] * inv; ss += (oacc[mt][0] * oacc[mt][0] + oacc[mt][1] * oacc[mt][1]) + (oacc[mt][2] * oacc[mt][2] + oacc[mt][3] * oacc[mt][3]); }
    ss += __shfl_xor(ss, 16); ss += __shfl_xor(ss, 32);
    const float rstd = rsqrtf(ss * (1.f / 256.f) + EPS);
    const float* og = INF(8);
#pragma unroll
    for (int mt = 0; mt < 16; ++mt) { const int dv = 16 * mt + 4 * g;
        const f32x4 o4 = *(const f32x4*)(og + h * 256 + dv); const u32x2 mo = *(const u32x2*)(PROJ + (size_t)trow * NPROJ + PC_MO + h * 256 + dv);
        const float v0 = oacc[mt][0] * rstd * o4[0] * sigmoidf_(bf_lo(mo.x)), v1 = oacc[mt][1] * rstd * o4[1] * sigmoidf_(bf_hi(mo.x));
        const float v2 = oacc[mt][2] * rstd * o4[2] * sigmoidf_(bf_lo(mo.y)), v3 = oacc[mt][3] * rstd * o4[3] * sigmoidf_(bf_hi(mo.y));
        u32x2 wv; wv.x = cvt_pk_bf16(v0, v1); wv.y = cvt_pk_bf16(v2, v3);
        *(u32x2*)(HCAT + (size_t)trow * 2048 + h * 256 + dv) = wv; }
    __syncthreads();
}

__device__ __forceinline__ void xattn_item(const Args& a, const Ctx& c, int h, int tile) {
    unsigned char* ws = c.ws; const bf16_t* QX = (const bf16_t*)(ws + WS_QX); const bf16_t* KM = (const bf16_t*)(ws + WS_KM); const bf16_t* VTM = (const bf16_t*)(ws + WS_VTM); bf16_t* OX = (bf16_t*)(ws + WS_OX);
    const int lane = c.lane, tt = lane & 15, g = lane >> 4, w = c.wave, trow = tile * 128 + 16 * w + tt;
    const float* qg = INF(16);
#ifdef XA_SEG
    unsigned long long ts_[5]; ts_[0] = __builtin_amdgcn_s_memrealtime();
#define XA_STAMP(i) do { asm volatile("s_waitcnt vmcnt(0) lgkmcnt(0)" ::: "memory"); ts_[i] = __builtin_amdgcn_s_memrealtime(); } while (0)
#else
#define XA_STAMP(i) do {} while (0)
#endif
    const bf16_t* kbase = KM + (size_t)h * 256 * 512; const bf16_t* vbase = VTM + (size_t)h * 512 * 256;
    int koff[4], voff[4];
#pragma unroll
    for (int i = 0; i < 4; ++i) { const int kr = 32 * w + 8 * i + (lane >> 3), fk = ((kr >> 1) & 1) | (((kr >> 3) & 3) << 1); koff[i] = kr * 512 + 8 * ((lane & 7) ^ fk);
        const int vr = 2 * (4 * w + i) + (lane >> 5), vc = (lane & 31) ^ (vr & 15); voff[i] = vr * 256 + 8 * vc; }
#define XA_DMA(ci) do { LAS unsigned char* bb = c.lds + ((ci) & 3) * 32768; _Pragma("unroll") for (int i = 0; i < 4; ++i) \
        __builtin_amdgcn_global_load_lds((const unsigned*)((ci) < 8 ? kbase + (koff[i] + 64 * (ci)) : vbase + (voff[i] + 64 * ((ci) - 8) * 256)), (LAS unsigned*)(bb + (4 * w + i) * 1024), 16, 0, 0); } while (0)
    asm volatile("s_waitcnt vmcnt(0)" ::: "memory");
    XA_DMA(0); XA_DMA(1); XA_DMA(2);
    bf16x8 qf[16]; float ss = 0.f;
#pragma unroll
    for (int ks = 0; ks < 16; ++ks) { qf[ks] = *(const bf16x8*)(QX + (size_t)trow * 2048 + h * 512 + 32 * ks + 8 * g); float v[8]; unpack8(as_u4(qf[ks]), v);
#pragma unroll
        for (int i = 0; i < 8; ++i) ss += v[i] * v[i]; }
    ss += __shfl_xor(ss, 16); ss += __shfl_xor(ss, 32);
    const float rs = rsqrtf(ss * (1.f / 512.f) + EPS) * 0.04419417382415922f;
#pragma unroll
    for (int ks = 0; ks < 16; ++ks) { float v[8]; unpack8(as_u4(qf[ks]), v); const f32x4 g0 = *(const f32x4*)(qg + 32 * ks + 8 * g), g1 = *(const f32x4*)(qg + 32 * ks + 8 * g + 4);
        v[0] *= rs * g0[0]; v[1] *= rs * g0[1]; v[2] *= rs * g0[2]; v[3] *= rs * g0[3]; v[4] *= rs * g1[0]; v[5] *= rs * g1[1]; v[6] *= rs * g1[2]; v[7] *= rs * g1[3];
        qf[ks] = as_frag(pack8(v)); }
    int kof[2][2], vof[8];
#pragma unroll
    for (int tq = 0; tq < 2; ++tq)
#pragma unroll
        for (int k2 = 0; k2 < 2; ++k2) { const int key = pi32(tq, tt), fk = ((key >> 1) & 1) | (((key >> 3) & 3) << 1); kof[tq][k2] = key * 128 + (((4 * k2 + g) ^ fk) << 4); }
#pragma unroll
    for (int kk = 0; kk < 8; ++kk) vof[kk] = tt * 512 + (((4 * kk + g) ^ tt) << 4);
    asm volatile("" : "+v"(kof[0][0]), "+v"(kof[0][1]), "+v"(kof[1][0]), "+v"(kof[1][1]));
    asm volatile("s_waitcnt vmcnt(0)" ::: "memory");
    XA_STAMP(1);
    f32x4 sacc[16];
#pragma unroll
    for (int mt = 0; mt < 16; ++mt) sacc[mt] = (f32x4){0.f, 0.f, 0.f, 0.f};
#pragma unroll
    for (int ci = 0; ci < 8; ++ci) {
        asm volatile("s_waitcnt vmcnt(8)" ::: "memory"); __builtin_amdgcn_s_barrier(); asm volatile("" ::: "memory");
        XA_DMA(ci + 3);
        const LAS unsigned char* bb = c.lds + (ci & 3) * 32768;
#pragma unroll
        for (int mt = 0; mt < 16; ++mt) {
#pragma unroll
            for (int k2 = 0; k2 < 2; ++k2) { const bf16x8 af = *(const LAS bf16x8*)(bb + kof[mt & 1][k2] + 4096 * (mt >> 1)); sacc[mt] = mfma16(af, qf[2 * ci + k2], sacc[mt]); } }
        LDS_WAIT();
    }
#ifdef XA_SEG
    ts_[2] = __builtin_amdgcn_s_memrealtime();
#endif
    float mx = -INFINITY;
#pragma unroll
    for (int mt = 0; mt < 16; ++mt) mx = fmaxf(mx, fmaxf(fmaxf(sacc[mt][0], sacc[mt][1]), fmaxf(sacc[mt][2], sacc[mt][3])));
    mx = fmaxf(mx, __shfl_xor(mx, 16)); mx = fmaxf(mx, __shfl_xor(mx, 32));
    float l = 0.f; bf16x8 pf[8];
#pragma unroll
    for (int kk = 0; kk < 8; ++kk) { float p[8];
#pragma unroll
        for (int r = 0; r < 4; ++r) { p[r] = __expf(sacc[2 * kk][r] - mx); p[4 + r] = __expf(sacc[2 * kk + 1][r] - mx); }
#pragma unroll
        for (int i = 0; i < 8; ++i) l += p[i];
        pf[kk] = as_frag(pack8(p)); }
    l += __shfl_xor(l, 16); l += __shfl_xor(l, 32);
    const float inv = 1.f / l;
    u32x2 ost[8][4];
#pragma unroll
    for (int ci = 8; ci < 16; ++ci) {
        if (ci == 13) asm volatile("s_waitcnt vmcnt(8)" ::: "memory"); else if (ci == 14) asm volatile("s_waitcnt vmcnt(4)" ::: "memory"); else if (ci == 15) asm volatile("s_waitcnt vmcnt(0)" ::: "memory"); else asm volatile("s_waitcnt vmcnt(8)" ::: "memory");
        __builtin_amdgcn_s_barrier(); asm volatile("" ::: "memory");
        if (ci + 3 < 16) XA_DMA(ci + 3);
        const LAS unsigned char* bb = c.lds + (ci & 3) * 32768;
#pragma unroll
        for (int m4 = 0; m4 < 4; ++m4) { f32x4 o0 = {0.f, 0.f, 0.f, 0.f}, o1 = o0;
#pragma unroll
            for (int kk = 0; kk < 8; kk += 2) {
                const bf16x8 a0 = *(const LAS bf16x8*)(bb + vof[kk] + 8192 * m4), a1 = *(const LAS bf16x8*)(bb + vof[kk + 1] + 8192 * m4);
                o0 = mfma16(a0, pf[kk], o0); o1 = mfma16(a1, pf[kk + 1], o1); }
            const f32x4 o = (o0 + o1) * inv; ost[ci - 8][m4].x = cvt_pk_bf16(o[0], o[1]); ost[ci - 8][m4].y = cvt_pk_bf16(o[2], o[3]); }
        LDS_WAIT();
    }
#pragma unroll
    for (int cc = 0; cc < 8; ++cc)
#pragma unroll
        for (int m4 = 0; m4 < 4; ++m4) *(u32x2*)(OX + (size_t)trow * 2048 + h * 512 + 64 * cc + 16 * m4 + 4 * g) = ost[cc][m4];
#undef XA_DMA
#ifdef XA_SEG
    ts_[3] = __builtin_amdgcn_s_memrealtime();
    asm volatile("s_waitcnt vmcnt(0)" ::: "memory"); ts_[4] = __builtin_amdgcn_s_memrealtime();
    { const unsigned long long dt = ts_[XA_SEG + 1] - ts_[XA_SEG]; const unsigned long long t_end = ts_[4] + 20ull * dt; if (c.bid == 0 && w == 0) { while (__builtin_amdgcn_s_memrealtime() < t_end) __builtin_amdgcn_s_sleep(8); } }
#endif
#undef XA_STAMP
    __syncthreads();
}

__device__ __forceinline__ void split_frag(const f32x4 v0, const f32x4 v1, bf16x8& fh, bf16x8& fl) {
    float x[8] = {v0[0], v0[1], v0[2], v0[3], v1[0], v1[1], v1[2], v1[3]}; float r[8]; u32x4 h = pack8(x); float hf[8]; unpack8(h, hf);
#pragma unroll
    for (int i = 0; i < 8; ++i) r[i] = x[i] - hf[i];
    fh = as_frag(h); fl = as_frag(pack8(r));
}
__device__ __forceinline__ void route_block(const Args& a, const Ctx& c) {
    unsigned char* ws = c.ws; const bf16_t* WRH = (const bf16_t*)(ws + WS_MISC + MO_WR); const bf16_t* WRL = WRH + 80 * 2048; const float* H2 = c.out;
    unsigned* ECNT = (unsigned*)(ws + WS_CTL) + CW_ECNT; float* PAIR_W = (float*)(ws + WS_MISC + MO_PAIR_W); int* ELIST = (int*)(ws + WS_ELIST);
    bf16_t* HNB = (bf16_t*)(ws + WS_HNB);
    LAS float* lg = (LAS float*)c.lds;
    LAS float* ssqp = lg + 8 * 32 * 80;
    LAS float* lgf = ssqp + 256;
    LAS float* rsd = lgf + 32 * 80;
    const int w = c.wave, lane = c.lane, n = lane & 15, g = lane >> 4, tid = c.tid;
    const int r0 = c.bid * 32;
    f32x4 acc[2][5];
#pragma unroll
    for (int t = 0; t < 2; ++t)
#pragma unroll
        for (int i = 0; i < 5; ++i) acc[t][i] = (f32x4){0.f, 0.f, 0.f, 0.f};
    float ssq0 = 0.f, ssq1 = 0.f;
    const float* a0p = H2 + (size_t)(r0 + n) * 2048 + 256 * w + 8 * g; const float* a1p = a0p + (size_t)16 * 2048;
    const bf16_t* bhp = WRH + (size_t)n * 2048 + 256 * w + 8 * g; const bf16_t* blp = WRL + (size_t)n * 2048 + 256 * w + 8 * g;
    f32x4 A0[2][2], A1[2][2]; bf16x8 Bh[2][5], Bl[2][5];
#define RT_LOAD(sb, ks) do { A0[sb][0] = *(const f32x4*)(a0p + 32 * (ks)); A0[sb][1] = *(const f32x4*)(a0p + 32 * (ks) + 4); A1[sb][0] = *(const f32x4*)(a1p + 32 * (ks)); A1[sb][1] = *(const f32x4*)(a1p + 32 * (ks) + 4); \
        _Pragma("unroll") for (int nt = 0; nt < 5; ++nt) { Bh[sb][nt] = *(const bf16x8*)(bhp + (size_t)(16 * nt) * 2048 + 32 * (ks)); Bl[sb][nt] = *(const bf16x8*)(blp + (size_t)(16 * nt) * 2048 + 32 * (ks)); } } while (0)
#define RT_COMP(sb) do { bf16x8 h0, l0, h1, l1; split_frag(A0[sb][0], A0[sb][1], h0, l0); split_frag(A1[sb][0], A1[sb][1], h1, l1); \
        _Pragma("unroll") for (int q = 0; q < 2; ++q) { const f32x4 v = A0[sb][q], u = A1[sb][q]; ssq0 += (v[0] * v[0] + v[1] * v[1]) + (v[2] * v[2] + v[3] * v[3]); ssq1 += (u[0] * u[0] + u[1] * u[1]) + (u[2] * u[2] + u[3] * u[3]); } \
        _Pragma("unroll") for (int nt = 0; nt < 5; ++nt) { \
            acc[0][nt] = mfma16(h0, Bh[sb][nt], acc[0][nt]); acc[0][nt] = mfma16(l0, Bh[sb][nt], acc[0][nt]); acc[0][nt] = mfma16(h0, Bl[sb][nt], acc[0][nt]); \
            acc[1][nt] = mfma16(h1, Bh[sb][nt], acc[1][nt]); acc[1][nt] = mfma16(l1, Bh[sb][nt], acc[1][nt]); acc[1][nt] = mfma16(h1, Bl[sb][nt], acc[1][nt]); } } while (0)
    RT_LOAD(0, 0);
#pragma unroll 1
    for (int ks = 0; ks < 8; ks += 2) {
        RT_LOAD(1, ks + 1); asm volatile("" ::: "memory");
        RT_COMP(0);
        if (ks + 2 < 8) RT_LOAD(0, ks + 2);
        asm volatile("" ::: "memory");
        RT_COMP(1);
    }
#undef RT_LOAD
#undef RT_COMP
    ssq0 += __shfl_xor(ssq0, 16); ssq0 += __shfl_xor(ssq0, 32); ssq1 += __shfl_xor(ssq1, 16); ssq1 += __shfl_xor(ssq1, 32);
#pragma unroll
    for (int t = 0; t < 2; ++t)
#pragma unroll
        for (int nt = 0; nt < 5; ++nt)
#pragma unroll
            for (int r = 0; r < 4; ++r) lg[(w * 32 + 16 * t + 4 * g + r) * 80 + 16 * nt + n] = acc[t][nt][r];
    if (g == 0) { ssqp[w * 32 + n] = ssq0; ssqp[w * 32 + 16 + n] = ssq1; }
    f32x4 xv[4][8];
#pragma unroll
    for (int i = 0; i < 4; ++i) { const f32x4* xr = (const f32x4*)(H2 + (size_t)(r0 + 4 * w + i) * 2048) + lane;
#pragma unroll
        for (int j = 0; j < 8; ++j) xv[i][j] = xr[64 * j]; }
    const float* bg = INF(21); const float* be = INF(23);
    float bgv[8];
#pragma unroll
    for (int j = 0; j < 8; ++j) bgv[j] = bg[j];
    __syncthreads();
    for (int i = tid; i < 32 * 80; i += 512) { float v = 0.f;
#pragma unroll
        for (int q = 0; q < 8; ++q) v += lg[q * 32 * 80 + i];
        lgf[i] = v; }
    __syncthreads();
    if (tid < 32) {
        const int rr = tid; const int t = r0 + rr;
        float sq = 0.f;
#pragma unroll
        for (int q = 0; q < 8; ++q) sq += ssqp[q * 32 + rr];
        const float rstd = rsqrtf(sq * (1.f / 2048.f) + EPS); rsd[rr] = rstd;
        float gl[8]; float gm = -INFINITY; int gs = 0;
#pragma unroll
        for (int j = 0; j < 8; ++j) { gl[j] = lgf[rr * 80 + j] * rstd + bgv[j]; if (gl[j] > gm) { gm = gl[j]; gs = j; } }
        float gsum = 0.f;
#pragma unroll
        for (int j = 0; j < 8; ++j) gsum += __expf(gl[j] - gm);
        const float pg = 1.f / gsum;
        float el[8]; float m0 = -INFINITY; int i0 = 0;
#pragma unroll
        for (int j = 0; j < 8; ++j) { el[j] = lgf[rr * 80 + 8 + 8 * gs + j] * rstd + be[8 * gs + j]; if (el[j] > m0) { m0 = el[j]; i0 = j; } }
        float m1 = -INFINITY; int i1 = 0;
#pragma unroll
        for (int j = 0; j < 8; ++j) if (j != i0 && el[j] > m1) { m1 = el[j]; i1 = j; }
        const float e1 = __expf(m1 - m0); const float w0 = pg / (1.f + e1), w1 = pg * e1 / (1.f + e1);
        const int ea = 8 * gs + i0, eb = 8 * gs + i1;
        const int sa = (int)__hip_atomic_fetch_add(ECNT + ea, 1u, __ATOMIC_RELAXED, __HIP_MEMORY_SCOPE_AGENT);
        const int sb = (int)__hip_atomic_fetch_add(ECNT + eb, 1u, __ATOMIC_RELAXED, __HIP_MEMORY_SCOPE_AGENT);
        PAIR_W[2 * t] = w0; PAIR_W[2 * t + 1] = w1; ELIST[(size_t)ea * 8192 + sa] = 2 * t; ELIST[(size_t)eb * 8192 + sb] = 2 * t + 1;
    }
    __syncthreads();
    const float* gf = INF(19);
    f32x4 gg[8];
#pragma unroll
    for (int j = 0; j < 8; ++j) gg[j] = *(const f32x4*)(gf + 256 * j + 4 * lane);
#pragma unroll
    for (int i = 0; i < 4; ++i) { const int rl = 4 * w + i; const float rstd = rsd[rl]; u32x2* o8 = (u32x2*)(HNB + (size_t)(r0 + rl) * 2048) + lane;
#pragma unroll
        for (int j = 0; j < 8; ++j) { const f32x4 y = xv[i][j] * rstd * gg[j]; u32x2 wv; wv.x = cvt_pk_bf16(y[0], y[1]); wv.y = cvt_pk_bf16(y[2], y[3]); o8[64 * j] = wv; } }
    __syncthreads();
}

__device__ __forceinline__ void moe_gather(const Ctx& c) {
    unsigned char* ws = c.ws; unsigned* CTLW = (unsigned*)(ws + WS_CTL); const unsigned* ECNT = CTLW + CW_ECNT;
    const int* PAIR_E = (const int*)(ws + WS_MISC + MO_PAIR_E); const int* PAIR_SLOT = (const int*)(ws + WS_MISC + MO_PAIR_SLOT); int* ROWPAIR = (int*)(ws + WS_MISC + MO_ROWPAIR);
    int* TILE_E = (int*)(ws + WS_MISC + MO_TILE_E); int* TOFF = (int*)(ws + WS_MISC + MO_TOFF);
    const bf16_t* HNB = (const bf16_t*)(ws + WS_HNB); bf16_t* XG = (bf16_t*)(ws + WS_XG);
    LAS int* toffs = (LAS int*)c.lds;
    if (c.tid < 64) { const int cn = (int)ECNT[c.tid]; const int nt = (cn + 255) >> 8; int incl = nt;
#pragma unroll
        for (int o = 1; o < 64; o <<= 1) { const int t = __shfl_up(incl, o); if (c.lane >= o) incl += t; }
        toffs[c.tid] = incl - nt; if (c.tid == 63) toffs[64] = incl;
        if (c.bid == 0) { TOFF[c.tid] = incl - nt; for (int k = 0; k < nt; ++k) TILE_E[incl - nt + k] = c.tid; if (c.tid == 63) CTLW[CW_NTILES] = (unsigned)incl; } }
    __syncthreads();
    for (int p = c.gw; p < 16384; p += c.NGW) { const int e = PAIR_E[p], sl = PAIR_SLOT[p]; const int row = toffs[e] * 256 + sl;
        const u32x4* src = (const u32x4*)(HNB + (size_t)(p >> 1) * 2048) + c.lane; u32x4* dst = (u32x4*)(XG + (size_t)row * 2048) + c.lane;
#pragma unroll
        for (int j = 0; j < 4; ++j) dst[64 * j] = src[64 * j];
        if (c.lane == 0) ROWPAIR[row] = p; }
    __syncthreads();
}

__device__ __forceinline__ void wait_vm(int n) {
    switch (n) {
        case 0: asm volatile("s_waitcnt vmcnt(0)" ::: "memory"); break;
        case 1: asm volatile("s_waitcnt vmcnt(1)" ::: "memory"); break;
        case 2: asm volatile("s_waitcnt vmcnt(2)" ::: "memory"); break;
        case 3: asm volatile("s_waitcnt vmcnt(3)" ::: "memory"); break;
        case 4: asm volatile("s_waitcnt vmcnt(4)" ::: "memory"); break;
        case 5: asm volatile("s_waitcnt vmcnt(5)" ::: "memory"); break;
        case 6: asm volatile("s_waitcnt vmcnt(6)" ::: "memory"); break;
        default: asm volatile("s_waitcnt vmcnt(7)" ::: "memory"); break;
    }
}
template <int MODE, int VAR = 0>
__device__ __forceinline__ void moe_direct(const Args& a, const Ctx& c) {
    unsigned char* ws = c.ws;
    constexpr int K = (MODE == 1) ? 2048 : 512, LDW = (MODE == 1) ? 512 : 2048, UPE = (MODE == 1) ? 8 : 16, NCH = K / 32, MAXT = 24, MROWS = MAXT * 16;
    constexpr int XBUF = MROWS * 64, WOFF = 3 * XBUF, TOFF = WOFF + 4 * 16384;
    const unsigned* ECNT = (const unsigned*)(ws + WS_CTL) + CW_ECNT; const int* ELIST = (const int*)(ws + WS_ELIST); const float* PAIR_W = (const float*)(ws + WS_MISC + MO_PAIR_W);
    const bf16_t* XSRC = (const bf16_t*)(ws + (MODE == 1 ? WS_HNB : WS_ACT)); bf16_t* ACT = (bf16_t*)(ws + (VAR ? WS_XG : WS_ACT)); bf16_t* YB = (bf16_t*)(ws + (VAR ? WS_XG : WS_YB));
    LAS unsigned char* xb = c.lds;
    LAS unsigned char* wb = c.lds + WOFF;
    LAS int* rowoff = (LAS int*)(c.lds + TOFF);
    LAS int* rowpair = rowoff + MROWS;
    LAS float* rowwt = (LAS float*)(rowpair + MROWS);
    const int tid = c.tid, lane = c.lane, w = c.wave, tt = lane & 15, g = lane >> 4;
    const int hh = w >> 2, cgp = w & 3;
    const int xcd_ = c.bid & 7, idx_ = c.bid >> 3, EPX = 32 / UPE;
    for (int r = 0; r < (64 * UPE) / 256; ++r) {
        int e, sl;
        if (c.G == 256) { e = r * (8 * EPX) + xcd_ * EPX + idx_ / UPE; sl = idx_ % UPE; } else { const int u = r * c.G + c.bid; if (u >= 64 * UPE) break; e = u / UPE; sl = u % UPE; }
        const int ne = (int)ECNT[e];
        const float* wsrc[2];
#pragma unroll
        for (int i = 0; i < 2; ++i) { const int k = 4 * w + 2 * i + (lane >> 5), q = w >> 1, sidx = lane & 31;
            if (MODE == 1) { const int h = sidx >> 4, cgs = ((sidx & 15) - 2 * q - 4 * h) & 15;
                wsrc[i] = (h ? INF(25) : INF(24)) + (size_t)e * 2048 * 512 + (size_t)k * LDW + sl * 64 + 4 * cgs; }
            else { const int cgs = (sidx - 4 * q) & 31; wsrc[i] = INF(26) + (size_t)e * 512 * 2048 + (size_t)k * LDW + sl * 128 + 4 * cgs; } }
        int wrd[2];
#pragma unroll
        for (int t = 0; t < 2; ++t) { const int wq = 2 * cgp + t;
            if (MODE == 1) { const int h = tt >> 3, cc = 8 * wq + (tt & 7); wrd[t] = ((8 * g) * 128 + 64 * h + ((cc + 8 * g + 16 * h) & 63)) * 4; }
            else { const int col = 16 * wq + tt; wrd[t] = ((8 * g) * 128 + ((col + 16 * g) & 127)) * 4; } }
        for (int m0 = 0; m0 < ne; m0 += MROWS) {
            const int mrows = min(MROWS, ne - m0), nt = (mrows + 15) >> 4;
            if (tid < MROWS) { const int rr = tid < mrows ? tid : mrows - 1; const int p = ELIST[(size_t)e * 8192 + m0 + rr];
              rowoff[tid] = (MODE == 1) ? (p >> 1) * 2048 : p * 512; rowpair[tid] = p; rowwt[tid] = PAIR_W[p]; }
            __syncthreads();
            f32x4 acc[2][12];
#pragma unroll
            for (int t = 0; t < 2; ++t)
#pragma unroll
                for (int i = 0; i < 12; ++i) acc[t][i] = (f32x4){0.f, 0.f, 0.f, 0.f};
            int roff[3];
#pragma unroll
            for (int i = 0; i < 3; ++i) roff[i] = rowoff[16 * (8 * i + w) + (lane >> 2)] + 8 * (lane & 3);
            const int nx = (VAR & 1) ? 0 : ((nt - w + 7) >> 3);
            const int nw = (VAR & 2) ? 0 : 2;
            const int xrd = tt * 64 + g * 16 + 1024 * hh;
#define MD_XDMA(ch) do { LAS unsigned char* bb = xb + ((ch) % 3) * XBUF; _Pragma("unroll") for (int i = 0; i < 3; ++i) if (i < nx) \
                __builtin_amdgcn_global_load_lds((const unsigned*)(XSRC + (size_t)roff[i] + 32 * (ch)), (LAS unsigned*)(bb + (8 * i + w) * 1024), 16, 0, 0); } while (0)
#define MD_WDMA(ch) do { LAS unsigned char* bb = wb + ((ch) & 3) * 16384; _Pragma("unroll") for (int i = 0; i < 2; ++i) if (i < nw) \
                __builtin_amdgcn_global_load_lds((const unsigned*)(wsrc[i] + (size_t)(32 * (ch)) * LDW), (LAS unsigned*)(bb + (2 * w + i) * 1024), 16, 0, 0); } while (0)
            asm volatile("s_waitcnt vmcnt(0)" ::: "memory");
            MD_WDMA(0); MD_XDMA(0); MD_WDMA(1); MD_XDMA(1); MD_WDMA(2);
            const int nmi = (nt - hh + 1) >> 1;
            for (int ch = 0; ch < NCH; ++ch) {
                wait_vm((ch + 1 < NCH ? nw + nx : 0) + (ch + 2 < NCH ? nw : 0));
                __builtin_amdgcn_s_barrier(); asm volatile("" ::: "memory");
                if (ch + 2 < NCH) MD_XDMA(ch + 2);
                if (ch + 3 < NCH) MD_WDMA(ch + 3);
                const LAS unsigned char* wsl = wb + (ch & 3) * 16384;
                float wr0[8], wr1[8];
#pragma unroll
                for (int j = 0; j < 8; ++j) { wr0[j] = *(const LAS float*)(wsl + wrd[0] + 512 * j); wr1[j] = *(const LAS float*)(wsl + wrd[1] + 512 * j); }
                u32x4 t0, t1; t0.x = cvt_pk_bf16(wr0[0], wr0[1]); t0.y = cvt_pk_bf16(wr0[2], wr0[3]); t0.z = cvt_pk_bf16(wr0[4], wr0[5]); t0.w = cvt_pk_bf16(wr0[6], wr0[7]);
                t1.x = cvt_pk_bf16(wr1[0], wr1[1]); t1.y = cvt_pk_bf16(wr1[2], wr1[3]); t1.z = cvt_pk_bf16(wr1[4], wr1[5]); t1.w = cvt_pk_bf16(wr1[6], wr1[7]);
                const bf16x8 wf0 = as_frag(t0), wf1 = as_frag(t1);
                const LAS unsigned char* bb = xb + (ch % 3) * XBUF + xrd;
#define MD_RD(X_, bq) do { _Pragma("unroll") for (int q = 0; q < 4; ++q) X_[q] = *(const LAS bf16x8*)(bb + 2048 * (4 * (bq) + q)); } while (0)
#define MD_MM(X_, bq) do { _Pragma("unroll") for (int q = 0; q < 4; ++q) { acc[0][4 * (bq) + q] = mfma16(wf0, X_[q], acc[0][4 * (bq) + q]); acc[1][4 * (bq) + q] = mfma16(wf1, X_[q], acc[1][4 * (bq) + q]); } } while (0)
                { bf16x8 xa[4], xc[4]; const bool b1 = nmi > 4, b2 = nmi > 8;
                  MD_RD(xa, 0); if (b1) MD_RD(xc, 1);
                  MD_MM(xa, 0); asm volatile("" ::: "memory");
                  if (b2) MD_RD(xa, 2);
                  if (b1) MD_MM(xc, 1);
                  if (b2) MD_MM(xa, 2); }
#undef MD_RD
#undef MD_MM
                LDS_WAIT();
            }
#undef MD_XDMA
#undef MD_WDMA
            const LAS int* rp_ = rowpair + tt + 16 * hh; const LAS float* rw_ = rowwt + tt + 16 * hh;
            asm volatile("" : "+v"(rp_), "+v"(rw_));
#pragma unroll
            for (int mi = 0; mi < 12; ++mi) if (mi < nmi) { const int row = 16 * (2 * mi + hh) + tt; const bool valid = row < mrows; const int p = rp_[32 * mi];
#pragma unroll
                for (int t = 0; t < 2; ++t) { const int wq = 2 * cgp + t;
                    if (MODE == 1) {
                        const float u0 = __shfl_xor(acc[t][mi][0], 32), u1 = __shfl_xor(acc[t][mi][1], 32), u2 = __shfl_xor(acc[t][mi][2], 32), u3 = __shfl_xor(acc[t][mi][3], 32);
                        if (valid && g < 2) { const float g0 = acc[t][mi][0], g1 = acc[t][mi][1], g2 = acc[t][mi][2], g3 = acc[t][mi][3];
                            u32x2 wv; wv.x = cvt_pk_bf16(g0 / (1.f + __expf(-g0)) * u0, g1 / (1.f + __expf(-g1)) * u1); wv.y = cvt_pk_bf16(g2 / (1.f + __expf(-g2)) * u2, g3 / (1.f + __expf(-g3)) * u3);
                            *(u32x2*)(ACT + (size_t)p * 512 + sl * 64 + 8 * wq + 4 * g) = wv; }
                    } else {
                        if (valid) { const float pw = rw_[32 * mi]; u32x2 wv; wv.x = cvt_pk_bf16(acc[t][mi][0] * pw, acc[t][mi][1] * pw); wv.y = cvt_pk_bf16(acc[t][mi][2] * pw, acc[t][mi][3] * pw);
                            *(u32x2*)(YB + (size_t)p * 2048 + sl * 128 + 16 * wq + 4 * g) = wv; }
                    }
                }
            }
            __syncthreads();
        }
    }
}

__device__ __forceinline__ void moe_combine(const Ctx& c) {
    const bf16_t* YB = (const bf16_t*)(c.ws + WS_YB);
    for (int t = c.gw; t < S; t += c.NGW) {
        f32x4* orow = (f32x4*)(c.out + (size_t)t * 2048); const u32x4* y0 = (const u32x4*)(YB + (size_t)(2 * t) * 2048); const u32x4* y1 = (const u32x4*)(YB + (size_t)(2 * t + 1) * 2048);
#pragma unroll
        for (int j = 0; j < 4; ++j) { const int ck = 64 * j + c.lane; float a8[8], b8[8]; unpack8(y0[ck], a8); unpack8(y1[ck], b8);
            f32x4 o0 = orow[2 * ck], o1 = orow[2 * ck + 1];
            o0[0] += a8[0] + b8[0]; o0[1] += a8[1] + b8[1]; o0[2] += a8[2] + b8[2]; o0[3] += a8[3] + b8[3]; o1[0] += a8[4] + b8[4]; o1[1] += a8[5] + b8[5]; o1[2] += a8[6] + b8[6]; o1[3] += a8[7] + b8[7];
            orow[2 * ck] = o0; orow[2 * ck + 1] = o1; }
    }
}

__global__ void __launch_bounds__(512, 2) mega(Args a) {
    extern __shared__ __attribute__((aligned(16))) unsigned char lds_raw[];
    Ctx c; c.lds = (LAS unsigned char*)lds_raw; c.tid = threadIdx.x; c.lane = c.tid & 63; c.wave = __builtin_amdgcn_readfirstlane(c.tid >> 6);
    c.bid = blockIdx.x; c.G = gridDim.x; c.gw = c.bid * 8 + c.wave; c.NGW = c.G * 8; c.ws = a.ws; c.out = a.out;
    unsigned char* ws = a.ws;
    const int lo = a.ph_lo, hi = a.ph_hi;
#ifdef ONLY_PH
#define IN(k) ((k) == ONLY_PH)
#elif defined(EXCL_PH)
#define IN(k) ((k) != EXCL_PH && lo <= (k) && (k) < hi)
#else
#define IN(k) (lo <= (k) && (k) < hi)
#endif
    volatile LAS unsigned* bst = (volatile LAS unsigned*)(c.lds + 147392);
    if (c.tid < 2) bst[c.tid] = 0u;
    __syncthreads();
    XcdBarrier xbar; xbar.bar = (unsigned*)(ws + WS_CTL) + CW_BAR; xbar.x = 0; xbar.st = bst;
    if (a.single) xbar = xcd_barrier_post((unsigned*)(ws + WS_CTL) + CW_BAR, bst);
#define GSYNC(k) do { xcd_barrier(xbar); } while (0)
#ifdef PROBE_PH
    unsigned long long tph_[16]; tph_[0] = __builtin_amdgcn_s_memrealtime();
#define SEAM(k) do { if (IN(k) && IN((k) + 1)) { GSYNC(k); } tph_[(k) + 1] = __builtin_amdgcn_s_memrealtime(); } while (0)
#else
#define SEAM(k) do { if (IN(k) && IN((k) + 1)) { GSYNC(k); } } while (0)
#endif
#define PH_CTX() do { int t_ = threadIdx.x; asm volatile("" : "+v"(t_)); c.tid = t_; c.lane = t_ & 63; } while (0)

    if (IN(0)) { PH_CTX(); phase0(a, c); __syncthreads(); }
    SEAM(0);
    if (IN(1)) { PH_CTX();
        { pg8::Gemm g{(const bf16_t*)(ws + WS_XN), (const bf16_t*)(ws + WS_WIN), 2048, 2048}; pg8::StaticOrder So; So.init(S, NPROJ, c.G, c.bid);
          pg8::EpiBf16 E{(bf16_t*)(ws + WS_PROJ), NPROJ, nullptr};
          pg8::gemm_phase<pg8::EpiBf16, pg8::StaticOrder, true, true>(c.lds, g, So, E); }
        { pg8::Gemm g{(const bf16_t*)(ws + WS_MEMN), (const bf16_t*)(ws + WS_WKV), 256, 2048}; pg8::SplitOrder So{16, 8, c.G, c.bid};
          pg8::EpiSlab E{(float*)(ws + WS_KVSLAB), 4096, (size_t)256 * 4096};
          pg8::gemm_phase<pg8::EpiSlab, pg8::SplitOrder, true, true>(c.lds, g, So, E); }
    }
    SEAM(1);
    if (IN(2)) { PH_CTX();
        for (int it = c.bid; it < 256; it += c.G) prep_mlstm(a, c, it >> 6, it & 63);
        for (int it = c.bid; it < 256; it += c.G) prep_moba(a, c, it >> 5, it & 31);
        prep_xamem(a, c);
        if (c.bid == 0 && c.tid < 256) ((unsigned*)(ws + WS_CTL))[CW_BCNT + c.tid] = 0u;
    }
    SEAM(2);
    if (IN(3)) { PH_CTX();
        for (int it = c.bid; it < 256; it += c.G) mlstm_local(c, it >> 6, it & 63);
        for (int it = c.bid; it < 512; it += c.G) { const int cb = (it < 256) ? (31 - (it >> 4)) : ((it - 256) >> 4); moba_select(c, (it & 15) >> 1, cb, it & 1); }
    }
    SEAM(3);
    if (IN(4)) { PH_CTX(); if (c.G * 512 >= 4 * DVP * 64) mlstm_scan(c); moba_bucket_phase(c); }
    SEAM(4);
    if (IN(5)) { PH_CTX();
        for (int it = c.bid; it < 256; it += c.G) mlstm_out(a, c, it >> 6, it & 63);
        for (int it = c.bid; it < 512; it += c.G) { const int cb = (it < 256) ? (31 - (it >> 4)) : ((it - 256) >> 4); moba_own(c, (it & 15) >> 1, cb, it & 1); }
    }
    SEAM(5);
    if (IN(6)) { PH_CTX();
        pg8::Gemm g{(const bf16_t*)(ws + WS_HCAT), (const bf16_t*)(ws + WS_WOUT), 2048, 2048}; pg8::StaticOrder So; So.init(S, 2048, c.G, c.bid);
        pg8::EpiResid E{INF(0), nullptr, nullptr, (bf16_t*)(ws + WS_H1B), (float*)(ws + WS_MISC + MO_SSQ)};
        pg8::gemm_phase<pg8::EpiResid, pg8::StaticOrder, false, true>(c.lds, g, So, E);
    }
    SEAM(6);
    if (IN(7)) { PH_CTX();
        pg8::Gemm g{(const bf16_t*)(ws + WS_H1B), (const bf16_t*)(ws + WS_WQ), 2048, 2048}; pg8::StaticOrder So; So.init(S, 2048, c.G, c.bid);
        pg8::EpiBf16 E{(bf16_t*)(ws + WS_QX), 2048, (const float*)(ws + WS_MISC + MO_SSQ)};
        pg8::gemm_phase<pg8::EpiBf16, pg8::StaticOrder, false, true>(c.lds, g, So, E);
    }
    SEAM(7);
    if (IN(8)) { PH_CTX(); for (int it = c.bid; it < 256; it += c.G) xattn_item(a, c, it & 3, it >> 2); }
    SEAM(8);
    if (IN(9)) { PH_CTX();
        pg8::Gemm g{(const bf16_t*)(ws + WS_OX), (const bf16_t*)(ws + WS_WO), 2048, 2048}; pg8::StaticOrder So; So.init(S, 2048, c.G, c.bid);
        pg8::EpiResid E{nullptr, (const bf16_t*)(ws + WS_H1B), a.out, nullptr, nullptr};
        if (c.bid == 0 && c.tid < 128) ((unsigned*)(ws + WS_CTL))[CW_ECNT + c.tid] = 0u;
        pg8::gemm_phase<pg8::EpiResid, pg8::StaticOrder, false, true>(c.lds, g, So, E);
    }
    SEAM(9);
    if (IN(10)) { PH_CTX(); if (c.G == 256) route_block(a, c); }
    do { if (IN(10) && IN(12)) { GSYNC(10); } } while (0);
#ifdef PROBE_PH
    tph_[11] = __builtin_amdgcn_s_memrealtime(); tph_[12] = tph_[11];
#endif
#ifdef PROBE_VAR
#if PROBE_VAR < 10
    if (IN(11)) moe_direct<1, PROBE_VAR>(a, c);
#elif PROBE_VAR == 10
    if (IN(11)) mlstm_scan(c);
#elif PROBE_VAR == 11
    if (IN(11)) moba_bucket_phase(c);
#elif PROBE_VAR == 12
    if (IN(11)) { PH_CTX(); for (int it = c.bid; it < 256; it += c.G) mlstm_out(a, c, it >> 6, it & 63); }
#elif PROBE_VAR == 13
    if (IN(11)) { PH_CTX(); for (int it = c.bid; it < 512; it += c.G) { const int cb = (it < 256) ? (31 - (it >> 4)) : ((it - 256) >> 4); moba_own(c, (it & 15) >> 1, cb, it & 1); } }
#elif PROBE_VAR == 14
    if (IN(11)) { PH_CTX(); for (int it = c.bid; it < 256; it += c.G) mlstm_local(c, it >> 6, it & 63); }
#endif
#endif
    if (IN(12)) { PH_CTX(); moe_direct<1>(a, c); }
    SEAM(12);
    if (IN(13)) { PH_CTX(); moe_direct<2>(a, c); }
    SEAM(13);
    if (IN(14)) { PH_CTX(); moe_combine(c); }
#ifdef PROBE_PH
    asm volatile("s_waitcnt vmcnt(0)" ::: "memory"); tph_[15] = __builtin_amdgcn_s_memrealtime();
    if (a.single && c.bid == 0 && c.wave == 0) { const unsigned long long dt = tph_[PROBE_PH + 1] - tph_[PROBE_PH]; const unsigned long long te = tph_[15] + 10ull * dt;
        unsigned guard = 0; while (__builtin_amdgcn_s_memrealtime() < te && ++guard < 4000000u) __builtin_amdgcn_s_sleep(16); }
#endif
#undef IN
#undef SEAM
}

constexpr int LDS_BYTES = 147456;
extern "C" void kernel_launch(void* const* d_in, const int* in_sizes, int n_in, void* d_out, int out_size, void* d_ws, size_t ws_size, hipStream_t stream) {
    static int grid = 0;
    if (grid == 0) {
        if (n_in != 27 || out_size != S * D || ws_size < WS_END2) { fprintf(stderr, "kernel_launch: unexpected shapes (n_in %d out %d ws %zu)\n", n_in, out_size, ws_size); grid = -1; return; }
        int dev = 0, cus = 0, per_cu = 0;
        hipGetDevice(&dev); hipDeviceGetAttribute(&cus, hipDeviceAttributeMultiprocessorCount, dev);
        hipFuncSetAttribute((const void*)mega, hipFuncAttributeMaxDynamicSharedMemorySize, LDS_BYTES);
        hipOccupancyMaxActiveBlocksPerMultiprocessor(&per_cu, (const void*)mega, 512, LDS_BYTES);
        (void)hipGetLastError();
        grid = (per_cu >= 1) ? cus : -1;
        if (grid != 256) { fprintf(stderr, "kernel_launch: needs a 256-CU device with one resident block per CU (cus %d per_cu %d)\n", cus, per_cu); grid = -1; return; }
    }
    if (grid < 0) return;
    (void)hipMemsetAsync((char*)d_ws + WS_CTL, 0, CTL_ZERO_BYTES, stream);
    Args a{};
    for (int i = 0; i < 27; ++i) a.in[i] = d_in[i];
    a.out = (float*)d_out; a.ws = (unsigned char*)d_ws; a.single = MK_SINGLE; a.pad = 0;
#if MK_SINGLE
    a.ph_lo = 0; a.ph_hi = NPH;
    void* args[] = {&a};
    hipError_t e = hipLaunchCooperativeKernel((const void*)mega, dim3(grid), dim3(512), args, LDS_BYTES, stream);
    if (e != hipSuccess) fprintf(stderr, "cooperative launch failed: %s\n", hipGetErrorString(e));
#else
    for (int p = 0; p < NPH; ++p) {
#ifdef REP_GROUP_LO
        if (p == REP_GROUP_LO) { for (int r = 0; r < 2; ++r) for (int q = REP_GROUP_LO; q <= REP_GROUP_HI; ++q) { a.ph_lo = q; a.ph_hi = q + 1; hipLaunchKernelGGL(mega, dim3(grid), dim3(512), LDS_BYTES, stream, a); } }
#endif
        a.ph_lo = p; a.ph_hi = p + 1;
#ifdef REP_MASK
        const int reps = ((REP_MASK >> p) & 1) ? 3 : 1;
#else
        const int reps = 1;
#endif
        for (int r = 0; r < reps; ++r) hipLaunchKernelGGL(mega, dim3(grid), dim3(512), LDS_BYTES, stream, a); }
#endif
}
```

```cpp
#include <hip/hip_runtime.h>
#include <hip/hip_cooperative_groups.h>
#include <cstdio>
#include <cstdint>
namespace cg = cooperative_groups;

#ifndef MK_SINGLE
#define MK_SINGLE 1
#endif

#define LAS __attribute__((address_space(3)))
typedef unsigned short bf16_t;
typedef short bf16x8 __attribute__((ext_vector_type(8)));
typedef float f32x4 __attribute__((ext_vector_type(4)));
typedef float f32x2 __attribute__((ext_vector_type(2)));
typedef unsigned u32x4 __attribute__((ext_vector_type(4)));
typedef unsigned u32x2 __attribute__((ext_vector_type(2)));

constexpr int S = 8192, D = 2048, DIN = 6152, NPROJ = 6144, MEML = 256;
constexpr int NPH = 15;
constexpr float EPS = 1e-6f;
constexpr int PC_MQ = 0, PC_MK = 512, PC_MV = 1024, PC_MO = 2048, PC_AQ = 3072, PC_AK = 4096, PC_AV = 5120;
constexpr int DVP = 272;

constexpr size_t MiB = 1u << 20;
constexpr size_t WS_CTL = 0;
constexpr size_t WS_WIN = 1 * MiB;
constexpr size_t WS_WOUT = 25 * MiB;
constexpr size_t WS_WQ = 33 * MiB;
constexpr size_t WS_WKV = 41 * MiB;
constexpr size_t WS_WO = 57 * MiB;
constexpr size_t WS_WGU = 65 * MiB;
constexpr size_t WS_WD = 321 * MiB;
constexpr size_t WS_XN = 449 * MiB;
constexpr size_t WS_MEMN = 481 * MiB;
constexpr size_t WS_PROJ = 482 * MiB;
constexpr size_t WS_KVMEM = 578 * MiB;
constexpr size_t WS_QC = 580 * MiB;
constexpr size_t WS_KC = 588 * MiB;
constexpr size_t WS_KWT = 596 * MiB;
constexpr size_t WS_VT = 604 * MiB;
constexpr size_t WS_CTL_LOC = 621 * MiB;
constexpr size_t WS_CTP = 655 * MiB;
constexpr size_t WS_QP = 672 * MiB;
constexpr size_t WS_KP = 688 * MiB;
constexpr size_t WS_VTP = 704 * MiB;
constexpr size_t WS_KM = 720 * MiB;
constexpr size_t WS_VTM = 721 * MiB;
constexpr size_t WS_HCAT = 722 * MiB;
constexpr size_t WS_H1B = 754 * MiB;
constexpr size_t WS_QX = 786 * MiB;
constexpr size_t WS_OX = 818 * MiB;
constexpr size_t WS_MISC = 850 * MiB;
constexpr size_t WS_ACT = 854 * MiB;
constexpr size_t WS_YB = 886 * MiB;
constexpr size_t WS_END = 950 * MiB;
constexpr size_t WS_PART = WS_END;
constexpr size_t WS_BLIST = WS_END + 48 * MiB;
constexpr size_t WS_LPART = WS_END + 52 * MiB;
constexpr size_t WS_PSLOT = WS_END + 53 * MiB;
constexpr size_t WS_POFF = WS_END + 54 * MiB;
constexpr size_t WS_ELIST = WS_END + 56 * MiB;
constexpr size_t WS_END2 = WS_END + 64 * MiB;
constexpr size_t WS_KVSLAB = WS_ACT;
constexpr size_t WS_H1F = WS_PROJ;
constexpr size_t WS_XG = WS_PROJ;
constexpr size_t WS_HNB = WS_XN;
constexpr size_t MO_GATES = 0;
constexpr size_t MO_BV = 256 * 1024;
constexpr size_t MO_UV = 384 * 1024;
constexpr size_t MO_PMX = 512 * 1024;
constexpr size_t MO_GC = 640 * 1024;
constexpr size_t MO_AMAX = 641 * 1024;
constexpr size_t MO_MPREV = 642 * 1024;
constexpr size_t MO_KMEAN = 648 * 1024;
constexpr size_t MO_SSQ = 1024 * 1024;
constexpr size_t MO_WR = 2048 * 1024;
constexpr size_t MO_PAIR_E = 2752 * 1024;
constexpr size_t MO_PAIR_SLOT = 2816 * 1024;
constexpr size_t MO_PAIR_W = 2880 * 1024;
constexpr size_t MO_ROWPAIR = 2944 * 1024;
constexpr size_t MO_TILE_E = 3072 * 1024;
constexpr size_t MO_TOFF = 3073 * 1024;
constexpr int CW_ECNT = 1024;
constexpr int CW_NTILES = 1100;
constexpr int CW_BCNT = 1536;
constexpr int CW_BAR = 4096;
constexpr size_t CTL_ZERO_BYTES = 65536;

struct Args { const void* in[27]; float* out; unsigned char* ws; int ph_lo, ph_hi; int single, pad; };

__device__ __forceinline__ unsigned cvt_pk_bf16(float lo, float hi) { unsigned r; asm("v_cvt_pk_bf16_f32 %0, %1, %2" : "=v"(r) : "v"(lo), "v"(hi)); return r; }
__device__ __forceinline__ float bf_lo(unsigned u) { return __uint_as_float(u << 16); }
__device__ __forceinline__ float bf_hi(unsigned u) { return __uint_as_float(u & 0xffff0000u); }
__device__ __forceinline__ float bf1(bf16_t h) { return __uint_as_float(((unsigned)h) << 16); }
__device__ __forceinline__ bf16_t f2bf(float f) { return (bf16_t)(cvt_pk_bf16(f, 0.f) & 0xffffu); }
__device__ __forceinline__ void unpack8(u32x4 v, float (&f)[8]) {
    f[0] = bf_lo(v.x); f[1] = bf_hi(v.x); f[2] = bf_lo(v.y); f[3] = bf_hi(v.y); f[4] = bf_lo(v.z); f[5] = bf_hi(v.z); f[6] = bf_lo(v.w); f[7] = bf_hi(v.w);
}
__device__ __forceinline__ u32x4 pack8(const float (&f)[8]) {
    u32x4 v; v.x = cvt_pk_bf16(f[0], f[1]); v.y = cvt_pk_bf16(f[2], f[3]); v.z = cvt_pk_bf16(f[4], f[5]); v.w = cvt_pk_bf16(f[6], f[7]); return v;
}
__device__ __forceinline__ bf16x8 as_frag(u32x4 v) { return __builtin_bit_cast(bf16x8, v); }
__device__ __forceinline__ u32x4 as_u4(bf16x8 v) { return __builtin_bit_cast(u32x4, v); }
__device__ __forceinline__ float wave_sum(float v) {
#pragma unroll
    for (int o = 1; o < 64; o <<= 1) v += __shfl_xor(v, o);
    return v;
}
__device__ __forceinline__ float sigmoidf_(float x) { return 1.f / (1.f + __expf(-x)); }
__device__ __forceinline__ f32x4 mfma16(bf16x8 a, bf16x8 b, f32x4 c) { return __builtin_amdgcn_mfma_f32_16x16x32_bf16(a, b, c, 0, 0, 0); }
__device__ __forceinline__ int pi32(int tq, int i) { return 8 * (i >> 2) + 4 * tq + (i & 3); }
#define LDS_WAIT() asm volatile("s_waitcnt lgkmcnt(0)" ::: "memory")
#ifdef PROBE_SUB
#define SUBSTAMP(c_, i) do { if ((c_).bid == 0 && threadIdx.x == 0) { asm volatile("s_waitcnt vmcnt(0) lgkmcnt(0)" ::: "memory"); ((LAS unsigned long long*)((c_).lds + 147264))[i] = __builtin_amdgcn_s_memrealtime(); } } while (0)
#else
#define SUBSTAMP(c_, i) do {} while (0)
#endif

namespace pg8 {
constexpr int BM = 256, BK = 64, HALF = 128, HTB = HALF * BK * 2, STAGE_BYTES = 8 * HTB, NXCD = 8, WGM = 8;
__device__ __forceinline__ int lds_byte(int r, int c) { const int st = (r >> 4) * 2 + (c >> 5), rr = r & 15, cc = c & 31, ob = rr * 64 + cc * 2; return st * 1024 + (ob ^ (((ob >> 9) & 1) << 5)); }
__device__ __forceinline__ void stage_rc(int b, int& R, int& C) { const int st = b / 1024, sb = b % 1024, swz = sb ^ (((sb >> 9) & 1) << 5); R = (st >> 1) * 16 + swz / 64; C = (st & 1) * 32 + (swz % 64) / 2; }
__device__ __forceinline__ int perm32(int rho) { const int n = rho >> 4, i = rho & 15; return 8 * (i >> 2) + 4 * n + (i & 3); }
struct Unit { int pm, pn, ks; };
struct Gemm { const bf16_t* A; const bf16_t* Bt; int K; int ld; };
struct StaticOrder {
    int nM, nN, nwg, G, c;
    __device__ void init(int M, int N, int G_, int c_) { nM = M / BM; nN = N / BM; nwg = nM * nN; G = G_; c = c_; }
    __device__ bool next(int i, Unit& u) const {
        const long L = (long)i * G + c; if (L >= nwg) return false;
        int wgid = (int)L; { const int q = nwg / NXCD, r = nwg % NXCD, xcd = wgid % NXCD, off = wgid / NXCD; wgid = (xcd < r ? xcd * (q + 1) : r * (q + 1) + (xcd - r) * q) + off; }
        const int nig = WGM * nN, gid = wgid / nig, fm = gid * WGM, gsz = (nM - fm) < WGM ? (nM - fm) : WGM;
        u.pm = fm + ((wgid % nig) % gsz); u.pn = (wgid % nig) / gsz; u.ks = 0; return true;
    }
};
struct SplitOrder {
    int nN, nS, G, c;
    __device__ bool next(int i, Unit& u) const { const long L = (long)i * G + c; if (L >= (long)nN * nS) return false; u.pm = 0; u.pn = (int)(L / nS); u.ks = (int)(L % nS); return true; }
};
struct GroupedOrder {
    const int* tile_e; int ntiles, nN, G, c;
    __device__ bool next(int i, Unit& u) const {
        const long L = (long)i * G + c; if (L >= (long)ntiles * nN) return false;
        const int pm = (int)(L / nN), pl = (int)(L % nN);
        const int e = __builtin_amdgcn_readfirstlane(__hip_atomic_load(tile_e + pm, __ATOMIC_RELAXED, __HIP_MEMORY_SCOPE_AGENT));
        u.pm = pm; u.pn = e * nN + pl; u.ks = 0; return true;
    }
};

template <class Epi, class Sched, bool ALIGN_EPI, bool SP2>
__device__ __forceinline__ void gemm_phase(LAS unsigned char* lds, const Gemm g, const Sched& S, const Epi& E) {
    const int tid = threadIdx.x, wid = __builtin_amdgcn_readfirstlane(tid >> 6), lane = tid & 63, wr = wid >> 2, wc = wid & 3, fr = lane & 15, fq = lane >> 4;
    const int K = g.ld, nt = g.K / BK;
    unsigned voffA[2], voffB[2];
#pragma unroll
    for (int i = 0; i < 2; ++i) { int R, C; stage_rc(tid * 16 + i * 8192, R, C); const int Rb = Epi::PERM ? ((R & ~31) + perm32(R & 31)) : R;
        voffA[i] = (unsigned)(R * K + C) * 2u; voffB[i] = (unsigned)(Rb * K + C) * 2u; }
    const size_t kstep = (size_t)(BK * 2);
    const size_t hstep = (size_t)HALF * K * 2;
    const size_t tstep = 2 * hstep;
    const unsigned ldsw = (unsigned)wid * 1024u;
    const int aoff = lds_byte(wr * 64 + fr, fq * 8), boff = lds_byte(wc * 32 + fr, fq * 8);
#define PG8_SA(b, h) (((b) * 2 + (h)) * HTB)
#define PG8_SB(b, h) ((4 + (b) * 2 + (h)) * HTB)
#define PG8_STAGE(bufoff, gbase, voff) do { _Pragma("unroll") for (int _i = 0; _i < 2; ++_i) \
        __builtin_amdgcn_global_load_lds((const unsigned*)((const char*)(gbase) + (voff)[_i]), (LAS unsigned*)(lds + (bufoff) + ldsw + _i * 8192), 16, 0, 0); } while (0)
#define PG8_LDA(dst, b, h) do { _Pragma("unroll") for (int m = 0; m < 4; ++m) _Pragma("unroll") for (int k = 0; k < 2; ++k) dst[m][k] = *(const LAS bf16x8*)(lds + PG8_SA(b, h) + aoff + m * 2048 + k * 1024); } while (0)
#define PG8_LDB(dst, b, h) do { _Pragma("unroll") for (int n = 0; n < 2; ++n) _Pragma("unroll") for (int k = 0; k < 2; ++k) dst[n][k] = *(const LAS bf16x8*)(lds + PG8_SB(b, h) + boff + n * 2048 + k * 1024); } while (0)
#define PG8_MMA(ai, bj, At, Bt) do { __builtin_amdgcn_s_setprio(1); _Pragma("unroll") for (int m = 0; m < 4; ++m) _Pragma("unroll") for (int n = 0; n < 2; ++n) _Pragma("unroll") for (int k = 0; k < 2; ++k) \
        acc[ai][bj][m][n] = __builtin_amdgcn_mfma_f32_16x16x32_bf16(Bt[n][k], At[m][k], acc[ai][bj][m][n], 0, 0, 0); __builtin_amdgcn_s_setprio(0); } while (0)
#define PG8_WAIT_V(n) asm volatile("s_waitcnt vmcnt(" #n ")" ::: "memory")
#define PG8_WAIT_L(n) asm volatile("s_waitcnt lgkmcnt(" #n ")" ::: "memory")
#define PG8_BAR __builtin_amdgcn_s_barrier()
#define PG8_SCHED __builtin_amdgcn_sched_barrier(0)
    Unit cur, nxt; int ui = 0;
    if (!S.next(0, cur)) return;
    f32x4 acc[2][2][4][2];
#pragma unroll
    for (int a = 0; a < 2; ++a)
#pragma unroll
        for (int b = 0; b < 2; ++b)
#pragma unroll
            for (int m = 0; m < 4; ++m)
#pragma unroll
                for (int n = 0; n < 2; ++n) acc[a][b][m][n] = (f32x4){0.f, 0.f, 0.f, 0.f};
    bf16x8 At[4][2], B0[2][2], B1[2][2];
    const char* cA = (const char*)g.A + (size_t)cur.pm * tstep + (size_t)cur.ks * g.K * 2; const char* cB = (const char*)g.Bt + (size_t)cur.pn * tstep + (size_t)cur.ks * g.K * 2;
    if constexpr (SP2) {
        PG8_STAGE(PG8_SB(0, 0), cB, voffB); PG8_STAGE(PG8_SB(0, 1), cB + hstep, voffB); PG8_STAGE(PG8_SA(0, 0), cA, voffA); PG8_STAGE(PG8_SA(0, 1), cA + hstep, voffA);
        if (wr == 1) PG8_BAR;
        PG8_WAIT_V(2); PG8_BAR;
        PG8_STAGE(PG8_SB(1, 0), cB + kstep, voffB); PG8_STAGE(PG8_SA(1, 0), cA + kstep, voffA); PG8_STAGE(PG8_SB(1, 1), cB + hstep + kstep, voffB);
        PG8_WAIT_V(6); PG8_BAR;
    } else {
        PG8_STAGE(PG8_SB(0, 0), cB, voffB); PG8_STAGE(PG8_SA(0, 0), cA, voffA); PG8_STAGE(PG8_SB(0, 1), cB + hstep, voffB); PG8_STAGE(PG8_SA(0, 1), cA + hstep, voffA);
        if (wr == 1) PG8_BAR;
        PG8_WAIT_V(4); PG8_BAR;
        PG8_STAGE(PG8_SB(1, 0), cB + kstep, voffB); PG8_STAGE(PG8_SA(1, 0), cA + kstep, voffA); PG8_STAGE(PG8_SB(1, 1), cB + hstep + kstep, voffB);
        PG8_WAIT_V(6); PG8_BAR;
    }
    for (;;) {
        const bool has_next = S.next(ui + 1, nxt);
        const char* nA = has_next ? (const char*)g.A + (size_t)nxt.pm * tstep + (size_t)nxt.ks * g.K * 2 : cA; const char* nB = has_next ? (const char*)g.Bt + (size_t)nxt.pn * tstep + (size_t)nxt.ks * g.K * 2 : cB;
        for (int t = 0; t < nt; t += 2) {
            const bool last = (t == nt - 2);
            const char* a1 = cA + (size_t)(t + 1) * kstep;
            const char* a2 = last ? nA : cA + (size_t)(t + 2) * kstep; const char* b2 = last ? nB : cB + (size_t)(t + 2) * kstep;
            const char* a3 = a2 + kstep; const char* b3 = b2 + kstep;
            if constexpr (SP2) {
            PG8_LDB(B0, 0, 0); PG8_LDB(B1, 0, 1); PG8_SCHED; PG8_LDA(At, 0, 0); PG8_STAGE(PG8_SA(1, 1), a1 + hstep, voffA);
            PG8_WAIT_V(8); PG8_WAIT_L(0); PG8_BAR; PG8_MMA(0, 0, At, B0); PG8_MMA(0, 1, At, B1); PG8_BAR; PG8_SCHED;
            PG8_LDA(At, 0, 1); PG8_STAGE(PG8_SB(0, 0), b2, voffB); PG8_STAGE(PG8_SB(0, 1), b2 + hstep, voffB); PG8_STAGE(PG8_SA(0, 0), a2, voffA);
            PG8_WAIT_V(8); PG8_WAIT_L(0); PG8_BAR; PG8_MMA(1, 0, At, B0); PG8_MMA(1, 1, At, B1); PG8_BAR; PG8_SCHED;
            PG8_LDB(B0, 1, 0); PG8_LDB(B1, 1, 1); PG8_SCHED; PG8_LDA(At, 1, 0); PG8_STAGE(PG8_SA(0, 1), a2 + hstep, voffA);
            PG8_WAIT_V(8); PG8_WAIT_L(0); PG8_BAR; PG8_MMA(0, 0, At, B0); PG8_MMA(0, 1, At, B1); PG8_BAR; PG8_SCHED;
            PG8_LDA(At, 1, 1); PG8_STAGE(PG8_SB(1, 0), b3, voffB); PG8_STAGE(PG8_SB(1, 1), b3 + hstep, voffB); PG8_STAGE(PG8_SA(1, 0), a3, voffA);
            PG8_WAIT_V(8); PG8_WAIT_L(0); PG8_BAR; PG8_MMA(1, 0, At, B0); PG8_MMA(1, 1, At, B1); PG8_BAR; PG8_SCHED;
            } else {
            PG8_LDB(B0, 0, 0); PG8_SCHED; PG8_LDA(At, 0, 0); PG8_STAGE(PG8_SA(1, 1), a1 + hstep, voffA);
            PG8_WAIT_L(8); PG8_BAR; PG8_WAIT_L(0); PG8_MMA(0, 0, At, B0); PG8_BAR; PG8_SCHED;
            PG8_LDB(B1, 0, 1); PG8_STAGE(PG8_SB(0, 0), b2, voffB);
            PG8_BAR; PG8_WAIT_L(0); PG8_MMA(0, 1, At, B1); PG8_BAR;
            PG8_LDA(At, 0, 1); PG8_STAGE(PG8_SA(0, 0), a2, voffA);
            PG8_BAR; PG8_WAIT_L(0); PG8_MMA(1, 0, At, B0); PG8_BAR; PG8_SCHED;
            PG8_STAGE(PG8_SB(0, 1), b2 + hstep, voffB);
            PG8_WAIT_V(6); PG8_BAR; PG8_MMA(1, 1, At, B1); PG8_BAR;
            PG8_LDB(B0, 1, 0); PG8_SCHED; PG8_LDA(At, 1, 0); PG8_STAGE(PG8_SA(0, 1), a2 + hstep, voffA);
            PG8_WAIT_L(8); PG8_BAR; PG8_WAIT_L(0); PG8_MMA(0, 0, At, B0); PG8_BAR; PG8_SCHED;
            PG8_LDB(B1, 1, 1); PG8_STAGE(PG8_SB(1, 0), b3, voffB);
            PG8_BAR; PG8_WAIT_L(0); PG8_MMA(0, 1, At, B1); PG8_BAR;
            PG8_LDA(At, 1, 1); PG8_STAGE(PG8_SA(1, 0), a3, voffA);
            PG8_BAR; PG8_WAIT_L(0); PG8_MMA(1, 0, At, B0); PG8_BAR; PG8_SCHED;
            PG8_STAGE(PG8_SB(1, 1), b3 + hstep, voffB);
            PG8_WAIT_V(6); PG8_BAR; PG8_MMA(1, 1, At, B1); PG8_BAR;
            }
        }
        if constexpr (ALIGN_EPI) { if (wr == 0) PG8_BAR; }
        E(acc, cur, wr, wc, fr, fq);
        if (!has_next) break;
#pragma unroll
        for (int a = 0; a < 2; ++a)
#pragma unroll
            for (int b = 0; b < 2; ++b)
#pragma unroll
                for (int m = 0; m < 4; ++m)
#pragma unroll
                    for (int n = 0; n < 2; ++n) acc[a][b][m][n] = (f32x4){0.f, 0.f, 0.f, 0.f};
        cur = nxt; cA = nA; cB = nB; ++ui;
        if constexpr (ALIGN_EPI) { if (wr == 1) PG8_BAR; }
    }
    PG8_WAIT_V(0);
    if constexpr (!ALIGN_EPI) { if (wr == 0) PG8_BAR; }
    PG8_BAR;
#undef PG8_SA
#undef PG8_SB
#undef PG8_STAGE
#undef PG8_LDA
#undef PG8_LDB
#undef PG8_MMA
#undef PG8_WAIT_V
#undef PG8_WAIT_L
#undef PG8_BAR
#undef PG8_SCHED
}

struct EpiBf16 {
    static constexpr bool PERM = true;
    bf16_t* O; int ldc; const float* ssq;
    __device__ __forceinline__ void operator()(const f32x4 (&acc)[2][2][4][2], const Unit& u, int wr, int wc, int fr, int fq) const {
        const int row0 = u.pm * BM + wr * 64 + fr, col0 = u.pn * BM + wc * 32 + 8 * fq;
#pragma unroll
        for (int ai = 0; ai < 2; ++ai)
#pragma unroll
            for (int m = 0; m < 4; ++m) {
                const int row = row0 + ai * HALF + m * 16; float sc = 1.f;
                if (ssq) { const f32x4* p = (const f32x4*)(ssq + (size_t)row * 32); float s = 0.f;
#pragma unroll
                    for (int q = 0; q < 8; ++q) { const f32x4 v = p[q]; s += (v[0] + v[1]) + (v[2] + v[3]); }
                    sc = rsqrtf(s * (1.f / 2048.f) + EPS); }
                bf16_t* rowp = O + (size_t)row * ldc + col0;
#pragma unroll
                for (int bj = 0; bj < 2; ++bj) { const f32x4 v0 = acc[ai][bj][m][0] * sc, v1 = acc[ai][bj][m][1] * sc;
                    u32x4 w; w.x = cvt_pk_bf16(v0[0], v0[1]); w.y = cvt_pk_bf16(v0[2], v0[3]); w.z = cvt_pk_bf16(v1[0], v1[1]); w.w = cvt_pk_bf16(v1[2], v1[3]);
                    *(u32x4*)(rowp + bj * HALF) = w; }
            }
    }
};
struct EpiResid {
    static constexpr bool PERM = false;
    const float* basef; const bf16_t* baseb; float* out; bf16_t* hb; float* ssq;
    __device__ __forceinline__ void operator()(const f32x4 (&acc)[2][2][4][2], const Unit& u, int wr, int wc, int fr, int fq) const {
        const int row0 = u.pm * BM + wr * 64 + fr, col0 = u.pn * BM + wc * 32 + 4 * fq;
#pragma unroll
        for (int ai = 0; ai < 2; ++ai)
#pragma unroll
            for (int m = 0; m < 4; ++m) {
                const int row = row0 + ai * HALF + m * 16; const size_t off = (size_t)row * 2048 + col0; float s = 0.f;
#pragma unroll
                for (int bj = 0; bj < 2; ++bj)
#pragma unroll
                    for (int n = 0; n < 2; ++n) {
                        f32x4 b;
                        if (basef) b = *(const f32x4*)(basef + off + bj * HALF + n * 16);
                        else { const u32x2 t = *(const u32x2*)(baseb + off + bj * HALF + n * 16); b = (f32x4){bf_lo(t.x), bf_hi(t.x), bf_lo(t.y), bf_hi(t.y)}; }
                        const f32x4 o = b + acc[ai][bj][m][n];
                        if (out) *(f32x4*)(out + off + bj * HALF + n * 16) = o;
                        if (hb) { u32x2 w; w.x = cvt_pk_bf16(o[0], o[1]); w.y = cvt_pk_bf16(o[2], o[3]); *(u32x2*)(hb + off + bj * HALF + n * 16) = w;
                            s += (o[0] * o[0] + o[1] * o[1]) + (o[2] * o[2] + o[3] * o[3]); }
                    }
                if (hb) { s += __shfl_xor(s, 16); s += __shfl_xor(s, 32); if (fq == 0) ssq[(size_t)row * 32 + u.pn * 4 + wc] = s; }
            }
    }
};
struct EpiSlab {
    static constexpr bool PERM = false;
    float* slab; int ldc; size_t slab_stride;
    __device__ __forceinline__ void operator()(const f32x4 (&acc)[2][2][4][2], const Unit& u, int wr, int wc, int fr, int fq) const {
        float* base = slab + (size_t)u.ks * slab_stride; unsigned off = (unsigned)((u.pm * BM + wr * 64 + fr) * ldc + u.pn * BM + wc * 32 + 4 * fq);
#pragma unroll
        for (int ai = 0; ai < 2; ++ai)
#pragma unroll
            for (int m = 0; m < 4; ++m) { float* rowp = base + off + (unsigned)((ai * HALF + m * 16) * ldc);
#pragma unroll
                for (int bj = 0; bj < 2; ++bj)
#pragma unroll
                    for (int n = 0; n < 2; ++n) *(f32x4*)(rowp + bj * HALF + n * 16) = acc[ai][bj][m][n];
                asm volatile("" ::: "memory"); }
    }
};
struct EpiMoe1 {
    static constexpr bool PERM = true;
    bf16_t* act;
    __device__ __forceinline__ void operator()(const f32x4 (&acc)[2][2][4][2], const Unit& u, int wr, int wc, int fr, int fq) const {
        const int row0 = u.pm * BM + wr * 64 + fr, col0 = (u.pn & 3) * 128 + wc * 32 + 8 * fq;
#pragma unroll
        for (int ai = 0; ai < 2; ++ai)
#pragma unroll
            for (int m = 0; m < 4; ++m) {
                const int row = row0 + ai * HALF + m * 16; float v[8];
#pragma unroll
                for (int n = 0; n < 2; ++n)
#pragma unroll
                    for (int i = 0; i < 4; ++i) { const float gt = acc[ai][0][m][n][i], up = acc[ai][1][m][n][i]; v[n * 4 + i] = gt / (1.f + __expf(-gt)) * up; }
                *(u32x4*)(act + (size_t)row * 512 + col0) = pack8(v);
            }
    }
};
struct EpiMoe2 {
    static constexpr bool PERM = true;
    bf16_t* yb; const int* rowpair; const float* pair_w; const int* tile_e; const int* toff; const unsigned* ecnt;
    __device__ __forceinline__ void operator()(const f32x4 (&acc)[2][2][4][2], const Unit& u, int wr, int wc, int fr, int fq) const {
        const int e = tile_e[u.pm]; const int base_slot = (u.pm - toff[e]) * 256; const int cnt = (int)ecnt[e];
        const int col0 = (u.pn & 7) * 256 + wc * 32 + 8 * fq;
        int prs[8]; float pws[8];
#pragma unroll
        for (int q = 0; q < 8; ++q) { const int rr = wr * 64 + fr + (q >> 2) * HALF + (q & 3) * 16; const int rc = (base_slot + rr < cnt) ? rr : 0; prs[q] = rowpair[u.pm * 256 + rc]; }
#pragma unroll
        for (int q = 0; q < 8; ++q) pws[q] = pair_w[prs[q]];
#pragma unroll
        for (int ai = 0; ai < 2; ++ai)
#pragma unroll
            for (int m = 0; m < 4; ++m) {
                const int rr = wr * 64 + fr + ai * HALF + m * 16;
                if (base_slot + rr < cnt) {
                    const int pr = prs[ai * 4 + m]; const float w = pws[ai * 4 + m];
                    bf16_t* rowp = yb + (size_t)pr * 2048 + col0;
#pragma unroll
                    for (int bj = 0; bj < 2; ++bj) { const f32x4 v0 = acc[ai][bj][m][0] * w, v1 = acc[ai][bj][m][1] * w;
                        u32x4 x; x.x = cvt_pk_bf16(v0[0], v0[1]); x.y = cvt_pk_bf16(v0[2], v0[3]); x.z = cvt_pk_bf16(v1[0], v1[1]); x.w = cvt_pk_bf16(v1[2], v1[3]);
                        *(u32x4*)(rowp + bj * HALF) = x; }
                }
            }
    }
};
}

#define XB_TMO      128
#define XB_XCNT(j)  (256  + 64 * (j))
#define XB_XSUB(j)  (1280 + 64 * (j))
#define XB_XGEN(j)  (2304 + 64 * (j))
#define XB_TOP      3328
#define XB_TOPGEN   3392
#define XCD_BAR_WORDS 3456
#define XB_SPIN_CAP (1u << 18)
__device__ __forceinline__ unsigned xb_ld(unsigned* p)              { return __hip_atomic_load(p, __ATOMIC_RELAXED, __HIP_MEMORY_SCOPE_AGENT); }
__device__ __forceinline__ unsigned xb_add(unsigned* p, unsigned v) { return __hip_atomic_fetch_add(p, v, __ATOMIC_RELAXED, __HIP_MEMORY_SCOPE_AGENT); }
__device__ __forceinline__ unsigned xb_xcc_id() { return (unsigned)__builtin_amdgcn_s_getreg((3 << 11) | 20) & 0xFu; }
#define XB_SPIN(cond, bar) do { unsigned _sp = 0; while (cond) { __builtin_amdgcn_s_sleep(1); \
    if ((++_sp & 255u) == 0u) { if (xb_ld(&(bar)[XB_TMO])) break; if (_sp > XB_SPIN_CAP) { atomicAdd(&(bar)[XB_TMO], 1u); break; } } } } while (0)
struct XcdBarrier { unsigned* bar; unsigned x; volatile LAS unsigned* st; };
__device__ __forceinline__ XcdBarrier xcd_barrier_post(unsigned* bar, volatile LAS unsigned* st) {
    XcdBarrier b; b.bar = bar; b.x = xb_xcc_id(); b.st = st;
    if (threadIdx.x == 0) (void)xb_add(&bar[XB_XCNT(b.x)], 1u);
    return b;
}
__device__ __forceinline__ void xcd_barrier_complete(unsigned* bar, unsigned x, unsigned& nloc, unsigned& nx) {
    const unsigned G = gridDim.x * gridDim.y * gridDim.z;
    unsigned sum, cnt, mine, sp = 0u;
    for (;;) {
        sum = 0u; cnt = 0u; mine = 0u;
#pragma unroll
        for (unsigned j = 0; j < 16; ++j) { const unsigned cc = xb_ld(&bar[XB_XCNT(j)]); sum += cc; cnt += (cc > 0u) ? 1u : 0u; mine = (j == x) ? cc : mine; }
        if (sum == G) break;
        __builtin_amdgcn_s_sleep(1);
        if ((++sp & 255u) == 0u) { if (xb_ld(&bar[XB_TMO])) break; if (sp > XB_SPIN_CAP) { atomicAdd(&bar[XB_TMO], 1u); break; } }
    }
    nloc = mine > 0u ? mine : 1u; nx = cnt > 0u ? cnt : 1u;
}
__device__ __forceinline__ void xcd_barrier(const XcdBarrier& b) {
    asm volatile("s_waitcnt vmcnt(0)" ::: "memory");
    __syncthreads();
    if (threadIdx.x == 0) {
        unsigned* bar = b.bar;
        __builtin_amdgcn_s_waitcnt(0);
        unsigned nloc = b.st[0], nx = b.st[1];
        if (nloc == 0u) { xcd_barrier_complete(bar, b.x, nloc, nx); b.st[0] = nloc; b.st[1] = nx; }
        const unsigned old = xb_add(&bar[XB_XSUB(b.x)], 1u);
        const unsigned gen = old / nloc;
        if (old + 1u == (gen + 1u) * nloc) {
            __builtin_amdgcn_fence(__ATOMIC_RELEASE, "agent");
            asm volatile("s_waitcnt vmcnt(0)" ::: "memory");
            const unsigned og = xb_add(&bar[XB_TOP], 1u);
            const unsigned tg = og / nx;
            if (og + 1u == (tg + 1u) * nx) xb_add(&bar[XB_TOPGEN], 1u);
            else XB_SPIN(xb_ld(&bar[XB_TOPGEN]) == tg, bar);
            __builtin_amdgcn_fence(__ATOMIC_ACQUIRE, "agent");
            xb_add(&bar[XB_XGEN(b.x)], 1u);
            asm volatile("s_waitcnt vmcnt(0)" ::: "memory");
        } else {
            XB_SPIN(xb_ld(&bar[XB_XGEN(b.x)]) == gen, bar);
            __builtin_amdgcn_fence(__ATOMIC_ACQUIRE, "agent");
            asm volatile("s_waitcnt vmcnt(0)" ::: "memory");
        }
    }
    __syncthreads();
}

struct Ctx {
    LAS unsigned char* lds;
    int tid, lane, wave, bid, G, gw, NGW;
    unsigned char* ws; float* out;
};
#define INF(i) ((const float*)a.in[i])

struct TItem { const float* W; int ldw, k0, n0; bf16_t* WT; int K_dst; const float* kscale; };
__device__ __forceinline__ void titem_load(const TItem& t, LAS float* scr, int lane) {
#pragma unroll 8
    for (int i = 0; i < 32; ++i) { const int kk = 2 * i + (lane >> 5); scr[kk * 33 + (lane & 31)] = t.W[(size_t)(t.k0 + kk) * t.ldw + t.n0 + (lane & 31)]; }
}
__device__ __forceinline__ void titem_store(const TItem& t, const LAS float* scr, int lane) {
    const int c = lane & 7;
    f32x4 s0 = {1.f, 1.f, 1.f, 1.f}, s1 = s0;
    if (t.kscale) { s0 = *(const f32x4*)(t.kscale + t.k0 + 8 * c); s1 = *(const f32x4*)(t.kscale + t.k0 + 8 * c + 4); }
#pragma unroll
    for (int j = 0; j < 4; ++j) { const int n = (lane >> 3) + 8 * j; const LAS float* s = scr + (8 * c) * 33 + n;
        u32x4 o; o.x = cvt_pk_bf16(s[0 * 33] * s0[0], s[1 * 33] * s0[1]); o.y = cvt_pk_bf16(s[2 * 33] * s0[2], s[3 * 33] * s0[3]); o.z = cvt_pk_bf16(s[4 * 33] * s1[0], s[5 * 33] * s1[1]); o.w = cvt_pk_bf16(s[6 * 33] * s1[2], s[7 * 33] * s1[3]);
        *(u32x4*)(t.WT + (size_t)n * t.K_dst + t.k0 + 8 * c) = o; }
}
__device__ __forceinline__ TItem dense_item(const Args& a, unsigned char* ws, int it) {
    TItem t; t.kscale = nullptr; t.K_dst = 2048; int r = it;
    if (r < 6144) { const int seg = r / 3072; r -= seg * 3072; const int kb = r / 96, nb = r % 96;
        t.W = INF(4); t.ldw = DIN; t.k0 = 64 * kb; t.n0 = (seg ? 3080 : 0) + 32 * nb; t.WT = (bf16_t*)(ws + WS_WIN) + (size_t)(seg * 3072 + 32 * nb) * 2048;
    } else if (r < 8192) { r -= 6144; const int kb = r / 64, nb = r % 64; t.W = INF(11); t.ldw = 2048; t.k0 = 64 * kb; t.n0 = 32 * nb; t.WT = (bf16_t*)(ws + WS_WOUT) + (size_t)(32 * nb) * 2048;
    } else if (r < 10240) { r -= 8192; const int kb = r / 64, nb = r % 64; t.W = INF(14); t.ldw = 2048; t.k0 = 64 * kb; t.n0 = 32 * nb; t.WT = (bf16_t*)(ws + WS_WQ) + (size_t)(32 * nb) * 2048; t.kscale = INF(12);
    } else if (r < 14336) { r -= 10240; const int kb = r / 128, nb = r % 128; t.W = INF(15); t.ldw = 4096; t.k0 = 64 * kb; t.n0 = 32 * nb; t.WT = (bf16_t*)(ws + WS_WKV) + (size_t)(32 * nb) * 2048;
    } else { r -= 14336; const int kb = r / 64, nb = r % 64; t.W = INF(18); t.ldw = 2048; t.k0 = 64 * kb; t.n0 = 32 * nb; t.WT = (bf16_t*)(ws + WS_WO) + (size_t)(32 * nb) * 2048; }
    return t;
}

__device__ __forceinline__ void phase0(const Args& a, const Ctx& c) {
    unsigned char* ws = c.ws;
    LAS float* scr = (LAS float*)(c.lds + c.wave * 17408);
    constexpr int N_DENSE = 16384;
    for (int it = c.gw; it < N_DENSE; it += 2 * c.NGW) {
        const TItem t0 = dense_item(a, ws, it); const bool two = (it + c.NGW < N_DENSE); const TItem t1 = dense_item(a, ws, two ? it + c.NGW : it);
        titem_load(t0, scr, c.lane); if (two) titem_load(t1, scr + 64 * 33, c.lane);
        LDS_WAIT();
        titem_store(t0, scr, c.lane); if (two) titem_store(t1, scr + 64 * 33, c.lane);
        LDS_WAIT();
    }
    {
        bf16_t* WR = (bf16_t*)(ws + WS_MISC + MO_WR);
        const float* gf = INF(19); const float* wg = INF(20); const float* we = INF(22);
        for (int i = c.bid * 512 + c.tid; i < 2048 * 80; i += c.G * 512) { const int j = i / 2048, k = i % 2048;
            float v = 0.f; if (j < 8) v = wg[k * 8 + j]; else if (j < 72) v = we[k * 64 + (j - 8)];
            v *= gf[k]; const bf16_t hi = f2bf(v); const bf16_t lo = f2bf(v - bf1(hi));
            WR[i] = hi; WR[80 * 2048 + i] = lo; }
        if (c.bid == 0 && c.tid < 256) { ((unsigned*)(ws + WS_CTL))[CW_ECNT + c.tid] = 0u; ((unsigned*)(ws + WS_CTL))[CW_BCNT + c.tid] = 0u; }
    }
    __syncthreads();
    {
        LAS float* wgl = (LAS float*)c.lds; const float* win = INF(4); const float* gm = INF(3);
        for (int idx = c.tid; idx < 4096; idx += 512) { const int k = idx >> 1, hf = idx & 1;
            f32x4 v = *(const f32x4*)(win + (size_t)k * DIN + 3072 + 4 * hf); v = v * gm[k];
            const int j = k >> 8, l = (k >> 2) & 63, i = k & 3;
            *(LAS f32x4*)(wgl + (((i * 8 + j) * 64 + l) * 8 + 4 * hf)) = v; }
    }
    __syncthreads();
    {
        const LAS float* wgl = (const LAS float*)c.lds; const float* gm = INF(3); const float* x = INF(0); const float* gb = INF(5);
        bf16_t* XN = (bf16_t*)(ws + WS_XN); float* GATES = (float*)(ws + WS_MISC + MO_GATES);
        f32x4 g4[8];
#pragma unroll
        for (int j = 0; j < 8; ++j) g4[j] = *(const f32x4*)(gm + 256 * j + 4 * c.lane);
        for (int m0 = c.gw; m0 < S; m0 += 2 * c.NGW) {
            f32x4 v2[2][8];
#pragma unroll
            for (int rr = 0; rr < 2; ++rr) { const f32x4* xr = (const f32x4*)(x + (size_t)(m0 + rr * c.NGW) * D) + c.lane;
#pragma unroll
                for (int j = 0; j < 8; ++j) v2[rr][j] = xr[64 * j]; }
#pragma unroll
            for (int rr = 0; rr < 2; ++rr) {
                const int m = m0 + rr * c.NGW; float ss = 0.f; float ga[8];
#pragma unroll
                for (int q = 0; q < 8; ++q) ga[q] = 0.f;
#pragma unroll
                for (int j = 0; j < 8; ++j) ss += (v2[rr][j][0] * v2[rr][j][0] + v2[rr][j][1] * v2[rr][j][1]) + (v2[rr][j][2] * v2[rr][j][2] + v2[rr][j][3] * v2[rr][j][3]);
#pragma unroll
                for (int j = 0; j < 8; ++j) {
                    asm volatile("" ::: "memory");
#pragma unroll
                    for (int i = 0; i < 4; ++i) { const LAS f32x4* wp = (const LAS f32x4*)(wgl + ((i * 8 + j) * 64 + c.lane) * 8); const f32x4 w0 = wp[0], w1 = wp[1]; const float xv = v2[rr][j][i];
                        ga[0] += xv * w0[0]; ga[1] += xv * w0[1]; ga[2] += xv * w0[2]; ga[3] += xv * w0[3]; ga[4] += xv * w1[0]; ga[5] += xv * w1[1]; ga[6] += xv * w1[2]; ga[7] += xv * w1[3]; }
                }
                ss = wave_sum(ss); const float rstd = rsqrtf(ss * (1.f / D) + EPS);
#pragma unroll
                for (int q = 0; q < 8; ++q) ga[q] = wave_sum(ga[q]);
                if (c.lane < 8) { float gv = ga[0];
#pragma unroll
                    for (int q = 1; q < 8; ++q) gv = (c.lane == q) ? ga[q] : gv;
                    GATES[(size_t)m * 8 + c.lane] = gv * rstd + gb[c.lane]; }
                u32x2* o8 = (u32x2*)(XN + (size_t)m * D) + c.lane;
#pragma unroll
                for (int j = 0; j < 8; ++j) { const f32x4 y = v2[rr][j] * rstd * g4[j]; u32x2 w; w.x = cvt_pk_bf16(y[0], y[1]); w.y = cvt_pk_bf16(y[2], y[3]); o8[64 * j] = w; }
            }
        }
        const float* mem = INF(1); const float* gmem = INF(13); bf16_t* MEMN = (bf16_t*)(ws + WS_MEMN);
        for (int m = c.gw; m < MEML; m += c.NGW) {
            const f32x4* xr = (const f32x4*)(mem + (size_t)m * D) + c.lane; f32x4 v[8]; float ss = 0.f;
#pragma unroll
            for (int j = 0; j < 8; ++j) { v[j] = xr[64 * j]; ss += (v[j][0] * v[j][0] + v[j][1] * v[j][1]) + (v[j][2] * v[j][2] + v[j][3] * v[j][3]); }
            ss = wave_sum(ss); const float rstd = rsqrtf(ss * (1.f / D) + EPS);
            u32x2* o8 = (u32x2*)(MEMN + (size_t)m * D) + c.lane;
#pragma unroll
            for (int j = 0; j < 8; ++j) { const f32x4 gg = *(const f32x4*)(gmem + 256 * j + 4 * c.lane); const f32x4 y = v[j] * rstd * gg; u32x2 w; w.x = cvt_pk_bf16(y[0], y[1]); w.y = cvt_pk_bf16(y[2], y[3]); o8[64 * j] = w; }
        }
    }
}

__device__ __forceinline__ void prep_mlstm(const Args& a, const Ctx& c, int h, int ch) {
    unsigned char* ws = c.ws; const int t0 = ch * 128;
    const float* GATES = (const float*)(ws + WS_MISC + MO_GATES);
    float* BV = (float*)(ws + WS_MISC + MO_BV); float* UV = (float*)(ws + WS_MISC + MO_UV); float* PMX = (float*)(ws + WS_MISC + MO_PMX);
    float* GC = (float*)(ws + WS_MISC + MO_GC); float* AMAX = (float*)(ws + WS_MISC + MO_AMAX);
    const bf16_t* PROJ = (const bf16_t*)(ws + WS_PROJ);
    LAS float* sc_w = (LAS float*)c.lds;
    LAS bf16_t* kws = (LAS bf16_t*)(c.lds + 1024);
    LAS bf16_t* vs = (LAS bf16_t*)(c.lds + 1024 + 128 * 260);
    u32x4 vraw[8];
    { const int t_ = c.tid >> 2, part_ = c.tid & 3;
#pragma unroll
      for (int q = 0; q < 8; ++q) vraw[q] = *(const u32x4*)(PROJ + (size_t)(t0 + t_) * NPROJ + PC_MV + h * 256 + part_ * 64 + 8 * q); }
    if (c.wave == 0) {
        const int l = c.lane; const int ta = 2 * l, tb = 2 * l + 1;
        const float i0 = GATES[(size_t)(t0 + ta) * 8 + h], f0 = GATES[(size_t)(t0 + ta) * 8 + 4 + h];
        const float i1 = GATES[(size_t)(t0 + tb) * 8 + h], f1 = GATES[(size_t)(t0 + tb) * 8 + 4 + h];
        const float lf0 = fminf(f0, 0.f) - log1pf(__expf(-fabsf(f0))), lf1 = fminf(f1, 0.f) - log1pf(__expf(-fabsf(f1)));
        float incl = lf0 + lf1;
#pragma unroll
        for (int o = 1; o < 64; o <<= 1) { const float t = __shfl_up(incl, o); if (l >= o) incl += t; }
        const float excl = incl - (lf0 + lf1);
        const float b0 = excl + lf0, b1 = excl + lf0 + lf1;
        const float u0 = i0 - b0, u1 = i1 - b1;
        float pm = fmaxf(u0, u1);
#pragma unroll
        for (int o = 1; o < 64; o <<= 1) { const float t = __shfl_up(pm, o); if (l >= o) pm = fmaxf(pm, t); }
        float pme = __shfl_up(pm, 1); if (l == 0) pme = -INFINITY;
        const float p0 = fmaxf(pme, u0), p1 = pm;
        const float ptot = __shfl(pm, 63), gtot = __shfl(b1, 63);
        BV[h * S + t0 + ta] = b0; BV[h * S + t0 + tb] = b1; UV[h * S + t0 + ta] = u0; UV[h * S + t0 + tb] = u1; PMX[h * S + t0 + ta] = p0; PMX[h * S + t0 + tb] = p1;
        sc_w[ta] = __expf(u0 - ptot); sc_w[tb] = __expf(u1 - ptot);
        if (l == 63) { GC[h * 64 + ch] = gtot; AMAX[h * 64 + ch] = gtot + ptot; }
    }
    __syncthreads();
    {
        const float* cw = INF(6); const float* cb = INF(7);
        bf16_t* QC = (bf16_t*)(ws + WS_QC); bf16_t* KC = (bf16_t*)(ws + WS_KC);
        const int t = c.tid >> 2, qt = c.tid & 3; const float ws_ = sc_w[t];
#pragma unroll
        for (int qk = 0; qk < 2; ++qk)
#pragma unroll
            for (int gq = 0; gq < 4; ++gq) {
                const int ch0 = qt * 32 + 8 * gq; const int cch = qk * 512 + h * 128 + ch0; const int pcol = (qk ? PC_MK : PC_MQ) + h * 128 + ch0;
                float y[8];
#pragma unroll
                for (int i = 0; i < 8; ++i) y[i] = cb[cch + i];
#pragma unroll
                for (int j = 0; j < 4; ++j) { const int tr = t0 + t - 3 + j; const float msk = tr >= 0 ? 1.f : 0.f;
                    float xv[8]; unpack8(*(const u32x4*)(PROJ + (size_t)(tr < 0 ? 0 : tr) * NPROJ + pcol), xv);
#pragma unroll
                    for (int i = 0; i < 8; ++i) y[i] += cw[j * 1024 + cch + i] * (xv[i] * msk); }
#pragma unroll
                for (int i = 0; i < 8; ++i) y[i] = y[i] / (1.f + __expf(-y[i]));
                if (qk == 0) {
#pragma unroll
                    for (int i = 0; i < 8; ++i) y[i] *= 0.08838834764831845f;
                    *(u32x4*)(QC + ((size_t)(h * S + t0 + t)) * 128 + ch0) = pack8(y);
                } else {
                    *(u32x4*)(KC + ((size_t)(h * S + t0 + t)) * 128 + ch0) = pack8(y);
#pragma unroll
                    for (int i = 0; i < 8; ++i) kws[t * 130 + ch0 + i] = f2bf(y[i] * ws_);
                }
            }
        const int part = c.tid & 3;
#pragma unroll
        for (int q = 0; q < 8; ++q) { const int dv0 = part * 64 + 8 * q;
            *(LAS u32x4*)(vs + t * 264 + dv0) = vraw[q]; }
    }
    __syncthreads();
    {
        bf16_t* KWT = (bf16_t*)(ws + WS_KWT); bf16_t* VT = (bf16_t*)(ws + WS_VT);
        const int d = c.tid >> 2, sq = c.tid & 3;
#pragma unroll
        for (int gq = 0; gq < 4; ++gq) { const int s0 = sq * 32 + 8 * gq; u32x4 o;
            o.x = (unsigned)kws[(s0 + 0) * 130 + d] | ((unsigned)kws[(s0 + 1) * 130 + d] << 16); o.y = (unsigned)kws[(s0 + 2) * 130 + d] | ((unsigned)kws[(s0 + 3) * 130 + d] << 16);
            o.z = (unsigned)kws[(s0 + 4) * 130 + d] | ((unsigned)kws[(s0 + 5) * 130 + d] << 16); o.w = (unsigned)kws[(s0 + 6) * 130 + d] | ((unsigned)kws[(s0 + 7) * 130 + d] << 16);
            *(u32x4*)(KWT + ((size_t)((h * 64 + ch) * 128 + d)) * 128 + s0) = o; }
        const int dv = c.tid >> 1, hf = c.tid & 1;
#pragma unroll
        for (int gq = 0; gq < 8; ++gq) { const int s0 = hf * 64 + 8 * gq; u32x4 o;
            o.x = (unsigned)vs[(s0 + 0) * 264 + dv] | ((unsigned)vs[(s0 + 1) * 264 + dv] << 16); o.y = (unsigned)vs[(s0 + 2) * 264 + dv] | ((unsigned)vs[(s0 + 3) * 264 + dv] << 16);
            o.z = (unsigned)vs[(s0 + 4) * 264 + dv] | ((unsigned)vs[(s0 + 5) * 264 + dv] << 16); o.w = (unsigned)vs[(s0 + 6) * 264 + dv] | ((unsigned)vs[(s0 + 7) * 264 + dv] << 16);
            *(u32x4*)(VT + ((size_t)((h * 64 + ch) * DVP + dv)) * 128 + s0) = o; }
        if (c.tid < 256) { const int row = 256 + (c.tid >> 4), ck = c.tid & 15; const unsigned val = (row == 256) ? 0x3F803F80u : 0u;
            *(u32x4*)(VT + ((size_t)((h * 64 + ch) * DVP + row)) * 128 + 8 * ck) = (u32x4){val, val, val, val}; }
    }
    __syncthreads();
}

__device__ __forceinline__ void prep_moba(const Args& a, const Ctx& c, int h, int jb) {
    unsigned char* ws = c.ws; const int t0 = jb * 256;
    const bf16_t* PROJ = (const bf16_t*)(ws + WS_PROJ); const int* pos = (const int*)a.in[2];
    bf16_t* QP = (bf16_t*)(ws + WS_QP); bf16_t* KP = (bf16_t*)(ws + WS_KP); bf16_t* VTP = (bf16_t*)(ws + WS_VTP); float* KMEAN = (float*)(ws + WS_MISC + MO_KMEAN);
    LAS float* red = (LAS float*)c.lds;
    LAS bf16_t* vs = (LAS bf16_t*)(c.lds + 16384);
    const int li = c.tid & 15, rg = c.tid >> 4, d0 = 8 * li;
    float qg[8], kg[8], kacc[8];
#pragma unroll
    for (int i = 0; i < 8; ++i) { qg[i] = INF(9)[d0 + i]; kg[i] = INF(10)[d0 + i]; kacc[i] = 0.f; }
    float invf[8];
#pragma unroll
    for (int i = 0; i < 8; ++i) { const int fi = (li & 1) * 8 + i; invf[i] = exp2f(-(float)fi * (18.931568569324174f / 16.f)); }
    u32x4 rawq[8], rawk[8], rawv[8]; float fposa[8];
#pragma unroll
    for (int p = 0; p < 8; ++p) { const int row = p * 32 + rg; const size_t prow = (size_t)(t0 + row) * NPROJ + h * 128 + d0;
        rawq[p] = *(const u32x4*)(PROJ + prow + PC_AQ); rawk[p] = *(const u32x4*)(PROJ + prow + PC_AK); rawv[p] = *(const u32x4*)(PROJ + prow + PC_AV); fposa[p] = (float)pos[t0 + row]; }
#pragma unroll
    for (int p = 0; p < 8; ++p) {
        const int row = p * 32 + rg;
        const float fpos = fposa[p];
        float cs[8], sn[8];
        if (li < 4) {
#pragma unroll
            for (int i = 0; i < 8; ++i) { float s_, c_; sincosf(fpos * invf[i], &s_, &c_); cs[i] = c_; sn[i] = s_; }
        } else {
#pragma unroll
            for (int i = 0; i < 8; ++i) { cs[i] = 1.f; sn[i] = 0.f; }
        }
#pragma unroll
        for (int qk = 0; qk < 2; ++qk) {
            float x[8]; unpack8(qk ? rawk[p] : rawq[p], x);
            float ss = 0.f;
#pragma unroll
            for (int i = 0; i < 8; ++i) ss += x[i] * x[i];
            ss += __shfl_xor(ss, 1); ss += __shfl_xor(ss, 2); ss += __shfl_xor(ss, 4); ss += __shfl_xor(ss, 8);
            const float rstd = rsqrtf(ss * (1.f / 128.f) + EPS);
            float y[8];
#pragma unroll
            for (int i = 0; i < 8; ++i) y[i] = x[i] * rstd * (qk ? kg[i] : qg[i]);
            float o[8];
#pragma unroll
            for (int i = 0; i < 8; ++i) { const float ot = __shfl_xor(y[i], 2); o[i] = (li < 2) ? (y[i] * cs[i] - ot * sn[i]) : (li < 4 ? (y[i] * cs[i] + ot * sn[i]) : y[i]); }
            if (qk == 0) *(u32x4*)(QP + ((size_t)(h * S + t0 + row)) * 128 + d0) = pack8(o);
            else { *(u32x4*)(KP + ((size_t)(h * S + t0 + row)) * 128 + d0) = pack8(o);
#pragma unroll
                for (int i = 0; i < 8; ++i) kacc[i] += o[i]; }
        }
        *(LAS u32x4*)(vs + row * 136 + d0) = rawv[p];
    }
#pragma unroll
    for (int i = 0; i < 8; ++i) red[rg * 128 + d0 + i] = kacc[i];
    __syncthreads();
    if (c.tid < 128) { float s = 0.f;
#pragma unroll 8
        for (int r = 0; r < 32; ++r) s += red[r * 128 + c.tid];
        KMEAN[(h * 32 + jb) * 128 + c.tid] = s * (1.f / 256.f); }
    {
        const int d = c.tid >> 2, sq = c.tid & 3;
#pragma unroll
        for (int gq = 0; gq < 8; ++gq) { const int s0 = sq * 64 + 8 * gq; u32x4 o;
            o.x = (unsigned)vs[(s0 + 0) * 136 + d] | ((unsigned)vs[(s0 + 1) * 136 + d] << 16); o.y = (unsigned)vs[(s0 + 2) * 136 + d] | ((unsigned)vs[(s0 + 3) * 136 + d] << 16);
            o.z = (unsigned)vs[(s0 + 4) * 136 + d] | ((unsigned)vs[(s0 + 5) * 136 + d] << 16); o.w = (unsigned)vs[(s0 + 6) * 136 + d] | ((unsigned)vs[(s0 + 7) * 136 + d] << 16);
            *(u32x4*)(VTP + ((size_t)((h * 32 + jb) * 128 + d)) * 256 + s0) = o; }
    }
    __syncthreads();
}

__device__ __forceinline__ void prep_xamem(const Args& a, const Ctx& c) {
    unsigned char* ws = c.ws; const float* SL = (const float*)(ws + WS_KVSLAB);
    bf16_t* KM = (bf16_t*)(ws + WS_KM); bf16_t* VTM = (bf16_t*)(ws + WS_VTM); const float* kg = INF(17);
    for (int it = c.gw; it < 1024; it += c.NGW) { const int m = it >> 2, h = it & 3;
        float x[8];
#pragma unroll
        for (int i = 0; i < 8; ++i) x[i] = 0.f;
#pragma unroll
        for (int sp = 0; sp < 8; ++sp) { const f32x4* p = (const f32x4*)(SL + ((size_t)(sp * 256 + m)) * 4096 + h * 512 + 8 * c.lane); const f32x4 v0 = p[0], v1 = p[1];
            x[0] += v0[0]; x[1] += v0[1]; x[2] += v0[2]; x[3] += v0[3]; x[4] += v1[0]; x[5] += v1[1]; x[6] += v1[2]; x[7] += v1[3]; }
        float ss = 0.f;
#pragma unroll
        for (int i = 0; i < 8; ++i) ss += x[i] * x[i];
        ss = wave_sum(ss); const float rstd = rsqrtf(ss * (1.f / 512.f) + EPS);
#pragma unroll
        for (int i = 0; i < 8; ++i) x[i] = x[i] * rstd * kg[8 * c.lane + i];
        *(u32x4*)(KM + ((size_t)(h * 256 + m)) * 512 + 8 * c.lane) = pack8(x); }
    for (int idx = c.bid * 512 + c.tid; idx < 65536; idx += c.G * 512) { const int d = idx & 511, mg = (idx >> 9) & 31, h = idx >> 14;
        float v[8];
#pragma unroll
        for (int j = 0; j < 8; ++j) { float t = 0.f;
#pragma unroll
            for (int sp = 0; sp < 8; ++sp) t += SL[((size_t)(sp * 256 + 8 * mg + j)) * 4096 + 2048 + h * 512 + d];
            v[j] = t; }
        *(u32x4*)(VTM + ((size_t)(h * 512 + d)) * 256 + 8 * mg) = pack8(v); }
}

__device__ __forceinline__ void tile256_load(LAS unsigned char* dst, const bf16_t* src, size_t src_ld, int nrows, int tid) {
    for (int idx = tid; idx < nrows * 16; idx += 512) { const int row = idx >> 4, ck = idx & 15;
        *(LAS u32x4*)(dst + row * 256 + ((ck ^ (row & 15)) << 4)) = *(const u32x4*)(src + (size_t)row * src_ld + 8 * ck); }
}
__device__ __forceinline__ bf16x8 tile256_frag(const LAS unsigned char* t, int row, int ck) { return *(const LAS bf16x8*)(t + row * 256 + ((ck ^ (row & 15)) << 4)); }

__device__ __forceinline__ void mlstm_local(const Ctx& c, int h, int ch) {
    unsigned char* ws = c.ws; const bf16_t* KWT = (const bf16_t*)(ws + WS_KWT); const bf16_t* VT = (const bf16_t*)(ws + WS_VT); float* CTL = (float*)(ws + WS_CTL_LOC);
    const int tt = c.lane & 15, g = c.lane >> 4, w = c.wave, t0 = ch * 128;
    tile256_load(c.lds, VT + (size_t)(h * 64 + ch) * DVP * 128, 128, DVP, c.tid);
    bf16x8 bfr[4];
#pragma unroll
    for (int ks = 0; ks < 4; ++ks) bfr[ks] = *(const bf16x8*)(KWT + ((size_t)((h * 64 + ch) * 128 + 16 * w + tt)) * 128 + 32 * ks + 8 * g);
    __syncthreads();
#pragma unroll
    for (int mt = 0; mt < 17; ++mt) {
        f32x4 acc = {0.f, 0.f, 0.f, 0.f};
#pragma unroll
        for (int ks = 0; ks < 4; ++ks) acc = mfma16(tile256_frag(c.lds, 16 * mt + tt, 4 * ks + g), bfr[ks], acc);
#pragma unroll
        for (int r = 0; r < 4; ++r) CTL[((size_t)((h * 64 + ch) * DVP + 16 * mt + 4 * g + r)) * 128 + 16 * w + tt] = acc[r];
    }
    __syncthreads();
}

#define MOBA_LOAD_KV(jb, K_, V_) do { const int kb_ = (jb) * 256; \
        _Pragma("unroll") for (int tq = 0; tq < 2; ++tq) _Pragma("unroll") for (int ks = 0; ks < 4; ++ks) \
            K_[tq][ks] = *(const bf16x8*)(KP + ((size_t)(h * S + kb_ + 32 * w + pi32(tq, tt))) * 128 + 32 * ks + 8 * g); \
        _Pragma("unroll") for (int ks = 0; ks < 8; ++ks) V_[ks] = *(const bf16x8*)(VTP + ((size_t)((h * 32 + (jb)) * 128 + 16 * w + tt)) * 256 + 32 * ks + 8 * g); } while (0)

#define MOBA_TOUCH_KV(K_, V_) do { _Pragma("unroll") for (int tq = 0; tq < 2; ++tq) _Pragma("unroll") for (int ks = 0; ks < 4; ++ks) asm volatile("" : "+v"(K_[tq][ks])); \
        _Pragma("unroll") for (int ks = 0; ks < 8; ++ks) asm volatile("" : "+v"(V_[ks])); } while (0)
__device__ __forceinline__ void moba_select(const Ctx& c, int h, int cb, int half) {
    unsigned char* ws = c.ws;
    const bf16_t* QP = (const bf16_t*)(ws + WS_QP); const float* KMEAN = (const float*)(ws + WS_MISC + MO_KMEAN);
    unsigned* BCNT = (unsigned*)(ws + WS_CTL) + CW_BCNT; unsigned short* BLIST = (unsigned short*)(ws + WS_BLIST); int* PSLOT = (int*)(ws + WS_PSLOT);
    LAS unsigned char* Qs = c.lds;
    LAS float* km = (LAS float*)(c.lds + 34816);
    LAS int* cnt = (LAS int*)(c.lds + 34816 + 16384);
    LAS int* gbase = cnt + 32;
    const int tid = c.tid, q0 = cb * 256 + half * 128;
    const int q = tid >> 2, sub = tid & 3;
    if (cb == 0) { if (sub == 0) { int* ps = PSLOT + ((size_t)(h * S + q0 + q)) * 3; ps[0] = -1; ps[1] = -1; ps[2] = -1; } return; }
    for (int i = tid; i < 128 * 16; i += 512) { const int r = i >> 4, ck = i & 15; *(LAS u32x4*)(Qs + r * 272 + ck * 16) = *(const u32x4*)(QP + ((size_t)(h * S + q0 + r)) * 128 + 8 * ck); }
    if (tid < 32) cnt[tid] = 0;
    { const f32x4* src = (const f32x4*)(KMEAN + (size_t)h * 32 * 128); for (int i = tid; i < cb * 32; i += 512) ((LAS f32x4*)km)[i] = src[i]; }
    __syncthreads();
    float bv0 = -INFINITY, bv1 = -INFINITY, bv2 = -INFINITY; int bi0 = 255, bi1 = 255, bi2 = 255;
    {
        float qv[128];
#pragma unroll
        for (int ck = 0; ck < 16; ++ck) { float t8[8]; unpack8(*(const LAS u32x4*)(Qs + q * 272 + ck * 16), t8);
#pragma unroll
            for (int i = 0; i < 8; ++i) qv[ck * 8 + i] = t8[i]; }
        for (int j = sub; j < cb; j += 4) {
            float s = 0.f;
#pragma unroll
            for (int d4 = 0; d4 < 32; ++d4) { const f32x4 kv = *(const LAS f32x4*)(km + j * 128 + 4 * d4); s += qv[4 * d4] * kv[0] + qv[4 * d4 + 1] * kv[1] + qv[4 * d4 + 2] * kv[2] + qv[4 * d4 + 3] * kv[3]; }
            if (s > bv0) { bv2 = bv1; bi2 = bi1; bv1 = bv0; bi1 = bi0; bv0 = s; bi0 = j; }
            else if (s > bv1) { bv2 = bv1; bi2 = bi1; bv1 = s; bi1 = j; }
            else if (s > bv2) { bv2 = s; bi2 = j; }
        }
    }
#pragma unroll
    for (int o = 1; o <= 2; o <<= 1) {
        const float ov0 = __shfl_xor(bv0, o), ov1 = __shfl_xor(bv1, o), ov2 = __shfl_xor(bv2, o);
        const int oi0 = __shfl_xor(bi0, o), oi1 = __shfl_xor(bi1, o), oi2 = __shfl_xor(bi2, o);
        float nv[3] = {ov0, ov1, ov2}; int ni[3] = {oi0, oi1, oi2};
#pragma unroll
        for (int k = 0; k < 3; ++k) { const float sv = nv[k]; const int j = ni[k];
            const bool b0 = (sv > bv0) || (sv == bv0 && j < bi0), b1 = (sv > bv1) || (sv == bv1 && j < bi1), b2 = (sv > bv2) || (sv == bv2 && j < bi2);
            if (b0) { bv2 = bv1; bi2 = bi1; bv1 = bv0; bi1 = bi0; bv0 = sv; bi0 = j; }
            else if (b1) { bv2 = bv1; bi2 = bi1; bv1 = sv; bi1 = j; }
            else if (b2) { bv2 = sv; bi2 = j; } }
    }
    int p0 = -1, p1 = -1, p2 = -1;
    if (sub == 0) {
        if (bi0 < cb) p0 = __hip_atomic_fetch_add(cnt + bi0, 1, __ATOMIC_RELAXED, __HIP_MEMORY_SCOPE_WORKGROUP);
        if (bi1 < cb) p1 = __hip_atomic_fetch_add(cnt + bi1, 1, __ATOMIC_RELAXED, __HIP_MEMORY_SCOPE_WORKGROUP);
        if (bi2 < cb) p2 = __hip_atomic_fetch_add(cnt + bi2, 1, __ATOMIC_RELAXED, __HIP_MEMORY_SCOPE_WORKGROUP);
    }
    __syncthreads();
    if (tid < cb) { const int cn = cnt[tid]; gbase[tid] = cn > 0 ? (int)__hip_atomic_fetch_add(BCNT + h * 32 + tid, (unsigned)cn, __ATOMIC_RELAXED, __HIP_MEMORY_SCOPE_AGENT) : 0; }
    __syncthreads();
    if (sub == 0) {
        int* ps = PSLOT + ((size_t)(h * S + q0 + q)) * 3; const unsigned short qq = (unsigned short)(q0 + q);
        if (p0 >= 0) { const int pos = gbase[bi0] + p0; BLIST[(size_t)(h * 32 + bi0) * 8192 + pos] = qq; ps[0] = (bi0 << 16) | pos; } else ps[0] = -1;
        if (p1 >= 0) { const int pos = gbase[bi1] + p1; BLIST[(size_t)(h * 32 + bi1) * 8192 + pos] = qq; ps[1] = (bi1 << 16) | pos; } else ps[1] = -1;
        if (p2 >= 0) { const int pos = gbase[bi2] + p2; BLIST[(size_t)(h * 32 + bi2) * 8192 + pos] = qq; ps[2] = (bi2 << 16) | pos; } else ps[2] = -1;
    }
    __syncthreads();
}

#define MOBA_TILE_PAIR(two, qrA, qrB, okA, okB, own, qlocA, qlocB, nkw) \
    f32x4 oA0 = {0.f, 0.f, 0.f, 0.f}, oA1 = oA0, oB0 = oA0, oB1 = oA0; float ltA = 0.f, ltB = 0.f; \
    { if (w < (nkw)) { \
        f32x4 sA0 = {0.f, 0.f, 0.f, 0.f}, sA1 = sA0, sB0 = sA0, sB1 = sA0; \
        _Pragma("unroll") for (int ks = 0; ks < 4; ++ks) { const bf16x8 qf = *(const LAS bf16x8*)(Qs + (qrA) * 272 + (32 * ks + 8 * g) * 2); sA0 = mfma16(Kc[0][ks], qf, sA0); sA1 = mfma16(Kc[1][ks], qf, sA1); } \
        if (two) { _Pragma("unroll") for (int ks = 0; ks < 4; ++ks) { const bf16x8 qf = *(const LAS bf16x8*)(Qs + (qrB) * 272 + (32 * ks + 8 * g) * 2); sB0 = mfma16(Kc[0][ks], qf, sB0); sB1 = mfma16(Kc[1][ks], qf, sB1); } } \
        const int kloc = 32 * w + 8 * g; \
        { float p[8]; float lsum = 0.f; \
          _Pragma("unroll") for (int r = 0; r < 4; ++r) { p[r] = __expf(sA0[r] * 0.08838834764831845f); p[4 + r] = __expf(sA1[r] * 0.08838834764831845f); } \
          _Pragma("unroll") for (int i = 0; i < 8; ++i) { const bool ok = (okA) && (!(own) || (kloc + i <= (qlocA))); p[i] = ok ? p[i] : 0.f; lsum += p[i]; } \
          lsum += __shfl_xor(lsum, 16); lsum += __shfl_xor(lsum, 32); \
          *(LAS u32x4*)(Pb + (buf * 2 + 0) * 8192 + w * 1024 + lane * 16) = pack8(p); \
          if (g == 0) lpart[((buf * 2 + 0) * 8 + w) * 16 + tt] = lsum; } \
        if (two) { float p[8]; float lsum = 0.f; \
          _Pragma("unroll") for (int r = 0; r < 4; ++r) { p[r] = __expf(sB0[r] * 0.08838834764831845f); p[4 + r] = __expf(sB1[r] * 0.08838834764831845f); } \
          _Pragma("unroll") for (int i = 0; i < 8; ++i) { const bool ok = (okB) && (!(own) || (kloc + i <= (qlocB))); p[i] = ok ? p[i] : 0.f; lsum += p[i]; } \
          lsum += __shfl_xor(lsum, 16); lsum += __shfl_xor(lsum, 32); \
          *(LAS u32x4*)(Pb + (buf * 2 + 1) * 8192 + w * 1024 + lane * 16) = pack8(p); \
          if (g == 0) lpart[((buf * 2 + 1) * 8 + w) * 16 + tt] = lsum; } \
      } \
      LDS_WAIT(); __builtin_amdgcn_s_barrier(); asm volatile("" ::: "memory"); \
      _Pragma("unroll") for (int ks = 0; ks < 8; ks += 2) if (ks < (nkw)) { \
          const bf16x8 pa = *(const LAS bf16x8*)(Pb + (buf * 2 + 0) * 8192 + ks * 1024 + lane * 16), pb = *(const LAS bf16x8*)(Pb + (buf * 2 + 0) * 8192 + (ks + 1) * 1024 + lane * 16); \
          oA0 = mfma16(Vc[ks], pa, oA0); oA1 = mfma16(Vc[ks + 1], pb, oA1); } \
      _Pragma("unroll") for (int ww = 0; ww < 8; ++ww) if (ww < (nkw)) ltA += lpart[((buf * 2 + 0) * 8 + ww) * 16 + tt]; \
      if (two) { \
          _Pragma("unroll") for (int ks = 0; ks < 8; ks += 2) if (ks < (nkw)) { \
              const bf16x8 pa = *(const LAS bf16x8*)(Pb + (buf * 2 + 1) * 8192 + ks * 1024 + lane * 16), pb = *(const LAS bf16x8*)(Pb + (buf * 2 + 1) * 8192 + (ks + 1) * 1024 + lane * 16); \
              oB0 = mfma16(Vc[ks], pa, oB0); oB1 = mfma16(Vc[ks + 1], pb, oB1); } \
          _Pragma("unroll") for (int ww = 0; ww < 8; ++ww) if (ww < (nkw)) ltB += lpart[((buf * 2 + 1) * 8 + ww) * 16 + tt]; } \
      oA0 = oA0 + oA1; oB0 = oB0 + oB1; buf ^= 1; }

__device__ __forceinline__ void moba_bucket_phase(const Ctx& c) {
    unsigned char* ws = c.ws;
    const bf16_t* QP = (const bf16_t*)(ws + WS_QP); const bf16_t* KP = (const bf16_t*)(ws + WS_KP); const bf16_t* VTP = (const bf16_t*)(ws + WS_VTP);
    unsigned* BCNT = (unsigned*)(ws + WS_CTL) + CW_BCNT; const unsigned short* BLIST = (const unsigned short*)(ws + WS_BLIST);
    bf16_t* PART = (bf16_t*)(ws + WS_PART); float* LPART = (float*)(ws + WS_LPART); int* POFF = (int*)(ws + WS_POFF);
    LAS unsigned char* Qs = c.lds;
    LAS unsigned char* Pb = c.lds + 34816;
    LAS float* lpart = (LAS float*)(c.lds + 34816 + 32768);
    LAS int* cnts = (LAS int*)(c.lds + 34816 + 32768 + 2048);
    LAS int* ipre = cnts + 256;
    LAS int* ppre = ipre + 260;
    LAS int* wsum = ppre + 260;
    LAS int* selb = wsum + 16;
    const int tid = c.tid, lane = c.lane, w = c.wave, tt = lane & 15, g = lane >> 4;
    {
        int cn = 0, nch = 0, pp = 0;
        if (tid < 256) { cn = (int)__hip_atomic_load(BCNT + tid, __ATOMIC_RELAXED, __HIP_MEMORY_SCOPE_AGENT); nch = (cn + 127) >> 7; pp = (cn + 15) & ~15; cnts[tid] = cn; }
        int i1 = nch, i2 = pp;
#pragma unroll
        for (int o = 1; o < 64; o <<= 1) { const int t1 = __shfl_up(i1, o), t2 = __shfl_up(i2, o); if (lane >= o) { i1 += t1; i2 += t2; } }
        if (lane == 63 && w < 4) { wsum[w] = i1; wsum[8 + w] = i2; }
        __syncthreads();
        if (tid < 256) { int a1 = 0, a2 = 0;
#pragma unroll
            for (int k = 0; k < 4; ++k) if (k < w) { a1 += wsum[k]; a2 += wsum[8 + k]; }
            ipre[tid + 1] = a1 + i1; ppre[tid + 1] = a2 + i2; if (tid == 0) { ipre[0] = 0; ppre[0] = 0; } }
        __syncthreads();
        if (c.bid == 0 && tid <= 256) POFF[tid] = ppre[tid];
    }
    const int total = ipre[256];
    int buf = 0;
    LAS unsigned char* Qs1 = c.lds + 34816 + 32768 + 2048 + 4096;
#define BK_FIND(it_, b_, ch_, n_) do { int lo_ = 0, hi_ = 256; while (hi_ - lo_ > 1) { const int md_ = (lo_ + hi_) >> 1; if (ipre[md_] <= (it_)) lo_ = md_; else hi_ = md_; } \
        b_ = lo_; ch_ = (it_) - ipre[lo_]; n_ = min(128, cnts[lo_] - 128 * ch_); } while (0)
#define BK_IDX(b_, ch_, n_, Q_) do { _Pragma("unroll") for (int k = 0; k < 4; ++k) { const int r_ = (tid + 512 * k) >> 4; Q_[k] = BLIST[(size_t)(b_) * 8192 + 128 * (ch_) + (r_ < (n_) ? r_ : (n_) - 1)]; } } while (0)
#define BK_ROWS(b_, Q_, R_) do { _Pragma("unroll") for (int k = 0; k < 4; ++k) R_[k] = *(const u32x4*)(QP + ((size_t)(((b_) >> 5) * S + Q_[k])) * 128 + 8 * (tid & 15)); } while (0)
#define BK_WRITE(n_, R_, QB_) do { _Pragma("unroll") for (int k = 0; k < 4; ++k) { const int r_ = (tid + 512 * k) >> 4; u32x4 v_ = R_[k]; if (r_ >= (n_)) v_ = (u32x4){0u, 0u, 0u, 0u}; *(LAS u32x4*)((QB_) + r_ * 272 + (tid & 15) * 16) = v_; } } while (0)
    int it = c.bid;
    if (it < total) {
        int bC, chC, nC, bN = 0, chN = 0, nN = 0; int qiN[4], qiNN[4]; u32x4 rowsN[4];
        bf16x8 Kc[2][4], Vc[8], Kn[2][4], Vn[8];
        BK_FIND(it, bC, chC, nC);
        { int qi0[4]; BK_IDX(bC, chC, nC, qi0); u32x4 r0[4]; BK_ROWS(bC, qi0, r0); const int h = bC >> 5; MOBA_LOAD_KV(bC & 31, Kc, Vc); BK_WRITE(nC, r0, Qs); }
        bool hasN = (it + c.G < total);
        if (hasN) { BK_FIND(it + c.G, bN, chN, nN); BK_IDX(bN, chN, nN, qiN); }
        LDS_WAIT(); __builtin_amdgcn_s_barrier(); asm volatile("" ::: "memory");
        int par = 0;
        for (;;) {
            LAS unsigned char* Qs = par ? Qs1 : c.lds;
            const int h = bC >> 5, ntile = (nC + 15) >> 4, n = nC; const int pbase = ppre[bC] + 128 * chC;
            const bool hasNN = (it + 2 * c.G < total); int bNN = 0, chNN = 0, nNN = 0;
            if (hasN) { BK_ROWS(bN, qiN, rowsN); { const int h = bN >> 5; MOBA_LOAD_KV(bN & 31, Kn, Vn); } }
            if (hasNN) { BK_FIND(it + 2 * c.G, bNN, chNN, nNN); BK_IDX(bNN, chNN, nNN, qiNN); }
            MOBA_TOUCH_KV(Kc, Vc);
            for (int tl = 0; tl < ntile; tl += 2) {
                const bool two = (tl + 1 < ntile);
                const int rA = 16 * tl + tt, rB = two ? rA + 16 : rA;
                MOBA_TILE_PAIR(two, rA, rB, (rA < n), (two && rB < n), 0, 0, 0, 8)
                { u32x2 wv; wv.x = cvt_pk_bf16(oA0[0], oA0[1]); wv.y = cvt_pk_bf16(oA0[2], oA0[3]); *(u32x2*)(PART + (size_t)(pbase + rA) * 128 + 16 * w + 4 * g) = wv;
                  if (w == 0 && g == 0) LPART[pbase + rA] = ltA; }
                if (two) { u32x2 wv; wv.x = cvt_pk_bf16(oB0[0], oB0[1]); wv.y = cvt_pk_bf16(oB0[2], oB0[3]); *(u32x2*)(PART + (size_t)(pbase + rB) * 128 + 16 * w + 4 * g) = wv;
                  if (w == 0 && g == 0) LPART[pbase + rB] = ltB; }
            }
            if (!hasN) break;
            BK_WRITE(nN, rowsN, (par ? c.lds : Qs1));
#pragma unroll
            for (int tq = 0; tq < 2; ++tq)
#pragma unroll
                for (int ks = 0; ks < 4; ++ks) Kc[tq][ks] = Kn[tq][ks];
#pragma unroll
            for (int ks = 0; ks < 8; ++ks) Vc[ks] = Vn[ks];
#pragma unroll
            for (int k = 0; k < 4; ++k) qiN[k] = qiNN[k];
            bC = bN; chC = chN; nC = nN; bN = bNN; chN = chNN; nN = nNN; hasN = hasNN; it += c.G; par ^= 1;
            LDS_WAIT(); __builtin_amdgcn_s_barrier(); asm volatile("" ::: "memory");
        }
    }
#undef BK_FIND
#undef BK_IDX
#undef BK_ROWS
#undef BK_WRITE
    __syncthreads();
}

__device__ __forceinline__ void moba_own(const Ctx& c, int h, int cb, int half) {
    unsigned char* ws = c.ws;
    const bf16_t* QP = (const bf16_t*)(ws + WS_QP); const bf16_t* KP = (const bf16_t*)(ws + WS_KP); const bf16_t* VTP = (const bf16_t*)(ws + WS_VTP);
    const bf16_t* PART = (const bf16_t*)(ws + WS_PART); const float* LPART = (const float*)(ws + WS_LPART); const int* POFF = (const int*)(ws + WS_POFF); const int* PSLOT = (const int*)(ws + WS_PSLOT);
    bf16_t* HCAT = (bf16_t*)(ws + WS_HCAT);
    LAS unsigned char* Qs = c.lds; LAS unsigned char* Pb = c.lds + 34816; LAS float* lpart = (LAS float*)(c.lds + 34816 + 32768);
    LAS float* Os = (LAS float*)(c.lds + 34816 + 32768 + 2048);
    LAS float* Ls = Os + 128 * 132;
    const int tid = c.tid, lane = c.lane, w = c.wave, tt = lane & 15, g = lane >> 4, q0 = cb * 256 + half * 128;
    bf16x8 Kc[2][4], Vc[8];
    MOBA_LOAD_KV(cb, Kc, Vc);
    const int cq = tid >> 2, cpart = tid & 3;
    int pr[3]; u32x4 prow[3][4]; float plv[3];
#pragma unroll
    for (int k = 0; k < 3; ++k) { const int sl = PSLOT[((size_t)(h * S + q0 + cq)) * 3 + k]; const int po = POFF[h * 32 + ((sl < 0 ? 0 : sl) >> 16)]; pr[k] = (sl >= 0) ? (po + (sl & 0xffff)) : -1; }
    for (int i = tid; i < 128 * 16; i += 512) { const int r = i >> 4, ck = i & 15; *(LAS u32x4*)(Qs + r * 272 + ck * 16) = *(const u32x4*)(QP + ((size_t)(h * S + q0 + r)) * 128 + 8 * ck); }
#pragma unroll
    for (int k = 0; k < 3; ++k) { const int pc = pr[k] < 0 ? 0 : pr[k]; plv[k] = LPART[pc];
#pragma unroll
        for (int j = 0; j < 4; ++j) prow[k][j] = *(const u32x4*)(PART + (size_t)pc * 128 + cpart * 32 + 8 * j); }
    MOBA_TOUCH_KV(Kc, Vc);
    __syncthreads();
    const int nkw = half ? 8 : 4;
    int buf = 0;
    for (int tl = 0; tl < 8; tl += 2) {
        const int rA = 16 * tl + tt, rB = rA + 16;
        MOBA_TILE_PAIR(true, rA, rB, true, true, 1, (half * 128 + rA), (half * 128 + rB), nkw)
        *(LAS f32x4*)(Os + rA * 132 + 16 * w + 4 * g) = oA0; *(LAS f32x4*)(Os + rB * 132 + 16 * w + 4 * g) = oB0;
        if (w == 0 && g == 0) { Ls[rA] = ltA; Ls[rB] = ltB; }
    }
    __syncthreads();
    { float l = Ls[cq];
#pragma unroll
      for (int k = 0; k < 3; ++k) if (pr[k] >= 0) l += plv[k];
      const float inv = 1.f / l;
#pragma unroll
      for (int j = 0; j < 4; ++j) { float v[8];
#pragma unroll
          for (int i = 0; i < 8; ++i) v[i] = Os[cq * 132 + cpart * 32 + 8 * j + i];
#pragma unroll
          for (int k = 0; k < 3; ++k) if (pr[k] >= 0) { float t8[8]; unpack8(prow[k][j], t8);
#pragma unroll
              for (int i = 0; i < 8; ++i) v[i] += t8[i]; }
#pragma unroll
          for (int i = 0; i < 8; ++i) v[i] *= inv;
          *(u32x4*)(HCAT + (size_t)(q0 + cq) * 2048 + 1024 + h * 128 + cpart * 32 + 8 * j) = pack8(v); } }
    __syncthreads();
}

__device__ __forceinline__ void mlstm_scan(const Ctx& c) {
    unsigned char* ws = c.ws; const float* CTL = (const float*)(ws + WS_CTL_LOC); bf16_t* CTP = (bf16_t*)(ws + WS_CTP);
    const float* GC = (const float*)(ws + WS_MISC + MO_GC); const float* AMAX = (const float*)(ws + WS_MISC + MO_AMAX); float* MPREV = (float*)(ws + WS_MISC + MO_MPREV);
    const int e2 = c.bid * 512 + c.tid; constexpr int PER_H = DVP * 128 / 2;
    if (e2 >= 4 * PER_H) return;
    const int h = e2 / PER_H, rem = e2 % PER_H;
    f32x2 st = {0.f, 0.f}; float mprev = 0.f;
    for (int c0 = 0; c0 < 64; c0 += 8) {
        f32x2 loc[8];
#pragma unroll
        for (int k = 0; k < 8; ++k) loc[k] = *(const f32x2*)(CTL + ((size_t)(h * 64 + c0 + k)) * (DVP * 128) + 2 * rem);
#pragma unroll
        for (int k = 0; k < 8; ++k) { const int ch = c0 + k; const float gg = GC[h * 64 + ch], am = AMAX[h * 64 + ch];
            *(unsigned*)(CTP + ((size_t)(h * 64 + ch)) * (DVP * 128) + 2 * rem) = cvt_pk_bf16(st[0], st[1]);
            if (rem == 0) MPREV[h * 64 + ch] = mprev;
            const float mnew = fmaxf(gg + mprev, am), dec = __expf(gg + mprev - mnew), sc = __expf(am - mnew);
            st = st * dec + loc[k] * sc; mprev = mnew; }
    }
}

__device__ __forceinline__ bf16x8 scale_frag(bf16x8 f, float s) { float v[8]; unpack8(as_u4(f), v);
#pragma unroll
    for (int i = 0; i < 8; ++i) v[i] *= s;
    return as_frag(pack8(v)); }

__device__ __forceinline__ void mlstm_out(const Args& a, const Ctx& c, int h, int ch) {
    unsigned char* ws = c.ws;
    const bf16_t* QC = (const bf16_t*)(ws + WS_QC); const bf16_t* KC = (const bf16_t*)(ws + WS_KC); const bf16_t* VT = (const bf16_t*)(ws + WS_VT); const bf16_t* CTP = (const bf16_t*)(ws + WS_CTP);
    const float* BV = (const float*)(ws + WS_MISC + MO_BV); const float* UV = (const float*)(ws + WS_MISC + MO_UV); const float* PMX = (const float*)(ws + WS_MISC + MO_PMX);
    const float* MPREV = (const float*)(ws + WS_MISC + MO_MPREV); const bf16_t* PROJ = (const bf16_t*)(ws + WS_PROJ); bf16_t* HCAT = (bf16_t*)(ws + WS_HCAT);
    const int tt = c.lane & 15, g = c.lane >> 4, w = c.wave, t0 = ch * 128, trow = t0 + 16 * w + tt, tid = c.tid;
    LAS unsigned char* RA = c.lds; LAS unsigned char* RB = c.lds + 69632;
    tile256_load(RA, KC + ((size_t)(h * S + t0)) * 128, 128, 128, tid);
    tile256_load(RB, CTP + ((size_t)(h * 64 + ch)) * DVP * 128, 128, DVP, tid);
    const float b_t = BV[h * S + trow], pm_t = PMX[h * S + trow], mprev = MPREV[h * 64 + ch];
    const float m_t = b_t + fmaxf(mprev, pm_t), w_inter = __expf((b_t + mprev) - m_t), bm = b_t - m_t;
    bf16x8 qf[4], qs[4], pf[4];
#pragma unroll
    for (int kd = 0; kd < 4; ++kd) { qf[kd] = *(const bf16x8*)(QC + ((size_t)(h * S + trow)) * 128 + 32 * kd + 8 * g); qs[kd] = scale_frag(qf[kd], w_inter); }
    __syncthreads();
    u32x4 vst[9];
#pragma unroll
    for (int i = 0; i < 9; ++i) { const int idx = tid + 512 * i; if (idx < DVP * 16) vst[i] = *(const u32x4*)(VT + ((size_t)((h * 64 + ch) * DVP + (idx >> 4))) * 128 + 8 * (idx & 15)); }
    const int nsg = (w >> 1) + 1;
#pragma unroll
    for (int sg = 0; sg < 4; ++sg) {
        if (sg < nsg) {
            f32x4 s0 = {0.f, 0.f, 0.f, 0.f}, s1 = {0.f, 0.f, 0.f, 0.f};
#pragma unroll
            for (int kd = 0; kd < 4; ++kd) {
                s0 = mfma16(tile256_frag(RA, 32 * sg + pi32(0, tt), 4 * kd + g), qf[kd], s0);
                s1 = mfma16(tile256_frag(RA, 32 * sg + pi32(1, tt), 4 * kd + g), qf[kd], s1); }
            const f32x4 ua = *(const f32x4*)(UV + h * S + t0 + 32 * sg + 8 * g), ub = *(const f32x4*)(UV + h * S + t0 + 32 * sg + 8 * g + 4);
            float p[8]; const int sl = 32 * sg + 8 * g, tl = 16 * w + tt;
#pragma unroll
            for (int r = 0; r < 4; ++r) { p[r] = (sl + r <= tl) ? s0[r] * __expf(bm + ua[r]) : 0.f; p[4 + r] = (sl + 4 + r <= tl) ? s1[r] * __expf(bm + ub[r]) : 0.f; }
            pf[sg] = as_frag(pack8(p));
        } else pf[sg] = (bf16x8){0, 0, 0, 0, 0, 0, 0, 0};
    }
    f32x4 oacc[17];
#pragma unroll
    for (int mt = 0; mt < 17; ++mt) {
        f32x4 o = {0.f, 0.f, 0.f, 0.f};
#pragma unroll
        for (int kd = 0; kd < 4; ++kd) o = mfma16(tile256_frag(RB, 16 * mt + tt, 4 * kd + g), qs[kd], o);
        oacc[mt] = o;
    }
    __syncthreads();
#pragma unroll
    for (int i = 0; i < 9; ++i) { const int idx = tid + 512 * i; if (idx < DVP * 16) { const int row = idx >> 4, ck = idx & 15; *(LAS u32x4*)(RA + row * 256 + ((ck ^ (row & 15)) << 4)) = vst[i]; } }
    __syncthreads();
#pragma unroll
    for (int mt = 0; mt < 17; ++mt) {
#pragma unroll
        for (int sg = 0; sg < 4; ++sg) if (sg < nsg) oacc[mt] = mfma16(tile256_frag(RA, 16 * mt + tt, 4 * sg + g), pf[sg], oacc[mt]);
    }
    const float den = __shfl(oacc[16][0], tt);
    const float inv = 1.f / fmaxf(fabsf(den), __expf(-m_t));
    float ss = 0.f;
#pragma unroll
    for (int mt = 0; mt < 16; ++mt) { oacc[mt] = oacc[mt] * inv; ss += (oacc[mt][0] * oacc[mt][0] + oacc[mt][1] * oacc[mt][1]) + (oacc[mt][2] * oacc[mt][2] + oacc[mt][3] * oacc[mt][3]); }
    ss += __shfl_xor(ss, 16); ss += __shfl_xor(ss, 32);
    const float rstd = rsqrtf(ss * (1.f / 256.f) + EPS);
    const float* og = INF(8);
#pragma unroll
    for (int mt = 0; mt < 16; ++mt) { const int dv = 16 * mt + 4 * g;
        const f32x4 o4 = *(const f32x4*)(og + h * 256 + dv); const u32x2 mo = *(const u32x2*)(PROJ + (size_t)trow * NPROJ + PC_MO + h * 256 + dv);
        const float v0 = oacc[mt][0] * rstd * o4[0] * sigmoidf_(bf_lo(mo.x)), v1 = oacc[mt][1] * rstd * o4[1] * sigmoidf_(bf_hi(mo.x));
        const float v2 = oacc[mt][2] * rstd * o4[2] * sigmoidf_(bf_lo(mo.y)), v3 = oacc[mt][3] * rstd * o4[3] * sigmoidf_(bf_hi(mo.y));
        u32x2 wv; wv.x = cvt_pk_bf16(v0, v1); wv.y = cvt_pk_bf16(v2, v3);
        *(u32x2*)(HCAT + (size_t)trow * 2048 + h * 256 + dv) = wv; }
    __syncthreads();
}

__device__ __forceinline__ void xattn_item(const Args& a, const Ctx& c, int h, int tile) {
    unsigned char* ws = c.ws; const bf16_t* QX = (const bf16_t*)(ws + WS_QX); const bf16_t* KM = (const bf16_t*)(ws + WS_KM); const bf16_t* VTM = (const bf16_t*)(ws + WS_VTM); bf16_t* OX = (bf16_t*)(ws + WS_OX);
    const int lane = c.lane, tt = lane & 15, g = lane >> 4, w = c.wave, trow = tile * 128 + 16 * w + tt;
    const float* qg = INF(16);
#ifdef XA_SEG
    unsigned long long ts_[5]; ts_[0] = __builtin_amdgcn_s_memrealtime();
#define XA_STAMP(i) do { asm volatile("s_waitcnt vmcnt(0) lgkmcnt(0)" ::: "memory"); ts_[i] = __builtin_amdgcn_s_memrealtime(); } while (0)
#else
#define XA_STAMP(i) do {} while (0)
#endif
    const bf16_t* kbase = KM + (size_t)h * 256 * 512; const bf16_t* vbase = VTM + (size_t)h * 512 * 256;
    int koff[4], voff[4];
#pragma unroll
    for (int i = 0; i < 4; ++i) { const int kr = 32 * w + 8 * i + (lane >> 3), fk = ((kr >> 1) & 1) | (((kr >> 3) & 3) << 1); koff[i] = kr * 512 + 8 * ((lane & 7) ^ fk);
        const int vr = 2 * (4 * w + i) + (lane >> 5), vc = (lane & 31) ^ (vr & 15); voff[i] = vr * 256 + 8 * vc; }
#define XA_DMA(ci) do { LAS unsigned char* bb = c.lds + ((ci) & 3) * 32768; _Pragma("unroll") for (int i = 0; i < 4; ++i) \
        __builtin_amdgcn_global_load_lds((const unsigned*)((ci) < 8 ? kbase + (koff[i] + 64 * (ci)) : vbase + (voff[i] + 64 * ((ci) - 8) * 256)), (LAS unsigned*)(bb + (4 * w + i) * 1024), 16, 0, 0); } while (0)
    asm volatile("s_waitcnt vmcnt(0)" ::: "memory");
    XA_DMA(0); XA_DMA(1); XA_DMA(2);
    bf16x8 qf[16]; float ss = 0.f;
#pragma unroll
    for (int ks = 0; ks < 16; ++ks) { qf[ks] = *(const bf16x8*)(QX + (size_t)trow * 2048 + h * 512 + 32 * ks + 8 * g); float v[8]; unpack8(as_u4(qf[ks]), v);
#pragma unroll
        for (int i = 0; i < 8; ++i) ss += v[i] * v[i]; }
    ss += __shfl_xor(ss, 16); ss += __shfl_xor(ss, 32);
    const float rs = rsqrtf(ss * (1.f / 512.f) + EPS) * 0.04419417382415922f;
#pragma unroll
    for (int ks = 0; ks < 16; ++ks) { float v[8]; unpack8(as_u4(qf[ks]), v); const f32x4 g0 = *(const f32x4*)(qg + 32 * ks + 8 * g), g1 = *(const f32x4*)(qg + 32 * ks + 8 * g + 4);
        v[0] *= rs * g0[0]; v[1] *= rs * g0[1]; v[2] *= rs * g0[2]; v[3] *= rs * g0[3]; v[4] *= rs * g1[0]; v[5] *= rs * g1[1]; v[6] *= rs * g1[2]; v[7] *= rs * g1[3];
        qf[ks] = as_frag(pack8(v)); }
    int kof[2][2], vof[8];
#pragma unroll
    for (int tq = 0; tq < 2; ++tq)
#pragma unroll
        for (int k2 = 0; k2 < 2; ++k2) { const int key = pi32(tq, tt), fk = ((key >> 1) & 1) | (((key >> 3) & 3) << 1); kof[tq][k2] = key * 128 + (((4 * k2 + g) ^ fk) << 4); }
#pragma unroll
    for (int kk = 0; kk < 8; ++kk) vof[kk] = tt * 512 + (((4 * kk + g) ^ tt) << 4);
    asm volatile("" : "+v"(kof[0][0]), "+v"(kof[0][1]), "+v"(kof[1][0]), "+v"(kof[1][1]));
    asm volatile("s_waitcnt vmcnt(0)" ::: "memory");
    XA_STAMP(1);
    f32x4 sacc[16];
#pragma unroll
    for (int mt = 0; mt < 16; ++mt) sacc[mt] = (f32x4){0.f, 0.f, 0.f, 0.f};
#pragma unroll
    for (int ci = 0; ci < 8; ++ci) {
        asm volatile("s_waitcnt vmcnt(8)" ::: "memory"); __builtin_amdgcn_s_barrier(); asm volatile("" ::: "memory");
        XA_DMA(ci + 3);
        const LAS unsigned char* bb = c.lds + (ci & 3) * 32768;
#pragma unroll
        for (int mt = 0; mt < 16; ++mt) {
#pragma unroll
            for (int k2 = 0; k2 < 2; ++k2) { const bf16x8 af = *(const LAS bf16x8*)(bb + kof[mt & 1][k2] + 4096 * (mt >> 1)); sacc[mt] = mfma16(af, qf[2 * ci + k2], sacc[mt]); } }
        LDS_WAIT();
    }
#ifdef XA_SEG
    ts_[2] = __builtin_amdgcn_s_memrealtime();
#endif
    float mx = -INFINITY;
#pragma unroll
    for (int mt = 0; mt < 16; ++mt) mx = fmaxf(mx, fmaxf(fmaxf(sacc[mt][0], sacc[mt][1]), fmaxf(sacc[mt][2], sacc[mt][3])));
    mx = fmaxf(mx, __shfl_xor(mx, 16)); mx = fmaxf(mx, __shfl_xor(mx, 32));
    float l = 0.f; bf16x8 pf[8];
#pragma unroll
    for (int kk = 0; kk < 8; ++kk) { float p[8];
#pragma unroll
        for (int r = 0; r < 4; ++r) { p[r] = __expf(sacc[2 * kk][r] - mx); p[4 + r] = __expf(sacc[2 * kk + 1][r] - mx); }
#pragma unroll
        for (int i = 0; i < 8; ++i) l += p[i];
        pf[kk] = as_frag(pack8(p)); }
    l += __shfl_xor(l, 16); l += __shfl_xor(l, 32);
    const float inv = 1.f / l;
    u32x2 ost[8][4];
#pragma unroll
    for (int ci = 8; ci < 16; ++ci) {
        if (ci == 13) asm volatile("s_waitcnt vmcnt(8)" ::: "memory"); else if (ci == 14) asm volatile("s_waitcnt vmcnt(4)" ::: "memory"); else if (ci == 15) asm volatile("s_waitcnt vmcnt(0)" ::: "memory"); else asm volatile("s_waitcnt vmcnt(8)" ::: "memory");
        __builtin_amdgcn_s_barrier(); asm volatile("" ::: "memory");
        if (ci + 3 < 16) XA_DMA(ci + 3);
        const LAS unsigned char* bb = c.lds + (ci & 3) * 32768;
#pragma unroll
        for (int m4 = 0; m4 < 4; ++m4) { f32x4 o0 = {0.f, 0.f, 0.f, 0.f}, o1 = o0;
#pragma unroll
            for (int kk = 0; kk < 8; kk += 2) {
                const bf16x8 a0 = *(const LAS bf16x8*)(bb + vof[kk] + 8192 * m4), a1 = *(const LAS bf16x8*)(bb + vof[kk + 1] + 8192 * m4);
                o0 = mfma16(a0, pf[kk], o0); o1 = mfma16(a1, pf[kk + 1], o1); }
            const f32x4 o = (o0 + o1) * inv; ost[ci - 8][m4].x = cvt_pk_bf16(o[0], o[1]); ost[ci - 8][m4].y = cvt_pk_bf16(o[2], o[3]); }
        LDS_WAIT();
    }
#pragma unroll
    for (int cc = 0; cc < 8; ++cc)
#pragma unroll
        for (int m4 = 0; m4 < 4; ++m4) *(u32x2*)(OX + (size_t)trow * 2048 + h * 512 + 64 * cc + 16 * m4 + 4 * g) = ost[cc][m4];
#undef XA_DMA
#ifdef XA_SEG
    ts_[3] = __builtin_amdgcn_s_memrealtime();
    asm volatile("s_waitcnt vmcnt(0)" ::: "memory"); ts_[4] = __builtin_amdgcn_s_memrealtime();
    { const unsigned long long dt = ts_[XA_SEG + 1] - ts_[XA_SEG]; const unsigned long long t_end = ts_[4] + 20ull * dt; if (c.bid == 0 && w == 0) { while (__builtin_amdgcn_s_memrealtime() < t_end) __builtin_amdgcn_s_sleep(8); } }
#endif
#undef XA_STAMP
    __syncthreads();
}

__device__ __forceinline__ void split_frag(const f32x4 v0, const f32x4 v1, bf16x8& fh, bf16x8& fl) {
    float x[8] = {v0[0], v0[1], v0[2], v0[3], v1[0], v1[1], v1[2], v1[3]}; float r[8]; u32x4 h = pack8(x); float hf[8]; unpack8(h, hf);
#pragma unroll
    for (int i = 0; i < 8; ++i) r[i] = x[i] - hf[i];
    fh = as_frag(h); fl = as_frag(pack8(r));
}
__device__ __forceinline__ void route_block(const Args& a, const Ctx& c) {
    unsigned char* ws = c.ws; const bf16_t* WRH = (const bf16_t*)(ws + WS_MISC + MO_WR); const bf16_t* WRL = WRH + 80 * 2048; const float* H2 = c.out;
    unsigned* ECNT = (unsigned*)(ws + WS_CTL) + CW_ECNT; float* PAIR_W = (float*)(ws + WS_MISC + MO_PAIR_W); int* ELIST = (int*)(ws + WS_ELIST);
    bf16_t* HNB = (bf16_t*)(ws + WS_HNB);
    LAS float* lg = (LAS float*)c.lds;
    LAS float* ssqp = lg + 8 * 32 * 80;
    LAS float* lgf = ssqp + 256;
    LAS float* rsd = lgf + 32 * 80;
    const int w = c.wave, lane = c.lane, n = lane & 15, g = lane >> 4, tid = c.tid;
    const int r0 = c.bid * 32;
    SUBSTAMP(c, 0);
    f32x4 acc[2][5];
#pragma unroll
    for (int t = 0; t < 2; ++t)
#pragma unroll
        for (int i = 0; i < 5; ++i) acc[t][i] = (f32x4){0.f, 0.f, 0.f, 0.f};
    float ssq0 = 0.f, ssq1 = 0.f;
    const float* a0p = H2 + (size_t)(r0 + n) * 2048 + 256 * w + 8 * g; const float* a1p = a0p + (size_t)16 * 2048;
    const bf16_t* bhp = WRH + (size_t)n * 2048 + 256 * w + 8 * g; const bf16_t* blp = WRL + (size_t)n * 2048 + 256 * w + 8 * g;
    f32x4 A0[2][2], A1[2][2]; bf16x8 Bh[2][5], Bl[2][5];
#define RT_LOAD(sb, ks) do { A0[sb][0] = *(const f32x4*)(a0p + 32 * (ks)); A0[sb][1] = *(const f32x4*)(a0p + 32 * (ks) + 4); A1[sb][0] = *(const f32x4*)(a1p + 32 * (ks)); A1[sb][1] = *(const f32x4*)(a1p + 32 * (ks) + 4); \
        _Pragma("unroll") for (int nt = 0; nt < 5; ++nt) { Bh[sb][nt] = *(const bf16x8*)(bhp + (size_t)(16 * nt) * 2048 + 32 * (ks)); Bl[sb][nt] = *(const bf16x8*)(blp + (size_t)(16 * nt) * 2048 + 32 * (ks)); } } while (0)
#define RT_COMP(sb) do { bf16x8 h0, l0, h1, l1; split_frag(A0[sb][0], A0[sb][1], h0, l0); split_frag(A1[sb][0], A1[sb][1], h1, l1); \
        _Pragma("unroll") for (int q = 0; q < 2; ++q) { const f32x4 v = A0[sb][q], u = A1[sb][q]; ssq0 += (v[0] * v[0] + v[1] * v[1]) + (v[2] * v[2] + v[3] * v[3]); ssq1 += (u[0] * u[0] + u[1] * u[1]) + (u[2] * u[2] + u[3] * u[3]); } \
        _Pragma("unroll") for (int nt = 0; nt < 5; ++nt) { \
            acc[0][nt] = mfma16(h0, Bh[sb][nt], acc[0][nt]); acc[0][nt] = mfma16(l0, Bh[sb][nt], acc[0][nt]); acc[0][nt] = mfma16(h0, Bl[sb][nt], acc[0][nt]); \
            acc[1][nt] = mfma16(h1, Bh[sb][nt], acc[1][nt]); acc[1][nt] = mfma16(l1, Bh[sb][nt], acc[1][nt]); acc[1][nt] = mfma16(h1, Bl[sb][nt], acc[1][nt]); } } while (0)
    RT_LOAD(0, 0);
#pragma unroll 1
    for (int ks = 0; ks < 8; ks += 2) {
        RT_LOAD(1, ks + 1); asm volatile("" ::: "memory");
        RT_COMP(0);
        if (ks + 2 < 8) RT_LOAD(0, ks + 2);
        asm volatile("" ::: "memory");
        RT_COMP(1);
    }
#undef RT_LOAD
#undef RT_COMP
    SUBSTAMP(c, 1);
    ssq0 += __shfl_xor(ssq0, 16); ssq0 += __shfl_xor(ssq0, 32); ssq1 += __shfl_xor(ssq1, 16); ssq1 += __shfl_xor(ssq1, 32);
#pragma unroll
    for (int t = 0; t < 2; ++t)
#pragma unroll
        for (int nt = 0; nt < 5; ++nt)
#pragma unroll
            for (int r = 0; r < 4; ++r) lg[(w * 32 + 16 * t + 4 * g + r) * 80 + 16 * nt + n] = acc[t][nt][r];
    if (g == 0) { ssqp[w * 32 + n] = ssq0; ssqp[w * 32 + 16 + n] = ssq1; }
    f32x4 xv[4][8];
#pragma unroll
    for (int i = 0; i < 4; ++i) { const f32x4* xr = (const f32x4*)(H2 + (size_t)(r0 + 4 * w + i) * 2048) + lane;
#pragma unroll
        for (int j = 0; j < 8; ++j) xv[i][j] = xr[64 * j]; }
    const float* bg = INF(21); const float* be = INF(23);
    float bgv[8];
#pragma unroll
    for (int j = 0; j < 8; ++j) bgv[j] = bg[j];
    __syncthreads();
    for (int i = tid; i < 32 * 80; i += 512) { float v = 0.f;
#pragma unroll
        for (int q = 0; q < 8; ++q) v += lg[q * 32 * 80 + i];
        lgf[i] = v; }
    __syncthreads();
    SUBSTAMP(c, 2);
    if (tid < 32) {
        const int rr = tid; const int t = r0 + rr;
        float sq = 0.f;
#pragma unroll
        for (int q = 0; q < 8; ++q) sq += ssqp[q * 32 + rr];
        const float rstd = rsqrtf(sq * (1.f / 2048.f) + EPS); rsd[rr] = rstd;
        float gl[8]; float gm = -INFINITY; int gs = 0;
#pragma unroll
        for (int j = 0; j < 8; ++j) { gl[j] = lgf[rr * 80 + j] * rstd + bgv[j]; if (gl[j] > gm) { gm = gl[j]; gs = j; } }
        float gsum = 0.f;
#pragma unroll
        for (int j = 0; j < 8; ++j) gsum += __expf(gl[j] - gm);
        const float pg = 1.f / gsum;
        float el[8]; float m0 = -INFINITY; int i0 = 0;
#pragma unroll
        for (int j = 0; j < 8; ++j) { el[j] = lgf[rr * 80 + 8 + 8 * gs + j] * rstd + be[8 * gs + j]; if (el[j] > m0) { m0 = el[j]; i0 = j; } }
        float m1 = -INFINITY; int i1 = 0;
#pragma unroll
        for (int j = 0; j < 8; ++j) if (j != i0 && el[j] > m1) { m1 = el[j]; i1 = j; }
        const float e1 = __expf(m1 - m0); const float w0 = pg / (1.f + e1), w1 = pg * e1 / (1.f + e1);
        const int ea = 8 * gs + i0, eb = 8 * gs + i1;
        const int sub = c.bid & 3;
        const int sa = (int)__hip_atomic_fetch_add(ECNT + ea * 4 + sub, 1u, __ATOMIC_RELAXED, __HIP_MEMORY_SCOPE_AGENT);
        const int sb = (int)__hip_atomic_fetch_add(ECNT + eb * 4 + sub, 1u, __ATOMIC_RELAXED, __HIP_MEMORY_SCOPE_AGENT);
        *(f32x2*)(PAIR_W + 2 * t) = (f32x2){w0, w1}; ELIST[(size_t)(ea * 4 + sub) * 8192 + sa] = 2 * t; ELIST[(size_t)(eb * 4 + sub) * 8192 + sb] = 2 * t + 1;
    }
    __syncthreads();
    SUBSTAMP(c, 3);
    const float* gf = INF(19);
    f32x4 gg[8];
#pragma unroll
    for (int j = 0; j < 8; ++j) gg[j] = *(const f32x4*)(gf + 256 * j + 4 * lane);
#pragma unroll
    for (int i = 0; i < 4; ++i) { const int rl = 4 * w + i; const float rstd = rsd[rl]; u32x2* o8 = (u32x2*)(HNB + (size_t)(r0 + rl) * 2048) + lane;
#pragma unroll
        for (int j = 0; j < 8; ++j) { const f32x4 y = xv[i][j] * rstd * gg[j]; u32x2 wv; wv.x = cvt_pk_bf16(y[0], y[1]); wv.y = cvt_pk_bf16(y[2], y[3]); o8[64 * j] = wv; } }
    SUBSTAMP(c, 4);
    __syncthreads();
}

__device__ __forceinline__ void moe_gather(const Ctx& c) {
    unsigned char* ws = c.ws; unsigned* CTLW = (unsigned*)(ws + WS_CTL); const unsigned* ECNT = CTLW + CW_ECNT;
    const int* PAIR_E = (const int*)(ws + WS_MISC + MO_PAIR_E); const int* PAIR_SLOT = (const int*)(ws + WS_MISC + MO_PAIR_SLOT); int* ROWPAIR = (int*)(ws + WS_MISC + MO_ROWPAIR);
    int* TILE_E = (int*)(ws + WS_MISC + MO_TILE_E); int* TOFF = (int*)(ws + WS_MISC + MO_TOFF);
    const bf16_t* HNB = (const bf16_t*)(ws + WS_HNB); bf16_t* XG = (bf16_t*)(ws + WS_XG);
    LAS int* toffs = (LAS int*)c.lds;
    if (c.tid < 64) { const int cn = (int)ECNT[c.tid]; const int nt = (cn + 255) >> 8; int incl = nt;
#pragma unroll
        for (int o = 1; o < 64; o <<= 1) { const int t = __shfl_up(incl, o); if (c.lane >= o) incl += t; }
        toffs[c.tid] = incl - nt; if (c.tid == 63) toffs[64] = incl;
        if (c.bid == 0) { TOFF[c.tid] = incl - nt; for (int k = 0; k < nt; ++k) TILE_E[incl - nt + k] = c.tid; if (c.tid == 63) CTLW[CW_NTILES] = (unsigned)incl; } }
    __syncthreads();
    for (int p = c.gw; p < 16384; p += c.NGW) { const int e = PAIR_E[p], sl = PAIR_SLOT[p]; const int row = toffs[e] * 256 + sl;
        const u32x4* src = (const u32x4*)(HNB + (size_t)(p >> 1) * 2048) + c.lane; u32x4* dst = (u32x4*)(XG + (size_t)row * 2048) + c.lane;
#pragma unroll
        for (int j = 0; j < 4; ++j) dst[64 * j] = src[64 * j];
        if (c.lane == 0) ROWPAIR[row] = p; }
    __syncthreads();
}

__device__ __forceinline__ void wait_vm(int n) {
    switch (n) {
        case 0: asm volatile("s_waitcnt vmcnt(0)" ::: "memory"); break;
        case 1: asm volatile("s_waitcnt vmcnt(1)" ::: "memory"); break;
        case 2: asm volatile("s_waitcnt vmcnt(2)" ::: "memory"); break;
        case 3: asm volatile("s_waitcnt vmcnt(3)" ::: "memory"); break;
        case 4: asm volatile("s_waitcnt vmcnt(4)" ::: "memory"); break;
        case 5: asm volatile("s_waitcnt vmcnt(5)" ::: "memory"); break;
        case 6: asm volatile("s_waitcnt vmcnt(6)" ::: "memory"); break;
        default: asm volatile("s_waitcnt vmcnt(7)" ::: "memory"); break;
    }
}
template <int MODE, int VAR = 0>
__device__ __forceinline__ void moe_direct(const Args& a, const Ctx& c) {
    unsigned char* ws = c.ws;
    constexpr int K = (MODE == 1) ? 2048 : 512, LDW = (MODE == 1) ? 512 : 2048, UPE = (MODE == 1) ? 8 : 16, NCH = K / 32, MAXT = 24, MROWS = MAXT * 16;
    constexpr int XBUF = MROWS * 64, WOFF = 3 * XBUF, TOFF = WOFF + 4 * 16384;
    const unsigned* ECNT = (const unsigned*)(ws + WS_CTL) + CW_ECNT; const int* ELIST = (const int*)(ws + WS_ELIST); const float* PAIR_W = (const float*)(ws + WS_MISC + MO_PAIR_W);
    const bf16_t* XSRC = (const bf16_t*)(ws + (MODE == 1 ? WS_HNB : WS_ACT)); bf16_t* ACT = (bf16_t*)(ws + (VAR ? WS_XG : WS_ACT)); bf16_t* YB = (bf16_t*)(ws + (VAR ? WS_XG : WS_YB));
    LAS unsigned char* xb = c.lds;
    LAS unsigned char* wb = c.lds + WOFF;
    LAS int* rowoff = (LAS int*)(c.lds + TOFF);
    LAS int* rowpair = rowoff + MROWS;
    LAS float* rowwt = (LAS float*)(rowpair + MROWS);
    const int tid = c.tid, lane = c.lane, w = c.wave, tt = lane & 15, g = lane >> 4;
    const int hh = w >> 2, cgp = w & 3;
    const int xcd_ = c.bid & 7, idx_ = c.bid >> 3, EPX = 32 / UPE;
    for (int r = 0; r < (64 * UPE) / 256; ++r) {
        int e, sl;
        if (c.G == 256) { e = r * (8 * EPX) + xcd_ * EPX + idx_ / UPE; sl = idx_ % UPE; } else { const int u = r * c.G + c.bid; if (u >= 64 * UPE) break; e = u / UPE; sl = u % UPE; }
        const int c0_ = (int)ECNT[e * 4], c1_ = c0_ + (int)ECNT[e * 4 + 1], c2_ = c1_ + (int)ECNT[e * 4 + 2], ne = c2_ + (int)ECNT[e * 4 + 3];
        const float* wsrc[2];
#pragma unroll
        for (int i = 0; i < 2; ++i) { const int k = 4 * w + 2 * i + (lane >> 5), q = w >> 1, sidx = lane & 31;
            if (MODE == 1) { const int h = sidx >> 4, cgs = ((sidx & 15) - 2 * q - 4 * h) & 15;
                wsrc[i] = (h ? INF(25) : INF(24)) + (size_t)e * 2048 * 512 + (size_t)k * LDW + sl * 64 + 4 * cgs; }
            else { const int cgs = (sidx - 4 * q) & 31; wsrc[i] = INF(26) + (size_t)e * 512 * 2048 + (size_t)k * LDW + sl * 128 + 4 * cgs; } }
        int wrd[2];
#pragma unroll
        for (int t = 0; t < 2; ++t) { const int wq = 2 * cgp + t;
            if (MODE == 1) { const int h = tt >> 3, cc = 8 * wq + (tt & 7); wrd[t] = ((8 * g) * 128 + 64 * h + ((cc + 8 * g + 16 * h) & 63)) * 4; }
            else { const int col = 16 * wq + tt; wrd[t] = ((8 * g) * 128 + ((col + 16 * g) & 127)) * 4; } }
        for (int m0 = 0; m0 < ne; m0 += MROWS) {
            const int mrows = min(MROWS, ne - m0), nt = (mrows + 15) >> 4;
            if (tid < MROWS) { const int rr = m0 + (tid < mrows ? tid : mrows - 1); const int sg = (rr >= c0_) + (rr >= c1_) + (rr >= c2_); const int ix = rr - (sg == 0 ? 0 : (sg == 1 ? c0_ : (sg == 2 ? c1_ : c2_)));
              const int p = ELIST[(size_t)(e * 4 + sg) * 8192 + ix];
              rowoff[tid] = (MODE == 1) ? (p >> 1) * 2048 : p * 512; rowpair[tid] = p; rowwt[tid] = PAIR_W[p]; }
            __syncthreads();
            f32x4 acc[2][12];
#pragma unroll
            for (int t = 0; t < 2; ++t)
#pragma unroll
                for (int i = 0; i < 12; ++i) acc[t][i] = (f32x4){0.f, 0.f, 0.f, 0.f};
            int roff[3];
#pragma unroll
            for (int i = 0; i < 3; ++i) roff[i] = rowoff[16 * (8 * i + w) + (lane >> 2)] + 8 * (lane & 3);
            const int nx = (VAR & 1) ? 0 : ((nt - w + 7) >> 3);
            const int nw = (VAR & 2) ? 0 : 2;
            const int xrd = tt * 64 + g * 16 + 1024 * hh;
#define MD_XDMA(ch) do { LAS unsigned char* bb = xb + ((ch) % 3) * XBUF; _Pragma("unroll") for (int i = 0; i < 3; ++i) if (i < nx) \
                __builtin_amdgcn_global_load_lds((const unsigned*)(XSRC + (size_t)roff[i] + 32 * (ch)), (LAS unsigned*)(bb + (8 * i + w) * 1024), 16, 0, 0); } while (0)
#define MD_WDMA(ch) do { LAS unsigned char* bb = wb + ((ch) & 3) * 16384; _Pragma("unroll") for (int i = 0; i < 2; ++i) if (i < nw) \
                __builtin_amdgcn_global_load_lds((const unsigned*)(wsrc[i] + (size_t)(32 * (ch)) * LDW), (LAS unsigned*)(bb + (2 * w + i) * 1024), 16, 0, 0); } while (0)
            asm volatile("s_waitcnt vmcnt(0)" ::: "memory");
            MD_WDMA(0); MD_XDMA(0); MD_WDMA(1); MD_XDMA(1); MD_WDMA(2);
            const int nmi = (nt - hh + 1) >> 1;
            for (int ch = 0; ch < NCH; ++ch) {
                wait_vm((ch + 1 < NCH ? nw + nx : 0) + (ch + 2 < NCH ? nw : 0));
                __builtin_amdgcn_s_barrier(); asm volatile("" ::: "memory");
                if (ch + 2 < NCH) MD_XDMA(ch + 2);
                if (ch + 3 < NCH) MD_WDMA(ch + 3);
                const LAS unsigned char* wsl = wb + (ch & 3) * 16384;
                float wr0[8], wr1[8];
#pragma unroll
                for (int j = 0; j < 8; ++j) { wr0[j] = *(const LAS float*)(wsl + wrd[0] + 512 * j); wr1[j] = *(const LAS float*)(wsl + wrd[1] + 512 * j); }
                u32x4 t0, t1; t0.x = cvt_pk_bf16(wr0[0], wr0[1]); t0.y = cvt_pk_bf16(wr0[2], wr0[3]); t0.z = cvt_pk_bf16(wr0[4], wr0[5]); t0.w = cvt_pk_bf16(wr0[6], wr0[7]);
                t1.x = cvt_pk_bf16(wr1[0], wr1[1]); t1.y = cvt_pk_bf16(wr1[2], wr1[3]); t1.z = cvt_pk_bf16(wr1[4], wr1[5]); t1.w = cvt_pk_bf16(wr1[6], wr1[7]);
                const bf16x8 wf0 = as_frag(t0), wf1 = as_frag(t1);
                const LAS unsigned char* bb = xb + (ch % 3) * XBUF + xrd;
#define MD_RD(X_, bq) do { _Pragma("unroll") for (int q = 0; q < 4; ++q) X_[q] = *(const LAS bf16x8*)(bb + 2048 * (4 * (bq) + q)); } while (0)
#define MD_MM(X_, bq) do { _Pragma("unroll") for (int q = 0; q < 4; ++q) { acc[0][4 * (bq) + q] = mfma16(wf0, X_[q], acc[0][4 * (bq) + q]); acc[1][4 * (bq) + q] = mfma16(wf1, X_[q], acc[1][4 * (bq) + q]); } } while (0)
                { bf16x8 xa[4], xc[4]; const bool b1 = nmi > 4, b2 = nmi > 8;
                  MD_RD(xa, 0); if (b1) MD_RD(xc, 1);
                  MD_MM(xa, 0); asm volatile("" ::: "memory");
                  if (b2) MD_RD(xa, 2);
                  if (b1) MD_MM(xc, 1);
                  if (b2) MD_MM(xa, 2); }
#undef MD_RD
#undef MD_MM
                LDS_WAIT();
            }
#undef MD_XDMA
#undef MD_WDMA
            const LAS int* rp_ = rowpair + tt + 16 * hh; const LAS float* rw_ = rowwt + tt + 16 * hh;
            asm volatile("" : "+v"(rp_), "+v"(rw_));
#pragma unroll
            for (int mi = 0; mi < 12; ++mi) if (mi < nmi) { const int row = 16 * (2 * mi + hh) + tt; const bool valid = row < mrows; const int p = rp_[32 * mi];
#pragma unroll
                for (int t = 0; t < 2; ++t) { const int wq = 2 * cgp + t;
                    if (MODE == 1) {
                        const float u0 = __shfl_xor(acc[t][mi][0], 32), u1 = __shfl_xor(acc[t][mi][1], 32), u2 = __shfl_xor(acc[t][mi][2], 32), u3 = __shfl_xor(acc[t][mi][3], 32);
                        if (valid && g < 2) { const float g0 = acc[t][mi][0], g1 = acc[t][mi][1], g2 = acc[t][mi][2], g3 = acc[t][mi][3];
                            u32x2 wv; wv.x = cvt_pk_bf16(g0 / (1.f + __expf(-g0)) * u0, g1 / (1.f + __expf(-g1)) * u1); wv.y = cvt_pk_bf16(g2 / (1.f + __expf(-g2)) * u2, g3 / (1.f + __expf(-g3)) * u3);
                            *(u32x2*)(ACT + (size_t)p * 512 + sl * 64 + 8 * wq + 4 * g) = wv; }
                    } else {
                        if (valid) { const float pw = rw_[32 * mi]; u32x2 wv; wv.x = cvt_pk_bf16(acc[t][mi][0] * pw, acc[t][mi][1] * pw); wv.y = cvt_pk_bf16(acc[t][mi][2] * pw, acc[t][mi][3] * pw);
                            *(u32x2*)(YB + (size_t)p * 2048 + sl * 128 + 16 * wq + 4 * g) = wv; }
                    }
                }
            }
            __syncthreads();
        }
    }
}

__device__ __forceinline__ void moe_combine(const Ctx& c) {
    const bf16_t* YB = (const bf16_t*)(c.ws + WS_YB);
    for (int t = c.gw; t < S; t += c.NGW) {
        f32x4* orow = (f32x4*)(c.out + (size_t)t * 2048); const u32x4* y0 = (const u32x4*)(YB + (size_t)(2 * t) * 2048); const u32x4* y1 = (const u32x4*)(YB + (size_t)(2 * t + 1) * 2048);
#pragma unroll
        for (int j = 0; j < 4; ++j) { const int ck = 64 * j + c.lane; float a8[8], b8[8]; unpack8(y0[ck], a8); unpack8(y1[ck], b8);
            f32x4 o0 = orow[2 * ck], o1 = orow[2 * ck + 1];
            o0[0] += a8[0] + b8[0]; o0[1] += a8[1] + b8[1]; o0[2] += a8[2] + b8[2]; o0[3] += a8[3] + b8[3]; o1[0] += a8[4] + b8[4]; o1[1] += a8[5] + b8[5]; o1[2] += a8[6] + b8[6]; o1[3] += a8[7] + b8[7];
            orow[2 * ck] = o0; orow[2 * ck + 1] = o1; }
    }
}

__global__ void __launch_bounds__(512, 2) mega(Args a) {
    extern __shared__ __attribute__((aligned(16))) unsigned char lds_raw[];
    Ctx c; c.lds = (LAS unsigned char*)lds_raw; c.tid = threadIdx.x; c.lane = c.tid & 63; c.wave = __builtin_amdgcn_readfirstlane(c.tid >> 6);
    c.bid = blockIdx.x; c.G = gridDim.x; c.gw = c.bid * 8 + c.wave; c.NGW = c.G * 8; c.ws = a.ws; c.out = a.out;
    unsigned char* ws = a.ws;
    const int lo = a.ph_lo, hi = a.ph_hi;
#ifdef ONLY_PH
#define IN(k) ((k) == ONLY_PH)
#elif defined(EXCL_PH)
#define IN(k) ((k) != EXCL_PH && lo <= (k) && (k) < hi)
#else
#define IN(k) (lo <= (k) && (k) < hi)
#endif
    volatile LAS unsigned* bst = (volatile LAS unsigned*)(c.lds + 147392);
    if (c.tid < 2) bst[c.tid] = 0u;
    __syncthreads();
    XcdBarrier xbar; xbar.bar = (unsigned*)(ws + WS_CTL) + CW_BAR; xbar.x = 0; xbar.st = bst;
    if (a.single) xbar = xcd_barrier_post((unsigned*)(ws + WS_CTL) + CW_BAR, bst);
#define GSYNC(k) do { xcd_barrier(xbar); } while (0)
#ifdef PROBE_PH
    unsigned long long tph_[16]; tph_[0] = __builtin_amdgcn_s_memrealtime();
#define SEAM(k) do { if (IN(k) && IN((k) + 1)) { GSYNC(k); } tph_[(k) + 1] = __builtin_amdgcn_s_memrealtime(); } while (0)
#else
#define SEAM(k) do { if (IN(k) && IN((k) + 1)) { GSYNC(k); } } while (0)
#endif
#define PH_CTX() do { int t_ = threadIdx.x; asm volatile("" : "+v"(t_)); c.tid = t_; c.lane = t_ & 63; } while (0)

    if (IN(0)) { PH_CTX(); phase0(a, c); __syncthreads(); }
    SEAM(0);
    if (IN(1)) { PH_CTX();
        { pg8::Gemm g{(const bf16_t*)(ws + WS_XN), (const bf16_t*)(ws + WS_WIN), 2048, 2048}; pg8::StaticOrder So; So.init(S, NPROJ, c.G, c.bid);
          pg8::EpiBf16 E{(bf16_t*)(ws + WS_PROJ), NPROJ, nullptr};
          pg8::gemm_phase<pg8::EpiBf16, pg8::StaticOrder, true, true>(c.lds, g, So, E); }
        { pg8::Gemm g{(const bf16_t*)(ws + WS_MEMN), (const bf16_t*)(ws + WS_WKV), 256, 2048}; pg8::SplitOrder So{16, 8, c.G, c.bid};
          pg8::EpiSlab E{(float*)(ws + WS_KVSLAB), 4096, (size_t)256 * 4096};
          pg8::gemm_phase<pg8::EpiSlab, pg8::SplitOrder, true, true>(c.lds, g, So, E); }
    }
    SEAM(1);
    if (IN(2)) { PH_CTX();
        for (int it = c.bid; it < 256; it += c.G) prep_mlstm(a, c, it >> 6, it & 63);
        for (int it = c.bid; it < 256; it += c.G) prep_moba(a, c, it >> 5, it & 31);
        prep_xamem(a, c);
        if (c.bid == 0 && c.tid < 256) ((unsigned*)(ws + WS_CTL))[CW_BCNT + c.tid] = 0u;
    }
    SEAM(2);
    if (IN(3)) { PH_CTX();
        for (int it = c.bid; it < 256; it += c.G) mlstm_local(c, it >> 6, it & 63);
        for (int it = c.bid; it < 512; it += c.G) { const int cb = (it < 256) ? (31 - (it >> 4)) : ((it - 256) >> 4); moba_select(c, (it & 15) >> 1, cb, it & 1); }
    }
    SEAM(3);
    if (IN(4)) { PH_CTX(); if (c.G * 512 >= 4 * DVP * 64) mlstm_scan(c); moba_bucket_phase(c); }
    SEAM(4);
    if (IN(5)) { PH_CTX();
        for (int it = c.bid; it < 256; it += c.G) mlstm_out(a, c, it >> 6, it & 63);
        for (int it = c.bid; it < 512; it += c.G) { const int cb = (it < 256) ? (31 - (it >> 4)) : ((it - 256) >> 4); moba_own(c, (it & 15) >> 1, cb, it & 1); }
    }
    SEAM(5);
    if (IN(6)) { PH_CTX();
        pg8::Gemm g{(const bf16_t*)(ws + WS_HCAT), (const bf16_t*)(ws + WS_WOUT), 2048, 2048}; pg8::StaticOrder So; So.init(S, 2048, c.G, c.bid);
        pg8::EpiResid E{INF(0), nullptr, nullptr, (bf16_t*)(ws + WS_H1B), (float*)(ws + WS_MISC + MO_SSQ)};
        pg8::gemm_phase<pg8::EpiResid, pg8::StaticOrder, false, true>(c.lds, g, So, E);
    }
    SEAM(6);
    if (IN(7)) { PH_CTX();
        pg8::Gemm g{(const bf16_t*)(ws + WS_H1B), (const bf16_t*)(ws + WS_WQ), 2048, 2048}; pg8::StaticOrder So; So.init(S, 2048, c.G, c.bid);
        pg8::EpiBf16 E{(bf16_t*)(ws + WS_QX), 2048, (const float*)(ws + WS_MISC + MO_SSQ)};
        pg8::gemm_phase<pg8::EpiBf16, pg8::StaticOrder, false, true>(c.lds, g, So, E);
    }
    SEAM(7);
    if (IN(8)) { PH_CTX(); for (int it = c.bid; it < 256; it += c.G) xattn_item(a, c, it & 3, it >> 2); }
    SEAM(8);
    if (IN(9)) { PH_CTX();
        pg8::Gemm g{(const bf16_t*)(ws + WS_OX), (const bf16_t*)(ws + WS_WO), 2048, 2048}; pg8::StaticOrder So; So.init(S, 2048, c.G, c.bid);
        pg8::EpiResid E{nullptr, (const bf16_t*)(ws + WS_H1B), a.out, nullptr, nullptr};
        if (c.bid == 0 && c.tid < 256) ((unsigned*)(ws + WS_CTL))[CW_ECNT + c.tid] = 0u;
        pg8::gemm_phase<pg8::EpiResid, pg8::StaticOrder, false, true>(c.lds, g, So, E);
    }
    SEAM(9);
    if (IN(10)) { PH_CTX(); if (c.G == 256) route_block(a, c); }
    do { if (IN(10) && IN(12)) { GSYNC(10); } } while (0);
#ifdef PROBE_PH
    tph_[11] = __builtin_amdgcn_s_memrealtime(); tph_[12] = tph_[11];
#endif
#ifdef PROBE_VAR
#if PROBE_VAR < 10
    if (IN(11)) moe_direct<1, PROBE_VAR>(a, c);
#elif PROBE_VAR == 10
    if (IN(11)) mlstm_scan(c);
#elif PROBE_VAR == 11
    if (IN(11)) moba_bucket_phase(c);
#elif PROBE_VAR == 12
    if (IN(11)) { PH_CTX(); for (int it = c.bid; it < 256; it += c.G) mlstm_out(a, c, it >> 6, it & 63); }
#elif PROBE_VAR == 13
    if (IN(11)) { PH_CTX(); for (int it = c.bid; it < 512; it += c.G) { const int cb = (it < 256) ? (31 - (it >> 4)) : ((it - 256) >> 4); moba_own(c, (it & 15) >> 1, cb, it & 1); } }
#elif PROBE_VAR == 14
    if (IN(11)) { PH_CTX(); for (int it = c.bid; it < 256; it += c.G) mlstm_local(c, it >> 6, it & 63); }
#endif
#endif
    if (IN(12)) { PH_CTX(); moe_direct<1>(a, c); }
    SEAM(12);
    if (IN(13)) { PH_CTX(); moe_direct<2>(a, c); }
    SEAM(13);
    if (IN(14)) { PH_CTX(); moe_combine(c); }
#ifdef PROBE_SUB
    __syncthreads();
    if (a.single && c.bid == 0 && threadIdx.x == 0) { asm volatile("s_waitcnt vmcnt(0)" ::: "memory"); const LAS unsigned long long* ts_ = (const LAS unsigned long long*)(c.lds + 147264);
        const unsigned long long dt = ts_[PROBE_SUB + 1] - ts_[PROBE_SUB]; const unsigned long long te = __builtin_amdgcn_s_memrealtime() + 10ull * dt;
        unsigned guard = 0; while (__builtin_amdgcn_s_memrealtime() < te && ++guard < 4000000u) __builtin_amdgcn_s_sleep(16); }
#endif
#ifdef PROBE_PH
    asm volatile("s_waitcnt vmcnt(0)" ::: "memory"); tph_[15] = __builtin_amdgcn_s_memrealtime();
    if (a.single && c.bid == 0 && c.wave == 0) { const unsigned long long dt = tph_[PROBE_PH + 1] - tph_[PROBE_PH]; const unsigned long long te = tph_[15] + 10ull * dt;
        unsigned guard = 0; while (__builtin_amdgcn_s_memrealtime() < te && ++guard < 4000000u) __builtin_amdgcn_s_sleep(16); }
#endif
#undef IN
#undef SEAM
}

constexpr int LDS_BYTES = 147456;
extern "C" void kernel_launch(void* const* d_in, const int* in_sizes, int n_in, void* d_out, int out_size, void* d_ws, size_t ws_size, hipStream_t stream) {
    static int grid = 0;
    if (grid == 0) {
        if (n_in != 27 || out_size != S * D || ws_size < WS_END2) { fprintf(stderr, "kernel_launch: unexpected shapes (n_in %d out %d ws %zu)\n", n_in, out_size, ws_size); grid = -1; return; }
        int dev = 0, cus = 0, per_cu = 0;
        hipGetDevice(&dev); hipDeviceGetAttribute(&cus, hipDeviceAttributeMultiprocessorCount, dev);
        hipFuncSetAttribute((const void*)mega, hipFuncAttributeMaxDynamicSharedMemorySize, LDS_BYTES);
        hipOccupancyMaxActiveBlocksPerMultiprocessor(&per_cu, (const void*)mega, 512, LDS_BYTES);
        (void)hipGetLastError();
        grid = (per_cu >= 1) ? cus : -1;
        if (grid != 256) { fprintf(stderr, "kernel_launch: needs a 256-CU device with one resident block per CU (cus %d per_cu %d)\n", cus, per_cu); grid = -1; return; }
    }
    if (grid < 0) return;
    (void)hipMemsetAsync((char*)d_ws + WS_CTL, 0, CTL_ZERO_BYTES, stream);
    Args a{};
    for (int i = 0; i < 27; ++i) a.in[i] = d_in[i];
    a.out = (float*)d_out; a.ws = (unsigned char*)d_ws; a.single = MK_SINGLE; a.pad = 0;
#if MK_SINGLE
    a.ph_lo = 0; a.ph_hi = NPH;
    void* args[] = {&a};
    hipError_t e = hipLaunchCooperativeKernel((const void*)mega, dim3(grid), dim3(512), args, LDS_BYTES, stream);
    if (e != hipSuccess) fprintf(stderr, "cooperative launch failed: %s\n", hipGetErrorString(e));
#else
    for (int p = 0; p < NPH; ++p) {
#ifdef REP_GROUP_LO
        if (p == REP_GROUP_LO) { for (int r = 0; r < 2; ++r) for (int q = REP_GROUP_LO; q <= REP_GROUP_HI; ++q) { a.ph_lo = q; a.ph_hi = q + 1; hipLaunchKernelGGL(mega, dim3(grid), dim3(512), LDS_BYTES, stream, a); } }
#endif
        a.ph_lo = p; a.ph_hi = p + 1;
#ifdef REP_MASK
        const int reps = ((REP_MASK >> p) & 1) ? 3 : 1;
#else
        const int reps = 1;
#endif
        for (int r = 0; r < reps; ++r) hipLaunchKernelGGL(mega, dim3(grid), dim3(512), LDS_BYTES, stream, a); }
#endif
}
```
